# Optimizing an MI355X kernel written in HIP

```python
import math
import jax, jax.numpy as jnp
from jax import lax
import numpy as np

D_MODEL = 1024
BATCH = 1
SEQ = 16384
DEPTH = 2
DEC_BATCH = 32
DEC_SEQ = 32
PAST_LEN = 2048

CHUNK = 64
SSD_EXPAND = 2
D_SSM = SSD_EXPAND * D_MODEL
SSD_HEAD_DIM = 64
SSD_HEADS = D_SSM // SSD_HEAD_DIM
SSD_GROUPS = 4
HEADS_PER_GROUP = SSD_HEADS // SSD_GROUPS
SSD_STATE = 128
SSD_CONV = 4
SSD_CONV_DIM = D_SSM + 2 * SSD_GROUPS * SSD_STATE
SB_HEAD_DIM = 128
SB_HEADS = D_MODEL // SB_HEAD_DIM
SB_WIDTH = SB_HEADS * SB_HEAD_DIM
SB_BLOCK = 128
D_FF = 4 * D_MODEL
FFN_CONV = 3
PLE_DIM = 256
IN_DIM = D_SSM + SSD_CONV_DIM + SSD_HEADS + 3 * SB_WIDTH + 2 * D_MODEL
EPS = 1e-6

kernel_name = 'hybrid_ssd_stickbreak_convffn_stream_step'


def rmsnorm(x, gain):
    xf = x.astype(jnp.float32)
    xf = xf * lax.rsqrt(jnp.mean(xf * xf, axis=-1, keepdims=True) + EPS)
    return (xf * gain.astype(jnp.float32)).astype(x.dtype)


def causal_dwconv(xp, w, b):
    width = w.shape[0]
    length = xp.shape[1] - (width - 1)
    out = b
    for tap in range(width):
        out = out + xp[:, tap:tap + length] * w[tap]
    return out


def gated_group_rmsnorm(y, z, w):
    g = (y * jax.nn.silu(z)).astype(jnp.float32)
    shp = g.shape
    g = g.reshape(shp[:-1] + (SSD_GROUPS, D_SSM // SSD_GROUPS))
    g = g * lax.rsqrt(jnp.mean(g * g, axis=-1, keepdims=True) + EPS)
    return (g.reshape(shp) * w.astype(jnp.float32)).astype(y.dtype)


def ssd_chunked_scan(xs, dt, a, bm, cm, h0):
    f32 = jnp.float32
    bsz, seqlen = xs.shape[:2]
    cl = CHUNK if seqlen >= CHUNK else seqlen
    nc = seqlen // cl
    xg = xs.astype(f32).reshape(bsz, nc, cl, SSD_GROUPS, HEADS_PER_GROUP, SSD_HEAD_DIM)
    dtg = dt.astype(f32).reshape(bsz, nc, cl, SSD_GROUPS, HEADS_PER_GROUP)
    ag = dtg * a.astype(f32).reshape(SSD_GROUPS, HEADS_PER_GROUP)
    bg = bm.astype(f32).reshape(bsz, nc, cl, SSD_GROUPS, SSD_STATE)
    cg = cm.astype(f32).reshape(bsz, nc, cl, SSD_GROUPS, SSD_STATE)
    a_cum = jnp.cumsum(ag, axis=2)
    x_dt = xg * dtg[..., None]
    causal = jnp.tril(jnp.ones((cl, cl), dtype=bool))[None, None, :, :, None, None]
    seg = a_cum[:, :, :, None] - a_cum[:, :, None, :]
    decay_ls = jnp.exp(jnp.where(causal, seg, -jnp.inf))
    cb = jnp.einsum('bclgn,bcsgn->bclsg', cg, bg)
    y_diag = jnp.einsum('bclsge,bcsgep->bclgep', cb[..., None] * decay_ls, x_dt)
    decay_to_end = jnp.exp(a_cum[:, :, -1:] - a_cum)
    chunk_states = jnp.einsum('bclgn,bclgep->bcgepn', bg, x_dt * decay_to_end[..., None])
    chunk_decay = jnp.exp(a_cum[:, :, -1])

    def step(h, inp):
        dec, st = inp
        return dec[..., None, None] * h + st, h

    h_init = h0.astype(f32).reshape(bsz, SSD_GROUPS, HEADS_PER_GROUP, SSD_HEAD_DIM, SSD_STATE)
    h_last, h_prev = lax.scan(step, h_init,
                              (jnp.moveaxis(chunk_decay, 1, 0), jnp.moveaxis(chunk_states, 1, 0)))
    h_prev = jnp.moveaxis(h_prev, 0, 1)
    y_off = jnp.einsum('bclgn,bcgepn->bclgep', cg, h_prev) * jnp.exp(a_cum)[..., None]
    y = (y_diag + y_off).reshape(bsz, seqlen, SSD_HEADS, SSD_HEAD_DIM)
    return y, h_last.reshape(bsz, SSD_HEADS, SSD_HEAD_DIM, SSD_STATE)


def stick_breaking(q, k, v, q_start):
    f32 = jnp.float32
    bsz, lq = q.shape[:2]
    lk = k.shape[1]
    nkb_total = -(-lk // SB_BLOCK)
    pad = nkb_total * SB_BLOCK - lk
    k = jnp.pad(k, ((0, 0), (0, pad), (0, 0), (0, 0)))
    v = jnp.pad(v, ((0, 0), (0, pad), (0, 0), (0, 0)))
    blk = SB_BLOCK if lq % SB_BLOCK == 0 else lq
    nb = lq // blk
    scale = SB_HEAD_DIM ** -0.5
    idx = jnp.arange(SB_BLOCK)
    tri_in = (idx[:, None] > idx[None, :]).astype(f32)
    outs = []
    for bi in range(nb):
        q_lo = q_start + bi * blk
        nkb = max(1, min(nkb_total, -(-(q_lo + blk - 1) // SB_BLOCK)))
        kk = k[:, :nkb * SB_BLOCK]
        vv = v[:, :nkb * SB_BLOCK]
        q_blk = q[:, bi * blk:(bi + 1) * blk]
        z = jnp.einsum('bqhd,bkhd->bhqk', q_blk, kk).astype(f32) * scale
        z = z.reshape(bsz, SB_HEADS, blk, nkb, SB_BLOCK)
        q_pos = q_lo + jnp.arange(blk)
        k_pos = jnp.arange(nkb * SB_BLOCK).reshape(nkb, SB_BLOCK)
        earlier = k_pos[None, None, None] < q_pos[None, None, :, None, None]
        log_keep = jnp.where(earlier, jax.nn.log_sigmoid(-z), 0.0)
        within = jnp.einsum('bhqcj,js->bhqcs', log_keep, tri_in)
        totals = jnp.sum(log_keep, axis=-1)
        cidx = jnp.arange(nkb)
        tri_blk = (cidx[:, None] > cidx[None, :]).astype(f32)
        later = jnp.einsum('bhqd,dc->bhqc', totals, tri_blk)
        weights = jnp.where(earlier,
                            jnp.exp(jax.nn.log_sigmoid(z) + within + later[..., None]), 0.0)
        weights = weights.reshape(bsz, SB_HEADS, blk, nkb * SB_BLOCK)
        outs.append(jnp.einsum('bhqk,bkhd->bqhd', weights.astype(v.dtype), vv))
    o = jnp.concatenate(outs, axis=1) if nb > 1 else outs[0]
    return o.reshape(bsz, lq, SB_WIDTH)


def trunk_layer(x, p_i, conv_st, ssm_st, k_past, v_past, ffn_st, lw):
    bsz, length, _ = x.shape
    h = rmsnorm(x, lw['norm_pre_mix'])
    proj = h @ lw['w_in']
    widths = (D_SSM, SSD_CONV_DIM, SSD_HEADS, SB_WIDTH, SB_WIDTH, SB_WIDTH, 2 * D_MODEL)
    offsets = [int(o) for o in np.cumsum(widths)[:-1]]
    z, xbc, dt_raw, q, k, v, gate_logits = jnp.split(proj, offsets, axis=-1)
    xbc_pad = jnp.concatenate([conv_st, xbc], axis=1)
    new_conv = xbc_pad[:, -(SSD_CONV - 1):]
    xbc_c = jax.nn.silu(causal_dwconv(xbc_pad, lw['ssd_conv_w'], lw['ssd_conv_b']))
    xs, bm, cm = jnp.split(xbc_c, [D_SSM, D_SSM + SSD_GROUPS * SSD_STATE], axis=-1)
    dt = jax.nn.softplus(dt_raw.astype(jnp.float32) + lw['ssd_dt_bias'].astype(jnp.float32))
    a = -jnp.exp(lw['ssd_a_log'].astype(jnp.float32))
    xs_h = xs.reshape(bsz, length, SSD_HEADS, SSD_HEAD_DIM)
    y, new_ssm = ssd_chunked_scan(xs_h, dt, a,
                                  bm.reshape(bsz, length, SSD_GROUPS, SSD_STATE),
                                  cm.reshape(bsz, length, SSD_GROUPS, SSD_STATE), ssm_st)
    y = (y + lw['ssd_d'].astype(jnp.float32)[:, None] * xs_h.astype(jnp.float32)).astype(x.dtype)
    y = gated_group_rmsnorm(y.reshape(bsz, length, D_SSM), z, lw['ssd_norm'])
    branch_ssd = y @ lw['w_br_ssd']
    q = q.reshape(bsz, length, SB_HEADS, SB_HEAD_DIM)
    k_new = k.reshape(bsz, length, SB_HEADS, SB_HEAD_DIM)
    v_new = v.reshape(bsz, length, SB_HEADS, SB_HEAD_DIM)
    k_all = jnp.concatenate([k_past, k_new], axis=1)
    v_all = jnp.concatenate([v_past, v_new], axis=1)
    branch_sb = stick_breaking(q, k_all, v_all, k_past.shape[1]) @ lw['w_br_sb']
    g_ssd, g_sb = jnp.split(jax.nn.sigmoid(gate_logits), 2, axis=-1)
    mixed = (g_ssd * branch_ssd + g_sb * branch_sb) @ lw['w_out']
    x = x + rmsnorm(mixed, lw['norm_post_mix'])
    h2 = rmsnorm(x, lw['norm_pre_ffn'])
    ff_gate, ff_up = jnp.split(h2 @ lw['w_up'], 2, axis=-1)
    gate_pad = jnp.concatenate([ffn_st, ff_gate], axis=1)
    new_ffn = gate_pad[:, -(FFN_CONV - 1):]
    ff = jax.nn.gelu(causal_dwconv(gate_pad, lw['ffn_conv_w'], lw['ffn_conv_b']), approximate=True) * ff_up
    x = x + rmsnorm(ff @ lw['w_down'], lw['norm_post_ffn'])
    ple = (p_i @ lw['w_ple']) * jax.nn.sigmoid(x @ lw['w_ple_gate'])
    x = x + rmsnorm(ple, lw['norm_ple'])
    return x, (new_conv, new_ssm.astype(ssm_st.dtype), k_new, v_new, new_ffn)


def setup_inputs(seed: int = 0) -> dict:
    key = jax.random.key(seed)
    ks = iter(jax.random.split(key, 40))

    def nrm(shape, scale=1.0):
        return jax.random.normal(next(ks), shape, jnp.float32) * scale

    def gain(shape):
        return 1.0 + nrm(shape, 0.05)

    dt_u = jax.random.uniform(next(ks), (DEPTH, SSD_HEADS), jnp.float32)
    dt0 = jnp.exp(dt_u * (math.log(0.1) - math.log(0.001)) + math.log(0.001))
    dt_bias = dt0 + jnp.log(-jnp.expm1(-dt0))
    a_log = jnp.log(jax.random.uniform(next(ks), (DEPTH, SSD_HEADS), jnp.float32, minval=1.0, maxval=16.0))
    return {
        'x_prompt': nrm((BATCH, SEQ, D_MODEL)),
        'x_sample': nrm((DEC_BATCH, DEC_SEQ, D_MODEL)),
        'state_ssd_conv': nrm((DEPTH, DEC_BATCH, SSD_CONV - 1, SSD_CONV_DIM)),
        'state_ssd': nrm((DEPTH, DEC_BATCH, SSD_HEADS, SSD_HEAD_DIM, SSD_STATE), 0.1),
        'cache_sb_k': nrm((DEPTH, DEC_BATCH, PAST_LEN, SB_HEADS, SB_HEAD_DIM)),
        'cache_sb_v': nrm((DEPTH, DEC_BATCH, PAST_LEN, SB_HEADS, SB_HEAD_DIM)),
        'state_ffn_conv': nrm((DEPTH, DEC_BATCH, FFN_CONV - 1, D_FF)),
        'p_prompt': nrm((DEPTH, BATCH, SEQ, PLE_DIM)),
        'p_sample': nrm((DEPTH, DEC_BATCH, DEC_SEQ, PLE_DIM)),
        'norm_pre_mix': gain((DEPTH, D_MODEL)),
        'w_in': nrm((DEPTH, D_MODEL, IN_DIM), D_MODEL ** -0.5),
        'ssd_conv_w': nrm((DEPTH, SSD_CONV, SSD_CONV_DIM), SSD_CONV ** -0.5),
        'ssd_conv_b': nrm((DEPTH, SSD_CONV_DIM), 0.02),
        'ssd_dt_bias': dt_bias,
        'ssd_a_log': a_log,
        'ssd_d': gain((DEPTH, SSD_HEADS)),
        'ssd_norm': gain((DEPTH, D_SSM)),
        'w_br_ssd': nrm((DEPTH, D_SSM, D_MODEL), D_SSM ** -0.5),
        'w_br_sb': nrm((DEPTH, SB_WIDTH, D_MODEL), SB_WIDTH ** -0.5),
        'w_out': nrm((DEPTH, D_MODEL, D_MODEL), D_MODEL ** -0.5),
        'norm_post_mix': gain((DEPTH, D_MODEL)),
        'norm_pre_ffn': gain((DEPTH, D_MODEL)),
        'w_up': nrm((DEPTH, D_MODEL, 2 * D_FF), D_MODEL ** -0.5),
        'ffn_conv_w': nrm((DEPTH, FFN_CONV, D_FF), FFN_CONV ** -0.5),
        'ffn_conv_b': nrm((DEPTH, D_FF), 0.02),
        'w_down': nrm((DEPTH, D_FF, D_MODEL), D_FF ** -0.5),
        'norm_post_ffn': gain((DEPTH, D_MODEL)),
        'w_ple': nrm((DEPTH, PLE_DIM, D_MODEL), PLE_DIM ** -0.5),
        'w_ple_gate': nrm((DEPTH, D_MODEL, D_MODEL), D_MODEL ** -0.5),
        'norm_ple': gain((DEPTH, D_MODEL)),
    }


def reference(x_prompt, x_sample, state_ssd_conv, state_ssd, cache_sb_k, cache_sb_v, state_ffn_conv,
              p_prompt, p_sample, norm_pre_mix, w_in, ssd_conv_w, ssd_conv_b, ssd_dt_bias, ssd_a_log,
              ssd_d, ssd_norm, w_br_ssd, w_br_sb, w_out, norm_post_mix, norm_pre_ffn, w_up, ffn_conv_w,
              ffn_conv_b, w_down, norm_post_ffn, w_ple, w_ple_gate, norm_ple):
    def run(x, p, conv0, ssm0, k0, v0, ffn0):
        per_layer = []
        for i in range(DEPTH):
            lw = {
                'norm_pre_mix': norm_pre_mix[i], 'w_in': w_in[i],
                'ssd_conv_w': ssd_conv_w[i], 'ssd_conv_b': ssd_conv_b[i],
                'ssd_dt_bias': ssd_dt_bias[i], 'ssd_a_log': ssd_a_log[i], 'ssd_d': ssd_d[i],
                'ssd_norm': ssd_norm[i], 'w_br_ssd': w_br_ssd[i], 'w_br_sb': w_br_sb[i],
                'w_out': w_out[i], 'norm_post_mix': norm_post_mix[i],
                'norm_pre_ffn': norm_pre_ffn[i], 'w_up': w_up[i],
                'ffn_conv_w': ffn_conv_w[i], 'ffn_conv_b': ffn_conv_b[i],
                'w_down': w_down[i], 'norm_post_ffn': norm_post_ffn[i],
                'w_ple': w_ple[i], 'w_ple_gate': w_ple_gate[i], 'norm_ple': norm_ple[i],
            }
            x, st = trunk_layer(x, p[i], conv0[i], ssm0[i], k0[i], v0[i], ffn0[i], lw)
            per_layer.append(st)
        stacked = [jnp.stack([st[j] for st in per_layer]) for j in range(5)]
        return x, stacked

    bp = x_prompt.shape[0]
    dtp = x_prompt.dtype
    zero_conv = jnp.zeros((DEPTH, bp, SSD_CONV - 1, SSD_CONV_DIM), dtp)
    zero_ssm = jnp.zeros((DEPTH, bp, SSD_HEADS, SSD_HEAD_DIM, SSD_STATE), dtp)
    empty_kv = jnp.zeros((DEPTH, bp, 0, SB_HEADS, SB_HEAD_DIM), dtp)
    zero_ffn = jnp.zeros((DEPTH, bp, FFN_CONV - 1, D_FF), dtp)
    y_prompt, prompt_states = run(x_prompt, p_prompt, zero_conv, zero_ssm, empty_kv, empty_kv, zero_ffn)
    y_sample, sample_states = run(x_sample, p_sample, state_ssd_conv, state_ssd, cache_sb_k, cache_sb_v,
                                  state_ffn_conv)
    prompt_ssd_conv, prompt_ssd_state, prompt_sb_k, prompt_sb_v, prompt_ffn_conv = prompt_states
    sample_ssd_conv, sample_ssd_state, sample_sb_k, sample_sb_v, sample_ffn_conv = sample_states
    return (y_prompt, y_sample,
            prompt_ssd_conv, prompt_ssd_state, prompt_sb_k, prompt_sb_v, prompt_ffn_conv,
            sample_ssd_conv, sample_ssd_state, sample_sb_k, sample_sb_v, sample_ffn_conv)
```

```cpp
#include <hip/hip_runtime.h>
#include <stdint.h>

constexpr int D_MODEL = 1024, SEQ = 16384, DEPTH = 2, DEC_BATCH = 32, DEC_SEQ = 32, PAST_LEN = 2048;
constexpr int D_SSM = 2048, SSD_HEAD_DIM = 64, SSD_HEADS = 32, SSD_GROUPS = 4, SSD_STATE = 128, SSD_CONV_DIM = 3072;
constexpr int SB_HEAD_DIM = 128, SB_HEADS = 8, SB_WIDTH = 1024, D_FF = 4096, PLE_DIM = 256;
constexpr int IN_DIM = 10272;
constexpr int M_P = SEQ, M_S = DEC_BATCH * DEC_SEQ, M_ALL = M_P + M_S;
constexpr float EPS = 1e-6f;
constexpr int C_Z = 0, C_XBC = 2048, C_DT = 5120, C_Q = 5152, C_K = 6176, C_V = 7200, C_G = 8224;
constexpr size_t O_Y_P = 0;
constexpr size_t O_Y_S = O_Y_P + (size_t)M_P * D_MODEL;
constexpr size_t O_P_CONV = O_Y_S + (size_t)M_S * D_MODEL;
constexpr size_t O_P_STATE = O_P_CONV + (size_t)DEPTH * 3 * SSD_CONV_DIM;
constexpr size_t O_P_K = O_P_STATE + (size_t)DEPTH * SSD_HEADS * SSD_HEAD_DIM * SSD_STATE;
constexpr size_t O_P_V = O_P_K + (size_t)DEPTH * M_P * SB_WIDTH;
constexpr size_t O_P_FFN = O_P_V + (size_t)DEPTH * M_P * SB_WIDTH;
constexpr size_t O_S_CONV = O_P_FFN + (size_t)DEPTH * 2 * D_FF;
constexpr size_t O_S_STATE = O_S_CONV + (size_t)DEPTH * DEC_BATCH * 3 * SSD_CONV_DIM;
constexpr size_t O_S_K = O_S_STATE + (size_t)DEPTH * DEC_BATCH * SSD_HEADS * SSD_HEAD_DIM * SSD_STATE;
constexpr size_t O_S_V = O_S_K + (size_t)DEPTH * M_S * SB_WIDTH;
constexpr size_t O_S_FFN = O_S_V + (size_t)DEPTH * M_S * SB_WIDTH;
constexpr size_t O_TOTAL = O_S_FFN + (size_t)DEPTH * DEC_BATCH * 2 * D_FF;

__device__ __forceinline__ float wave_sum(float v) {
#pragma unroll
    for (int o = 32; o >= 1; o >>= 1) v += __shfl_xor(v, o);
    return v;
}
__device__ __forceinline__ float sigmoidf_(float x) { return 1.0f / (1.0f + __expf(-x)); }
__device__ __forceinline__ float softplusf_(float x) { return fmaxf(x, 0.f) + log1pf(__expf(-fabsf(x))); }
__device__ __forceinline__ float siluf_(float x) { return x * sigmoidf_(x); }
__device__ __forceinline__ float gelu_tanhf_(float x) { const float u = 0.7978845608028654f * (x + 0.044715f * x * x * x); return 0.5f * x * (1.0f + tanhf(u)); }

namespace nv {
__global__ void k_rmsnorm(const float* __restrict__ x, const float* __restrict__ gain, float* out, int M, int add) {
    const int wave = (blockIdx.x * blockDim.x + threadIdx.x) >> 6, nw = (gridDim.x * blockDim.x) >> 6, lane = threadIdx.x & 63;
    for (int row = wave; row < M; row += nw) {
        const float* xr = x + (size_t)row * D_MODEL; float v[16]; float ss = 0.f;
#pragma unroll
        for (int i = 0; i < 16; ++i) { v[i] = xr[lane + 64 * i]; ss += v[i] * v[i]; }
        ss = wave_sum(ss);
        const float r = rsqrtf(ss * (1.0f / D_MODEL) + EPS);
        float* o = out + (size_t)row * D_MODEL;
#pragma unroll
        for (int i = 0; i < 16; ++i) { const float t = v[i] * r * gain[lane + 64 * i]; o[lane + 64 * i] = add ? o[lane + 64 * i] + t : t; }
    }
}
__global__ void __launch_bounds__(256) k_gemm(const float* __restrict__ A, int lda, const float* __restrict__ W, int ldw, float* __restrict__ C, int ldc, int N, int K) {
    __shared__ float As[16][68];
    __shared__ float Bs[16][68];
    const int tid = threadIdx.x, tx = tid & 15, ty = tid >> 4;
    const int row0 = blockIdx.y * 64, col0 = blockIdx.x * 64;
    float acc[4][4];
#pragma unroll
    for (int i = 0; i < 4; ++i)
#pragma unroll
        for (int j = 0; j < 4; ++j) acc[i][j] = 0.f;
    for (int k0 = 0; k0 < K; k0 += 16) {
#pragma unroll
        for (int i = 0; i < 4; ++i) { const int e = tid + i * 256, r = e >> 4, kk = e & 15; As[kk][r] = A[(size_t)(row0 + r) * lda + k0 + kk]; }
#pragma unroll
        for (int i = 0; i < 4; ++i) { const int e = tid + i * 256, kk = e >> 6, n = e & 63; Bs[kk][n] = (col0 + n < N) ? W[(size_t)(k0 + kk) * ldw + col0 + n] : 0.f; }
        __syncthreads();
#pragma unroll
        for (int kk = 0; kk < 16; ++kk) {
            float a[4], b[4];
#pragma unroll
            for (int i = 0; i < 4; ++i) { a[i] = As[kk][ty * 4 + i]; b[i] = Bs[kk][tx * 4 + i]; }
#pragma unroll
            for (int i = 0; i < 4; ++i)
#pragma unroll
                for (int j = 0; j < 4; ++j) acc[i][j] = fmaf(a[i], b[j], acc[i][j]);
        }
        __syncthreads();
    }
#pragma unroll
    for (int i = 0; i < 4; ++i)
#pragma unroll
        for (int j = 0; j < 4; ++j) { const int c = col0 + tx * 4 + j; if (c < N) C[(size_t)(row0 + ty * 4 + i) * ldc + c] = acc[i][j]; }
}
__global__ void k_split_out(const float* __restrict__ proj, float* __restrict__ out, int l) {
    const size_t n = (size_t)M_ALL * SB_WIDTH;
    for (size_t i = (size_t)blockIdx.x * blockDim.x + threadIdx.x; i < n; i += (size_t)gridDim.x * blockDim.x) {
        const int row = (int)(i / SB_WIDTH), c = (int)(i % SB_WIDTH);
        const float kv = proj[(size_t)row * IN_DIM + C_K + c], vv = proj[(size_t)row * IN_DIM + C_V + c];
        if (row < M_P) { out[O_P_K + (size_t)l * M_P * SB_WIDTH + i] = kv; out[O_P_V + (size_t)l * M_P * SB_WIDTH + i] = vv; }
        else { const size_t j = i - (size_t)M_P * SB_WIDTH; out[O_S_K + (size_t)l * M_S * SB_WIDTH + j] = kv; out[O_S_V + (size_t)l * M_S * SB_WIDTH + j] = vv; }
    }
    const int nc = (1 + DEC_BATCH) * 3 * SSD_CONV_DIM;
    for (int i = blockIdx.x * blockDim.x + threadIdx.x; i < nc; i += gridDim.x * blockDim.x) {
        const int c = i % SSD_CONV_DIM, j = (i / SSD_CONV_DIM) % 3, s = i / (3 * SSD_CONV_DIM);
        if (s == 0) out[O_P_CONV + (size_t)l * 3 * SSD_CONV_DIM + j * SSD_CONV_DIM + c] = proj[(size_t)(M_P - 3 + j) * IN_DIM + C_XBC + c];
        else { const int b = s - 1; out[O_S_CONV + ((size_t)(l * DEC_BATCH + b) * 3 + j) * SSD_CONV_DIM + c] = proj[(size_t)(M_P + b * DEC_SEQ + DEC_SEQ - 3 + j) * IN_DIM + C_XBC + c]; }
    }
}
__global__ void k_conv_ssd(const float* __restrict__ proj, const float* __restrict__ hist  , const float* __restrict__ cw  , const float* __restrict__ cb,
                           const float* __restrict__ dt_bias  , float* __restrict__ xbcc, float* __restrict__ dtb) {
    const size_t n = (size_t)M_ALL * SSD_CONV_DIM;
    for (size_t i = (size_t)blockIdx.x * blockDim.x + threadIdx.x; i < n; i += (size_t)gridDim.x * blockDim.x) {
        const int row = (int)(i / SSD_CONV_DIM), c = (int)(i % SSD_CONV_DIM);
        int rowbase, t, b = -1;
        if (row < M_P) { rowbase = 0; t = row; } else { b = (row - M_P) / DEC_SEQ; t = (row - M_P) % DEC_SEQ; rowbase = M_P + b * DEC_SEQ; }
        float acc = cb[c];
#pragma unroll
        for (int tap = 0; tap < 4; ++tap) {
            const int hj = t + tap;
            float v;
            if (hj < 3) v = (b < 0) ? 0.f : hist[((size_t)b * 3 + hj) * SSD_CONV_DIM + c];
            else v = proj[(size_t)(rowbase + hj - 3) * IN_DIM + C_XBC + c];
            acc = fmaf(cw[tap * SSD_CONV_DIM + c], v, acc);
        }
        xbcc[i] = siluf_(acc);
    }
    const int nd = M_ALL * SSD_HEADS;
    for (int i = blockIdx.x * blockDim.x + threadIdx.x; i < nd; i += gridDim.x * blockDim.x) {
        const int row = i / SSD_HEADS, h = i % SSD_HEADS;
        dtb[i] = softplusf_(proj[(size_t)row * IN_DIM + C_DT + h] + dt_bias[h]);
    }
}
__global__ void __launch_bounds__(256) k_ssd_scan(const float* __restrict__ xbcc, const float* __restrict__ dtb, const float* __restrict__ h0  ,
                                                  const float* __restrict__ a_log, const float* __restrict__ dvec, float* __restrict__ ys, float* __restrict__ out, int l) {
    const int w = (blockIdx.x * blockDim.x + threadIdx.x) >> 6, lane = threadIdx.x & 63;
    const int per = SSD_HEADS * SSD_HEAD_DIM;
    if (w >= per * (1 + DEC_BATCH)) return;
    int b, h, p, rowbase, L;
    if (w < per) { b = -1; h = w / 64; p = w % 64; rowbase = 0; L = M_P; }
    else { const int w2 = w - per; b = w2 / per; h = (w2 % per) / 64; p = w2 % 64; rowbase = M_P + b * DEC_SEQ; L = DEC_SEQ; }
    const int g = h / 8;
    const float a = -__expf(a_log[h]), Dh = dvec[h];
    float s0 = 0.f, s1 = 0.f;
    if (b >= 0) { const float* hp = h0 + (((size_t)b * SSD_HEADS + h) * SSD_HEAD_DIM + p) * SSD_STATE; s0 = hp[lane]; s1 = hp[lane + 64]; }
#pragma unroll 4
    for (int t = 0; t < L; ++t) {
        const size_t row = (size_t)(rowbase + t);
        const float* xr = xbcc + row * SSD_CONV_DIM;
        const float dt = dtb[row * SSD_HEADS + h], x = xr[h * 64 + p];
        const float B0 = xr[2048 + g * 128 + lane], B1 = xr[2048 + g * 128 + 64 + lane], C0 = xr[2560 + g * 128 + lane], C1 = xr[2560 + g * 128 + 64 + lane];
        const float dA = __expf(dt * a), dx = dt * x;
        s0 = fmaf(dA, s0, dx * B0); s1 = fmaf(dA, s1, dx * B1);
        const float y = wave_sum(C0 * s0 + C1 * s1) + Dh * x;
        if (lane == 0) ys[row * D_SSM + h * 64 + p] = y;
    }
    float* op = (b < 0) ? out + O_P_STATE + (size_t)l * SSD_HEADS * SSD_HEAD_DIM * SSD_STATE + ((size_t)h * SSD_HEAD_DIM + p) * SSD_STATE
                        : out + O_S_STATE + ((((size_t)l * DEC_BATCH + b) * SSD_HEADS + h) * SSD_HEAD_DIM + p) * SSD_STATE;
    op[lane] = s0; op[lane + 64] = s1;
}
__global__ void k_gated_norm(float* __restrict__ ys, const float* __restrict__ proj, const float* __restrict__ w) {
    const int wave = (blockIdx.x * blockDim.x + threadIdx.x) >> 6, nw = (gridDim.x * blockDim.x) >> 6, lane = threadIdx.x & 63;
    for (int u = wave; u < M_ALL * SSD_GROUPS; u += nw) {
        const int row = u / SSD_GROUPS, g = u % SSD_GROUPS;
        float v[8]; float ss = 0.f;
#pragma unroll
        for (int i = 0; i < 8; ++i) { const int c = g * 512 + lane + 64 * i; v[i] = ys[(size_t)row * D_SSM + c] * siluf_(proj[(size_t)row * IN_DIM + C_Z + c]); ss += v[i] * v[i]; }
        ss = wave_sum(ss);
        const float r = rsqrtf(ss * (1.0f / 512.f) + EPS);
#pragma unroll
        for (int i = 0; i < 8; ++i) { const int c = g * 512 + lane + 64 * i; ys[(size_t)row * D_SSM + c] = v[i] * r * w[c]; }
    }
}
__global__ void __launch_bounds__(256) k_attn(const float* __restrict__ proj, const float* __restrict__ ck  , const float* __restrict__ cv, float* __restrict__ att) {
    const int w = (blockIdx.x * blockDim.x + threadIdx.x) >> 6, lane = threadIdx.x & 63;
    if (w >= M_ALL * SB_HEADS) return;
    const int hd = w % SB_HEADS; int row = w / SB_HEADS;
    if (row < M_P) row = M_P - 1 - row;
    int b = -1, t = row, rowbase = 0, past = 0;
    if (row >= M_P) { b = (row - M_P) / DEC_SEQ; t = (row - M_P) % DEC_SEQ; rowbase = M_P + b * DEC_SEQ; past = PAST_LEN; }
    const int qpos = past + t;
    const float scale = 0.08838834764831845f;
    const float q0 = proj[(size_t)row * IN_DIM + C_Q + hd * 128 + lane] * scale, q1 = proj[(size_t)row * IN_DIM + C_Q + hd * 128 + 64 + lane] * scale;
    float o0 = 0.f, o1 = 0.f, carry = 0.f;
#pragma unroll 4
    for (int j = qpos - 1; j >= 0; --j) {
        const float* kp; const float* vp;
        if (j < past) { const size_t off = (((size_t)b * PAST_LEN + j) * SB_HEADS + hd) * SB_HEAD_DIM; kp = ck + off; vp = cv + off; }
        else { const size_t off = (size_t)(rowbase + j - past) * IN_DIM + hd * 128; kp = proj + off + C_K; vp = proj + off + C_V; }
        const float z = wave_sum(q0 * kp[lane] + q1 * kp[lane + 64]);
        const float sp = softplusf_(z);
        const float wgt = __expf(z - sp + carry);
        o0 = fmaf(wgt, vp[lane], o0); o1 = fmaf(wgt, vp[lane + 64], o1);
        carry -= sp;
    }
    att[(size_t)row * SB_WIDTH + hd * 128 + lane] = o0; att[(size_t)row * SB_WIDTH + hd * 128 + 64 + lane] = o1;
}
__global__ void k_mix(const float* __restrict__ proj, const float* __restrict__ br1, const float* __restrict__ br2, float* __restrict__ mixin) {
    const size_t n = (size_t)M_ALL * D_MODEL;
    for (size_t i = (size_t)blockIdx.x * blockDim.x + threadIdx.x; i < n; i += (size_t)gridDim.x * blockDim.x) {
        const size_t row = i / D_MODEL; const int c = (int)(i % D_MODEL);
        mixin[i] = sigmoidf_(proj[row * IN_DIM + C_G + c]) * br1[i] + sigmoidf_(proj[row * IN_DIM + C_G + D_MODEL + c]) * br2[i];
    }
}
__global__ void k_ffn_act(const float* __restrict__ up  , const float* __restrict__ hist  , const float* __restrict__ cw  , const float* __restrict__ cb,
                          float* __restrict__ ff, float* __restrict__ out, int l) {
    const size_t n = (size_t)M_ALL * D_FF;
    for (size_t i = (size_t)blockIdx.x * blockDim.x + threadIdx.x; i < n; i += (size_t)gridDim.x * blockDim.x) {
        const int row = (int)(i / D_FF), c = (int)(i % D_FF);
        int rowbase, t, b = -1;
        if (row < M_P) { rowbase = 0; t = row; } else { b = (row - M_P) / DEC_SEQ; t = (row - M_P) % DEC_SEQ; rowbase = M_P + b * DEC_SEQ; }
        float acc = cb[c];
#pragma unroll
        for (int tap = 0; tap < 3; ++tap) {
            const int hj = t + tap;
            float v;
            if (hj < 2) v = (b < 0) ? 0.f : hist[((size_t)b * 2 + hj) * D_FF + c];
            else v = up[(size_t)(rowbase + hj - 2) * (2 * D_FF) + c];
            acc = fmaf(cw[tap * D_FF + c], v, acc);
        }
        ff[i] = gelu_tanhf_(acc) * up[(size_t)row * (2 * D_FF) + D_FF + c];
    }
    const int nc = (1 + DEC_BATCH) * 2 * D_FF;
    for (int i = blockIdx.x * blockDim.x + threadIdx.x; i < nc; i += gridDim.x * blockDim.x) {
        const int c = i % D_FF, j = (i / D_FF) % 2, s = i / (2 * D_FF);
        if (s == 0) out[O_P_FFN + (size_t)l * 2 * D_FF + j * D_FF + c] = up[(size_t)(M_P - 2 + j) * (2 * D_FF) + c];
        else { const int b = s - 1; out[O_S_FFN + ((size_t)(l * DEC_BATCH + b) * 2 + j) * D_FF + c] = up[(size_t)(M_P + b * DEC_SEQ + DEC_SEQ - 2 + j) * (2 * D_FF) + c]; }
    }
}
__global__ void k_ple(const float* __restrict__ pa, const float* __restrict__ pg, float* __restrict__ ple) {
    const size_t n = (size_t)M_ALL * D_MODEL;
    for (size_t i = (size_t)blockIdx.x * blockDim.x + threadIdx.x; i < n; i += (size_t)gridDim.x * blockDim.x) ple[i] = pa[i] * sigmoidf_(pg[i]);
}
}

static void nv_gemm(const float* A, int lda, const float* W, int ldw, float* C, int ldc, int N, int K, hipStream_t s) {
    dim3 grid((N + 63) / 64, M_ALL / 64);
    nv::k_gemm<<<grid, 256, 0, s>>>(A, lda, W, ldw, C, ldc, N, K);
}

extern "C" void kernel_launch(void* const* d_in, const int* in_sizes, int n_in, void* d_out, int out_size, void* d_ws, size_t ws_size, hipStream_t stream) {
    const float* x_prompt = (const float*)d_in[0];
    const float* x_sample = (const float*)d_in[1];
    const float* state_ssd_conv = (const float*)d_in[2];
    const float* state_ssd = (const float*)d_in[3];
    const float* cache_k = (const float*)d_in[4];
    const float* cache_v = (const float*)d_in[5];
    const float* state_ffn_conv = (const float*)d_in[6];
    const float* p_prompt = (const float*)d_in[7];
    const float* p_sample = (const float*)d_in[8];
    const float* norm_pre_mix = (const float*)d_in[9];
    const float* w_in = (const float*)d_in[10];
    const float* ssd_conv_w = (const float*)d_in[11];
    const float* ssd_conv_b = (const float*)d_in[12];
    const float* ssd_dt_bias = (const float*)d_in[13];
    const float* ssd_a_log = (const float*)d_in[14];
    const float* ssd_d = (const float*)d_in[15];
    const float* ssd_norm = (const float*)d_in[16];
    const float* w_br_ssd = (const float*)d_in[17];
    const float* w_br_sb = (const float*)d_in[18];
    const float* w_out = (const float*)d_in[19];
    const float* norm_post_mix = (const float*)d_in[20];
    const float* norm_pre_ffn = (const float*)d_in[21];
    const float* w_up = (const float*)d_in[22];
    const float* ffn_conv_w = (const float*)d_in[23];
    const float* ffn_conv_b = (const float*)d_in[24];
    const float* w_down = (const float*)d_in[25];
    const float* norm_post_ffn = (const float*)d_in[26];
    const float* w_ple = (const float*)d_in[27];
    const float* w_ple_gate = (const float*)d_in[28];
    const float* norm_ple = (const float*)d_in[29];
    float* out = (float*)d_out;

    float* ws = (float*)d_ws;
    const size_t R = (size_t)M_ALL;
    float* X = ws;               ws += R * 1024;
    float* H = ws;               ws += R * 1024;
    float* BIG = ws;             ws += R * IN_DIM;
    float* XBCC = ws;            ws += R * (3072 + 2048);
    float* YS = XBCC + R * 3072;
    float* FF = XBCC;
    float* DTB = ws;             ws += R * 32;
    float* ATT = ws;             ws += R * 1024;
    float* T1 = ws;              ws += R * 1024;
    float* T2 = ws;              ws += R * 1024;
    float* T3 = ws;              ws += R * 1024;
    float* PC = ws;              ws += R * 256;

    hipMemcpyAsync(X, x_prompt, (size_t)M_P * 1024 * 4, hipMemcpyDeviceToDevice, stream);
    hipMemcpyAsync(X + (size_t)M_P * 1024, x_sample, (size_t)M_S * 1024 * 4, hipMemcpyDeviceToDevice, stream);
    const int EW_GRID = 4096;
    for (int l = 0; l < DEPTH; ++l) {
        nv::k_rmsnorm<<<2048, 256, 0, stream>>>(X, norm_pre_mix + l * 1024, H, M_ALL, 0);
        nv_gemm(H, 1024, w_in + (size_t)l * 1024 * IN_DIM, IN_DIM, BIG, IN_DIM, IN_DIM, 1024, stream);
        nv::k_split_out<<<EW_GRID, 256, 0, stream>>>(BIG, out, l);
        nv::k_conv_ssd<<<EW_GRID, 256, 0, stream>>>(BIG, state_ssd_conv + (size_t)l * DEC_BATCH * 3 * SSD_CONV_DIM, ssd_conv_w + (size_t)l * 4 * SSD_CONV_DIM, ssd_conv_b + (size_t)l * SSD_CONV_DIM,
                                                    ssd_dt_bias + l * SSD_HEADS, XBCC, DTB);
        nv::k_ssd_scan<<<(2048 * (1 + DEC_BATCH)) / 4, 256, 0, stream>>>(XBCC, DTB, state_ssd + (size_t)l * DEC_BATCH * SSD_HEADS * SSD_HEAD_DIM * SSD_STATE, ssd_a_log + l * SSD_HEADS, ssd_d + l * SSD_HEADS, YS, out, l);
        nv::k_gated_norm<<<2048, 256, 0, stream>>>(YS, BIG, ssd_norm + (size_t)l * D_SSM);
        nv_gemm(YS, D_SSM, w_br_ssd + (size_t)l * D_SSM * 1024, 1024, T1, 1024, 1024, D_SSM, stream);
        nv::k_attn<<<(M_ALL * SB_HEADS) / 4, 256, 0, stream>>>(BIG, cache_k + (size_t)l * DEC_BATCH * PAST_LEN * SB_WIDTH, cache_v + (size_t)l * DEC_BATCH * PAST_LEN * SB_WIDTH, ATT);
        nv_gemm(ATT, 1024, w_br_sb + (size_t)l * 1024 * 1024, 1024, T2, 1024, 1024, 1024, stream);
        nv::k_mix<<<EW_GRID, 256, 0, stream>>>(BIG, T1, T2, T3);
        nv_gemm(T3, 1024, w_out + (size_t)l * 1024 * 1024, 1024, T1, 1024, 1024, 1024, stream);
        nv::k_rmsnorm<<<2048, 256, 0, stream>>>(T1, norm_post_mix + l * 1024, X, M_ALL, 1);
        nv::k_rmsnorm<<<2048, 256, 0, stream>>>(X, norm_pre_ffn + l * 1024, H, M_ALL, 0);
        nv_gemm(H, 1024, w_up + (size_t)l * 1024 * 2 * D_FF, 2 * D_FF, BIG, 2 * D_FF, 2 * D_FF, 1024, stream);
        nv::k_ffn_act<<<EW_GRID, 256, 0, stream>>>(BIG, state_ffn_conv + (size_t)l * DEC_BATCH * 2 * D_FF, ffn_conv_w + (size_t)l * 3 * D_FF, ffn_conv_b + (size_t)l * D_FF, FF, out, l);
        nv_gemm(FF, D_FF, w_down + (size_t)l * D_FF * 1024, 1024, T1, 1024, 1024, D_FF, stream);
        nv::k_rmsnorm<<<2048, 256, 0, stream>>>(T1, norm_post_ffn + l * 1024, X, M_ALL, 1);
        hipMemcpyAsync(PC, p_prompt + (size_t)l * M_P * PLE_DIM, (size_t)M_P * PLE_DIM * 4, hipMemcpyDeviceToDevice, stream);
        hipMemcpyAsync(PC + (size_t)M_P * PLE_DIM, p_sample + (size_t)l * M_S * PLE_DIM, (size_t)M_S * PLE_DIM * 4, hipMemcpyDeviceToDevice, stream);
        nv_gemm(PC, PLE_DIM, w_ple + (size_t)l * PLE_DIM * 1024, 1024, T1, 1024, 1024, PLE_DIM, stream);
        nv_gemm(X, 1024, w_ple_gate + (size_t)l * 1024 * 1024, 1024, T2, 1024, 1024, 1024, stream);
        nv::k_ple<<<EW_GRID, 256, 0, stream>>>(T1, T2, T3);
        nv::k_rmsnorm<<<2048, 256, 0, stream>>>(T3, norm_ple + l * 1024, X, M_ALL, 1);
    }
    hipMemcpyAsync(out + O_Y_P, X, (size_t)M_P * 1024 * 4, hipMemcpyDeviceToDevice, stream);
    hipMemcpyAsync(out + O_Y_S, X + (size_t)M_P * 1024, (size_t)M_S * 1024 * 4, hipMemcpyDeviceToDevice, stream);
}
```

```cpp
#include <hip/hip_runtime.h>
#include <stdint.h>
#include <string.h>

constexpr int D_MODEL = 1024, SEQ = 16384, DEPTH = 2, DEC_BATCH = 32, DEC_SEQ = 32, PAST_LEN = 2048;
constexpr int D_SSM = 2048, SSD_HEAD_DIM = 64, SSD_HEADS = 32, SSD_GROUPS = 4, SSD_STATE = 128, SSD_CONV_DIM = 3072;
constexpr int SB_HEAD_DIM = 128, SB_HEADS = 8, SB_WIDTH = 1024, D_FF = 4096, PLE_DIM = 256;
constexpr int IN_DIM = 10272;
constexpr int M_P = SEQ, M_S = DEC_BATCH * DEC_SEQ, M_ALL = M_P + M_S;
constexpr float EPS = 1e-6f;
constexpr int C_Z = 0, C_XBC = 2048, C_DT = 5120, C_Q = 5152, C_K = 6176, C_V = 7200, C_G = 8224;
constexpr size_t O_Y_P = 0;
constexpr size_t O_Y_S = O_Y_P + (size_t)M_P * D_MODEL;
constexpr size_t O_P_CONV = O_Y_S + (size_t)M_S * D_MODEL;
constexpr size_t O_P_STATE = O_P_CONV + (size_t)DEPTH * 3 * SSD_CONV_DIM;
constexpr size_t O_P_K = O_P_STATE + (size_t)DEPTH * SSD_HEADS * SSD_HEAD_DIM * SSD_STATE;
constexpr size_t O_P_V = O_P_K + (size_t)DEPTH * M_P * SB_WIDTH;
constexpr size_t O_P_FFN = O_P_V + (size_t)DEPTH * M_P * SB_WIDTH;
constexpr size_t O_S_CONV = O_P_FFN + (size_t)DEPTH * 2 * D_FF;
constexpr size_t O_S_STATE = O_S_CONV + (size_t)DEPTH * DEC_BATCH * 3 * SSD_CONV_DIM;
constexpr size_t O_S_K = O_S_STATE + (size_t)DEPTH * DEC_BATCH * SSD_HEADS * SSD_HEAD_DIM * SSD_STATE;
constexpr size_t O_S_V = O_S_K + (size_t)DEPTH * M_S * SB_WIDTH;
constexpr size_t O_S_FFN = O_S_V + (size_t)DEPTH * M_S * SB_WIDTH;
constexpr size_t O_TOTAL = O_S_FFN + (size_t)DEPTH * DEC_BATCH * 2 * D_FF;
constexpr size_t STATE_SZ = (size_t)SSD_HEADS * SSD_HEAD_DIM * SSD_STATE;

typedef unsigned short bf16_t;

__device__ __forceinline__ float wave_sum(float v) {
#pragma unroll
    for (int o = 32; o >= 1; o >>= 1) v += __shfl_xor(v, o);
    return v;
}
__device__ __forceinline__ float sigmoidf_(float x) { return 1.0f / (1.0f + __expf(-x)); }
__device__ __forceinline__ float softplusf_(float x) { return fmaxf(x, 0.f) + log1pf(__expf(-fabsf(x))); }
__device__ __forceinline__ float siluf_(float x) { return x * sigmoidf_(x); }
__device__ __forceinline__ float gelu_tanhf_(float x) { const float u = 0.7978845608028654f * (x + 0.044715f * x * x * x); return 0.5f * x * (1.0f + tanhf(u)); }
__device__ __forceinline__ bf16_t f2bf(float f) { unsigned u = __float_as_uint(f); u += 0x7FFFu + ((u >> 16) & 1u); return (bf16_t)(u >> 16); }
__device__ __forceinline__ float bf2f(bf16_t b) { return __uint_as_float(((unsigned)b) << 16); }
typedef __bf16 bf16x2_t __attribute__((ext_vector_type(2)));
typedef float f32x2_t __attribute__((ext_vector_type(2)));
__device__ __forceinline__ unsigned pk2(float lo, float hi) { unsigned r; asm volatile("v_cvt_pk_bf16_f32 %0, %1, %2" : "=v"(r) : "v"(lo), "v"(hi)); return r; }
__device__ __forceinline__ unsigned pk2c(float lo, float hi) { const f32x2_t v = {lo, hi}; return __builtin_bit_cast(unsigned, __builtin_convertvector(v, bf16x2_t)); }
__device__ __forceinline__ f32x2_t exp2_2(f32x2_t x) { f32x2_t e; e.x = __builtin_amdgcn_exp2f(x.x); e.y = __builtin_amdgcn_exp2f(x.y); return e; }
__device__ __forceinline__ f32x2_t rcp_2(f32x2_t x) { f32x2_t r; r.x = __builtin_amdgcn_rcpf(x.x); r.y = __builtin_amdgcn_rcpf(x.y); return r; }
__device__ __forceinline__ f32x2_t sigmoid2(f32x2_t a) { return rcp_2(exp2_2(a * (-1.4426950408889634f)) + 1.0f); }
__device__ __forceinline__ f32x2_t silu2(f32x2_t a) { return a * sigmoid2(a); }
__device__ __forceinline__ f32x2_t gelu2(f32x2_t x) { const f32x2_t u2 = (x * x * 0.044715f + 1.0f) * x * 1.5957691216057308f; return x * sigmoid2(u2); }
__device__ __forceinline__ float bflo(unsigned w) { return __uint_as_float(w << 16); }
__device__ __forceinline__ float bfhi(unsigned w) { return __uint_as_float(w & 0xffff0000u); }

__device__ __forceinline__ int bid_opaque() { int b = blockIdx.x; asm volatile("" : "+s"(b)); return b; }
__device__ __forceinline__ int nblk_opaque() { int b = gridDim.x; asm volatile("" : "+s"(b)); return b; }
__device__ __forceinline__ int tid_opaque() { int t = threadIdx.x; asm volatile("" : "+v"(t)); return t; }

namespace pg8 {
#define PG8_LAS __attribute__((address_space(3)))
typedef unsigned short bf16_t;
typedef short bf16x8 __attribute__((ext_vector_type(8)));
typedef float f32x4 __attribute__((ext_vector_type(4)));
typedef unsigned u32x4 __attribute__((ext_vector_type(4)));
constexpr int BM = 256, BK = 64, HALF = 128, HTB = HALF * BK * 2  , STAGE_BYTES = 8 * HTB, NXCD = 8, WGM = 8;

__host__ __device__ __forceinline__ int lds_byte(int r, int c) { const int st = (r >> 4) * 2 + (c >> 5), rr = r & 15, cc = c & 31, ob = rr * 64 + cc * 2; return st * 1024 + (ob ^ (((ob >> 9) & 1) << 5)); }
__host__ __device__ __forceinline__ void stage_rc(int b, int& R, int& C) { const int st = b / 1024, sb = b % 1024, swz = sb ^ (((sb >> 9) & 1) << 5); R = (st >> 1) * 16 + swz / 64; C = (st & 1) * 32 + (swz % 64) / 2; }
__host__ __device__ __forceinline__ int perm32(int rho) { const int n = rho >> 4, i = rho & 15; return 8 * (i >> 2) + 4 * n + (i & 3); }

struct Unit { int pm, pn; };
struct Gemm { const bf16_t* A; const bf16_t* Bt; int M, N, K; };

struct StaticOrder {
    int nM, nN, nwg, G, c, wgm;
    __host__ __device__ void init(int M, int N, int G_, int c_, int wgm_ = WGM) { nM = M / BM; nN = N / BM; nwg = nM * nN; G = G_; c = c_; wgm = wgm_; }
    __host__ __device__ bool next(int i, Unit& u) const {
        const long L = (long)i * G + c; if (L >= nwg) return false;
        int wgid = (int)L; { const int q = nwg / NXCD, r = nwg % NXCD, xcd = wgid % NXCD, off = wgid / NXCD; wgid = (xcd < r ? xcd * (q + 1) : r * (q + 1) + (xcd - r) * q) + off; }
        const int nig = wgm * nN, gid = wgid / nig, fm = gid * wgm, gsz = (nM - fm) < wgm ? (nM - fm) : wgm;
        u.pm = fm + ((wgid % nig) % gsz); u.pn = (wgid % nig) / gsz; return true;
    }
    __device__ __forceinline__ void a_ready(const Unit&) const {}
    __device__ __forceinline__ void done(const Unit&) const {}
};
__device__ __forceinline__ unsigned cvt_pk_bf16(float lo, float hi) { unsigned r; asm volatile("v_cvt_pk_bf16_f32 %0, %1, %2" : "=v"(r) : "v"(lo), "v"(hi)); return r; }
typedef float f32x2 __attribute__((ext_vector_type(2)));
__device__ __forceinline__ f32x2 gelu_pk(f32x2 v) {
    const f32x2 av = __builtin_elementwise_abs(v), d = av * 0.2316418882f + 1.0f;
    f32x2 t; t.x = __builtin_amdgcn_rcpf(d.x); t.y = __builtin_amdgcn_rcpf(d.y);
    f32x2 q = t * 0.5307027145f + (-0.7265760135f); q = q * t + 0.7107068705f; q = q * t + (-0.142248368f); q = q * t + 0.127414796f; q = q * t;
    const f32x2 s = (v * v) * (-0.72134752044f);
    f32x2 e; e.x = __builtin_amdgcn_exp2f(s.x); e.y = __builtin_amdgcn_exp2f(s.y);
    const f32x2 m = v * (q * e), r = v - m;
    f32x2 o; o.x = v.x < 0.f ? m.x : r.x; o.y = v.y < 0.f ? m.y : r.y; return o;
}

struct EpiF32 {
    static constexpr bool PERM = false, AFTER_DRAIN = false;
    float* C; int ldc; const float* bias;
    __device__ __forceinline__ void operator()(const f32x4 (&acc)[2][2][4][2], const Unit& u, int wr, int wc, int fr, int fq) const {
        const int row0 = u.pm * BM + wr * 64 + fr, col0 = u.pn * BM + wc * 32 + 4 * fq;
        f32x4 bv[2][2];
#pragma unroll
        for (int bj = 0; bj < 2; ++bj)
#pragma unroll
            for (int n = 0; n < 2; ++n) bv[bj][n] = bias ? *(const f32x4*)(bias + col0 + bj * HALF + n * 16) : (f32x4){0.f, 0.f, 0.f, 0.f};
#pragma unroll
        for (int ai = 0; ai < 2; ++ai)
#pragma unroll
            for (int m = 0; m < 4; ++m) { float* rowp = C + (size_t)(row0 + ai * HALF + m * 16) * ldc + col0;
#pragma unroll
                for (int bj = 0; bj < 2; ++bj)
#pragma unroll
                    for (int n = 0; n < 2; ++n) *(f32x4*)(rowp + bj * HALF + n * 16) = acc[ai][bj][m][n] + bv[bj][n]; }
    }
};
template <int ACT  > struct EpiBf16 {
    static constexpr bool PERM = true, AFTER_DRAIN = false;
    bf16_t* O; int ldc; const float* bias; int split_cols; size_t split_stride;
    __device__ __forceinline__ void operator()(const f32x4 (&acc)[2][2][4][2], const Unit& u, int wr, int wc, int fr, int fq) const {
        const int row0 = u.pm * BM + wr * 64 + fr; int colt = u.pn * BM; bf16_t* base = O;
        if (split_cols) { const int t = colt / split_cols; base += (size_t)t * split_stride; colt -= t * split_cols; }
        const int col0 = colt + wc * 32 + 8 * fq, bcol0 = u.pn * BM + wc * 32 + 8 * fq;
        f32x4 bv[2][2];
#pragma unroll
        for (int bj = 0; bj < 2; ++bj)
#pragma unroll
            for (int n = 0; n < 2; ++n) bv[bj][n] = bias ? *(const f32x4*)(bias + bcol0 + bj * HALF + 4 * n) : (f32x4){0.f, 0.f, 0.f, 0.f};
#pragma unroll
        for (int ai = 0; ai < 2; ++ai)
#pragma unroll
            for (int m = 0; m < 4; ++m) { bf16_t* rowp = base + (size_t)(row0 + ai * HALF + m * 16) * ldc + col0;
#pragma unroll
                for (int bj = 0; bj < 2; ++bj) { f32x4 v0 = acc[ai][bj][m][0] + bv[bj][0], v1 = acc[ai][bj][m][1] + bv[bj][1];
                    if (ACT == 1) { f32x2 a = gelu_pk((f32x2){v0[0], v0[1]}), b = gelu_pk((f32x2){v0[2], v0[3]}), c = gelu_pk((f32x2){v1[0], v1[1]}), d = gelu_pk((f32x2){v1[2], v1[3]});
                        v0 = (f32x4){a.x, a.y, b.x, b.y}; v1 = (f32x4){c.x, c.y, d.x, d.y}; }
                    if (ACT == 2) {
#pragma unroll
                        for (int j = 0; j < 4; ++j) { v0[j] = 0.5f * v0[j] * (1.0f + erff(v0[j] * 0.70710678f)); v1[j] = 0.5f * v1[j] * (1.0f + erff(v1[j] * 0.70710678f)); } }
                    u32x4 w; w.x = cvt_pk_bf16(v0[0], v0[1]); w.y = cvt_pk_bf16(v0[2], v0[3]); w.z = cvt_pk_bf16(v1[0], v1[1]); w.w = cvt_pk_bf16(v1[2], v1[3]);
                    *(u32x4*)(rowp + bj * HALF) = w; } }
    }
};

template <class Epi, class Sched, bool STAMP = false>
__device__ __forceinline__ void gemm_phase(PG8_LAS unsigned char* lds, const Gemm g, const Sched& S, const Epi& E, unsigned long long* stamps) {
    const int tid = tid_opaque(), wid = __builtin_amdgcn_readfirstlane(tid >> 6), lane = tid & 63, wr = wid >> 2, wc = wid & 3, fr = lane & 15, fq = lane >> 4;
    const int K = g.K, nt = K / BK;
    int ts_lo = 0, ts_hi = 0, nts = 0; const unsigned long long rt_entry = STAMP ? (unsigned long long)wall_clock64() : 0ull;
#define PG8_STAMP() do { if (STAMP && wid == 0 && nts < 64) { const unsigned long long _c = (unsigned long long)clock64(); \
        ts_lo = (lane == nts) ? (int)(unsigned)_c : ts_lo; ts_hi = (lane == nts) ? (int)(unsigned)(_c >> 32) : ts_hi; ++nts; } } while (0)
    PG8_STAMP();
    unsigned voffA[2], voffB[2];
#pragma unroll
    for (int i = 0; i < 2; ++i) { int R, C; stage_rc(tid * 16 + i * 8192, R, C); const int Rb = Epi::PERM ? ((R & ~31) + perm32(R & 31)) : R;
        voffA[i] = (unsigned)(R * K + C) * 2u; voffB[i] = (unsigned)(Rb * K + C) * 2u; }
    const size_t kstep = (size_t)(BK * 2);
    const size_t hstep = (size_t)HALF * K * 2;
    const size_t tstep = 2 * hstep;
    const unsigned ldsw = (unsigned)wid * 1024u;
    const int aoff = lds_byte(wr * 64 + fr, fq * 8), boff = lds_byte(wc * 32 + fr, fq * 8);
#define PG8_SA(b, h) (((b) * 2 + (h)) * HTB)
#define PG8_SB(b, h) ((4 + (b) * 2 + (h)) * HTB)
#define PG8_STAGE(bufoff, gbase, voff) do { _Pragma("unroll") for (int _i = 0; _i < 2; ++_i) \
        __builtin_amdgcn_global_load_lds((const unsigned*)((const char*)(gbase) + (voff)[_i]), (PG8_LAS unsigned*)(lds + (bufoff) + ldsw + _i * 8192), 16, 0, 0); } while (0)
#define PG8_LDA(dst, b, h) do { _Pragma("unroll") for (int m = 0; m < 4; ++m) _Pragma("unroll") for (int k = 0; k < 2; ++k) dst[m][k] = *(const PG8_LAS bf16x8*)(lds + PG8_SA(b, h) + aoff + m * 2048 + k * 1024); } while (0)
#define PG8_LDB(dst, b, h) do { _Pragma("unroll") for (int n = 0; n < 2; ++n) _Pragma("unroll") for (int k = 0; k < 2; ++k) dst[n][k] = *(const PG8_LAS bf16x8*)(lds + PG8_SB(b, h) + boff + n * 2048 + k * 1024); } while (0)
#define PG8_MMA(ai, bj, At, Bt) do { __builtin_amdgcn_s_setprio(1); _Pragma("unroll") for (int m = 0; m < 4; ++m) _Pragma("unroll") for (int n = 0; n < 2; ++n) _Pragma("unroll") for (int k = 0; k < 2; ++k) \
        acc[ai][bj][m][n] = __builtin_amdgcn_mfma_f32_16x16x32_bf16(Bt[n][k], At[m][k], acc[ai][bj][m][n], 0, 0, 0); __builtin_amdgcn_s_setprio(0); } while (0)
#define PG8_WAIT_V(n) asm volatile("s_waitcnt vmcnt(" #n ")" ::: "memory")
#define PG8_WAIT_L(n) asm volatile("s_waitcnt lgkmcnt(" #n ")" ::: "memory")
#define PG8_BAR __builtin_amdgcn_s_barrier()
#define PG8_SCHED __builtin_amdgcn_sched_barrier(0)
    Unit cur, nxt; int ui = 0;
    if (!S.next(0, cur)) return;
    f32x4 acc[2][2][4][2];
#pragma unroll
    for (int a = 0; a < 2; ++a)
#pragma unroll
        for (int b = 0; b < 2; ++b)
#pragma unroll
            for (int m = 0; m < 4; ++m)
#pragma unroll
                for (int n = 0; n < 2; ++n) acc[a][b][m][n] = (f32x4){0.f, 0.f, 0.f, 0.f};
    bf16x8 At[4][2], B0[2][2], B1[2][2];
    const char* cA = (const char*)g.A + (size_t)cur.pm * tstep; const char* cB = (const char*)g.Bt + (size_t)cur.pn * tstep;
    S.a_ready(cur);
    PG8_STAGE(PG8_SB(0, 0), cB, voffB); PG8_STAGE(PG8_SA(0, 0), cA, voffA); PG8_STAGE(PG8_SB(0, 1), cB + hstep, voffB); PG8_STAGE(PG8_SA(0, 1), cA + hstep, voffA);
    if (wr == 1) PG8_BAR;
    PG8_WAIT_V(4); PG8_BAR;
    PG8_STAGE(PG8_SB(1, 0), cB + kstep, voffB); PG8_STAGE(PG8_SA(1, 0), cA + kstep, voffA); PG8_STAGE(PG8_SB(1, 1), cB + hstep + kstep, voffB);
    PG8_WAIT_V(6); PG8_BAR;
    PG8_STAMP();
    for (;;) {
        const bool has_next = S.next(ui + 1, nxt);
        const char* nA = has_next ? (const char*)g.A + (size_t)nxt.pm * tstep : cA; const char* nB = has_next ? (const char*)g.Bt + (size_t)nxt.pn * tstep : cB;
        for (int t = 0; t < nt; t += 2) {
            const bool last = (t == nt - 2);
            const char* a1 = cA + (size_t)(t + 1) * kstep;
            const char* a2 = last ? nA : cA + (size_t)(t + 2) * kstep; const char* b2 = last ? nB : cB + (size_t)(t + 2) * kstep;
            const char* a3 = a2 + kstep; const char* b3 = b2 + kstep;
            if (last && has_next) S.a_ready(nxt);
            PG8_LDB(B0, 0, 0); PG8_SCHED; PG8_LDA(At, 0, 0); PG8_STAGE(PG8_SA(1, 1), a1 + hstep, voffA);
            PG8_WAIT_L(8); PG8_BAR; PG8_WAIT_L(0); PG8_MMA(0, 0, At, B0); PG8_BAR; PG8_SCHED;
            PG8_LDB(B1, 0, 1); PG8_STAGE(PG8_SB(0, 0), b2, voffB);
            PG8_BAR; PG8_WAIT_L(0); PG8_MMA(0, 1, At, B1); PG8_BAR;
            PG8_LDA(At, 0, 1); PG8_STAGE(PG8_SA(0, 0), a2, voffA);
            PG8_BAR; PG8_WAIT_L(0); PG8_MMA(1, 0, At, B0); PG8_BAR; PG8_SCHED;
            PG8_STAGE(PG8_SB(0, 1), b2 + hstep, voffB);
            PG8_WAIT_V(6); PG8_BAR; PG8_MMA(1, 1, At, B1); PG8_BAR;
            PG8_LDB(B0, 1, 0); PG8_SCHED; PG8_LDA(At, 1, 0); PG8_STAGE(PG8_SA(0, 1), a2 + hstep, voffA);
            PG8_WAIT_L(8); PG8_BAR; PG8_WAIT_L(0); PG8_MMA(0, 0, At, B0); PG8_BAR; PG8_SCHED;
            PG8_LDB(B1, 1, 1); PG8_STAGE(PG8_SB(1, 0), b3, voffB);
            PG8_BAR; PG8_WAIT_L(0); PG8_MMA(0, 1, At, B1); PG8_BAR;
            PG8_LDA(At, 1, 1); PG8_STAGE(PG8_SA(1, 0), a3, voffA);
            PG8_BAR; PG8_WAIT_L(0); PG8_MMA(1, 0, At, B0); PG8_BAR; PG8_SCHED;
            PG8_STAGE(PG8_SB(1, 1), b3 + hstep, voffB);
            PG8_WAIT_V(6); PG8_BAR; PG8_MMA(1, 1, At, B1); PG8_BAR;
        }
        PG8_STAMP();
        if constexpr (!Epi::AFTER_DRAIN) { E(acc, cur, wr, wc, fr, fq); S.done(cur); }
        PG8_STAMP();
        if (!has_next) break;
#pragma unroll
        for (int a = 0; a < 2; ++a)
#pragma unroll
            for (int b = 0; b < 2; ++b)
#pragma unroll
                for (int m = 0; m < 4; ++m)
#pragma unroll
                    for (int n = 0; n < 2; ++n) acc[a][b][m][n] = (f32x4){0.f, 0.f, 0.f, 0.f};
        cur = nxt; cA = nA; cB = nB; ++ui;
    }
    PG8_WAIT_V(0);
    if (wr == 0) PG8_BAR;
    PG8_BAR;
    if constexpr (Epi::AFTER_DRAIN) { E.fused(acc, cur, wr, wc, fr, fq, lds, wid, lane); S.done(cur); }
    PG8_STAMP();
    if (STAMP && wid == 0) { stamps[lane] = lane < nts ? (((unsigned long long)(unsigned)ts_hi << 32) | (unsigned)ts_lo) : 0ull;
        if (lane == 62) stamps[62] = rt_entry; if (lane == 63) stamps[63] = (unsigned long long)wall_clock64(); }
#undef PG8_STAMP
#undef PG8_SA
#undef PG8_SB
#undef PG8_STAGE
#undef PG8_LDA
#undef PG8_LDB
#undef PG8_MMA
#undef PG8_WAIT_V
#undef PG8_WAIT_L
#undef PG8_BAR
#undef PG8_SCHED
}
}
#define XB_TMO      128
#define XB_XCNT(j)  (256  + 64 * (j))
#define XB_XSUB(j)  (1280 + 64 * (j))
#define XB_XGEN(j)  (2304 + 64 * (j))
#define XB_TOP      3328
#define XB_TOPGEN   3392
#define XCD_BAR_WORDS 3456
#define XB_SPIN_CAP (1u << 18)
#define LAS __attribute__((address_space(3)))

__device__ __forceinline__ unsigned xb_ld(unsigned* p)              { return __hip_atomic_load(p, __ATOMIC_RELAXED, __HIP_MEMORY_SCOPE_AGENT); }
__device__ __forceinline__ unsigned xb_add(unsigned* p, unsigned v) { return __hip_atomic_fetch_add(p, v, __ATOMIC_RELAXED, __HIP_MEMORY_SCOPE_AGENT); }
__device__ __forceinline__ unsigned xb_xcc_id() { return (unsigned)__builtin_amdgcn_s_getreg((3 << 11) | 20) & 0xFu; }
#define XB_SPIN(cond, bar) do { unsigned _sp = 0; while (cond) { __builtin_amdgcn_s_sleep(1); \
    if ((++_sp & 255u) == 0u) { if (xb_ld(&(bar)[XB_TMO])) break; if (_sp > XB_SPIN_CAP) { atomicAdd(&(bar)[XB_TMO], 1u); break; } } } } while (0)

struct XcdBarrier {
    unsigned* bar; unsigned x;
    volatile LAS unsigned* st;
};

__device__ __forceinline__ XcdBarrier xcd_barrier_post(unsigned* bar, volatile LAS unsigned* st) {
    XcdBarrier b; b.bar = bar; b.x = xb_xcc_id(); b.st = st;
    if (threadIdx.x == 0) (void)xb_add(&bar[XB_XCNT(b.x)], 1u);
    return b;
}
__device__ __forceinline__ void xcd_barrier_complete(unsigned* bar, unsigned x, unsigned& nloc, unsigned& nx) {
    const unsigned G = gridDim.x * gridDim.y * gridDim.z;
    unsigned sum, cnt, mine, sp = 0u;
    for (;;) {
        sum = 0u; cnt = 0u; mine = 0u;
#pragma unroll
        for (unsigned j = 0; j < 16; ++j) { const unsigned c = xb_ld(&bar[XB_XCNT(j)]); sum += c; cnt += (c > 0u) ? 1u : 0u; mine = (j == x) ? c : mine; }
        if (sum == G) break;
        __builtin_amdgcn_s_sleep(1);
        if ((++sp & 255u) == 0u) { if (xb_ld(&bar[XB_TMO])) break; if (sp > XB_SPIN_CAP) { atomicAdd(&bar[XB_TMO], 1u); break; } }
    }
    nloc = mine > 0u ? mine : 1u; nx = cnt > 0u ? cnt : 1u;
}

__device__ __forceinline__ void xcd_barrier(const XcdBarrier& b) {
    asm volatile("s_waitcnt vmcnt(0)" ::: "memory");
    __syncthreads();
    if (threadIdx.x == 0) {
        unsigned* bar = b.bar;
        __builtin_amdgcn_s_waitcnt(0);
        unsigned nloc = b.st[0], nx = b.st[1];
        if (nloc == 0u) { xcd_barrier_complete(bar, b.x, nloc, nx); b.st[0] = nloc; b.st[1] = nx; }
        const unsigned old = xb_add(&bar[XB_XSUB(b.x)], 1u);
        const unsigned gen = old / nloc;
        if (old + 1u == (gen + 1u) * nloc) {
            __builtin_amdgcn_fence(__ATOMIC_RELEASE, "agent");
            asm volatile("s_waitcnt vmcnt(0)" ::: "memory");
            const unsigned og = xb_add(&bar[XB_TOP], 1u);
            const unsigned tg = og / nx;
            if (og + 1u == (tg + 1u) * nx) xb_add(&bar[XB_TOPGEN], 1u);
            else XB_SPIN(xb_ld(&bar[XB_TOPGEN]) == tg, bar);
            __builtin_amdgcn_fence(__ATOMIC_ACQUIRE, "agent");
            xb_add(&bar[XB_XGEN(b.x)], 1u);
            asm volatile("s_waitcnt vmcnt(0)" ::: "memory");
        } else {
            XB_SPIN(xb_ld(&bar[XB_XGEN(b.x)]) == gen, bar);
            __builtin_amdgcn_fence(__ATOMIC_ACQUIRE, "agent");
            asm volatile("s_waitcnt vmcnt(0)" ::: "memory");
        }
    }
    __syncthreads();
}


using pg8::f32x4; using pg8::u32x4; using pg8::Unit; using pg8::Gemm; using pg8::StaticOrder;
typedef unsigned u32x2 __attribute__((ext_vector_type(2)));
#define LDSP PG8_LAS unsigned char*

constexpr int N1 = 10496;
constexpr size_t OW1 = 0, OW2 = OW1 + (size_t)N1 * 1024, OW3 = OW2 + (size_t)1024 * 2048, OW4 = OW3 + (size_t)1024 * 1024, OW5 = OW4 + (size_t)1024 * 1024,
                 OW6 = OW5 + (size_t)8192 * 1024, OW7 = OW6 + (size_t)1024 * 4096, OW8 = OW7 + (size_t)1024 * 256, WT_LAYER = OW8 + (size_t)1024 * 1024;
constexpr int NCHUNK = 256 + DEC_BATCH;

struct Params {
    const float *x_prompt, *x_sample, *state_ssd_conv, *state_ssd, *cache_k, *cache_v, *state_ffn_conv, *p_prompt, *p_sample;
    const float *norm_pre_mix, *w_in, *ssd_conv_w, *ssd_conv_b, *ssd_dt_bias, *ssd_a_log, *ssd_d, *ssd_norm, *w_br_ssd, *w_br_sb, *w_out, *norm_post_mix, *norm_pre_ffn,
                *w_up, *ffn_conv_w, *ffn_conv_b, *w_down, *norm_post_ffn, *w_ple, *w_ple_gate, *norm_ple;
    float* out;
    unsigned* bar;
    bf16_t* wt; bf16_t* xr; bf16_t* xb; float* rs; float* rs2; bf16_t* pb;
    bf16_t *zb, *xbcb, *qb, *gb, *kb, *vb; float* dtb;
    float* sst; float* dec; bf16_t* hpb;
    bf16_t *yn, *att, *t1, *mixin; bf16_t* mixed;
    bf16_t *gh, *xh, *ffb; bf16_t* down; bf16_t* plea; bf16_t* ple;
};

typedef const __attribute__((address_space(4))) Params CP;
#define CPR CP&
__device__ __forceinline__ CP* kargs() { CP* q = (CP*)__builtin_amdgcn_kernarg_segment_ptr(); asm volatile("" : "+s"(q)); return q; }

__device__ __forceinline__ void wt_item(const float* __restrict__ W, int K, int ldw, const float* __restrict__ gain, bf16_t* __restrict__ Wt, int nblk, int item, int w1map, PG8_LAS float* scr, int lane) {
    const int kb = item / nblk, nb = item % nblk, k0 = 64 * kb, n0 = 32 * nb;
    int sc0 = n0; if (w1map == 1) sc0 = (n0 < 5120) ? n0 : (n0 < 10240 ? n0 + 32 : (n0 < 10272 ? n0 - 5120 : -1));
    else if (w1map == 2) sc0 = ((n0 & 255) < 128 ? 0 : 4096) + (n0 >> 8) * 128 + (n0 & 127);
    const int kr = lane >> 3, c4 = (lane & 7) * 4;
    float4 v[8];
#pragma unroll
    for (int i = 0; i < 8; ++i) v[i] = (sc0 >= 0) ? *(const float4*)(W + (size_t)(k0 + kr + 8 * i) * ldw + sc0 + c4) : make_float4(0.f, 0.f, 0.f, 0.f);
#pragma unroll
    for (int i = 0; i < 8; ++i) { const int kk = kr + 8 * i; const float gm = gain ? gain[k0 + kk] : 1.0f; PG8_LAS float* d = scr + kk * 33 + c4;
        d[0] = v[i].x * gm; d[1] = v[i].y * gm; d[2] = v[i].z * gm; d[3] = v[i].w * gm; }
    asm volatile("s_waitcnt lgkmcnt(0)" ::: "memory");
    const int c = lane & 7;
#pragma unroll
    for (int j = 0; j < 4; ++j) { const int nn = (lane >> 3) + 8 * j; const PG8_LAS float* s = scr + (8 * c) * 33 + nn;
        *(u32x4*)(Wt + (size_t)(n0 + nn) * K + k0 + 8 * c) = (u32x4){pk2(s[0], s[33]), pk2(s[2 * 33], s[3 * 33]), pk2(s[4 * 33], s[5 * 33]), pk2(s[6 * 33], s[7 * 33])}; }
    asm volatile("s_waitcnt lgkmcnt(0)" ::: "memory");
}
__device__ __forceinline__ void ph_wt(CPR p, LDSP lds) {
    constexpr int U1 = 16 * 328, U2 = U1 + 32 * 32, U3 = U2 + 512, U4 = U3 + 512, U5 = U4 + 16 * 256, U6 = U5 + 64 * 32, U7 = U6 + 4 * 32, U8 = U7 + 512;
    const int tidx = tid_opaque(), lane = tidx & 63, wv = tidx >> 6, gw = bid_opaque() * 8 + wv, NGW = nblk_opaque() * 8;
    PG8_LAS float* scr = (PG8_LAS float*)(lds + wv * (64 * 33 * 4));
    for (int u = gw; u < DEPTH * U8; u += NGW) {
        const int l = u / U8; int v = u % U8; bf16_t* wl = p.wt + (size_t)l * WT_LAYER;
        if (v < U1)      { wt_item(p.w_in + (size_t)l * 1024 * IN_DIM, 1024, IN_DIM, p.norm_pre_mix + l * 1024, wl + OW1, 328, v, 1, scr, lane); }
        else if (v < U2) { v -= U1; wt_item(p.w_br_ssd + (size_t)l * 2048 * 1024, 2048, 1024, p.ssd_norm + l * 2048, wl + OW2, 32, v, 0, scr, lane); }
        else if (v < U3) { v -= U2; wt_item(p.w_br_sb + (size_t)l * 1024 * 1024, 1024, 1024, nullptr, wl + OW3, 32, v, 0, scr, lane); }
        else if (v < U4) { v -= U3; wt_item(p.w_out + (size_t)l * 1024 * 1024, 1024, 1024, nullptr, wl + OW4, 32, v, 0, scr, lane); }
        else if (v < U5) { v -= U4; wt_item(p.w_up + (size_t)l * 1024 * 8192, 1024, 8192, p.norm_pre_ffn + l * 1024, wl + OW5, 256, v, 2, scr, lane); }
        else if (v < U6) { v -= U5; wt_item(p.w_down + (size_t)l * 4096 * 1024, 4096, 1024, nullptr, wl + OW6, 32, v, 0, scr, lane); }
        else if (v < U7) { v -= U6; wt_item(p.w_ple + (size_t)l * 256 * 1024, 256, 1024, nullptr, wl + OW7, 32, v, 0, scr, lane); }
        else             { v -= U7; wt_item(p.w_ple_gate + (size_t)l * 1024 * 1024, 1024, 1024, nullptr, wl + OW8, 32, v, 0, scr, lane); }
    }
    __syncthreads();
}
__device__ __forceinline__ void ph_xprep(CPR p) {
    const int tidx = tid_opaque(); const int lane = tidx & 63, gw = bid_opaque() * 8 + (tidx >> 6), NGW = nblk_opaque() * 8;
    for (int row0 = 2 * gw; row0 < M_ALL; row0 += 2 * NGW) {
        float4 v[2][4]; float ss[2] = {0.f, 0.f};
#pragma unroll
        for (int q = 0; q < 2; ++q) { const int row = row0 + q; const float4* src = (const float4*)(row < M_P ? p.x_prompt + (size_t)row * 1024 : p.x_sample + (size_t)(row - M_P) * 1024);
#pragma unroll
            for (int j = 0; j < 4; ++j) v[q][j] = src[lane + 64 * j]; }
#pragma unroll
        for (int q = 0; q < 2; ++q) { const int row = row0 + q;
#pragma unroll
            for (int j = 0; j < 4; ++j) { ss[q] += v[q][j].x * v[q][j].x + v[q][j].y * v[q][j].y + v[q][j].z * v[q][j].z + v[q][j].w * v[q][j].w;
                ((u32x2*)(p.xr + (size_t)row * 1024))[lane + 64 * j] = (u32x2){pk2(v[q][j].x, v[q][j].y), pk2(v[q][j].z, v[q][j].w)}; }
            const float rn = rsqrtf(wave_sum(ss[q]) * (1.0f / 1024.f) + EPS);
#pragma unroll
            for (int j = 0; j < 4; ++j) ((u32x2*)(p.xb + (size_t)row * 1024))[lane + 64 * j] = (u32x2){pk2(v[q][j].x * rn, v[q][j].y * rn), pk2(v[q][j].z * rn, v[q][j].w * rn)}; }
    }
    for (int r0 = 4 * gw; r0 < DEPTH * M_ALL; r0 += 4 * NGW) {
        float4 v[4];
#pragma unroll
        for (int q = 0; q < 4; ++q) { const int r2 = r0 + q, l = r2 / M_ALL, row = r2 % M_ALL;
            v[q] = ((const float4*)(row < M_P ? p.p_prompt + ((size_t)l * M_P + row) * PLE_DIM : p.p_sample + ((size_t)l * M_S + row - M_P) * PLE_DIM))[lane]; }
#pragma unroll
        for (int q = 0; q < 4; ++q) ((u32x2*)(p.pb + (size_t)(r0 + q) * PLE_DIM))[lane] = (u32x2){pk2(v[q].x, v[q].y), pk2(v[q].z, v[q].w)};
    }
}
__device__ __forceinline__ void ph_norm(const bf16_t* __restrict__ src, const float* __restrict__ gain, bf16_t* xr, bf16_t* xb, float* yP, float* yS, bf16_t* xh = nullptr) {
    const int tidx = tid_opaque(); const int lane = tidx & 63, gw = bid_opaque() * 8 + (tidx >> 6), NGW = nblk_opaque() * 8;
    float4 g[4];
#pragma unroll
    for (int j = 0; j < 4; ++j) g[j] = ((const float4*)gain)[lane + 64 * j];
    for (int row0 = 2 * gw; row0 < M_ALL; row0 += 2 * NGW) {
        u32x2 sv[2][4], xv[2][4];
#pragma unroll
        for (int q = 0; q < 2; ++q)
#pragma unroll
            for (int j = 0; j < 4; ++j) { sv[q][j] = ((const u32x2*)(src + (size_t)(row0 + q) * 1024))[lane + 64 * j]; xv[q][j] = ((const u32x2*)(xr + (size_t)(row0 + q) * 1024))[lane + 64 * j]; }
#pragma unroll
        for (int q = 0; q < 2; ++q) {
            const int row = row0 + q;
            float4 v[4], x[4]; float ss = 0.f;
#pragma unroll
            for (int j = 0; j < 4; ++j) { v[j] = make_float4(bflo(sv[q][j].x), bfhi(sv[q][j].x), bflo(sv[q][j].y), bfhi(sv[q][j].y)); x[j] = make_float4(bflo(xv[q][j].x), bfhi(xv[q][j].x), bflo(xv[q][j].y), bfhi(xv[q][j].y));
                ss += v[j].x * v[j].x + v[j].y * v[j].y + v[j].z * v[j].z + v[j].w * v[j].w; }
            ss = wave_sum(ss);
            const float r = rsqrtf(ss * (1.0f / 1024.f) + EPS); float s2 = 0.f;
#pragma unroll
            for (int j = 0; j < 4; ++j) {
                x[j].x += v[j].x * r * g[j].x; x[j].y += v[j].y * r * g[j].y; x[j].z += v[j].z * r * g[j].z; x[j].w += v[j].w * r * g[j].w;
                s2 += x[j].x * x[j].x + x[j].y * x[j].y + x[j].z * x[j].z + x[j].w * x[j].w;
                ((u32x2*)(xr + (size_t)row * 1024))[lane + 64 * j] = (u32x2){pk2(x[j].x, x[j].y), pk2(x[j].z, x[j].w)};
            }
            if (xb) {
                const float rn = rsqrtf(wave_sum(s2) * (1.0f / 1024.f) + EPS);
#pragma unroll
                for (int j = 0; j < 4; ++j) {
                    const u32x2 wq = (u32x2){pk2(x[j].x * rn, x[j].y * rn), pk2(x[j].z * rn, x[j].w * rn)};
                    ((u32x2*)(xb + (size_t)row * 1024))[lane + 64 * j] = wq;
                    if (xh && (row & 63) >= 62) ((u32x2*)(xh + (size_t)(2 * ((row >> 6) + 1) + (row & 63) - 62) * 1024))[lane + 64 * j] = wq;
                }
            }
            if (yP) { float4* y4 = (float4*)(row < M_P ? yP + (size_t)row * 1024 : yS + (size_t)(row - M_P) * 1024);
#pragma unroll
                for (int j = 0; j < 4; ++j) y4[lane + 64 * j] = x[j]; }
        }
    }
}
__device__ __forceinline__ void unpack8(const u32x4 w, float (&v)[8]) {
    v[0] = bflo(w.x); v[1] = bfhi(w.x); v[2] = bflo(w.y); v[3] = bfhi(w.y); v[4] = bflo(w.z); v[5] = bfhi(w.z); v[6] = bflo(w.w); v[7] = bfhi(w.w);
}
__device__ __forceinline__ void load8f(const float* p, float (&v)[8]) { const float4 a = ((const float4*)p)[0], b = ((const float4*)p)[1]; v[0] = a.x; v[1] = a.y; v[2] = a.z; v[3] = a.w; v[4] = b.x; v[5] = b.y; v[6] = b.z; v[7] = b.w; }
__device__ __forceinline__ float gelu_fast(float x) { const float u2 = 1.5957691216057308f * (x + 0.044715f * x * x * x); return x * __builtin_amdgcn_rcpf(1.0f + __expf(-u2)); }
struct EpiIn {
    static constexpr bool PERM = true, AFTER_DRAIN = false;
    const float* rs; bf16_t *zb, *xbcb, *qb, *gb, *kb, *vb; float* dtb; const float* dt_bias; float *kP, *vP, *kS, *vS, *convP, *convS;
    __device__ __forceinline__ void operator()(const f32x4 (&acc)[2][2][4][2], const Unit& u, int wr, int wc, int fr, int fq) const {
        const int row0 = u.pm * 256 + wr * 64 + fr, seg = u.pn, cl = wc * 32 + 8 * fq;
#pragma unroll
        for (int ai = 0; ai < 2; ++ai)
#pragma unroll
            for (int m = 0; m < 4; ++m) {
                const int r = row0 + ai * 128 + m * 16;
#pragma unroll
                for (int bj = 0; bj < 2; ++bj) {
                    const int ct = cl + bj * 128; const f32x4 v0 = acc[ai][bj][m][0], v1 = acc[ai][bj][m][1];
                    const u32x4 w = (u32x4){pk2c(v0[0], v0[1]), pk2c(v0[2], v0[3]), pk2c(v1[0], v1[1]), pk2c(v1[2], v1[3])};
                    if (seg < 8) { *(u32x4*)(zb + (size_t)r * 2048 + seg * 256 + ct) = w; }
                    else if (seg < 20) {
                        const int c = (seg - 8) * 256 + ct; *(u32x4*)(xbcb + (size_t)r * 3072 + c) = w;
                        float* dst = nullptr;
                        if (r < M_P) { if (r >= M_P - 3) dst = convP + (size_t)(r - (M_P - 3)) * 3072; }
                        else { const int t = (r - M_P) & 31, b = (r - M_P) >> 5; if (t >= 29) dst = convS + ((size_t)b * 3 + (t - 29)) * 3072; }
                        if (dst) { *(f32x4*)(dst + c) = v0; *(f32x4*)(dst + c + 4) = v1; }
                    }
                    else if (seg < 24) { *(u32x4*)(qb + (size_t)r * 1024 + (seg - 20) * 256 + ct) = w; }
                    else if (seg < 32) {
                        const int c = ((seg - 24) & 3) * 256 + ct; const bool isk = seg < 28;
                        float* dst = (r < M_P) ? (isk ? kP : vP) + (size_t)r * 1024 : (isk ? kS : vS) + (size_t)(r - M_P) * 1024;
                        *(f32x4*)(dst + c) = v0; *(f32x4*)(dst + c + 4) = v1;
                        *(u32x4*)((isk ? kb : vb) + (size_t)r * 1024 + c) = w;
                    }
                    else if (seg < 40) {
                        const f32x2_t s0 = sigmoid2((f32x2_t){v0[0], v0[1]}), s1 = sigmoid2((f32x2_t){v0[2], v0[3]}), s2 = sigmoid2((f32x2_t){v1[0], v1[1]}), s3 = sigmoid2((f32x2_t){v1[2], v1[3]});
                        *(u32x4*)(gb + (size_t)r * 2048 + (seg - 32) * 256 + ct) = (u32x4){pk2(s0.x, s0.y), pk2(s1.x, s1.y), pk2(s2.x, s2.y), pk2(s3.x, s3.y)};
                    }
                    else if (wc == 0 && bj == 0) {
                        const f32x4 b0 = *(const f32x4*)(dt_bias + 8 * fq), b1 = *(const f32x4*)(dt_bias + 8 * fq + 4);
                        f32x4 o0, o1;
#pragma unroll
                        for (int j = 0; j < 4; ++j) { o0[j] = softplusf_(v0[j] + b0[j]); o1[j] = softplusf_(v1[j] + b1[j]); }
                        *(f32x4*)(dtb + (size_t)r * 32 + 8 * fq) = o0; *(f32x4*)(dtb + (size_t)r * 32 + 8 * fq + 4) = o1;
                    }
                }
            }
    }
};
struct EpiHalo {
    static constexpr bool PERM = true, AFTER_DRAIN = false;
    const float* rs; bf16_t* gh;
    __device__ __forceinline__ void elem(int hi, int ch, float v) const { gh[(size_t)hi * D_FF + ch] = f2bf(v); }
    __device__ __forceinline__ void operator()(const f32x4 (&acc)[2][2][4][2], const Unit& u, int wr, int wc, int fr, int fq) const {
        const int row0 = u.pm * 256 + wr * 64 + fr, c0 = u.pn * 128 + wc * 32 + 8 * fq;
#pragma unroll
        for (int ai = 0; ai < 2; ++ai)
#pragma unroll
            for (int m = 0; m < 4; ++m) {
                const int hi = row0 + ai * 128 + m * 16;
                const f32x4 v0 = acc[ai][0][m][0], v1 = acc[ai][0][m][1];
                *(u32x4*)(gh + (size_t)hi * D_FF + c0) = (u32x4){pk2c(v0[0], v0[1]), pk2c(v0[2], v0[3]), pk2c(v1[0], v1[1]), pk2c(v1[2], v1[3])};
            }
    }
};
struct EpiUpAct {
    static constexpr bool PERM = true, AFTER_DRAIN = false;
    const float* rs; const bf16_t* gh; bf16_t* ffb; float *ffnP, *ffnS; const float* cw; const float* cb; const float* hist;
    __device__ __forceinline__ void operator()(const f32x4 (&acc)[2][2][4][2], const Unit& u, int wr, int wc, int fr, int fq) const {
        const int c0 = u.pn * 128 + wc * 32 + 8 * fq;
        float w0[8], w1[8], w2[8], bb[8];
        load8f(cw + c0, w0); load8f(cw + D_FF + c0, w1); load8f(cw + 2 * D_FF + c0, w2); load8f(cb + c0, bb);
#pragma unroll
        for (int ai = 0; ai < 2; ++ai) {
            const int strip = 4 * u.pm + 2 * ai + wr;
            float gprev[8];
#pragma unroll
            for (int m = 0; m < 4; ++m) {
                const int r = strip * 64 + 16 * m + fr;
                float g[8], uv[8], p1[8], p2[8];
#pragma unroll
                for (int j = 0; j < 4; ++j) { g[j] = acc[ai][0][m][0][j]; g[4 + j] = acc[ai][0][m][1][j]; uv[j] = acc[ai][1][m][0][j]; uv[4 + j] = acc[ai][1][m][1][j]; }
                if (m == 0) { float e14[8], e15[8]; unpack8(*(const u32x4*)(gh + (size_t)(2 * strip) * D_FF + c0), e14); unpack8(*(const u32x4*)(gh + (size_t)(2 * strip + 1) * D_FF + c0), e15);
#pragma unroll
                    for (int j = 0; j < 8; ++j) gprev[j] = (fr == 15) ? e15[j] : e14[j]; }
#pragma unroll
                for (int j = 0; j < 8; ++j) {
                    const float c1 = (fr == 15) ? gprev[j] : g[j], c2 = (fr >= 14) ? gprev[j] : g[j];
                    p1[j] = __builtin_bit_cast(float, __builtin_amdgcn_update_dpp(0, __builtin_bit_cast(int, c1), 0x121, 0xf, 0xf, false));
                    p2[j] = __builtin_bit_cast(float, __builtin_amdgcn_update_dpp(0, __builtin_bit_cast(int, c2), 0x122, 0xf, 0xf, false));
                }
                const int t = (r < M_P) ? r : ((r - M_P) & 31);
                if (t < 2) {
                    float h0[8], h1[8];
                    if (r >= M_P) { const float* hp = hist + (size_t)((r - M_P) >> 5) * 2 * D_FF + c0; load8f(hp, h0); load8f(hp + D_FF, h1); }
                    else {
#pragma unroll
                        for (int j = 0; j < 8; ++j) { h0[j] = 0.f; h1[j] = 0.f; } }
#pragma unroll
                    for (int j = 0; j < 8; ++j) { if (t == 0) { p2[j] = h0[j]; p1[j] = h1[j]; } else { p2[j] = h1[j]; } }
                }
                float o[8];
#pragma unroll
                for (int j = 0; j < 8; j += 2) {
                    const f32x2_t a = (f32x2_t){bb[j], bb[j + 1]} + (f32x2_t){w0[j], w0[j + 1]} * (f32x2_t){p2[j], p2[j + 1]} + (f32x2_t){w1[j], w1[j + 1]} * (f32x2_t){p1[j], p1[j + 1]} + (f32x2_t){w2[j], w2[j + 1]} * (f32x2_t){g[j], g[j + 1]};
                    const f32x2_t ov = gelu2(a) * (f32x2_t){uv[j], uv[j + 1]}; o[j] = ov.x; o[j + 1] = ov.y; }
                *(u32x4*)(ffb + (size_t)r * D_FF + c0) = (u32x4){pk2(o[0], o[1]), pk2(o[2], o[3]), pk2(o[4], o[5]), pk2(o[6], o[7])};
                float* dst = nullptr;
                if (r < M_P) { if (r >= M_P - 2) dst = ffnP + (size_t)(r - (M_P - 2)) * D_FF; }
                else { const int b = (r - M_P) >> 5; if (t >= 30) dst = ffnS + ((size_t)b * 2 + (t - 30)) * D_FF; }
                if (dst) { *(f32x4*)(dst + c0) = (f32x4){g[0], g[1], g[2], g[3]}; *(f32x4*)(dst + c0 + 4) = (f32x4){g[4], g[5], g[6], g[7]}; }
#pragma unroll
                for (int j = 0; j < 8; ++j) gprev[j] = g[j];
            }
        }
    }
};
struct EpiBr {
    static constexpr bool PERM = true, AFTER_DRAIN = false;
    const bf16_t* gb; const bf16_t* t1in; bf16_t* dst; int mode; int pad;
    __device__ __forceinline__ void elem(int r, int c, float v) const {
        float o = bf2f(gb[(size_t)r * 2048 + (mode == 0 ? 1024 : 0) + c]) * v; if (mode == 1) o += bf2f(t1in[(size_t)r * 1024 + c]);
        dst[(size_t)r * 1024 + c] = f2bf(o); }
    __device__ __forceinline__ void operator()(const f32x4 (&acc)[2][2][4][2], const Unit& u, int wr, int wc, int fr, int fq) const {
        const int row0 = u.pm * 256 + wr * 64 + fr, cl = u.pn * 256 + wc * 32 + 8 * fq;
#pragma unroll
        for (int ai = 0; ai < 2; ++ai)
#pragma unroll
            for (int m = 0; m < 4; ++m) {
                const int r = row0 + ai * 128 + m * 16;
#pragma unroll
                for (int bj = 0; bj < 2; ++bj) {
                    const int c = cl + bj * 128; float g[8], o[8];
                    unpack8(*(const u32x4*)(gb + (size_t)r * 2048 + (mode == 0 ? 1024 : 0) + c), g);
                    const f32x4 v0 = acc[ai][bj][m][0], v1 = acc[ai][bj][m][1];
                    float tv[8];
                    if (mode == 1) unpack8(*(const u32x4*)(t1in + (size_t)r * 1024 + c), tv);
                    else {
#pragma unroll
                        for (int j = 0; j < 8; ++j) tv[j] = 0.f; }
#pragma unroll
                    for (int j = 0; j < 4; j += 2) {
                        const f32x2_t oa = (f32x2_t){g[j], g[j + 1]} * (f32x2_t){v0[j], v0[j + 1]} + (f32x2_t){tv[j], tv[j + 1]}, ob = (f32x2_t){g[4 + j], g[5 + j]} * (f32x2_t){v1[j], v1[j + 1]} + (f32x2_t){tv[4 + j], tv[5 + j]};
                        o[j] = oa.x; o[j + 1] = oa.y; o[4 + j] = ob.x; o[5 + j] = ob.y; }
                    *(u32x4*)(dst + (size_t)r * 1024 + c) = (u32x4){pk2(o[0], o[1]), pk2(o[2], o[3]), pk2(o[4], o[5]), pk2(o[6], o[7])};
                }
            }
    }
};
struct EpiPlain {
    static constexpr bool PERM = true, AFTER_DRAIN = false;
    bf16_t* dst;
    __device__ __forceinline__ void elem(int r, int c, float v) const { dst[(size_t)r * 1024 + c] = f2bf(v); }
    __device__ __forceinline__ void operator()(const f32x4 (&acc)[2][2][4][2], const Unit& u, int wr, int wc, int fr, int fq) const {
        const int row0 = u.pm * 256 + wr * 64 + fr, cl = u.pn * 256 + wc * 32 + 8 * fq;
#pragma unroll
        for (int ai = 0; ai < 2; ++ai)
#pragma unroll
            for (int m = 0; m < 4; ++m) {
                const int r = row0 + ai * 128 + m * 16;
#pragma unroll
                for (int bj = 0; bj < 2; ++bj) { const f32x4 v0 = acc[ai][bj][m][0], v1 = acc[ai][bj][m][1];
                    *(u32x4*)(dst + (size_t)r * 1024 + cl + bj * 128) = (u32x4){pk2c(v0[0], v0[1]), pk2c(v0[2], v0[3]), pk2c(v1[0], v1[1]), pk2c(v1[2], v1[3])}; }
            }
    }
};
struct EpiF32Out {
    static constexpr bool PERM = true, AFTER_DRAIN = false;
    bf16_t* dst;
    __device__ __forceinline__ void elem(int r, int c, float v) const { dst[(size_t)r * 1024 + c] = f2bf(v); }
    __device__ __forceinline__ void operator()(const f32x4 (&acc)[2][2][4][2], const Unit& u, int wr, int wc, int fr, int fq) const {
        const int row0 = u.pm * 256 + wr * 64 + fr, cl = u.pn * 256 + wc * 32 + 8 * fq;
#pragma unroll
        for (int ai = 0; ai < 2; ++ai)
#pragma unroll
            for (int m = 0; m < 4; ++m) {
                const int r = row0 + ai * 128 + m * 16;
#pragma unroll
                for (int bj = 0; bj < 2; ++bj) { const f32x4 v0 = acc[ai][bj][m][0], v1 = acc[ai][bj][m][1];
                    *(u32x4*)(dst + (size_t)r * 1024 + cl + bj * 128) = (u32x4){pk2c(v0[0], v0[1]), pk2c(v0[2], v0[3]), pk2c(v1[0], v1[1]), pk2c(v1[2], v1[3])}; }
            }
    }
};
struct EpiPle {
    static constexpr bool PERM = false, AFTER_DRAIN = false;
    const bf16_t* plea; bf16_t* dst;
    __device__ __forceinline__ void elem(int r, int c, float v) const { dst[(size_t)r * 1024 + c] = f2bf(bf2f(plea[(size_t)r * 1024 + c]) * sigmoidf_(v)); }
    __device__ __forceinline__ void operator()(const f32x4 (&acc)[2][2][4][2], const Unit& u, int wr, int wc, int fr, int fq) const {
        const int row0 = u.pm * 256 + wr * 64 + fr, col0 = u.pn * 256 + wc * 32 + 4 * fq;
#pragma unroll
        for (int ai = 0; ai < 2; ++ai)
#pragma unroll
            for (int m = 0; m < 4; ++m) { const size_t ro = (size_t)(row0 + ai * 128 + m * 16) * 1024 + col0;
#pragma unroll
                for (int bj = 0; bj < 2; ++bj)
#pragma unroll
                    for (int n = 0; n < 2; ++n) { const u32x2 a = *(const u32x2*)(plea + ro + bj * 128 + n * 16); const f32x4 v = acc[ai][bj][m][n];
                        const f32x2_t o0 = (f32x2_t){bflo(a.x), bfhi(a.x)} * sigmoid2((f32x2_t){v[0], v[1]}), o1 = (f32x2_t){bflo(a.y), bfhi(a.y)} * sigmoid2((f32x2_t){v[2], v[3]});
                        *(u32x2*)(dst + ro + bj * 128 + n * 16) = (u32x2){pk2(o0.x, o0.y), pk2(o1.x, o1.y)}; } }
    }
};

typedef short bf16x8 __attribute__((ext_vector_type(8)));
typedef float f32x16 __attribute__((ext_vector_type(16)));
typedef short bf16x4 __attribute__((ext_vector_type(4)));
#define MFMA32(a, b, c) __builtin_amdgcn_mfma_f32_32x32x16_bf16((a), (b), (c), 0, 0, 0)
__device__ __forceinline__ f32x16 zero16() { f32x16 z;
#pragma unroll
    for (int i = 0; i < 16; ++i) z[i] = 0.f; return z; }
__device__ __forceinline__ bf16x8 pack8f(const float (&v)[8]) { const u32x4 w = (u32x4){pk2(v[0], v[1]), pk2(v[2], v[3]), pk2(v[4], v[5]), pk2(v[6], v[7])}; return __builtin_bit_cast(bf16x8, w); }
__device__ __forceinline__ bf16x8 join44(bf16x4 lo, bf16x4 hi) { return __builtin_shufflevector(lo, hi, 0, 1, 2, 3, 4, 5, 6, 7); }

constexpr int PX = 72;
constexpr int PR = 136;
constexpr int L_XT = 0;
constexpr int L_B = L_XT + 8 * 64 * PX * 2;
constexpr int L_C = L_B + 128 * PX * 2;
constexpr int L_AC = L_C + 64 * PR * 2;
constexpr int L_DT = L_AC + 2048;
constexpr int L_WS = L_DT + 2048;
constexpr int ZP = 1040;
constexpr int SSD_LDS = L_WS + 2048;

struct ChunkInfo { int seqbase, row0, t0, nvalid; const float* hist; };
__device__ __forceinline__ ChunkInfo chunk_info(CPR p, int l, int ck) {
    ChunkInfo c;
    if (ck < 256) { c.seqbase = 0; c.row0 = 64 * ck; c.t0 = 64 * ck; c.nvalid = 64; c.hist = nullptr; }
    else { const int b = ck - 256; c.seqbase = M_P + 32 * b; c.row0 = c.seqbase; c.t0 = 0; c.nvalid = 32; c.hist = p.state_ssd_conv + ((size_t)l * DEC_BATCH + b) * 3 * 3072; }
    return c;
}
template <int NP> __device__ __forceinline__ void xbc_pad_raw(const bf16_t* __restrict__ xbcb, const float* __restrict__ hist, int rowbase, int hj, int c, unsigned (&d)[NP]) {
    if (hj >= 3) { const bf16_t* q = xbcb + (size_t)(rowbase + hj - 3) * 3072 + c;
        if (NP == 4) { const u32x4 t = *(const u32x4*)q; d[0] = t.x; d[1 % NP] = t.y; d[2 % NP] = t.z; d[3 % NP] = t.w; }
        else if (NP == 2) { const u32x2 t = *(const u32x2*)q; d[0] = t.x; d[1 % NP] = t.y; }
        else d[0] = *(const unsigned*)q; }
    else if (hist) {
#pragma unroll
        for (int k = 0; k < NP; ++k) { const float2 t = *(const float2*)(hist + (size_t)hj * 3072 + c + 2 * k); d[k] = pk2(t.x, t.y); } }
    else {
#pragma unroll
        for (int k = 0; k < NP; ++k) d[k] = 0u; }
}
__device__ __forceinline__ int xt_off(int R, int g) { return R * (PX * 2) + ((g ^ ((R >> 3) & 7)) << 4); }
template <int NP, class F> __device__ __forceinline__ void conv8(CPR p, int l, const ChunkInfo& ci, int s0, int c, F emit) {
    if (s0 >= ci.nvalid) {
        const float z[8] = {0.f, 0.f, 0.f, 0.f, 0.f, 0.f, 0.f, 0.f};
#pragma unroll
        for (int jp = 0; jp < NP; ++jp) emit(jp, z, z);
        return;
    }
    const float* cw = p.ssd_conv_w + (size_t)l * 4 * 3072 + c; const float* cb = p.ssd_conv_b + (size_t)l * 3072 + c;
    const int t = ci.t0 + s0;
    unsigned raw[11][NP];
#pragma unroll
    for (int k = 0; k < 11; ++k) xbc_pad_raw<NP>(p.xbcb, ci.hist, ci.seqbase, t + k, c, raw[k]);
#pragma unroll
    for (int jp = 0; jp < NP; ++jp) {
        const f32x2_t w0 = *(const f32x2_t*)(cw + 2 * jp), w1 = *(const f32x2_t*)(cw + 3072 + 2 * jp), w2 = *(const f32x2_t*)(cw + 2 * 3072 + 2 * jp), w3 = *(const f32x2_t*)(cw + 3 * 3072 + 2 * jp), bb = *(const f32x2_t*)(cb + 2 * jp);
        f32x2_t rv[11];
#pragma unroll
        for (int k = 0; k < 11; ++k) rv[k] = (f32x2_t){bflo(raw[k][jp]), bfhi(raw[k][jp])};
        float lo[8], hi[8];
#pragma unroll
        for (int i = 0; i < 8; ++i) {
            const f32x2_t a = bb + w0 * rv[i] + w1 * rv[i + 1] + w2 * rv[i + 2] + w3 * rv[i + 3];
            const f32x2_t sv = silu2(a);
            lo[i] = sv.x; hi[i] = sv.y;
        }
        emit(jp, lo, hi);
    }
}
__device__ __forceinline__ float unit_dt(CPR p, int l, int u, int wid, int lane) {
    const ChunkInfo ci = chunk_info(p, l, u >> 2);
    return (lane < ci.nvalid) ? p.dtb[(size_t)(ci.row0 + lane) * 32 + (u & 3) * 8 + wid] : 0.f;
}
__device__ __forceinline__ void head_scan(CPR p, int l, int h, int lane, float dtv, float& ac, float& aclast) {
    const float a = -__expf(p.ssd_a_log[l * 32 + h]);
    ac = dtv * a;
#pragma unroll
    for (int o = 1; o < 64; o <<= 1) { const float t = __shfl_up(ac, o); if (lane >= o) ac += t; }
    aclast = __shfl(ac, 63);
}
__device__ __forceinline__ void ph_ssd_p1(CPR p, int l, LDSP lds) {
    const int tid = tid_opaque(), wid = tid >> 6, lane = tid & 63, r = lane & 31, hh = lane >> 5;
    PG8_LAS float* acS = (PG8_LAS float*)(lds + L_AC); PG8_LAS float* wS = (PG8_LAS float*)(lds + L_WS);
    PG8_LAS bf16_t* xT = (PG8_LAS bf16_t*)(lds + L_XT); PG8_LAS bf16_t* BT = (PG8_LAS bf16_t*)(lds + L_B);
    const int u0 = bid_opaque(), nb = nblk_opaque();
    float dt_nx = (u0 < NCHUNK * 4) ? unit_dt(p, l, u0, wid, lane) : 0.f;
    for (int u = u0; u < NCHUNK * 4; u += nb) {
        const int ck = u >> 2, g = u & 3, h = g * 8 + wid;
        const ChunkInfo ci = chunk_info(p, l, ck);
        const float dtv = dt_nx; float ac, aclast; head_scan(p, l, h, lane, dtv, ac, aclast);
        dt_nx = (u + nb < NCHUNK * 4) ? unit_dt(p, l, u + nb, wid, lane) : 0.f;
        wS[wid * 64 + lane] = __expf(aclast - ac) * dtv;
        if (lane == 63) p.dec[ck * 32 + h] = __expf(aclast);
        __syncthreads();
        { const int cc = tid & 63, s0 = (tid >> 6) * 8, g8 = s0 >> 3, hl = cc >> 3, p0 = (cc & 7) * 8;
          float wv[8];
#pragma unroll
          for (int i = 0; i < 8; ++i) wv[i] = wS[hl * 64 + s0 + i];
          conv8<4>(p, l, ci, s0, g * 512 + cc * 8, [&](int jp, const float (&lo)[8], const float (&hi)[8]) {
              const int R = hl * 64 + p0 + 2 * jp;
              *(PG8_LAS u32x4*)(lds + L_XT + xt_off(R, g8)) = (u32x4){pk2(lo[0] * wv[0], lo[1] * wv[1]), pk2(lo[2] * wv[2], lo[3] * wv[3]), pk2(lo[4] * wv[4], lo[5] * wv[5]), pk2(lo[6] * wv[6], lo[7] * wv[7])};
              *(PG8_LAS u32x4*)(lds + L_XT + xt_off(R + 1, g8)) = (u32x4){pk2(hi[0] * wv[0], hi[1] * wv[1]), pk2(hi[2] * wv[2], hi[3] * wv[3]), pk2(hi[4] * wv[4], hi[5] * wv[5]), pk2(hi[6] * wv[6], hi[7] * wv[7])}; }); }
        { const int q = tid & 63, s0 = (tid >> 6) * 8, g8 = s0 >> 3, n0 = 2 * q;
          conv8<1>(p, l, ci, s0, 2048 + g * 128 + n0, [&](int jp, const float (&lo)[8], const float (&hi)[8]) {
              *(PG8_LAS u32x4*)(lds + L_B + xt_off(n0, g8)) = (u32x4){pk2(lo[0], lo[1]), pk2(lo[2], lo[3]), pk2(lo[4], lo[5]), pk2(lo[6], lo[7])};
              *(PG8_LAS u32x4*)(lds + L_B + xt_off(n0 + 1, g8)) = (u32x4){pk2(hi[0], hi[1]), pk2(hi[2], hi[3]), pk2(hi[4], hi[5]), pk2(hi[6], hi[7])}; }); }
        __syncthreads();
        f32x16 acc[4][2];
#pragma unroll
        for (int a = 0; a < 4; ++a)
#pragma unroll
            for (int b = 0; b < 2; ++b) acc[a][b] = zero16();
#pragma unroll
        for (int ks = 0; ks < 4; ++ks) {
            bf16x8 A[2], Bf[4];
#pragma unroll
            for (int pt = 0; pt < 2; ++pt) A[pt] = *(const PG8_LAS bf16x8*)(lds + L_XT + xt_off(wid * 64 + 32 * pt + r, 2 * ks + hh));
#pragma unroll
            for (int nt = 0; nt < 4; ++nt) Bf[nt] = *(const PG8_LAS bf16x8*)(lds + L_B + xt_off(32 * nt + r, 2 * ks + hh));
#pragma unroll
            for (int nt = 0; nt < 4; ++nt)
#pragma unroll
                for (int pt = 0; pt < 2; ++pt) acc[nt][pt] = MFMA32(Bf[nt], A[pt], acc[nt][pt]);
        }
        bf16_t* dst = (bf16_t*)p.sst + ((size_t)ck * 32 + h) * 8192 + lane * 16;
#pragma unroll
        for (int nt = 0; nt < 4; ++nt)
#pragma unroll
            for (int pt = 0; pt < 2; ++pt) {
                const f32x16& a = acc[nt][pt];
                *(u32x4*)(dst + (nt * 2 + pt) * 1024) = (u32x4){pk2c(a[0], a[1]), pk2c(a[2], a[3]), pk2c(a[4], a[5]), pk2c(a[6], a[7])};
                *(u32x4*)(dst + (nt * 2 + pt) * 1024 + 8) = (u32x4){pk2c(a[8], a[9]), pk2c(a[10], a[11]), pk2c(a[12], a[13]), pk2c(a[14], a[15])};
            }
        __syncthreads();
    }
}
__device__ __forceinline__ int frag_to_logical(int x) {
    const int h = x >> 13, y = x & 8191, T = y >> 10, L = (y >> 4) & 63, q = y & 15;
    const int p = 32 * (T & 1) + (L & 31), n = 32 * (T >> 1) + (q & 3) + 8 * (q >> 2) + 4 * (L >> 5);
    return h * 8192 + p * 128 + n;
}
__device__ __forceinline__ void ph_ssd_p2(CPR p, int l) {
    const int gtid = bid_opaque() * 512 + tid_opaque(), gsz = nblk_opaque() * 512;
    const unsigned* sst2 = (const unsigned*)p.sst; unsigned* hp2 = (unsigned*)p.hpb;
    for (int e = gtid; e < 131072; e += gsz) {
        const int h = e >> 12; float2 hc = make_float2(0.f, 0.f);
        for (int c0 = 0; c0 < 256; c0 += 32) {
            unsigned S[32]; float d[32];
#pragma unroll
            for (int i = 0; i < 32; ++i) { S[i] = sst2[(size_t)(c0 + i) * 131072 + e]; d[i] = p.dec[(c0 + i) * 32 + h]; }
#pragma unroll
            for (int i = 0; i < 32; ++i) { hp2[(size_t)(c0 + i) * 131072 + e] = pk2(hc.x, hc.y); const f32x2_t hn = (f32x2_t){hc.x, hc.y} * d[i] + (f32x2_t){bflo(S[i]), bfhi(S[i])}; hc.x = hn.x; hc.y = hn.y; }
        }
        ((float2*)(p.out + O_P_STATE + (size_t)l * STATE_SZ))[frag_to_logical(2 * e) >> 1] = hc;
    }
    for (int i = gtid; i < DEC_BATCH * 131072; i += gsz) {
        const int b = i >> 17, e = i & 131071, h = e >> 12, ck = 256 + b;
        const int el = frag_to_logical(2 * e) >> 1;
        const float2 h0 = ((const float2*)(p.state_ssd + ((size_t)l * DEC_BATCH + b) * STATE_SZ))[el]; const unsigned Sw = sst2[(size_t)ck * 131072 + e]; const float2 S = make_float2(bflo(Sw), bfhi(Sw)); const float d = p.dec[ck * 32 + h];
        hp2[(size_t)ck * 131072 + e] = pk2(h0.x, h0.y);
        ((float2*)(p.out + O_S_STATE + ((size_t)l * DEC_BATCH + b) * STATE_SZ))[el] = make_float2(fmaf(d, h0.x, S.x), fmaf(d, h0.y, S.y));
    }
}
__device__ __forceinline__ void ph_ssd_p3(CPR p, int l, LDSP lds) {
    const int tid = tid_opaque(), wid = tid >> 6, lane = tid & 63, r = lane & 31, hh = lane >> 5;
    PG8_LAS float* acS = (PG8_LAS float*)(lds + L_AC); PG8_LAS float* dtS = (PG8_LAS float*)(lds + L_DT); PG8_LAS float* red = (PG8_LAS float*)(lds + L_WS);
    PG8_LAS bf16_t* xT = (PG8_LAS bf16_t*)(lds + L_XT);
    const int u0 = bid_opaque(), nb = nblk_opaque();
    float dt_nx = (u0 < NCHUNK * 4) ? unit_dt(p, l, u0, wid, lane) : 0.f;
    for (int u = u0; u < NCHUNK * 4; u += nb) {
        const int ck = u >> 2, g = u & 3, h = g * 8 + wid;
        const ChunkInfo ci = chunk_info(p, l, ck);
        const float Dh = p.ssd_d[l * 32 + h];
        { const float dtv = dt_nx; float ac, aclast; head_scan(p, l, h, lane, dtv, ac, aclast); acS[wid * 64 + lane] = ac; dtS[wid * 64 + lane] = dtv; }
        dt_nx = (u + nb < NCHUNK * 4) ? unit_dt(p, l, u + nb, wid, lane) : 0.f;
        bf16x8 HA[8][2];
        const bf16_t* hp = p.hpb + ((size_t)ck * 32 + h) * 8192;
        { const int cc = tid & 63, s0 = (tid >> 6) * 8, g8 = s0 >> 3, hl = cc >> 3, p0 = (cc & 7) * 8;
          conv8<4>(p, l, ci, s0, g * 512 + cc * 8, [&](int jp, const float (&lo)[8], const float (&hi)[8]) {
              const int R = hl * 64 + p0 + 2 * jp;
              *(PG8_LAS u32x4*)(lds + L_XT + xt_off(R, g8)) = (u32x4){pk2(lo[0], lo[1]), pk2(lo[2], lo[3]), pk2(lo[4], lo[5]), pk2(lo[6], lo[7])};
              *(PG8_LAS u32x4*)(lds + L_XT + xt_off(R + 1, g8)) = (u32x4){pk2(hi[0], hi[1]), pk2(hi[2], hi[3]), pk2(hi[4], hi[5]), pk2(hi[6], hi[7])}; }); }
        { const int q = tid & 63, s0 = (tid >> 6) * 8, n4 = 4 * (q & 31), off = (q < 32 ? L_B : L_C) + n4 * 2;
          conv8<2>(p, l, ci, s0, (q < 32 ? 2048 : 2560) + g * 128 + n4, [&](int jp, const float (&lo)[8], const float (&hi)[8]) {
#pragma unroll
              for (int i = 0; i < 8; ++i) *(PG8_LAS unsigned*)(lds + off + jp * 4 + (s0 + i) * PR * 2) = pk2(lo[i], hi[i]); }); }
#pragma unroll
        for (int ks = 0; ks < 8; ++ks) { HA[ks][0] = *(const bf16x8*)(hp + ((ks >> 1) * 2 + 0) * 1024 + lane * 16 + 8 * (ks & 1)); HA[ks][1] = *(const bf16x8*)(hp + ((ks >> 1) * 2 + 1) * 1024 + lane * 16 + 8 * (ks & 1)); }
        __syncthreads();
        f32x16 yd[2][2];
#pragma unroll
        for (int a = 0; a < 2; ++a)
#pragma unroll
            for (int b = 0; b < 2; ++b) yd[a][b] = zero16();
#pragma unroll
        for (int ks = 0; ks < 8; ++ks) {
            bf16x8 Bf[2];
#pragma unroll
            for (int lt = 0; lt < 2; ++lt) { const int eo = ((32 * lt + r) * PR + 16 * ks + 4 * hh) * 2;
                Bf[lt] = join44(*(const PG8_LAS bf16x4*)(lds + L_C + eo), *(const PG8_LAS bf16x4*)(lds + L_C + eo + 16)); }
#pragma unroll
            for (int pt = 0; pt < 2; ++pt)
#pragma unroll
                for (int lt = 0; lt < 2; ++lt) yd[pt][lt] = MFMA32(HA[ks][pt], Bf[lt], yd[pt][lt]);
        }
#pragma unroll
        for (int lt = 0; lt < 2; ++lt) { const float eal = __expf(acS[wid * 64 + 32 * lt + r]);
#pragma unroll
            for (int pt = 0; pt < 2; ++pt)
#pragma unroll
                for (int q = 0; q < 16; q += 2) { const f32x2_t t = (f32x2_t){yd[pt][lt][q], yd[pt][lt][q + 1]} * eal; yd[pt][lt][q] = t.x; yd[pt][lt][q + 1] = t.y; } }
        u32x4 zraw[8];
#pragma unroll
        for (int i = 0; i < 8; ++i) { const int e = tid + 512 * i, tok = e >> 6; zraw[i] = *(const u32x4*)(p.zb + (size_t)(ci.row0 + (tok < ci.nvalid ? tok : 0)) * 2048 + g * 512 + (e & 63) * 8); }
#pragma unroll
        for (int tix = 0; tix < 3; ++tix) {
            const int st = (tix == 2) ? 1 : 0, lt = (tix == 0) ? 0 : 1;
            f32x16 G = zero16();
#pragma unroll
            for (int ks = 0; ks < 8; ++ks) {
                const bf16x8 A = *(const PG8_LAS bf16x8*)(lds + L_B + ((32 * st + r) * PR + 16 * ks + 8 * hh) * 2);
                const bf16x8 Bf = *(const PG8_LAS bf16x8*)(lds + L_C + ((32 * lt + r) * PR + 16 * ks + 8 * hh) * 2);
                G = MFMA32(A, Bf, G);
            }
            const int lcol = 32 * lt + r; const float acl = acS[wid * 64 + lcol];
            float mv[16];
#pragma unroll
            for (int q = 0; q < 16; q += 2) {
                const int s = 32 * st + (q & 3) + 8 * (q >> 2) + 4 * hh;
                const f32x2_t acs = *(const PG8_LAS f32x2_t*)(acS + wid * 64 + s), dts = *(const PG8_LAS f32x2_t*)(dtS + wid * 64 + s);
                const f32x2_t dd = __builtin_elementwise_min((f32x2_t){acl, acl} - acs, (f32x2_t){0.f, 0.f}) * 1.4426950408889634f;
                const f32x2_t v2 = (f32x2_t){G[q], G[q + 1]} * exp2_2(dd) * dts;
                float va = (s <= lcol) ? v2.x : 0.f, vb = (s + 1 <= lcol) ? v2.y : 0.f;
                if (s == lcol) va += Dh; if (s + 1 == lcol) vb += Dh;
                mv[q] = va; mv[q + 1] = vb;
            }
#pragma unroll
            for (int kk = 0; kk < 2; ++kk) {
                const float m8[8] = {mv[8 * kk], mv[8 * kk + 1], mv[8 * kk + 2], mv[8 * kk + 3], mv[8 * kk + 4], mv[8 * kk + 5], mv[8 * kk + 6], mv[8 * kk + 7]};
                const bf16x8 Bm = pack8f(m8);
#pragma unroll
                for (int pt = 0; pt < 2; ++pt) {
                    const int R = wid * 64 + 32 * pt + r, g = 4 * st + 2 * kk;
                    const bf16x4 lo = *(const PG8_LAS bf16x4*)(lds + L_XT + xt_off(R, g) + 8 * hh), hi = *(const PG8_LAS bf16x4*)(lds + L_XT + xt_off(R, g + 1) + 8 * hh);
                    yd[pt][lt] = MFMA32(join44(lo, hi), Bm, yd[pt][lt]);
                }
            }
        }
        __syncthreads();
#pragma unroll
        for (int i = 0; i < 8; ++i) { const int e = tid + 512 * i; *(PG8_LAS u32x4*)(lds + L_XT + (e >> 6) * ZP + (e & 63) * 16) = zraw[i]; }
        __syncthreads();
        float ssl[2];
#pragma unroll
        for (int lt = 0; lt < 2; ++lt) {
            const int lcol = 32 * lt + r;
            float ss = 0.f;
#pragma unroll
            for (int pt = 0; pt < 2; ++pt)
#pragma unroll
                for (int i = 0; i < 4; ++i) {
                    const u32x2 zw = *(const PG8_LAS u32x2*)(lds + L_XT + lcol * ZP + (wid * 64 + 32 * pt + 8 * i + 4 * hh) * 2);
                    const f32x2_t za = (f32x2_t){bflo(zw.x), bfhi(zw.x)}, zb2 = (f32x2_t){bflo(zw.y), bfhi(zw.y)};
                    const f32x2_t ga = (f32x2_t){yd[pt][lt][4 * i], yd[pt][lt][4 * i + 1]} * silu2(za), gb2 = (f32x2_t){yd[pt][lt][4 * i + 2], yd[pt][lt][4 * i + 3]} * silu2(zb2);
                    yd[pt][lt][4 * i] = ga.x; yd[pt][lt][4 * i + 1] = ga.y; yd[pt][lt][4 * i + 2] = gb2.x; yd[pt][lt][4 * i + 3] = gb2.y;
                    const f32x2_t sq = ga * ga + gb2 * gb2; ss += sq.x + sq.y;
                }
            ss += __shfl_xor(ss, 32);
            ssl[lt] = ss;
        }
        if (hh == 0) { red[wid * 64 + r] = ssl[0]; red[wid * 64 + 32 + r] = ssl[1]; }
        __syncthreads();
#pragma unroll
        for (int lt = 0; lt < 2; ++lt) {
            const int lcol = 32 * lt + r;
            float tot = 0.f;
#pragma unroll
            for (int w = 0; w < 8; ++w) tot += red[w * 64 + lcol];
            const float rstd = rsqrtf(tot * (1.0f / 512.f) + EPS);
#pragma unroll
            for (int pt = 0; pt < 2; ++pt)
#pragma unroll
                for (int i = 0; i < 4; ++i)
                { const f32x2_t a = (f32x2_t){yd[pt][lt][4 * i], yd[pt][lt][4 * i + 1]} * rstd, b = (f32x2_t){yd[pt][lt][4 * i + 2], yd[pt][lt][4 * i + 3]} * rstd;
                    *(PG8_LAS u32x2*)(lds + L_XT + lcol * ZP + (wid * 64 + 32 * pt + 8 * i + 4 * hh) * 2) = (u32x2){pk2(a.x, a.y), pk2(b.x, b.y)}; }
        }
        __syncthreads();
#pragma unroll
        for (int i = 0; i < 8; ++i) { const int e = tid + 512 * i, tok = e >> 6;
            if (tok < ci.nvalid) *(u32x4*)(p.yn + (size_t)(ci.row0 + tok) * 2048 + g * 512 + (e & 63) * 8) = *(const PG8_LAS u32x4*)(lds + L_XT + tok * ZP + (e & 63) * 16); }
        __syncthreads();
    }
}
#ifndef ATT_EXIT_P
#define ATT_EXIT_P 1e-20f
#endif
typedef short v4i16_t __attribute__((ext_vector_type(4)));
constexpr int AT_PITCH = 272;
constexpr int AT_TILE = 32 * AT_PITCH;
constexpr int ATT_LDS = 8 * 2 * AT_TILE;
__device__ __forceinline__ void ph_attn(CPR p, int l, LDSP lds) {
    const int tidx = tid_opaque(); const int lane = tidx & 63, r = lane & 31, hh = lane >> 5, wv = tidx >> 6, NGW = nblk_opaque() * 8, gw = (bid_opaque() * 8 + wv + (NGW >> 1)) % NGW;
    const bf16_t* kbb = p.kb; const bf16_t* vbb = p.vb;
    const float* ck = p.cache_k + (size_t)l * DEC_BATCH * PAST_LEN * 1024; const float* cv = p.cache_v + (size_t)l * DEC_BATCH * PAST_LEN * 1024;
    const float scale = 0.08838834764831845f;
    LDSP kl = lds + wv * (2 * AT_TILE); LDSP vl = kl + AT_TILE;
    const int st_g = (lane >> 5) * 1024 + (lane & 31) * 4;
    const int st_l = (lane >> 5) * AT_PITCH + (lane & 31) * 8;
    const int vs_g = (lane >> 4) * 1024 + (lane & 15) * 8;
    const int vs_l = (lane >> 4) * AT_PITCH + (lane & 15) * 16;
    const int ka_off = r * AT_PITCH + 16 * hh;
    const int vt_off = (4 * hh + ((lane & 15) >> 2)) * AT_PITCH + (16 * ((lane >> 4) & 1) + 4 * (lane & 3)) * 2;
    const int nwg = NGW >> 3, wgr = gw >> 3;
    for (int U = wgr; U < 512 + 32; U += nwg) {
        int hd, b, rowq0, P0;
        if (U < 512) { hd = U & 7; const int qt = 8 * (U >> 3) + wv; b = -1; rowq0 = 32 * qt; P0 = 32 * qt; }
        else { hd = wv; b = U - 512; rowq0 = M_P + 32 * b; P0 = PAST_LEN; }
        const bf16_t* qrow = p.qb + (size_t)(rowq0 + r) * 1024 + hd * 128 + 8 * hh;
        bf16x8 qf[8];
#pragma unroll
        for (int ks = 0; ks < 8; ++ks) qf[ks] = *(const bf16x8*)(qrow + 16 * ks);
        f32x16 O[4];
#pragma unroll
        for (int d = 0; d < 4; ++d) O[d] = zero16();
        float carry = 1.0f;
        const int ktd = P0 >> 5;
        u32x4 buf[16];
        { const bf16_t* kq = kbb + (size_t)(rowq0 + r) * 1024 + hd * 128 + 8 * hh;
#pragma unroll
          for (int ks = 0; ks < 8; ++ks) buf[8 + ks] = *(const u32x4*)(kq + 16 * ks); }
        for (int kt = ktd; kt >= 0; --kt) {
            const bool bfs = (b < 0) || (kt == ktd);
            f32x16 S = zero16();
            if (bfs) {
                const bf16_t* vq = vbb + (size_t)(b < 0 ? 32 * kt : rowq0) * 1024 + hd * 128 + vs_g;
#pragma unroll
                for (int i = 0; i < 8; ++i) buf[i] = *(const u32x4*)(vq + 4096 * i);
#pragma unroll
                for (int ks = 0; ks < 8; ++ks) S = MFMA32(__builtin_bit_cast(bf16x8, buf[8 + ks]), qf[ks], S);
            } else {
                const float* vb = cv + ((size_t)b * PAST_LEN + 32 * kt) * 1024 + hd * 128 + st_g;
#pragma unroll
                for (int i = 0; i < 16; ++i) buf[i] = *(const u32x4*)(vb + 2048 * i);
                asm volatile("s_waitcnt lgkmcnt(0)" ::: "memory");
#pragma unroll
                for (int ks = 0; ks < 8; ++ks) S = MFMA32(*(const PG8_LAS bf16x8*)(kl + ka_off + 32 * ks), qf[ks], S);
            }
            const bool diag = (kt == ktd);
            float kp[16], sg[16];
#pragma unroll
            for (int q = 0; q < 16; q += 2) {
                const int key = (q & 3) + 8 * (q >> 2) + 4 * hh;
                const f32x2_t z = (f32x2_t){S[q], S[q + 1]} * scale, e = exp2_2(__builtin_elementwise_abs(z) * (-1.4426950408889634f)), big = rcp_2(e + 1.0f), small = e * big;
                const bool v0 = !diag || key < r, v1 = !diag || key + 1 < r;
                sg[q] = v0 ? (z.x >= 0.f ? big.x : small.x) : 0.f; kp[q] = v0 ? (z.x >= 0.f ? small.x : big.x) : 1.0f;
                sg[q + 1] = v1 ? (z.y >= 0.f ? big.y : small.y) : 0.f; kp[q + 1] = v1 ? (z.y >= 0.f ? small.y : big.y) : 1.0f;
            }
            float T[4], Tp[4];
#pragma unroll
            for (int gi = 0; gi < 4; ++gi) { T[gi] = (kp[4 * gi] * kp[4 * gi + 1]) * (kp[4 * gi + 2] * kp[4 * gi + 3]); Tp[gi] = __shfl_xor(T[gi], 32); }
            float wg[16]; float aft = carry;
#pragma unroll
            for (int gi = 3; gi >= 0; --gi) {
                float suf = aft * (hh == 0 ? Tp[gi] : 1.0f);
#pragma unroll
                for (int j = 3; j >= 0; --j) { wg[4 * gi + j] = sg[4 * gi + j] * suf; suf *= kp[4 * gi + j]; }
                aft *= T[gi] * Tp[gi];
            }
            carry = aft;
            bf16x8 Pf[2];
#pragma unroll
            for (int kk = 0; kk < 2; ++kk) {
                const float w8[8] = {wg[8 * kk], wg[8 * kk + 1], wg[8 * kk + 2], wg[8 * kk + 3], wg[8 * kk + 4], wg[8 * kk + 5], wg[8 * kk + 6], wg[8 * kk + 7]};
                Pf[kk] = pack8f(w8);
            }
            if (bfs) {
#pragma unroll
                for (int i = 0; i < 8; ++i) *(PG8_LAS u32x4*)(vl + vs_l + 4 * AT_PITCH * i) = buf[i];
            } else {
#pragma unroll
                for (int i = 0; i < 16; ++i) { const float4 t = __builtin_bit_cast(float4, buf[i]); *(PG8_LAS u32x2*)(vl + st_l + 2 * AT_PITCH * i) = (u32x2){pk2(t.x, t.y), pk2(t.z, t.w)}; }
            }
            const bool more = (kt > 0) && !__all(carry < ATT_EXIT_P);
            if (more) {
                if (b < 0) { const bf16_t* kq = kbb + (size_t)(32 * (kt - 1) + r) * 1024 + hd * 128 + 8 * hh;
#pragma unroll
                    for (int ks = 0; ks < 8; ++ks) buf[8 + ks] = *(const u32x4*)(kq + 16 * ks); }
                else { const float* kb = ck + ((size_t)b * PAST_LEN + 32 * (kt - 1)) * 1024 + hd * 128 + st_g;
#pragma unroll
                    for (int i = 0; i < 16; ++i) buf[i] = *(const u32x4*)(kb + 2048 * i); }
            }
            asm volatile("s_waitcnt lgkmcnt(0)" ::: "memory");
#pragma unroll
            for (int kk = 0; kk < 2; ++kk)
#pragma unroll
                for (int d = 0; d < 4; ++d) {
                    const bf16x4 lo = __builtin_bit_cast(bf16x4, __builtin_amdgcn_ds_read_tr16_b64_v4i16((PG8_LAS v4i16_t*)(vl + vt_off + kk * 16 * AT_PITCH + d * 64)));
                    const bf16x4 hi = __builtin_bit_cast(bf16x4, __builtin_amdgcn_ds_read_tr16_b64_v4i16((PG8_LAS v4i16_t*)(vl + vt_off + kk * 16 * AT_PITCH + 8 * AT_PITCH + d * 64)));
                    O[d] = MFMA32(Pf[kk], join44(lo, hi), O[d]);
                }
            if (!more) break;
            if (b >= 0) {
#pragma unroll
                for (int i = 0; i < 16; ++i) { const float4 t = __builtin_bit_cast(float4, buf[i]); *(PG8_LAS u32x2*)(kl + st_l + 2 * AT_PITCH * i) = (u32x2){pk2(t.x, t.y), pk2(t.z, t.w)}; }
            }
        }
#pragma unroll
        for (int d = 0; d < 4; ++d)
#pragma unroll
            for (int q = 0; q < 16; ++q) *(PG8_LAS unsigned short*)(kl + ((q & 3) + 8 * (q >> 2) + 4 * hh) * AT_PITCH + (32 * d + r) * 2) = (unsigned short)pk2c(O[d][q], 0.0f);
        asm volatile("s_waitcnt lgkmcnt(0)" ::: "memory");
#pragma unroll
        for (int i = 0; i < 8; ++i) *(u32x4*)(p.att + (size_t)(rowq0 + (lane >> 4) + 4 * i) * 1024 + hd * 128 + (lane & 15) * 8) = *(const PG8_LAS u32x4*)(kl + vs_l + 4 * AT_PITCH * i);
    }
}

constexpr int MEGA_BODY = (ATT_LDS > pg8::STAGE_BYTES ? ATT_LDS : pg8::STAGE_BYTES);
constexpr int MEGA_LDS = MEGA_BODY + 64;
#ifndef WGM_IN
#define WGM_IN 4
#endif
#ifndef WGM_UP
#define WGM_UP 8
#endif
#ifndef PROBE_GBIG
#define PROBE_GBIG 1
#endif
#ifndef PROBE_GSMALL
#define PROBE_GSMALL 1
#endif
#ifndef PROBE_S
#define PROBE_S 1
#endif
#ifndef PROBE_A
#define PROBE_A 1
#endif
#ifndef PROBE_M
#define PROBE_M 1
#endif
#ifndef PROBE_P1
#define PROBE_P1 PROBE_S
#endif
#ifndef PROBE_P3
#define PROBE_P3 PROBE_S
#endif
#ifndef PROBE_P2
#define PROBE_P2 PROBE_M
#endif
#ifndef PROBE_FFN
#define PROBE_FFN PROBE_M
#endif
#ifndef PROBE_PRO
#define PROBE_PRO PROBE_M
#endif
#ifndef PROBE_NORM
#define PROBE_NORM 0
#endif
#ifndef PROBE_BAR
#define PROBE_BAR 1
#endif
#define GRID_BARRIER() do { for (int rb_ = 0; rb_ < PROBE_BAR; ++rb_) xcd_barrier(bar); } while (0)
template <class Epi> __device__ __forceinline__ void gemm_site(LDSP lds, const bf16_t* A, const bf16_t* Bt, int N, int K, const Epi& E) {
    for (int rep_ = 0; rep_ < (N > 1024 ? PROBE_GBIG : PROBE_GSMALL); ++rep_) {
    Gemm g; g.A = A; g.Bt = Bt; g.M = M_ALL; g.N = N; g.K = K;
    StaticOrder S; S.init(M_ALL, N, nblk_opaque(), bid_opaque(), N == 8192 ? WGM_UP : WGM_IN);
    pg8::gemm_phase<Epi, StaticOrder, false>(lds, g, S, E, nullptr);
    }
}
template <bool HALO, class Epi> __device__ __forceinline__ void gemm_small(LDSP lds, const bf16_t* A, const bf16_t* Bt, int K, const Epi& E) {
    const int tid = tid_opaque(), wid = tid >> 6, lane = tid & 63, r = lane & 31, hh = lane >> 5;
    const int nb = nblk_opaque();
    for (int t = bid_opaque(); t < (HALO ? 512 : 256); t += nb) {
        const int m0 = HALO ? (t >> 6) * 64 : M_P + (t >> 4) * 64, n0 = HALO ? (t & 63) * 64 : (t & 15) * 64, kbeg = wid * (K >> 3), nst = K >> 7;
        const int nrow = HALO ? (n0 >> 7) * 256 + (n0 & 127) : n0;
        const bf16_t* ap = A + (size_t)(m0 + r) * K + kbeg + 8 * hh; const bf16_t* bp = Bt + (size_t)(nrow + r) * K + kbeg + 8 * hh;
        const size_t hop = (size_t)32 * K;
        f32x16 acc[2][2];
#pragma unroll
        for (int a = 0; a < 2; ++a)
#pragma unroll
            for (int b = 0; b < 2; ++b) acc[a][b] = zero16();
        bf16x8 fa[4][2], fb[4][2];
#pragma unroll
        for (int s = 0; s < 3; ++s) { const int ko = 16 * (s < nst ? s : 0);
            fa[s][0] = *(const bf16x8*)(ap + ko); fa[s][1] = *(const bf16x8*)(ap + hop + ko); fb[s][0] = *(const bf16x8*)(bp + ko); fb[s][1] = *(const bf16x8*)(bp + hop + ko); }
        for (int st = 0; st < nst; st += 2) {
#pragma unroll
            for (int s2 = 0; s2 < 2; ++s2) {
                const int cur = (st + s2) & 3, nxs = (st + s2 + 3) & 3, nx = st + s2 + 3, ko = 16 * (nx < nst ? nx : 0);
                if (((st >> 1) & 1) == 0) {
                    fa[(s2 + 3) & 3][0] = *(const bf16x8*)(ap + ko); fa[(s2 + 3) & 3][1] = *(const bf16x8*)(ap + hop + ko); fb[(s2 + 3) & 3][0] = *(const bf16x8*)(bp + ko); fb[(s2 + 3) & 3][1] = *(const bf16x8*)(bp + hop + ko);
#pragma unroll
                    for (int a = 0; a < 2; ++a)
#pragma unroll
                        for (int b = 0; b < 2; ++b) acc[a][b] = MFMA32(fa[s2][a], fb[s2][b], acc[a][b]);
                } else {
                    fa[(s2 + 1) & 3][0] = *(const bf16x8*)(ap + ko); fa[(s2 + 1) & 3][1] = *(const bf16x8*)(ap + hop + ko); fb[(s2 + 1) & 3][0] = *(const bf16x8*)(bp + ko); fb[(s2 + 1) & 3][1] = *(const bf16x8*)(bp + hop + ko);
#pragma unroll
                    for (int a = 0; a < 2; ++a)
#pragma unroll
                        for (int b = 0; b < 2; ++b) acc[a][b] = MFMA32(fa[s2 + 2][a], fb[s2 + 2][b], acc[a][b]);
                }
                (void)cur; (void)nxs;
            }
        }
        PG8_LAS float* red = (PG8_LAS float*)lds;
#pragma unroll
        for (int a = 0; a < 2; ++a)
#pragma unroll
            for (int b = 0; b < 2; ++b)
#pragma unroll
                for (int q = 0; q < 16; ++q) red[((wid * 4 + a * 2 + b) * 16 + q) * 64 + lane] = acc[a][b][q];
        __syncthreads();
        { const int blk = wid & 3, q0 = (wid >> 2) * 8, a = blk >> 1, b = blk & 1;
#pragma unroll
          for (int q = 0; q < 8; ++q) { float v = 0.f;
#pragma unroll
              for (int w = 0; w < 8; ++w) v += red[((w * 4 + blk) * 16 + q0 + q) * 64 + lane];
              const int qq = q0 + q; E.elem(m0 + 32 * a + (qq & 3) + 8 * (qq >> 2) + 4 * hh, n0 + 32 * b + r, v); } }
        __syncthreads();
    }
}
template <class Epi> __device__ __forceinline__ void gemm_site_n1024(LDSP lds, const bf16_t* A, const bf16_t* Bt, int K, const Epi& E) {
    for (int rep_ = 0; rep_ < PROBE_GSMALL; ++rep_) {
    Gemm g; g.A = A; g.Bt = Bt; g.M = M_P; g.N = 1024; g.K = K;
    StaticOrder S; S.init(M_P, 1024, nblk_opaque(), bid_opaque());
    pg8::gemm_phase<Epi, StaticOrder, false>(lds, g, S, E, nullptr);
    gemm_small<false>(lds, A, Bt, K, E);
    }
}
__global__ void __launch_bounds__(512, 2) k_mega(Params p_) {
    extern __shared__ __attribute__((aligned(16))) unsigned char shm[];
    LDSP lds = (LDSP)shm;
    volatile LAS unsigned* xbw = (volatile LAS unsigned*)(lds + MEGA_BODY);
    if (threadIdx.x < 4) xbw[threadIdx.x] = 0u;
    __syncthreads();
    XcdBarrier bar = xcd_barrier_post(kargs()->bar, xbw);
    for (int rep_ = 0; rep_ < PROBE_PRO; ++rep_) { { CPR p = *kargs(); ph_wt(p, lds); }
    { CPR p = *kargs(); ph_xprep(p); } }
    GRID_BARRIER();
    for (int l = 0; l < DEPTH; ++l) {
        { CPR p = *kargs(); float* out = p.out; const bf16_t* wl = p.wt + (size_t)l * WT_LAYER; EpiIn E; E.rs = p.rs; E.zb = p.zb; E.xbcb = p.xbcb; E.qb = p.qb; E.kb = p.kb; E.vb = p.vb; E.gb = p.gb; E.dtb = p.dtb; E.dt_bias = p.ssd_dt_bias + l * 32;
          E.kP = out + O_P_K + (size_t)l * M_P * 1024; E.vP = out + O_P_V + (size_t)l * M_P * 1024; E.kS = out + O_S_K + (size_t)l * M_S * 1024; E.vS = out + O_S_V + (size_t)l * M_S * 1024;
          E.convP = out + O_P_CONV + (size_t)l * 3 * 3072; E.convS = out + O_S_CONV + (size_t)l * DEC_BATCH * 3 * 3072;
          gemm_site(lds, p.xb, wl + OW1, N1, 1024, E); }
        GRID_BARRIER();
        for (int rep_ = 0; rep_ < PROBE_P1; ++rep_) { CPR p = *kargs(); ph_ssd_p1(p, l, lds); }
        for (int rep_ = 0; rep_ < PROBE_A; ++rep_) { CPR p = *kargs(); ph_attn(p, l, lds); }
        GRID_BARRIER();
        for (int rep_ = 0; rep_ < PROBE_P2; ++rep_) { CPR p = *kargs(); ph_ssd_p2(p, l); }
        { CPR p = *kargs(); float* out = p.out; const bf16_t* wl = p.wt + (size_t)l * WT_LAYER; EpiBr E; E.gb = p.gb; E.t1in = nullptr; E.dst = p.t1; E.mode = 0; E.pad = 0; gemm_site_n1024(lds, p.att, wl + OW3, 1024, E); }
        { CPR p = *kargs(); float* out = p.out; const bf16_t* wl = p.wt + (size_t)l * WT_LAYER; EpiPlain E; E.dst = p.plea; gemm_site_n1024(lds, p.pb + (size_t)l * M_ALL * 256, wl + OW7, 256, E); }
        GRID_BARRIER();
        for (int rep_ = 0; rep_ < PROBE_P3; ++rep_) { CPR p = *kargs(); ph_ssd_p3(p, l, lds); }
        GRID_BARRIER();
        { CPR p = *kargs(); float* out = p.out; const bf16_t* wl = p.wt + (size_t)l * WT_LAYER; EpiBr E; E.gb = p.gb; E.t1in = p.t1; E.dst = p.mixin; E.mode = 1; E.pad = 0; gemm_site_n1024(lds, p.yn, wl + OW2, 2048, E); }
        GRID_BARRIER();
        { CPR p = *kargs(); float* out = p.out; const bf16_t* wl = p.wt + (size_t)l * WT_LAYER; EpiF32Out E; E.dst = p.mixed; gemm_site_n1024(lds, p.mixin, wl + OW4, 1024, E); }
        GRID_BARRIER();
        { CPR p = *kargs(); float* out = p.out; (void)out; ph_norm(p.mixed, p.norm_post_mix + l * 1024, p.xr, p.xb, nullptr, nullptr, p.xh); }
        GRID_BARRIER();
        { CPR p = *kargs(); const bf16_t* wl = p.wt + (size_t)l * WT_LAYER; EpiHalo E; E.rs = nullptr; E.gh = p.gh; gemm_small<true>(lds, p.xh, wl + OW5, 1024, E); }
        GRID_BARRIER();
        { CPR p = *kargs(); float* out = p.out; const bf16_t* wl = p.wt + (size_t)l * WT_LAYER; EpiUpAct E; E.rs = p.rs2; E.gh = p.gh; E.ffb = p.ffb;
          E.ffnP = out + O_P_FFN + (size_t)l * 2 * D_FF; E.ffnS = out + O_S_FFN + (size_t)l * DEC_BATCH * 2 * D_FF;
          E.cw = p.ffn_conv_w + (size_t)l * 3 * D_FF; E.cb = p.ffn_conv_b + (size_t)l * D_FF; E.hist = p.state_ffn_conv + (size_t)l * DEC_BATCH * 2 * D_FF;
          gemm_site(lds, p.xb, wl + OW5, 8192, 1024, E); }
        GRID_BARRIER();
        { CPR p = *kargs(); float* out = p.out; const bf16_t* wl = p.wt + (size_t)l * WT_LAYER; EpiF32Out E; E.dst = p.down; gemm_site_n1024(lds, p.ffb, wl + OW6, 4096, E); }
        GRID_BARRIER();
        { CPR p = *kargs(); float* out = p.out; (void)out; ph_norm(p.down, p.norm_post_ffn + l * 1024, p.xr, nullptr, nullptr, nullptr); }
        GRID_BARRIER();
        { CPR p = *kargs(); float* out = p.out; const bf16_t* wl = p.wt + (size_t)l * WT_LAYER; EpiPle E; E.plea = p.plea; E.dst = p.ple; gemm_site_n1024(lds, p.xr, wl + OW8, 1024, E); }
        GRID_BARRIER();
        { CPR p = *kargs(); float* out = p.out; (void)out; ph_norm(p.ple, p.norm_ple + l * 1024, p.xr, p.xb, l == DEPTH - 1 ? out + O_Y_P : nullptr, out + O_Y_S); }
        if (l + 1 < DEPTH) GRID_BARRIER();
    }
}

struct Bump { char* base; size_t off; template <class T> T* take(size_t n) { off = (off + 255) & ~(size_t)255; T* p = (T*)(base + off); off += n * sizeof(T); return p; } };
__global__ void k_fail_code(float* out, float code) { if (threadIdx.x == 0 && blockIdx.x == 0) out[0] = code; }

extern "C" void kernel_launch(void* const* d_in, const int* in_sizes, int n_in, void* d_out, int out_size, void* d_ws, size_t ws_size, hipStream_t stream) {
    Params p; memset(&p, 0, sizeof p);
    p.x_prompt = (const float*)d_in[0]; p.x_sample = (const float*)d_in[1]; p.state_ssd_conv = (const float*)d_in[2]; p.state_ssd = (const float*)d_in[3];
    p.cache_k = (const float*)d_in[4]; p.cache_v = (const float*)d_in[5]; p.state_ffn_conv = (const float*)d_in[6]; p.p_prompt = (const float*)d_in[7]; p.p_sample = (const float*)d_in[8];
    p.norm_pre_mix = (const float*)d_in[9]; p.w_in = (const float*)d_in[10]; p.ssd_conv_w = (const float*)d_in[11]; p.ssd_conv_b = (const float*)d_in[12]; p.ssd_dt_bias = (const float*)d_in[13];
    p.ssd_a_log = (const float*)d_in[14]; p.ssd_d = (const float*)d_in[15]; p.ssd_norm = (const float*)d_in[16]; p.w_br_ssd = (const float*)d_in[17]; p.w_br_sb = (const float*)d_in[18];
    p.w_out = (const float*)d_in[19]; p.norm_post_mix = (const float*)d_in[20]; p.norm_pre_ffn = (const float*)d_in[21]; p.w_up = (const float*)d_in[22]; p.ffn_conv_w = (const float*)d_in[23];
    p.ffn_conv_b = (const float*)d_in[24]; p.w_down = (const float*)d_in[25]; p.norm_post_ffn = (const float*)d_in[26]; p.w_ple = (const float*)d_in[27]; p.w_ple_gate = (const float*)d_in[28];
    p.norm_ple = (const float*)d_in[29];
    float* out = (float*)d_out; p.out = out;

    Bump B{(char*)d_ws, 0};
    const size_t R = M_ALL;
    p.bar = B.take<unsigned>(4096);
    p.wt = B.take<bf16_t>(DEPTH * WT_LAYER);
    p.xr = B.take<bf16_t>(R * 1024); p.xb = B.take<bf16_t>(R * 1024); p.rs = B.take<float>(R); p.rs2 = B.take<float>(R); p.pb = B.take<bf16_t>(DEPTH * R * 256);
    p.zb = B.take<bf16_t>(R * 2048); p.xbcb = B.take<bf16_t>(R * 3072); p.qb = B.take<bf16_t>(R * 1024); p.kb = B.take<bf16_t>(R * 1024); p.vb = B.take<bf16_t>(R * 1024); p.gb = B.take<bf16_t>(R * 2048); p.dtb = B.take<float>(R * 32);
    p.sst = B.take<float>((size_t)NCHUNK * STATE_SZ / 2); p.dec = B.take<float>(NCHUNK * 32); p.hpb = B.take<bf16_t>((size_t)NCHUNK * STATE_SZ);
    p.yn = B.take<bf16_t>(R * 2048); p.att = B.take<bf16_t>(R * 1024); p.t1 = B.take<bf16_t>(R * 1024); p.mixin = B.take<bf16_t>(R * 1024); p.mixed = B.take<bf16_t>(R * 1024);
    p.gh = B.take<bf16_t>((size_t)768 * 4096); p.xh = B.take<bf16_t>((size_t)768 * 1024); p.ffb = B.take<bf16_t>(R * 4096); p.down = B.take<bf16_t>(R * 1024); p.plea = B.take<bf16_t>(R * 1024); p.ple = B.take<bf16_t>(R * 1024);
    if (B.off > ws_size) { k_fail_code<<<1, 64, 0, stream>>>(out, 777000.f); return; }

    (void)hipMemsetAsync(p.bar, 0, 4096 * 4, stream);
    static bool minit = false;
    if (!minit) { (void)hipFuncSetAttribute((const void*)k_mega, hipFuncAttributeMaxDynamicSharedMemorySize, MEGA_LDS); minit = true; }
    hipLaunchKernelGGL(k_mega, dim3(256), dim3(512), MEGA_LDS, stream, p);
}
```

```cpp
#include <hip/hip_runtime.h>
#include <stdint.h>
#include <string.h>

constexpr int D_MODEL = 1024, SEQ = 16384, DEPTH = 2, DEC_BATCH = 32, DEC_SEQ = 32, PAST_LEN = 2048;
constexpr int D_SSM = 2048, SSD_HEAD_DIM = 64, SSD_HEADS = 32, SSD_GROUPS = 4, SSD_STATE = 128, SSD_CONV_DIM = 3072;
constexpr int SB_HEAD_DIM = 128, SB_HEADS = 8, SB_WIDTH = 1024, D_FF = 4096, PLE_DIM = 256;
constexpr int IN_DIM = 10272;
constexpr int M_P = SEQ, M_S = DEC_BATCH * DEC_SEQ, M_ALL = M_P + M_S;
constexpr float EPS = 1e-6f;
constexpr int C_Z = 0, C_XBC = 2048, C_DT = 5120, C_Q = 5152, C_K = 6176, C_V = 7200, C_G = 8224;
constexpr size_t O_Y_P = 0;
constexpr size_t O_Y_S = O_Y_P + (size_t)M_P * D_MODEL;
constexpr size_t O_P_CONV = O_Y_S + (size_t)M_S * D_MODEL;
constexpr size_t O_P_STATE = O_P_CONV + (size_t)DEPTH * 3 * SSD_CONV_DIM;
constexpr size_t O_P_K = O_P_STATE + (size_t)DEPTH * SSD_HEADS * SSD_HEAD_DIM * SSD_STATE;
constexpr size_t O_P_V = O_P_K + (size_t)DEPTH * M_P * SB_WIDTH;
constexpr size_t O_P_FFN = O_P_V + (size_t)DEPTH * M_P * SB_WIDTH;
constexpr size_t O_S_CONV = O_P_FFN + (size_t)DEPTH * 2 * D_FF;
constexpr size_t O_S_STATE = O_S_CONV + (size_t)DEPTH * DEC_BATCH * 3 * SSD_CONV_DIM;
constexpr size_t O_S_K = O_S_STATE + (size_t)DEPTH * DEC_BATCH * SSD_HEADS * SSD_HEAD_DIM * SSD_STATE;
constexpr size_t O_S_V = O_S_K + (size_t)DEPTH * M_S * SB_WIDTH;
constexpr size_t O_S_FFN = O_S_V + (size_t)DEPTH * M_S * SB_WIDTH;
constexpr size_t O_TOTAL = O_S_FFN + (size_t)DEPTH * DEC_BATCH * 2 * D_FF;
constexpr size_t STATE_SZ = (size_t)SSD_HEADS * SSD_HEAD_DIM * SSD_STATE;

typedef unsigned short bf16_t;

__device__ __forceinline__ float wave_sum(float v) {
#pragma unroll
    for (int o = 32; o >= 1; o >>= 1) v += __shfl_xor(v, o);
    return v;
}
__device__ __forceinline__ float sigmoidf_(float x) { return 1.0f / (1.0f + __expf(-x)); }
__device__ __forceinline__ float softplusf_(float x) { return fmaxf(x, 0.f) + log1pf(__expf(-fabsf(x))); }
__device__ __forceinline__ float siluf_(float x) { return x * sigmoidf_(x); }
__device__ __forceinline__ float gelu_tanhf_(float x) { const float u = 0.7978845608028654f * (x + 0.044715f * x * x * x); return 0.5f * x * (1.0f + tanhf(u)); }
__device__ __forceinline__ bf16_t f2bf(float f) { unsigned u = __float_as_uint(f); u += 0x7FFFu + ((u >> 16) & 1u); return (bf16_t)(u >> 16); }
__device__ __forceinline__ float bf2f(bf16_t b) { return __uint_as_float(((unsigned)b) << 16); }
typedef __bf16 bf16x2_t __attribute__((ext_vector_type(2)));
typedef float f32x2_t __attribute__((ext_vector_type(2)));
__device__ __forceinline__ unsigned pk2(float lo, float hi) { unsigned r; asm volatile("v_cvt_pk_bf16_f32 %0, %1, %2" : "=v"(r) : "v"(lo), "v"(hi)); return r; }
__device__ __forceinline__ unsigned pk2c(float lo, float hi) { const f32x2_t v = {lo, hi}; return __builtin_bit_cast(unsigned, __builtin_convertvector(v, bf16x2_t)); }
__device__ __forceinline__ f32x2_t exp2_2(f32x2_t x) { f32x2_t e; e.x = __builtin_amdgcn_exp2f(x.x); e.y = __builtin_amdgcn_exp2f(x.y); return e; }
__device__ __forceinline__ f32x2_t rcp_2(f32x2_t x) { f32x2_t r; r.x = __builtin_amdgcn_rcpf(x.x); r.y = __builtin_amdgcn_rcpf(x.y); return r; }
__device__ __forceinline__ f32x2_t sigmoid2(f32x2_t a) { return rcp_2(exp2_2(a * (-1.4426950408889634f)) + 1.0f); }
__device__ __forceinline__ f32x2_t silu2(f32x2_t a) { return a * sigmoid2(a); }
__device__ __forceinline__ f32x2_t gelu2(f32x2_t x) { const f32x2_t u2 = (x * x * 0.044715f + 1.0f) * x * 1.5957691216057308f; return x * sigmoid2(u2); }
__device__ __forceinline__ float bflo(unsigned w) { return __uint_as_float(w << 16); }
__device__ __forceinline__ float bfhi(unsigned w) { return __uint_as_float(w & 0xffff0000u); }

__device__ __forceinline__ int bid_opaque() { int b = blockIdx.x; asm volatile("" : "+s"(b)); return b; }
__device__ __forceinline__ int nblk_opaque() { int b = gridDim.x; asm volatile("" : "+s"(b)); return b; }
__device__ __forceinline__ int tid_opaque() { int t = threadIdx.x; asm volatile("" : "+v"(t)); return t; }

namespace pg8 {
#define PG8_LAS __attribute__((address_space(3)))
typedef unsigned short bf16_t;
typedef short bf16x8 __attribute__((ext_vector_type(8)));
typedef float f32x4 __attribute__((ext_vector_type(4)));
typedef unsigned u32x4 __attribute__((ext_vector_type(4)));
constexpr int BM = 256, BK = 64, HALF = 128, HTB = HALF * BK * 2  , STAGE_BYTES = 8 * HTB, NXCD = 8, WGM = 8;

__host__ __device__ __forceinline__ int lds_byte(int r, int c) { const int st = (r >> 4) * 2 + (c >> 5), rr = r & 15, cc = c & 31, ob = rr * 64 + cc * 2; return st * 1024 + (ob ^ (((ob >> 9) & 1) << 5)); }
__host__ __device__ __forceinline__ void stage_rc(int b, int& R, int& C) { const int st = b / 1024, sb = b % 1024, swz = sb ^ (((sb >> 9) & 1) << 5); R = (st >> 1) * 16 + swz / 64; C = (st & 1) * 32 + (swz % 64) / 2; }
__host__ __device__ __forceinline__ int perm32(int rho) { const int n = rho >> 4, i = rho & 15; return 8 * (i >> 2) + 4 * n + (i & 3); }

struct Unit { int pm, pn; };
struct Gemm { const bf16_t* A; const bf16_t* Bt; int M, N, K; };

struct StaticOrder {
    int nM, nN, nwg, G, c, wgm;
    __host__ __device__ void init(int M, int N, int G_, int c_, int wgm_ = WGM) { nM = M / BM; nN = N / BM; nwg = nM * nN; G = G_; c = c_; wgm = wgm_; }
    __host__ __device__ bool next(int i, Unit& u) const {
        const long L = (long)i * G + c; if (L >= nwg) return false;
        int wgid = (int)L; { const int q = nwg / NXCD, r = nwg % NXCD, xcd = wgid % NXCD, off = wgid / NXCD; wgid = (xcd < r ? xcd * (q + 1) : r * (q + 1) + (xcd - r) * q) + off; }
        const int nig = wgm * nN, gid = wgid / nig, fm = gid * wgm, gsz = (nM - fm) < wgm ? (nM - fm) : wgm;
        u.pm = fm + ((wgid % nig) % gsz); u.pn = (wgid % nig) / gsz; return true;
    }
    __device__ __forceinline__ void a_ready(const Unit&) const {}
    __device__ __forceinline__ void done(const Unit&) const {}
};
__device__ __forceinline__ unsigned cvt_pk_bf16(float lo, float hi) { unsigned r; asm volatile("v_cvt_pk_bf16_f32 %0, %1, %2" : "=v"(r) : "v"(lo), "v"(hi)); return r; }
typedef float f32x2 __attribute__((ext_vector_type(2)));
__device__ __forceinline__ f32x2 gelu_pk(f32x2 v) {
    const f32x2 av = __builtin_elementwise_abs(v), d = av * 0.2316418882f + 1.0f;
    f32x2 t; t.x = __builtin_amdgcn_rcpf(d.x); t.y = __builtin_amdgcn_rcpf(d.y);
    f32x2 q = t * 0.5307027145f + (-0.7265760135f); q = q * t + 0.7107068705f; q = q * t + (-0.142248368f); q = q * t + 0.127414796f; q = q * t;
    const f32x2 s = (v * v) * (-0.72134752044f);
    f32x2 e; e.x = __builtin_amdgcn_exp2f(s.x); e.y = __builtin_amdgcn_exp2f(s.y);
    const f32x2 m = v * (q * e), r = v - m;
    f32x2 o; o.x = v.x < 0.f ? m.x : r.x; o.y = v.y < 0.f ? m.y : r.y; return o;
}

struct EpiF32 {
    static constexpr bool PERM = false, AFTER_DRAIN = false;
    float* C; int ldc; const float* bias;
    __device__ __forceinline__ void operator()(const f32x4 (&acc)[2][2][4][2], const Unit& u, int wr, int wc, int fr, int fq) const {
        const int row0 = u.pm * BM + wr * 64 + fr, col0 = u.pn * BM + wc * 32 + 4 * fq;
        f32x4 bv[2][2];
#pragma unroll
        for (int bj = 0; bj < 2; ++bj)
#pragma unroll
            for (int n = 0; n < 2; ++n) bv[bj][n] = bias ? *(const f32x4*)(bias + col0 + bj * HALF + n * 16) : (f32x4){0.f, 0.f, 0.f, 0.f};
#pragma unroll
        for (int ai = 0; ai < 2; ++ai)
#pragma unroll
            for (int m = 0; m < 4; ++m) { float* rowp = C + (size_t)(row0 + ai * HALF + m * 16) * ldc + col0;
#pragma unroll
                for (int bj = 0; bj < 2; ++bj)
#pragma unroll
                    for (int n = 0; n < 2; ++n) *(f32x4*)(rowp + bj * HALF + n * 16) = acc[ai][bj][m][n] + bv[bj][n]; }
    }
};
template <int ACT  > struct EpiBf16 {
    static constexpr bool PERM = true, AFTER_DRAIN = false;
    bf16_t* O; int ldc; const float* bias; int split_cols; size_t split_stride;
    __device__ __forceinline__ void operator()(const f32x4 (&acc)[2][2][4][2], const Unit& u, int wr, int wc, int fr, int fq) const {
        const int row0 = u.pm * BM + wr * 64 + fr; int colt = u.pn * BM; bf16_t* base = O;
        if (split_cols) { const int t = colt / split_cols; base += (size_t)t * split_stride; colt -= t * split_cols; }
        const int col0 = colt + wc * 32 + 8 * fq, bcol0 = u.pn * BM + wc * 32 + 8 * fq;
        f32x4 bv[2][2];
#pragma unroll
        for (int bj = 0; bj < 2; ++bj)
#pragma unroll
            for (int n = 0; n < 2; ++n) bv[bj][n] = bias ? *(const f32x4*)(bias + bcol0 + bj * HALF + 4 * n) : (f32x4){0.f, 0.f, 0.f, 0.f};
#pragma unroll
        for (int ai = 0; ai < 2; ++ai)
#pragma unroll
            for (int m = 0; m < 4; ++m) { bf16_t* rowp = base + (size_t)(row0 + ai * HALF + m * 16) * ldc + col0;
#pragma unroll
                for (int bj = 0; bj < 2; ++bj) { f32x4 v0 = acc[ai][bj][m][0] + bv[bj][0], v1 = acc[ai][bj][m][1] + bv[bj][1];
                    if (ACT == 1) { f32x2 a = gelu_pk((f32x2){v0[0], v0[1]}), b = gelu_pk((f32x2){v0[2], v0[3]}), c = gelu_pk((f32x2){v1[0], v1[1]}), d = gelu_pk((f32x2){v1[2], v1[3]});
                        v0 = (f32x4){a.x, a.y, b.x, b.y}; v1 = (f32x4){c.x, c.y, d.x, d.y}; }
                    if (ACT == 2) {
#pragma unroll
                        for (int j = 0; j < 4; ++j) { v0[j] = 0.5f * v0[j] * (1.0f + erff(v0[j] * 0.70710678f)); v1[j] = 0.5f * v1[j] * (1.0f + erff(v1[j] * 0.70710678f)); } }
                    u32x4 w; w.x = cvt_pk_bf16(v0[0], v0[1]); w.y = cvt_pk_bf16(v0[2], v0[3]); w.z = cvt_pk_bf16(v1[0], v1[1]); w.w = cvt_pk_bf16(v1[2], v1[3]);
                    *(u32x4*)(rowp + bj * HALF) = w; } }
    }
};

template <class Epi, class Sched, bool STAMP = false>
__device__ __forceinline__ void gemm_phase(PG8_LAS unsigned char* lds, const Gemm g, const Sched& S, const Epi& E, unsigned long long* stamps) {
    const int tid = tid_opaque(), wid = __builtin_amdgcn_readfirstlane(tid >> 6), lane = tid & 63, wr = wid >> 2, wc = wid & 3, fr = lane & 15, fq = lane >> 4;
    const int K = g.K, nt = K / BK;
    int ts_lo = 0, ts_hi = 0, nts = 0; const unsigned long long rt_entry = STAMP ? (unsigned long long)wall_clock64() : 0ull;
#define PG8_STAMP() do { if (STAMP && wid == 0 && nts < 64) { const unsigned long long _c = (unsigned long long)clock64(); \
        ts_lo = (lane == nts) ? (int)(unsigned)_c : ts_lo; ts_hi = (lane == nts) ? (int)(unsigned)(_c >> 32) : ts_hi; ++nts; } } while (0)
    PG8_STAMP();
    unsigned voffA[2], voffB[2];
#pragma unroll
    for (int i = 0; i < 2; ++i) { int R, C; stage_rc(tid * 16 + i * 8192, R, C); const int Rb = Epi::PERM ? ((R & ~31) + perm32(R & 31)) : R;
        voffA[i] = (unsigned)(R * K + C) * 2u; voffB[i] = (unsigned)(Rb * K + C) * 2u; }
    const size_t kstep = (size_t)(BK * 2);
    const size_t hstep = (size_t)HALF * K * 2;
    const size_t tstep = 2 * hstep;
    const unsigned ldsw = (unsigned)wid * 1024u;
    const int aoff = lds_byte(wr * 64 + fr, fq * 8), boff = lds_byte(wc * 32 + fr, fq * 8);
#define PG8_SA(b, h) (((b) * 2 + (h)) * HTB)
#define PG8_SB(b, h) ((4 + (b) * 2 + (h)) * HTB)
#define PG8_STAGE(bufoff, gbase, voff) do { _Pragma("unroll") for (int _i = 0; _i < 2; ++_i) \
        __builtin_amdgcn_global_load_lds((const unsigned*)((const char*)(gbase) + (voff)[_i]), (PG8_LAS unsigned*)(lds + (bufoff) + ldsw + _i * 8192), 16, 0, 0); } while (0)
#define PG8_LDA(dst, b, h) do { _Pragma("unroll") for (int m = 0; m < 4; ++m) _Pragma("unroll") for (int k = 0; k < 2; ++k) dst[m][k] = *(const PG8_LAS bf16x8*)(lds + PG8_SA(b, h) + aoff + m * 2048 + k * 1024); } while (0)
#define PG8_LDB(dst, b, h) do { _Pragma("unroll") for (int n = 0; n < 2; ++n) _Pragma("unroll") for (int k = 0; k < 2; ++k) dst[n][k] = *(const PG8_LAS bf16x8*)(lds + PG8_SB(b, h) + boff + n * 2048 + k * 1024); } while (0)
#define PG8_MMA(ai, bj, At, Bt) do { __builtin_amdgcn_s_setprio(1); _Pragma("unroll") for (int m = 0; m < 4; ++m) _Pragma("unroll") for (int n = 0; n < 2; ++n) _Pragma("unroll") for (int k = 0; k < 2; ++k) \
        acc[ai][bj][m][n] = __builtin_amdgcn_mfma_f32_16x16x32_bf16(Bt[n][k], At[m][k], acc[ai][bj][m][n], 0, 0, 0); __builtin_amdgcn_s_setprio(0); } while (0)
#define PG8_WAIT_V(n) asm volatile("s_waitcnt vmcnt(" #n ")" ::: "memory")
#define PG8_WAIT_L(n) asm volatile("s_waitcnt lgkmcnt(" #n ")" ::: "memory")
#define PG8_BAR __builtin_amdgcn_s_barrier()
#define PG8_SCHED __builtin_amdgcn_sched_barrier(0)
    Unit cur, nxt; int ui = 0;
    if (!S.next(0, cur)) return;
    f32x4 acc[2][2][4][2];
#pragma unroll
    for (int a = 0; a < 2; ++a)
#pragma unroll
        for (int b = 0; b < 2; ++b)
#pragma unroll
            for (int m = 0; m < 4; ++m)
#pragma unroll
                for (int n = 0; n < 2; ++n) acc[a][b][m][n] = (f32x4){0.f, 0.f, 0.f, 0.f};
    bf16x8 At[4][2], B0[2][2], B1[2][2];
    const char* cA = (const char*)g.A + (size_t)cur.pm * tstep; const char* cB = (const char*)g.Bt + (size_t)cur.pn * tstep;
    S.a_ready(cur);
    PG8_STAGE(PG8_SB(0, 0), cB, voffB); PG8_STAGE(PG8_SA(0, 0), cA, voffA); PG8_STAGE(PG8_SB(0, 1), cB + hstep, voffB); PG8_STAGE(PG8_SA(0, 1), cA + hstep, voffA);
    if (wr == 1) PG8_BAR;
    PG8_WAIT_V(4); PG8_BAR;
    PG8_STAGE(PG8_SB(1, 0), cB + kstep, voffB); PG8_STAGE(PG8_SA(1, 0), cA + kstep, voffA); PG8_STAGE(PG8_SB(1, 1), cB + hstep + kstep, voffB);
    PG8_WAIT_V(6); PG8_BAR;
    PG8_STAMP();
    for (;;) {
        const bool has_next = S.next(ui + 1, nxt);
        const char* nA = has_next ? (const char*)g.A + (size_t)nxt.pm * tstep : cA; const char* nB = has_next ? (const char*)g.Bt + (size_t)nxt.pn * tstep : cB;
        for (int t = 0; t < nt; t += 2) {
            const bool last = (t == nt - 2);
            const char* a1 = cA + (size_t)(t + 1) * kstep;
            const char* a2 = last ? nA : cA + (size_t)(t + 2) * kstep; const char* b2 = last ? nB : cB + (size_t)(t + 2) * kstep;
            const char* a3 = a2 + kstep; const char* b3 = b2 + kstep;
            if (last && has_next) S.a_ready(nxt);
            PG8_LDB(B0, 0, 0); PG8_SCHED; PG8_LDA(At, 0, 0); PG8_STAGE(PG8_SA(1, 1), a1 + hstep, voffA);
            PG8_WAIT_L(8); PG8_BAR; PG8_WAIT_L(0); PG8_MMA(0, 0, At, B0); PG8_BAR; PG8_SCHED;
            PG8_LDB(B1, 0, 1); PG8_STAGE(PG8_SB(0, 0), b2, voffB);
            PG8_BAR; PG8_WAIT_L(0); PG8_MMA(0, 1, At, B1); PG8_BAR;
            PG8_LDA(At, 0, 1); PG8_STAGE(PG8_SA(0, 0), a2, voffA);
            PG8_BAR; PG8_WAIT_L(0); PG8_MMA(1, 0, At, B0); PG8_BAR; PG8_SCHED;
            PG8_STAGE(PG8_SB(0, 1), b2 + hstep, voffB);
            PG8_WAIT_V(6); PG8_BAR; PG8_MMA(1, 1, At, B1); PG8_BAR;
            PG8_LDB(B0, 1, 0); PG8_SCHED; PG8_LDA(At, 1, 0); PG8_STAGE(PG8_SA(0, 1), a2 + hstep, voffA);
            PG8_WAIT_L(8); PG8_BAR; PG8_WAIT_L(0); PG8_MMA(0, 0, At, B0); PG8_BAR; PG8_SCHED;
            PG8_LDB(B1, 1, 1); PG8_STAGE(PG8_SB(1, 0), b3, voffB);
            PG8_BAR; PG8_WAIT_L(0); PG8_MMA(0, 1, At, B1); PG8_BAR;
            PG8_LDA(At, 1, 1); PG8_STAGE(PG8_SA(1, 0), a3, voffA);
            PG8_BAR; PG8_WAIT_L(0); PG8_MMA(1, 0, At, B0); PG8_BAR; PG8_SCHED;
            PG8_STAGE(PG8_SB(1, 1), b3 + hstep, voffB);
            PG8_WAIT_V(6); PG8_BAR; PG8_MMA(1, 1, At, B1); PG8_BAR;
        }
        PG8_STAMP();
        if constexpr (!Epi::AFTER_DRAIN) { E(acc, cur, wr, wc, fr, fq); S.done(cur); }
        PG8_STAMP();
        if (!has_next) break;
#pragma unroll
        for (int a = 0; a < 2; ++a)
#pragma unroll
            for (int b = 0; b < 2; ++b)
#pragma unroll
                for (int m = 0; m < 4; ++m)
#pragma unroll
                    for (int n = 0; n < 2; ++n) acc[a][b][m][n] = (f32x4){0.f, 0.f, 0.f, 0.f};
        cur = nxt; cA = nA; cB = nB; ++ui;
    }
    PG8_WAIT_V(0);
    if (wr == 0) PG8_BAR;
    PG8_BAR;
    if constexpr (Epi::AFTER_DRAIN) { E.fused(acc, cur, wr, wc, fr, fq, lds, wid, lane); S.done(cur); }
    PG8_STAMP();
    if (STAMP && wid == 0) { stamps[lane] = lane < nts ? (((unsigned long long)(unsigned)ts_hi << 32) | (unsigned)ts_lo) : 0ull;
        if (lane == 62) stamps[62] = rt_entry; if (lane == 63) stamps[63] = (unsigned long long)wall_clock64(); }
#undef PG8_STAMP
#undef PG8_SA
#undef PG8_SB
#undef PG8_STAGE
#undef PG8_LDA
#undef PG8_LDB
#undef PG8_MMA
#undef PG8_WAIT_V
#undef PG8_WAIT_L
#undef PG8_BAR
#undef PG8_SCHED
}
}
#define XB_TMO      128
#define XB_XCNT(j)  (256  + 64 * (j))
#define XB_XSUB(j)  (1280 + 64 * (j))
#define XB_XGEN(j)  (2304 + 64 * (j))
#define XB_TOP      3328
#define XB_TOPGEN   3392
#define XCD_BAR_WORDS 3456
#define XB_SPIN_CAP (1u << 18)
#define LAS __attribute__((address_space(3)))

__device__ __forceinline__ unsigned xb_ld(unsigned* p)              { return __hip_atomic_load(p, __ATOMIC_RELAXED, __HIP_MEMORY_SCOPE_AGENT); }
__device__ __forceinline__ unsigned xb_add(unsigned* p, unsigned v) { return __hip_atomic_fetch_add(p, v, __ATOMIC_RELAXED, __HIP_MEMORY_SCOPE_AGENT); }
__device__ __forceinline__ unsigned xb_xcc_id() { return (unsigned)__builtin_amdgcn_s_getreg((3 << 11) | 20) & 0xFu; }
#define XB_SPIN(cond, bar) do { unsigned _sp = 0; while (cond) { __builtin_amdgcn_s_sleep(1); \
    if ((++_sp & 255u) == 0u) { if (xb_ld(&(bar)[XB_TMO])) break; if (_sp > XB_SPIN_CAP) { atomicAdd(&(bar)[XB_TMO], 1u); break; } } } } while (0)

struct XcdBarrier {
    unsigned* bar; unsigned x;
    volatile LAS unsigned* st;
};

__device__ __forceinline__ XcdBarrier xcd_barrier_post(unsigned* bar, volatile LAS unsigned* st) {
    XcdBarrier b; b.bar = bar; b.x = xb_xcc_id(); b.st = st;
    if (threadIdx.x == 0) (void)xb_add(&bar[XB_XCNT(b.x)], 1u);
    return b;
}
__device__ __forceinline__ void xcd_barrier_complete(unsigned* bar, unsigned x, unsigned& nloc, unsigned& nx) {
    const unsigned G = gridDim.x * gridDim.y * gridDim.z;
    unsigned sum, cnt, mine, sp = 0u;
    for (;;) {
        sum = 0u; cnt = 0u; mine = 0u;
#pragma unroll
        for (unsigned j = 0; j < 16; ++j) { const unsigned c = xb_ld(&bar[XB_XCNT(j)]); sum += c; cnt += (c > 0u) ? 1u : 0u; mine = (j == x) ? c : mine; }
        if (sum == G) break;
        __builtin_amdgcn_s_sleep(1);
        if ((++sp & 255u) == 0u) { if (xb_ld(&bar[XB_TMO])) break; if (sp > XB_SPIN_CAP) { atomicAdd(&bar[XB_TMO], 1u); break; } }
    }
    nloc = mine > 0u ? mine : 1u; nx = cnt > 0u ? cnt : 1u;
}

__device__ __forceinline__ void xcd_barrier(const XcdBarrier& b) {
    asm volatile("s_waitcnt vmcnt(0)" ::: "memory");
    __syncthreads();
    if (threadIdx.x == 0) {
        unsigned* bar = b.bar;
        __builtin_amdgcn_s_waitcnt(0);
        unsigned nloc = b.st[0], nx = b.st[1];
        if (nloc == 0u) { xcd_barrier_complete(bar, b.x, nloc, nx); b.st[0] = nloc; b.st[1] = nx; }
        const unsigned old = xb_add(&bar[XB_XSUB(b.x)], 1u);
        const unsigned gen = old / nloc;
        if (old + 1u == (gen + 1u) * nloc) {
            __builtin_amdgcn_fence(__ATOMIC_RELEASE, "agent");
            asm volatile("s_waitcnt vmcnt(0)" ::: "memory");
            const unsigned og = xb_add(&bar[XB_TOP], 1u);
            const unsigned tg = og / nx;
            if (og + 1u == (tg + 1u) * nx) xb_add(&bar[XB_TOPGEN], 1u);
            else XB_SPIN(xb_ld(&bar[XB_TOPGEN]) == tg, bar);
            __builtin_amdgcn_fence(__ATOMIC_ACQUIRE, "agent");
            xb_add(&bar[XB_XGEN(b.x)], 1u);
            asm volatile("s_waitcnt vmcnt(0)" ::: "memory");
        } else {
            XB_SPIN(xb_ld(&bar[XB_XGEN(b.x)]) == gen, bar);
            __builtin_amdgcn_fence(__ATOMIC_ACQUIRE, "agent");
            asm volatile("s_waitcnt vmcnt(0)" ::: "memory");
        }
    }
    __syncthreads();
}


using pg8::f32x4; using pg8::u32x4; using pg8::Unit; using pg8::Gemm; using pg8::StaticOrder;
typedef unsigned u32x2 __attribute__((ext_vector_type(2)));
#define LDSP PG8_LAS unsigned char*

constexpr int N1 = 10496;
constexpr size_t OW1 = 0, OW2 = OW1 + (size_t)N1 * 1024, OW3 = OW2 + (size_t)1024 * 2048, OW4 = OW3 + (size_t)1024 * 1024, OW5 = OW4 + (size_t)1024 * 1024,
                 OW6 = OW5 + (size_t)8192 * 1024, OW7 = OW6 + (size_t)1024 * 4096, OW8 = OW7 + (size_t)1024 * 256, WT_LAYER = OW8 + (size_t)1024 * 1024;
constexpr int NCHUNK = 256 + DEC_BATCH;

struct Params {
    const float *x_prompt, *x_sample, *state_ssd_conv, *state_ssd, *cache_k, *cache_v, *state_ffn_conv, *p_prompt, *p_sample;
    const float *norm_pre_mix, *w_in, *ssd_conv_w, *ssd_conv_b, *ssd_dt_bias, *ssd_a_log, *ssd_d, *ssd_norm, *w_br_ssd, *w_br_sb, *w_out, *norm_post_mix, *norm_pre_ffn,
                *w_up, *ffn_conv_w, *ffn_conv_b, *w_down, *norm_post_ffn, *w_ple, *w_ple_gate, *norm_ple;
    float* out;
    unsigned* bar;
    bf16_t* wt; bf16_t* xr; bf16_t* xb; float* rs; float* rs2; bf16_t* pb;
    bf16_t *zb, *xbcb, *qb, *gb, *kb, *vb; float* dtb;
    float* sst; float* dec; bf16_t* hpb;
    bf16_t *yn, *att, *t1, *mixin; bf16_t* mixed;
    bf16_t *gh, *xh, *ffb; bf16_t* down; bf16_t* plea; bf16_t* ple;
};

typedef const __attribute__((address_space(4))) Params CP;
#define CPR CP&
__device__ __forceinline__ CP* kargs() { CP* q = (CP*)__builtin_amdgcn_kernarg_segment_ptr(); asm volatile("" : "+s"(q)); return q; }

__device__ __forceinline__ void wt_item(const float* __restrict__ W, int K, int ldw, const float* __restrict__ gain, bf16_t* __restrict__ Wt, int nblk, int item, int w1map, PG8_LAS float* scr, int lane) {
    const int kb = item / nblk, nb = item % nblk, k0 = 64 * kb, n0 = 32 * nb;
    int sc0 = n0; if (w1map == 1) sc0 = (n0 < 5120) ? n0 : (n0 < 10240 ? n0 + 32 : (n0 < 10272 ? n0 - 5120 : -1));
    else if (w1map == 2) sc0 = ((n0 & 255) < 128 ? 0 : 4096) + (n0 >> 8) * 128 + (n0 & 127);
    const int kr = lane >> 3, c4 = (lane & 7) * 4;
    float4 v[8];
#pragma unroll
    for (int i = 0; i < 8; ++i) v[i] = (sc0 >= 0) ? *(const float4*)(W + (size_t)(k0 + kr + 8 * i) * ldw + sc0 + c4) : make_float4(0.f, 0.f, 0.f, 0.f);
#pragma unroll
    for (int i = 0; i < 8; ++i) { const int kk = kr + 8 * i; const float gm = gain ? gain[k0 + kk] : 1.0f; PG8_LAS float* d = scr + kk * 33 + c4;
        d[0] = v[i].x * gm; d[1] = v[i].y * gm; d[2] = v[i].z * gm; d[3] = v[i].w * gm; }
    asm volatile("s_waitcnt lgkmcnt(0)" ::: "memory");
    const int c = lane & 7;
#pragma unroll
    for (int j = 0; j < 4; ++j) { const int nn = (lane >> 3) + 8 * j; const PG8_LAS float* s = scr + (8 * c) * 33 + nn;
        *(u32x4*)(Wt + (size_t)(n0 + nn) * K + k0 + 8 * c) = (u32x4){pk2(s[0], s[33]), pk2(s[2 * 33], s[3 * 33]), pk2(s[4 * 33], s[5 * 33]), pk2(s[6 * 33], s[7 * 33])}; }
    asm volatile("s_waitcnt lgkmcnt(0)" ::: "memory");
}
__device__ __forceinline__ void ph_wt(CPR p, LDSP lds) {
    constexpr int U1 = 16 * 328, U2 = U1 + 32 * 32, U3 = U2 + 512, U4 = U3 + 512, U5 = U4 + 16 * 256, U6 = U5 + 64 * 32, U7 = U6 + 4 * 32, U8 = U7 + 512;
    const int tidx = tid_opaque(), lane = tidx & 63, wv = tidx >> 6, gw = bid_opaque() * 8 + wv, NGW = nblk_opaque() * 8;
    PG8_LAS float* scr = (PG8_LAS float*)(lds + wv * (64 * 33 * 4));
    for (int u = gw; u < DEPTH * U8; u += NGW) {
        const int l = u / U8; int v = u % U8; bf16_t* wl = p.wt + (size_t)l * WT_LAYER;
        if (v < U1)      { wt_item(p.w_in + (size_t)l * 1024 * IN_DIM, 1024, IN_DIM, p.norm_pre_mix + l * 1024, wl + OW1, 328, v, 1, scr, lane); }
        else if (v < U2) { v -= U1; wt_item(p.w_br_ssd + (size_t)l * 2048 * 1024, 2048, 1024, p.ssd_norm + l * 2048, wl + OW2, 32, v, 0, scr, lane); }
        else if (v < U3) { v -= U2; wt_item(p.w_br_sb + (size_t)l * 1024 * 1024, 1024, 1024, nullptr, wl + OW3, 32, v, 0, scr, lane); }
        else if (v < U4) { v -= U3; wt_item(p.w_out + (size_t)l * 1024 * 1024, 1024, 1024, nullptr, wl + OW4, 32, v, 0, scr, lane); }
        else if (v < U5) { v -= U4; wt_item(p.w_up + (size_t)l * 1024 * 8192, 1024, 8192, p.norm_pre_ffn + l * 1024, wl + OW5, 256, v, 2, scr, lane); }
        else if (v < U6) { v -= U5; wt_item(p.w_down + (size_t)l * 4096 * 1024, 4096, 1024, nullptr, wl + OW6, 32, v, 0, scr, lane); }
        else if (v < U7) { v -= U6; wt_item(p.w_ple + (size_t)l * 256 * 1024, 256, 1024, nullptr, wl + OW7, 32, v, 0, scr, lane); }
        else             { v -= U7; wt_item(p.w_ple_gate + (size_t)l * 1024 * 1024, 1024, 1024, nullptr, wl + OW8, 32, v, 0, scr, lane); }
    }
    __syncthreads();
}
__device__ __forceinline__ void ph_xprep(CPR p) {
    const int tidx = tid_opaque(); const int lane = tidx & 63, gw = bid_opaque() * 8 + (tidx >> 6), NGW = nblk_opaque() * 8;
    for (int row0 = 2 * gw; row0 < M_ALL; row0 += 2 * NGW) {
        float4 v[2][4]; float ss[2] = {0.f, 0.f};
#pragma unroll
        for (int q = 0; q < 2; ++q) { const int row = row0 + q; const float4* src = (const float4*)(row < M_P ? p.x_prompt + (size_t)row * 1024 : p.x_sample + (size_t)(row - M_P) * 1024);
#pragma unroll
            for (int j = 0; j < 4; ++j) v[q][j] = src[lane + 64 * j]; }
#pragma unroll
        for (int q = 0; q < 2; ++q) { const int row = row0 + q;
#pragma unroll
            for (int j = 0; j < 4; ++j) { ss[q] += v[q][j].x * v[q][j].x + v[q][j].y * v[q][j].y + v[q][j].z * v[q][j].z + v[q][j].w * v[q][j].w;
                ((u32x2*)(p.xr + (size_t)row * 1024))[lane + 64 * j] = (u32x2){pk2(v[q][j].x, v[q][j].y), pk2(v[q][j].z, v[q][j].w)}; }
            const float rn = rsqrtf(wave_sum(ss[q]) * (1.0f / 1024.f) + EPS);
#pragma unroll
            for (int j = 0; j < 4; ++j) ((u32x2*)(p.xb + (size_t)row * 1024))[lane + 64 * j] = (u32x2){pk2(v[q][j].x * rn, v[q][j].y * rn), pk2(v[q][j].z * rn, v[q][j].w * rn)}; }
    }
    for (int r0 = 4 * gw; r0 < DEPTH * M_ALL; r0 += 4 * NGW) {
        float4 v[4];
#pragma unroll
        for (int q = 0; q < 4; ++q) { const int r2 = r0 + q, l = r2 / M_ALL, row = r2 % M_ALL;
            v[q] = ((const float4*)(row < M_P ? p.p_prompt + ((size_t)l * M_P + row) * PLE_DIM : p.p_sample + ((size_t)l * M_S + row - M_P) * PLE_DIM))[lane]; }
#pragma unroll
        for (int q = 0; q < 4; ++q) ((u32x2*)(p.pb + (size_t)(r0 + q) * PLE_DIM))[lane] = (u32x2){pk2(v[q].x, v[q].y), pk2(v[q].z, v[q].w)};
    }
}
__device__ __forceinline__ void ph_norm(const bf16_t* __restrict__ src, const float* __restrict__ gain, bf16_t* xr, bf16_t* xb, float* yP, float* yS, bf16_t* xh = nullptr) {
    const int tidx = tid_opaque(); const int lane = tidx & 63, gw = bid_opaque() * 8 + (tidx >> 6), NGW = nblk_opaque() * 8;
    float4 g[4];
#pragma unroll
    for (int j = 0; j < 4; ++j) g[j] = ((const float4*)gain)[lane + 64 * j];
    for (int row0 = 2 * gw; row0 < M_ALL; row0 += 2 * NGW) {
        u32x2 sv[2][4], xv[2][4];
#pragma unroll
        for (int q = 0; q < 2; ++q)
#pragma unroll
            for (int j = 0; j < 4; ++j) { sv[q][j] = ((const u32x2*)(src + (size_t)(row0 + q) * 1024))[lane + 64 * j]; xv[q][j] = ((const u32x2*)(xr + (size_t)(row0 + q) * 1024))[lane + 64 * j]; }
#pragma unroll
        for (int q = 0; q < 2; ++q) {
            const int row = row0 + q;
            float4 v[4], x[4]; float ss = 0.f;
#pragma unroll
            for (int j = 0; j < 4; ++j) { v[j] = make_float4(bflo(sv[q][j].x), bfhi(sv[q][j].x), bflo(sv[q][j].y), bfhi(sv[q][j].y)); x[j] = make_float4(bflo(xv[q][j].x), bfhi(xv[q][j].x), bflo(xv[q][j].y), bfhi(xv[q][j].y));
                ss += v[j].x * v[j].x + v[j].y * v[j].y + v[j].z * v[j].z + v[j].w * v[j].w; }
            ss = wave_sum(ss);
            const float r = rsqrtf(ss * (1.0f / 1024.f) + EPS); float s2 = 0.f;
#pragma unroll
            for (int j = 0; j < 4; ++j) {
                x[j].x += v[j].x * r * g[j].x; x[j].y += v[j].y * r * g[j].y; x[j].z += v[j].z * r * g[j].z; x[j].w += v[j].w * r * g[j].w;
                s2 += x[j].x * x[j].x + x[j].y * x[j].y + x[j].z * x[j].z + x[j].w * x[j].w;
                ((u32x2*)(xr + (size_t)row * 1024))[lane + 64 * j] = (u32x2){pk2(x[j].x, x[j].y), pk2(x[j].z, x[j].w)};
            }
            if (xb) {
                const float rn = rsqrtf(wave_sum(s2) * (1.0f / 1024.f) + EPS);
#pragma unroll
                for (int j = 0; j < 4; ++j) {
                    const u32x2 wq = (u32x2){pk2(x[j].x * rn, x[j].y * rn), pk2(x[j].z * rn, x[j].w * rn)};
                    ((u32x2*)(xb + (size_t)row * 1024))[lane + 64 * j] = wq;
                    if (xh && (row & 63) >= 62) ((u32x2*)(xh + (size_t)(2 * ((row >> 6) + 1) + (row & 63) - 62) * 1024))[lane + 64 * j] = wq;
                }
            }
            if (yP) { float4* y4 = (float4*)(row < M_P ? yP + (size_t)row * 1024 : yS + (size_t)(row - M_P) * 1024);
#pragma unroll
                for (int j = 0; j < 4; ++j) y4[lane + 64 * j] = x[j]; }
        }
    }
}
__device__ __forceinline__ void unpack8(const u32x4 w, float (&v)[8]) {
    v[0] = bflo(w.x); v[1] = bfhi(w.x); v[2] = bflo(w.y); v[3] = bfhi(w.y); v[4] = bflo(w.z); v[5] = bfhi(w.z); v[6] = bflo(w.w); v[7] = bfhi(w.w);
}
__device__ __forceinline__ void load8f(const float* p, float (&v)[8]) { const float4 a = ((const float4*)p)[0], b = ((const float4*)p)[1]; v[0] = a.x; v[1] = a.y; v[2] = a.z; v[3] = a.w; v[4] = b.x; v[5] = b.y; v[6] = b.z; v[7] = b.w; }
__device__ __forceinline__ float gelu_fast(float x) { const float u2 = 1.5957691216057308f * (x + 0.044715f * x * x * x); return x * __builtin_amdgcn_rcpf(1.0f + __expf(-u2)); }
struct EpiIn {
    static constexpr bool PERM = true, AFTER_DRAIN = false;
    const float* rs; bf16_t *zb, *xbcb, *qb, *gb, *kb, *vb; float* dtb; const float* dt_bias; float *kP, *vP, *kS, *vS, *convP, *convS;
    __device__ __forceinline__ void operator()(const f32x4 (&acc)[2][2][4][2], const Unit& u, int wr, int wc, int fr, int fq) const {
        const int row0 = u.pm * 256 + wr * 64 + fr, seg = u.pn, cl = wc * 32 + 8 * fq;
#pragma unroll
        for (int ai = 0; ai < 2; ++ai)
#pragma unroll
            for (int m = 0; m < 4; ++m) {
                const int r = row0 + ai * 128 + m * 16;
#pragma unroll
                for (int bj = 0; bj < 2; ++bj) {
                    const int ct = cl + bj * 128; const f32x4 v0 = acc[ai][bj][m][0], v1 = acc[ai][bj][m][1];
                    const u32x4 w = (u32x4){pk2c(v0[0], v0[1]), pk2c(v0[2], v0[3]), pk2c(v1[0], v1[1]), pk2c(v1[2], v1[3])};
                    if (seg < 8) { *(u32x4*)(zb + (size_t)r * 2048 + seg * 256 + ct) = w; }
                    else if (seg < 20) {
                        const int c = (seg - 8) * 256 + ct; *(u32x4*)(xbcb + (size_t)r * 3072 + c) = w;
                        float* dst = nullptr;
                        if (r < M_P) { if (r >= M_P - 3) dst = convP + (size_t)(r - (M_P - 3)) * 3072; }
                        else { const int t = (r - M_P) & 31, b = (r - M_P) >> 5; if (t >= 29) dst = convS + ((size_t)b * 3 + (t - 29)) * 3072; }
                        if (dst) { *(f32x4*)(dst + c) = v0; *(f32x4*)(dst + c + 4) = v1; }
                    }
                    else if (seg < 24) { *(u32x4*)(qb + (size_t)r * 1024 + (seg - 20) * 256 + ct) = w; }
                    else if (seg < 32) {
                        const int c = ((seg - 24) & 3) * 256 + ct; const bool isk = seg < 28;
                        float* dst = (r < M_P) ? (isk ? kP : vP) + (size_t)r * 1024 : (isk ? kS : vS) + (size_t)(r - M_P) * 1024;
                        *(f32x4*)(dst + c) = v0; *(f32x4*)(dst + c + 4) = v1;
                        *(u32x4*)((isk ? kb : vb) + (size_t)r * 1024 + c) = w;
                    }
                    else if (seg < 40) {
                        const f32x2_t s0 = sigmoid2((f32x2_t){v0[0], v0[1]}), s1 = sigmoid2((f32x2_t){v0[2], v0[3]}), s2 = sigmoid2((f32x2_t){v1[0], v1[1]}), s3 = sigmoid2((f32x2_t){v1[2], v1[3]});
                        *(u32x4*)(gb + (size_t)r * 2048 + (seg - 32) * 256 + ct) = (u32x4){pk2(s0.x, s0.y), pk2(s1.x, s1.y), pk2(s2.x, s2.y), pk2(s3.x, s3.y)};
                    }
                    else if (wc == 0 && bj == 0) {
                        const f32x4 b0 = *(const f32x4*)(dt_bias + 8 * fq), b1 = *(const f32x4*)(dt_bias + 8 * fq + 4);
                        f32x4 o0, o1;
#pragma unroll
                        for (int j = 0; j < 4; ++j) { o0[j] = softplusf_(v0[j] + b0[j]); o1[j] = softplusf_(v1[j] + b1[j]); }
                        *(f32x4*)(dtb + (size_t)r * 32 + 8 * fq) = o0; *(f32x4*)(dtb + (size_t)r * 32 + 8 * fq + 4) = o1;
                    }
                }
            }
    }
};
struct EpiHalo {
    static constexpr bool PERM = true, AFTER_DRAIN = false;
    const float* rs; bf16_t* gh;
    __device__ __forceinline__ void elem(int hi, int ch, float v) const { gh[(size_t)hi * D_FF + ch] = f2bf(v); }
    __device__ __forceinline__ void operator()(const f32x4 (&acc)[2][2][4][2], const Unit& u, int wr, int wc, int fr, int fq) const {
        const int row0 = u.pm * 256 + wr * 64 + fr, c0 = u.pn * 128 + wc * 32 + 8 * fq;
#pragma unroll
        for (int ai = 0; ai < 2; ++ai)
#pragma unroll
            for (int m = 0; m < 4; ++m) {
                const int hi = row0 + ai * 128 + m * 16;
                const f32x4 v0 = acc[ai][0][m][0], v1 = acc[ai][0][m][1];
                *(u32x4*)(gh + (size_t)hi * D_FF + c0) = (u32x4){pk2c(v0[0], v0[1]), pk2c(v0[2], v0[3]), pk2c(v1[0], v1[1]), pk2c(v1[2], v1[3])};
            }
    }
};
struct EpiUpAct {
    static constexpr bool PERM = true, AFTER_DRAIN = false;
    const float* rs; const bf16_t* gh; bf16_t* ffb; float *ffnP, *ffnS; const float* cw; const float* cb; const float* hist;
    __device__ __forceinline__ void operator()(const f32x4 (&acc)[2][2][4][2], const Unit& u, int wr, int wc, int fr, int fq) const {
        const int c0 = u.pn * 128 + wc * 32 + 8 * fq;
        float w0[8], w1[8], w2[8], bb[8];
        load8f(cw + c0, w0); load8f(cw + D_FF + c0, w1); load8f(cw + 2 * D_FF + c0, w2); load8f(cb + c0, bb);
#pragma unroll
        for (int ai = 0; ai < 2; ++ai) {
            const int strip = 4 * u.pm + 2 * ai + wr;
            float gprev[8];
#pragma unroll
            for (int m = 0; m < 4; ++m) {
                const int r = strip * 64 + 16 * m + fr;
                float g[8], uv[8], p1[8], p2[8];
#pragma unroll
                for (int j = 0; j < 4; ++j) { g[j] = acc[ai][0][m][0][j]; g[4 + j] = acc[ai][0][m][1][j]; uv[j] = acc[ai][1][m][0][j]; uv[4 + j] = acc[ai][1][m][1][j]; }
                if (m == 0) { float e14[8], e15[8]; unpack8(*(const u32x4*)(gh + (size_t)(2 * strip) * D_FF + c0), e14); unpack8(*(const u32x4*)(gh + (size_t)(2 * strip + 1) * D_FF + c0), e15);
#pragma unroll
                    for (int j = 0; j < 8; ++j) gprev[j] = (fr == 15) ? e15[j] : e14[j]; }
#pragma unroll
                for (int j = 0; j < 8; ++j) {
                    const float c1 = (fr == 15) ? gprev[j] : g[j], c2 = (fr >= 14) ? gprev[j] : g[j];
                    p1[j] = __builtin_bit_cast(float, __builtin_amdgcn_update_dpp(0, __builtin_bit_cast(int, c1), 0x121, 0xf, 0xf, false));
                    p2[j] = __builtin_bit_cast(float, __builtin_amdgcn_update_dpp(0, __builtin_bit_cast(int, c2), 0x122, 0xf, 0xf, false));
                }
                const int t = (r < M_P) ? r : ((r - M_P) & 31);
                if (t < 2) {
                    float h0[8], h1[8];
                    if (r >= M_P) { const float* hp = hist + (size_t)((r - M_P) >> 5) * 2 * D_FF + c0; load8f(hp, h0); load8f(hp + D_FF, h1); }
                    else {
#pragma unroll
                        for (int j = 0; j < 8; ++j) { h0[j] = 0.f; h1[j] = 0.f; } }
#pragma unroll
                    for (int j = 0; j < 8; ++j) { if (t == 0) { p2[j] = h0[j]; p1[j] = h1[j]; } else { p2[j] = h1[j]; } }
                }
                float o[8];
#pragma unroll
                for (int j = 0; j < 8; j += 2) {
                    const f32x2_t a = (f32x2_t){bb[j], bb[j + 1]} + (f32x2_t){w0[j], w0[j + 1]} * (f32x2_t){p2[j], p2[j + 1]} + (f32x2_t){w1[j], w1[j + 1]} * (f32x2_t){p1[j], p1[j + 1]} + (f32x2_t){w2[j], w2[j + 1]} * (f32x2_t){g[j], g[j + 1]};
                    const f32x2_t ov = gelu2(a) * (f32x2_t){uv[j], uv[j + 1]}; o[j] = ov.x; o[j + 1] = ov.y; }
                *(u32x4*)(ffb + (size_t)r * D_FF + c0) = (u32x4){pk2(o[0], o[1]), pk2(o[2], o[3]), pk2(o[4], o[5]), pk2(o[6], o[7])};
                float* dst = nullptr;
                if (r < M_P) { if (r >= M_P - 2) dst = ffnP + (size_t)(r - (M_P - 2)) * D_FF; }
                else { const int b = (r - M_P) >> 5; if (t >= 30) dst = ffnS + ((size_t)b * 2 + (t - 30)) * D_FF; }
                if (dst) { *(f32x4*)(dst + c0) = (f32x4){g[0], g[1], g[2], g[3]}; *(f32x4*)(dst + c0 + 4) = (f32x4){g[4], g[5], g[6], g[7]}; }
#pragma unroll
                for (int j = 0; j < 8; ++j) gprev[j] = g[j];
            }
        }
    }
};
struct EpiBr {
    static constexpr bool PERM = true, AFTER_DRAIN = false;
    const bf16_t* gb; const bf16_t* t1in; bf16_t* dst; int mode; int pad;
    __device__ __forceinline__ void elem(int r, int c, float v) const {
        float o = bf2f(gb[(size_t)r * 2048 + (mode == 0 ? 1024 : 0) + c]) * v; if (mode == 1) o += bf2f(t1in[(size_t)r * 1024 + c]);
        dst[(size_t)r * 1024 + c] = f2bf(o); }
    __device__ __forceinline__ void operator()(const f32x4 (&acc)[2][2][4][2], const Unit& u, int wr, int wc, int fr, int fq) const {
        const int row0 = u.pm * 256 + wr * 64 + fr, cl = u.pn * 256 + wc * 32 + 8 * fq;
#pragma unroll
        for (int ai = 0; ai < 2; ++ai)
#pragma unroll
            for (int m = 0; m < 4; ++m) {
                const int r = row0 + ai * 128 + m * 16;
#pragma unroll
                for (int bj = 0; bj < 2; ++bj) {
                    const int c = cl + bj * 128; float g[8], o[8];
                    unpack8(*(const u32x4*)(gb + (size_t)r * 2048 + (mode == 0 ? 1024 : 0) + c), g);
                    const f32x4 v0 = acc[ai][bj][m][0], v1 = acc[ai][bj][m][1];
                    float tv[8];
                    if (mode == 1) unpack8(*(const u32x4*)(t1in + (size_t)r * 1024 + c), tv);
                    else {
#pragma unroll
                        for (int j = 0; j < 8; ++j) tv[j] = 0.f; }
#pragma unroll
                    for (int j = 0; j < 4; j += 2) {
                        const f32x2_t oa = (f32x2_t){g[j], g[j + 1]} * (f32x2_t){v0[j], v0[j + 1]} + (f32x2_t){tv[j], tv[j + 1]}, ob = (f32x2_t){g[4 + j], g[5 + j]} * (f32x2_t){v1[j], v1[j + 1]} + (f32x2_t){tv[4 + j], tv[5 + j]};
                        o[j] = oa.x; o[j + 1] = oa.y; o[4 + j] = ob.x; o[5 + j] = ob.y; }
                    *(u32x4*)(dst + (size_t)r * 1024 + c) = (u32x4){pk2(o[0], o[1]), pk2(o[2], o[3]), pk2(o[4], o[5]), pk2(o[6], o[7])};
                }
            }
    }
};
struct EpiPlain {
    static constexpr bool PERM = true, AFTER_DRAIN = false;
    bf16_t* dst;
    __device__ __forceinline__ void elem(int r, int c, float v) const { dst[(size_t)r * 1024 + c] = f2bf(v); }
    __device__ __forceinline__ void operator()(const f32x4 (&acc)[2][2][4][2], const Unit& u, int wr, int wc, int fr, int fq) const {
        const int row0 = u.pm * 256 + wr * 64 + fr, cl = u.pn * 256 + wc * 32 + 8 * fq;
#pragma unroll
        for (int ai = 0; ai < 2; ++ai)
#pragma unroll
            for (int m = 0; m < 4; ++m) {
                const int r = row0 + ai * 128 + m * 16;
#pragma unroll
                for (int bj = 0; bj < 2; ++bj) { const f32x4 v0 = acc[ai][bj][m][0], v1 = acc[ai][bj][m][1];
                    *(u32x4*)(dst + (size_t)r * 1024 + cl + bj * 128) = (u32x4){pk2c(v0[0], v0[1]), pk2c(v0[2], v0[3]), pk2c(v1[0], v1[1]), pk2c(v1[2], v1[3])}; }
            }
    }
};
struct EpiF32Out {
    static constexpr bool PERM = true, AFTER_DRAIN = false;
    bf16_t* dst;
    __device__ __forceinline__ void elem(int r, int c, float v) const { dst[(size_t)r * 1024 + c] = f2bf(v); }
    __device__ __forceinline__ void operator()(const f32x4 (&acc)[2][2][4][2], const Unit& u, int wr, int wc, int fr, int fq) const {
        const int row0 = u.pm * 256 + wr * 64 + fr, cl = u.pn * 256 + wc * 32 + 8 * fq;
#pragma unroll
        for (int ai = 0; ai < 2; ++ai)
#pragma unroll
            for (int m = 0; m < 4; ++m) {
                const int r = row0 + ai * 128 + m * 16;
#pragma unroll
                for (int bj = 0; bj < 2; ++bj) { const f32x4 v0 = acc[ai][bj][m][0], v1 = acc[ai][bj][m][1];
                    *(u32x4*)(dst + (size_t)r * 1024 + cl + bj * 128) = (u32x4){pk2c(v0[0], v0[1]), pk2c(v0[2], v0[3]), pk2c(v1[0], v1[1]), pk2c(v1[2], v1[3])}; }
            }
    }
};
struct EpiPle {
    static constexpr bool PERM = false, AFTER_DRAIN = false;
    const bf16_t* plea; bf16_t* dst;
    __device__ __forceinline__ void elem(int r, int c, float v) const { dst[(size_t)r * 1024 + c] = f2bf(bf2f(plea[(size_t)r * 1024 + c]) * sigmoidf_(v)); }
    __device__ __forceinline__ void operator()(const f32x4 (&acc)[2][2][4][2], const Unit& u, int wr, int wc, int fr, int fq) const {
        const int row0 = u.pm * 256 + wr * 64 + fr, col0 = u.pn * 256 + wc * 32 + 4 * fq;
#pragma unroll
        for (int ai = 0; ai < 2; ++ai)
#pragma unroll
            for (int m = 0; m < 4; ++m) { const size_t ro = (size_t)(row0 + ai * 128 + m * 16) * 1024 + col0;
#pragma unroll
                for (int bj = 0; bj < 2; ++bj)
#pragma unroll
                    for (int n = 0; n < 2; ++n) { const u32x2 a = *(const u32x2*)(plea + ro + bj * 128 + n * 16); const f32x4 v = acc[ai][bj][m][n];
                        const f32x2_t o0 = (f32x2_t){bflo(a.x), bfhi(a.x)} * sigmoid2((f32x2_t){v[0], v[1]}), o1 = (f32x2_t){bflo(a.y), bfhi(a.y)} * sigmoid2((f32x2_t){v[2], v[3]});
                        *(u32x2*)(dst + ro + bj * 128 + n * 16) = (u32x2){pk2(o0.x, o0.y), pk2(o1.x, o1.y)}; } }
    }
};

typedef short bf16x8 __attribute__((ext_vector_type(8)));
typedef float f32x16 __attribute__((ext_vector_type(16)));
typedef short bf16x4 __attribute__((ext_vector_type(4)));
#define MFMA32(a, b, c) __builtin_amdgcn_mfma_f32_32x32x16_bf16((a), (b), (c), 0, 0, 0)
__device__ __forceinline__ f32x16 zero16() { f32x16 z;
#pragma unroll
    for (int i = 0; i < 16; ++i) z[i] = 0.f; return z; }
__device__ __forceinline__ bf16x8 pack8f(const float (&v)[8]) { const u32x4 w = (u32x4){pk2(v[0], v[1]), pk2(v[2], v[3]), pk2(v[4], v[5]), pk2(v[6], v[7])}; return __builtin_bit_cast(bf16x8, w); }
__device__ __forceinline__ bf16x8 join44(bf16x4 lo, bf16x4 hi) { return __builtin_shufflevector(lo, hi, 0, 1, 2, 3, 4, 5, 6, 7); }

constexpr int PX = 72;
constexpr int PR = 136;
constexpr int L_XT = 0;
constexpr int L_B = L_XT + 8 * 64 * PX * 2;
constexpr int L_C = L_B + 128 * PX * 2;
constexpr int L_AC = L_C + 64 * PR * 2;
constexpr int L_DT = L_AC + 2048;
constexpr int L_WS = L_DT + 2048;
constexpr int ZP = 1040;
constexpr int SSD_LDS = L_WS + 2048;

struct ChunkInfo { int seqbase, row0, t0, nvalid; const float* hist; };
__device__ __forceinline__ ChunkInfo chunk_info(CPR p, int l, int ck) {
    ChunkInfo c;
    if (ck < 256) { c.seqbase = 0; c.row0 = 64 * ck; c.t0 = 64 * ck; c.nvalid = 64; c.hist = nullptr; }
    else { const int b = ck - 256; c.seqbase = M_P + 32 * b; c.row0 = c.seqbase; c.t0 = 0; c.nvalid = 32; c.hist = p.state_ssd_conv + ((size_t)l * DEC_BATCH + b) * 3 * 3072; }
    return c;
}
template <int NP> __device__ __forceinline__ void xbc_pad_raw(const bf16_t* __restrict__ xbcb, const float* __restrict__ hist, int rowbase, int hj, int c, unsigned (&d)[NP]) {
    if (hj >= 3) { const bf16_t* q = xbcb + (size_t)(rowbase + hj - 3) * 3072 + c;
        if (NP == 4) { const u32x4 t = *(const u32x4*)q; d[0] = t.x; d[1 % NP] = t.y; d[2 % NP] = t.z; d[3 % NP] = t.w; }
        else if (NP == 2) { const u32x2 t = *(const u32x2*)q; d[0] = t.x; d[1 % NP] = t.y; }
        else d[0] = *(const unsigned*)q; }
    else if (hist) {
#pragma unroll
        for (int k = 0; k < NP; ++k) { const float2 t = *(const float2*)(hist + (size_t)hj * 3072 + c + 2 * k); d[k] = pk2(t.x, t.y); } }
    else {
#pragma unroll
        for (int k = 0; k < NP; ++k) d[k] = 0u; }
}
__device__ __forceinline__ int xt_off(int R, int g) { return R * (PX * 2) + ((g ^ ((R >> 3) & 7)) << 4); }
template <int NP, class F> __device__ __forceinline__ void conv8(CPR p, int l, const ChunkInfo& ci, int s0, int c, F emit) {
    if (s0 >= ci.nvalid) {
        const float z[8] = {0.f, 0.f, 0.f, 0.f, 0.f, 0.f, 0.f, 0.f};
#pragma unroll
        for (int jp = 0; jp < NP; ++jp) emit(jp, z, z);
        return;
    }
    const float* cw = p.ssd_conv_w + (size_t)l * 4 * 3072 + c; const float* cb = p.ssd_conv_b + (size_t)l * 3072 + c;
    const int t = ci.t0 + s0;
    unsigned raw[11][NP];
#pragma unroll
    for (int k = 0; k < 11; ++k) xbc_pad_raw<NP>(p.xbcb, ci.hist, ci.seqbase, t + k, c, raw[k]);
#pragma unroll
    for (int jp = 0; jp < NP; ++jp) {
        const f32x2_t w0 = *(const f32x2_t*)(cw + 2 * jp), w1 = *(const f32x2_t*)(cw + 3072 + 2 * jp), w2 = *(const f32x2_t*)(cw + 2 * 3072 + 2 * jp), w3 = *(const f32x2_t*)(cw + 3 * 3072 + 2 * jp), bb = *(const f32x2_t*)(cb + 2 * jp);
        f32x2_t rv[11];
#pragma unroll
        for (int k = 0; k < 11; ++k) rv[k] = (f32x2_t){bflo(raw[k][jp]), bfhi(raw[k][jp])};
        float lo[8], hi[8];
#pragma unroll
        for (int i = 0; i < 8; ++i) {
            const f32x2_t a = bb + w0 * rv[i] + w1 * rv[i + 1] + w2 * rv[i + 2] + w3 * rv[i + 3];
            const f32x2_t sv = silu2(a);
            lo[i] = sv.x; hi[i] = sv.y;
        }
        emit(jp, lo, hi);
    }
}
__device__ __forceinline__ float unit_dt(CPR p, int l, int u, int wid, int lane) {
    const ChunkInfo ci = chunk_info(p, l, u >> 2);
    return (lane < ci.nvalid) ? p.dtb[(size_t)(ci.row0 + lane) * 32 + (u & 3) * 8 + wid] : 0.f;
}
__device__ __forceinline__ void head_scan(CPR p, int l, int h, int lane, float dtv, float& ac, float& aclast) {
    const float a = -__expf(p.ssd_a_log[l * 32 + h]);
    ac = dtv * a;
#pragma unroll
    for (int o = 1; o < 64; o <<= 1) { const float t = __shfl_up(ac, o); if (lane >= o) ac += t; }
    aclast = __shfl(ac, 63);
}
__device__ __forceinline__ void ph_ssd_p1(CPR p, int l, LDSP lds) {
    const int tid = tid_opaque(), wid = tid >> 6, lane = tid & 63, r = lane & 31, hh = lane >> 5;
    PG8_LAS float* acS = (PG8_LAS float*)(lds + L_AC); PG8_LAS float* wS = (PG8_LAS float*)(lds + L_WS);
    PG8_LAS bf16_t* xT = (PG8_LAS bf16_t*)(lds + L_XT); PG8_LAS bf16_t* BT = (PG8_LAS bf16_t*)(lds + L_B);
    const int u0 = bid_opaque(), nb = nblk_opaque();
    float dt_nx = (u0 < NCHUNK * 4) ? unit_dt(p, l, u0, wid, lane) : 0.f;
    for (int u = u0; u < NCHUNK * 4; u += nb) {
        const int ck = u >> 2, g = u & 3, h = g * 8 + wid;
        const ChunkInfo ci = chunk_info(p, l, ck);
        const float dtv = dt_nx; float ac, aclast; head_scan(p, l, h, lane, dtv, ac, aclast);
        dt_nx = (u + nb < NCHUNK * 4) ? unit_dt(p, l, u + nb, wid, lane) : 0.f;
        wS[wid * 64 + lane] = __expf(aclast - ac) * dtv;
        if (lane == 63) p.dec[ck * 32 + h] = __expf(aclast);
        __syncthreads();
        { const int cc = tid & 63, s0 = (tid >> 6) * 8, g8 = s0 >> 3, hl = cc >> 3, p0 = (cc & 7) * 8;
          float wv[8];
#pragma unroll
          for (int i = 0; i < 8; ++i) wv[i] = wS[hl * 64 + s0 + i];
          conv8<4>(p, l, ci, s0, g * 512 + cc * 8, [&](int jp, const float (&lo)[8], const float (&hi)[8]) {
              const int R = hl * 64 + p0 + 2 * jp;
              *(PG8_LAS u32x4*)(lds + L_XT + xt_off(R, g8)) = (u32x4){pk2(lo[0] * wv[0], lo[1] * wv[1]), pk2(lo[2] * wv[2], lo[3] * wv[3]), pk2(lo[4] * wv[4], lo[5] * wv[5]), pk2(lo[6] * wv[6], lo[7] * wv[7])};
              *(PG8_LAS u32x4*)(lds + L_XT + xt_off(R + 1, g8)) = (u32x4){pk2(hi[0] * wv[0], hi[1] * wv[1]), pk2(hi[2] * wv[2], hi[3] * wv[3]), pk2(hi[4] * wv[4], hi[5] * wv[5]), pk2(hi[6] * wv[6], hi[7] * wv[7])}; }); }
        { const int q = tid & 63, s0 = (tid >> 6) * 8, g8 = s0 >> 3, n0 = 2 * q;
          conv8<1>(p, l, ci, s0, 2048 + g * 128 + n0, [&](int jp, const float (&lo)[8], const float (&hi)[8]) {
              *(PG8_LAS u32x4*)(lds + L_B + xt_off(n0, g8)) = (u32x4){pk2(lo[0], lo[1]), pk2(lo[2], lo[3]), pk2(lo[4], lo[5]), pk2(lo[6], lo[7])};
              *(PG8_LAS u32x4*)(lds + L_B + xt_off(n0 + 1, g8)) = (u32x4){pk2(hi[0], hi[1]), pk2(hi[2], hi[3]), pk2(hi[4], hi[5]), pk2(hi[6], hi[7])}; }); }
        __syncthreads();
        f32x16 acc[4][2];
#pragma unroll
        for (int a = 0; a < 4; ++a)
#pragma unroll
            for (int b = 0; b < 2; ++b) acc[a][b] = zero16();
#pragma unroll
        for (int ks = 0; ks < 4; ++ks) {
            bf16x8 A[2], Bf[4];
#pragma unroll
            for (int pt = 0; pt < 2; ++pt) A[pt] = *(const PG8_LAS bf16x8*)(lds + L_XT + xt_off(wid * 64 + 32 * pt + r, 2 * ks + hh));
#pragma unroll
            for (int nt = 0; nt < 4; ++nt) Bf[nt] = *(const PG8_LAS bf16x8*)(lds + L_B + xt_off(32 * nt + r, 2 * ks + hh));
#pragma unroll
            for (int nt = 0; nt < 4; ++nt)
#pragma unroll
                for (int pt = 0; pt < 2; ++pt) acc[nt][pt] = MFMA32(Bf[nt], A[pt], acc[nt][pt]);
        }
        bf16_t* dst = (bf16_t*)p.sst + ((size_t)ck * 32 + h) * 8192 + lane * 16;
#pragma unroll
        for (int nt = 0; nt < 4; ++nt)
#pragma unroll
            for (int pt = 0; pt < 2; ++pt) {
                const f32x16& a = acc[nt][pt];
                *(u32x4*)(dst + (nt * 2 + pt) * 1024) = (u32x4){pk2c(a[0], a[1]), pk2c(a[2], a[3]), pk2c(a[4], a[5]), pk2c(a[6], a[7])};
                *(u32x4*)(dst + (nt * 2 + pt) * 1024 + 8) = (u32x4){pk2c(a[8], a[9]), pk2c(a[10], a[11]), pk2c(a[12], a[13]), pk2c(a[14], a[15])};
            }
        __syncthreads();
    }
}
__device__ __forceinline__ int frag_to_logical(int x) {
    const int h = x >> 13, y = x & 8191, T = y >> 10, L = (y >> 4) & 63, q = y & 15;
    const int p = 32 * (T & 1) + (L & 31), n = 32 * (T >> 1) + (q & 3) + 8 * (q >> 2) + 4 * (L >> 5);
    return h * 8192 + p * 128 + n;
}
__device__ __forceinline__ void ph_ssd_p2(CPR p, int l) {
    const int gtid = bid_opaque() * 512 + tid_opaque(), gsz = nblk_opaque() * 512;
    const unsigned* sst2 = (const unsigned*)p.sst; unsigned* hp2 = (unsigned*)p.hpb;
    for (int e = gtid; e < 131072; e += gsz) {
        const int h = e >> 12; float2 hc = make_float2(0.f, 0.f);
        for (int c0 = 0; c0 < 256; c0 += 32) {
            unsigned S[32]; float d[32];
#pragma unroll
            for (int i = 0; i < 32; ++i) { S[i] = sst2[(size_t)(c0 + i) * 131072 + e]; d[i] = p.dec[(c0 + i) * 32 + h]; }
#pragma unroll
            for (int i = 0; i < 32; ++i) { hp2[(size_t)(c0 + i) * 131072 + e] = pk2(hc.x, hc.y); const f32x2_t hn = (f32x2_t){hc.x, hc.y} * d[i] + (f32x2_t){bflo(S[i]), bfhi(S[i])}; hc.x = hn.x; hc.y = hn.y; }
        }
        ((float2*)(p.out + O_P_STATE + (size_t)l * STATE_SZ))[frag_to_logical(2 * e) >> 1] = hc;
    }
    for (int i = gtid; i < DEC_BATCH * 131072; i += gsz) {
        const int b = i >> 17, e = i & 131071, h = e >> 12, ck = 256 + b;
        const int el = frag_to_logical(2 * e) >> 1;
        const float2 h0 = ((const float2*)(p.state_ssd + ((size_t)l * DEC_BATCH + b) * STATE_SZ))[el]; const unsigned Sw = sst2[(size_t)ck * 131072 + e]; const float2 S = make_float2(bflo(Sw), bfhi(Sw)); const float d = p.dec[ck * 32 + h];
        hp2[(size_t)ck * 131072 + e] = pk2(h0.x, h0.y);
        ((float2*)(p.out + O_S_STATE + ((size_t)l * DEC_BATCH + b) * STATE_SZ))[el] = make_float2(fmaf(d, h0.x, S.x), fmaf(d, h0.y, S.y));
    }
}
__device__ __forceinline__ void ph_ssd_p3(CPR p, int l, LDSP lds) {
    const int tid = tid_opaque(), wid = tid >> 6, lane = tid & 63, r = lane & 31, hh = lane >> 5;
    PG8_LAS float* acS = (PG8_LAS float*)(lds + L_AC); PG8_LAS float* dtS = (PG8_LAS float*)(lds + L_DT); PG8_LAS float* red = (PG8_LAS float*)(lds + L_WS);
    PG8_LAS bf16_t* xT = (PG8_LAS bf16_t*)(lds + L_XT);
    const int u0 = bid_opaque(), nb = nblk_opaque();
    float dt_nx = (u0 < NCHUNK * 4) ? unit_dt(p, l, u0, wid, lane) : 0.f;
    for (int u = u0; u < NCHUNK * 4; u += nb) {
        const int ck = u >> 2, g = u & 3, h = g * 8 + wid;
        const ChunkInfo ci = chunk_info(p, l, ck);
        const float Dh = p.ssd_d[l * 32 + h];
        { const float dtv = dt_nx; float ac, aclast; head_scan(p, l, h, lane, dtv, ac, aclast); acS[wid * 64 + lane] = ac; dtS[wid * 64 + lane] = dtv; }
        dt_nx = (u + nb < NCHUNK * 4) ? unit_dt(p, l, u + nb, wid, lane) : 0.f;
        bf16x8 HA[8][2];
        const bf16_t* hp = p.hpb + ((size_t)ck * 32 + h) * 8192;
        { const int cc = tid & 63, s0 = (tid >> 6) * 8, g8 = s0 >> 3, hl = cc >> 3, p0 = (cc & 7) * 8;
          conv8<4>(p, l, ci, s0, g * 512 + cc * 8, [&](int jp, const float (&lo)[8], const float (&hi)[8]) {
              const int R = hl * 64 + p0 + 2 * jp;
              *(PG8_LAS u32x4*)(lds + L_XT + xt_off(R, g8)) = (u32x4){pk2(lo[0], lo[1]), pk2(lo[2], lo[3]), pk2(lo[4], lo[5]), pk2(lo[6], lo[7])};
              *(PG8_LAS u32x4*)(lds + L_XT + xt_off(R + 1, g8)) = (u32x4){pk2(hi[0], hi[1]), pk2(hi[2], hi[3]), pk2(hi[4], hi[5]), pk2(hi[6], hi[7])}; }); }
        { const int q = tid & 63, s0 = (tid >> 6) * 8, n4 = 4 * (q & 31), off = (q < 32 ? L_B : L_C) + n4 * 2;
          conv8<2>(p, l, ci, s0, (q < 32 ? 2048 : 2560) + g * 128 + n4, [&](int jp, const float (&lo)[8], const float (&hi)[8]) {
#pragma unroll
              for (int i = 0; i < 8; ++i) *(PG8_LAS unsigned*)(lds + off + jp * 4 + (s0 + i) * PR * 2) = pk2(lo[i], hi[i]); }); }
#pragma unroll
        for (int ks = 0; ks < 8; ++ks) { HA[ks][0] = *(const bf16x8*)(hp + ((ks >> 1) * 2 + 0) * 1024 + lane * 16 + 8 * (ks & 1)); HA[ks][1] = *(const bf16x8*)(hp + ((ks >> 1) * 2 + 1) * 1024 + lane * 16 + 8 * (ks & 1)); }
        __syncthreads();
        f32x16 yd[2][2];
#pragma unroll
        for (int a = 0; a < 2; ++a)
#pragma unroll
            for (int b = 0; b < 2; ++b) yd[a][b] = zero16();
#pragma unroll
        for (int ks = 0; ks < 8; ++ks) {
            bf16x8 Bf[2];
#pragma unroll
            for (int lt = 0; lt < 2; ++lt) { const int eo = ((32 * lt + r) * PR + 16 * ks + 4 * hh) * 2;
                Bf[lt] = join44(*(const PG8_LAS bf16x4*)(lds + L_C + eo), *(const PG8_LAS bf16x4*)(lds + L_C + eo + 16)); }
#pragma unroll
            for (int pt = 0; pt < 2; ++pt)
#pragma unroll
                for (int lt = 0; lt < 2; ++lt) yd[pt][lt] = MFMA32(HA[ks][pt], Bf[lt], yd[pt][lt]);
        }
#pragma unroll
        for (int lt = 0; lt < 2; ++lt) { const float eal = __expf(acS[wid * 64 + 32 * lt + r]);
#pragma unroll
            for (int pt = 0; pt < 2; ++pt)
#pragma unroll
                for (int q = 0; q < 16; q += 2) { const f32x2_t t = (f32x2_t){yd[pt][lt][q], yd[pt][lt][q + 1]} * eal; yd[pt][lt][q] = t.x; yd[pt][lt][q + 1] = t.y; } }
        u32x4 zraw[8];
#pragma unroll
        for (int i = 0; i < 8; ++i) { const int e = tid + 512 * i, tok = e >> 6; zraw[i] = *(const u32x4*)(p.zb + (size_t)(ci.row0 + (tok < ci.nvalid ? tok : 0)) * 2048 + g * 512 + (e & 63) * 8); }
#pragma unroll
        for (int tix = 0; tix < 3; ++tix) {
            const int st = (tix == 2) ? 1 : 0, lt = (tix == 0) ? 0 : 1;
            f32x16 G = zero16();
#pragma unroll
            for (int ks = 0; ks < 8; ++ks) {
                const bf16x8 A = *(const PG8_LAS bf16x8*)(lds + L_B + ((32 * st + r) * PR + 16 * ks + 8 * hh) * 2);
                const bf16x8 Bf = *(const PG8_LAS bf16x8*)(lds + L_C + ((32 * lt + r) * PR + 16 * ks + 8 * hh) * 2);
                G = MFMA32(A, Bf, G);
            }
            const int lcol = 32 * lt + r; const float acl = acS[wid * 64 + lcol];
            float mv[16];
#pragma unroll
            for (int q = 0; q < 16; q += 2) {
                const int s = 32 * st + (q & 3) + 8 * (q >> 2) + 4 * hh;
                const f32x2_t acs = *(const PG8_LAS f32x2_t*)(acS + wid * 64 + s), dts = *(const PG8_LAS f32x2_t*)(dtS + wid * 64 + s);
                const f32x2_t dd = __builtin_elementwise_min((f32x2_t){acl, acl} - acs, (f32x2_t){0.f, 0.f}) * 1.4426950408889634f;
                const f32x2_t v2 = (f32x2_t){G[q], G[q + 1]} * exp2_2(dd) * dts;
                float va = (s <= lcol) ? v2.x : 0.f, vb = (s + 1 <= lcol) ? v2.y : 0.f;
                if (s == lcol) va += Dh; if (s + 1 == lcol) vb += Dh;
                mv[q] = va; mv[q + 1] = vb;
            }
#pragma unroll
            for (int kk = 0; kk < 2; ++kk) {
                const float m8[8] = {mv[8 * kk], mv[8 * kk + 1], mv[8 * kk + 2], mv[8 * kk + 3], mv[8 * kk + 4], mv[8 * kk + 5], mv[8 * kk + 6], mv[8 * kk + 7]};
                const bf16x8 Bm = pack8f(m8);
#pragma unroll
                for (int pt = 0; pt < 2; ++pt) {
                    const int R = wid * 64 + 32 * pt + r, g = 4 * st + 2 * kk;
                    const bf16x4 lo = *(const PG8_LAS bf16x4*)(lds + L_XT + xt_off(R, g) + 8 * hh), hi = *(const PG8_LAS bf16x4*)(lds + L_XT + xt_off(R, g + 1) + 8 * hh);
                    yd[pt][lt] = MFMA32(join44(lo, hi), Bm, yd[pt][lt]);
                }
            }
        }
        __syncthreads();
#pragma unroll
        for (int i = 0; i < 8; ++i) { const int e = tid + 512 * i; *(PG8_LAS u32x4*)(lds + L_XT + (e >> 6) * ZP + (e & 63) * 16) = zraw[i]; }
        __syncthreads();
        float ssl[2];
#pragma unroll
        for (int lt = 0; lt < 2; ++lt) {
            const int lcol = 32 * lt + r;
            float ss = 0.f;
#pragma unroll
            for (int pt = 0; pt < 2; ++pt)
#pragma unroll
                for (int i = 0; i < 4; ++i) {
                    const u32x2 zw = *(const PG8_LAS u32x2*)(lds + L_XT + lcol * ZP + (wid * 64 + 32 * pt + 8 * i + 4 * hh) * 2);
                    const f32x2_t za = (f32x2_t){bflo(zw.x), bfhi(zw.x)}, zb2 = (f32x2_t){bflo(zw.y), bfhi(zw.y)};
                    const f32x2_t ga = (f32x2_t){yd[pt][lt][4 * i], yd[pt][lt][4 * i + 1]} * silu2(za), gb2 = (f32x2_t){yd[pt][lt][4 * i + 2], yd[pt][lt][4 * i + 3]} * silu2(zb2);
                    yd[pt][lt][4 * i] = ga.x; yd[pt][lt][4 * i + 1] = ga.y; yd[pt][lt][4 * i + 2] = gb2.x; yd[pt][lt][4 * i + 3] = gb2.y;
                    const f32x2_t sq = ga * ga + gb2 * gb2; ss += sq.x + sq.y;
                }
            ss += __shfl_xor(ss, 32);
            ssl[lt] = ss;
        }
        if (hh == 0) { red[wid * 64 + r] = ssl[0]; red[wid * 64 + 32 + r] = ssl[1]; }
        __syncthreads();
#pragma unroll
        for (int lt = 0; lt < 2; ++lt) {
            const int lcol = 32 * lt + r;
            float tot = 0.f;
#pragma unroll
            for (int w = 0; w < 8; ++w) tot += red[w * 64 + lcol];
            const float rstd = rsqrtf(tot * (1.0f / 512.f) + EPS);
#pragma unroll
            for (int pt = 0; pt < 2; ++pt)
#pragma unroll
                for (int i = 0; i < 4; ++i)
                { const f32x2_t a = (f32x2_t){yd[pt][lt][4 * i], yd[pt][lt][4 * i + 1]} * rstd, b = (f32x2_t){yd[pt][lt][4 * i + 2], yd[pt][lt][4 * i + 3]} * rstd;
                    *(PG8_LAS u32x2*)(lds + L_XT + lcol * ZP + (wid * 64 + 32 * pt + 8 * i + 4 * hh) * 2) = (u32x2){pk2(a.x, a.y), pk2(b.x, b.y)}; }
        }
        __syncthreads();
#pragma unroll
        for (int i = 0; i < 8; ++i) { const int e = tid + 512 * i, tok = e >> 6;
            if (tok < ci.nvalid) *(u32x4*)(p.yn + (size_t)(ci.row0 + tok) * 2048 + g * 512 + (e & 63) * 8) = *(const PG8_LAS u32x4*)(lds + L_XT + tok * ZP + (e & 63) * 16); }
        __syncthreads();
    }
}
#ifndef ATT_EXIT_P
#define ATT_EXIT_P 1e-20f
#endif
typedef short v4i16_t __attribute__((ext_vector_type(4)));
constexpr int AT_PITCH = 272;
constexpr int AT_TILE = 32 * AT_PITCH;
constexpr int ATT_LDS = 8 * 2 * AT_TILE;
__device__ __forceinline__ void ph_attn(CPR p, int l, LDSP lds) {
    const int tidx = tid_opaque(); const int lane = tidx & 63, r = lane & 31, hh = lane >> 5, wv = tidx >> 6, NGW = nblk_opaque() * 8, gw = (bid_opaque() * 8 + wv + (NGW >> 1)) % NGW;
    const bf16_t* kbb = p.kb; const bf16_t* vbb = p.vb;
    const float* ck = p.cache_k + (size_t)l * DEC_BATCH * PAST_LEN * 1024; const float* cv = p.cache_v + (size_t)l * DEC_BATCH * PAST_LEN * 1024;
    const float scale = 0.08838834764831845f;
    LDSP kl = lds + wv * (2 * AT_TILE); LDSP vl = kl + AT_TILE;
    const int st_g = (lane >> 5) * 1024 + (lane & 31) * 4;
    const int st_l = (lane >> 5) * AT_PITCH + (lane & 31) * 8;
    const int vs_g = (lane >> 4) * 1024 + (lane & 15) * 8;
    const int vs_l = (lane >> 4) * AT_PITCH + (lane & 15) * 16;
    const int ka_off = r * AT_PITCH + 16 * hh;
    const int vt_off = (4 * hh + ((lane & 15) >> 2)) * AT_PITCH + (16 * ((lane >> 4) & 1) + 4 * (lane & 3)) * 2;
    const int nwg = NGW >> 3, wgr = gw >> 3;
    for (int U = wgr; U < 512 + 32; U += nwg) {
        int hd, b, rowq0, P0;
        if (U < 512) { hd = U & 7; const int qt = 8 * (U >> 3) + wv; b = -1; rowq0 = 32 * qt; P0 = 32 * qt; }
        else { hd = wv; b = U - 512; rowq0 = M_P + 32 * b; P0 = PAST_LEN; }
        const bf16_t* qrow = p.qb + (size_t)(rowq0 + r) * 1024 + hd * 128 + 8 * hh;
        bf16x8 qf[8];
#pragma unroll
        for (int ks = 0; ks < 8; ++ks) qf[ks] = *(const bf16x8*)(qrow + 16 * ks);
        f32x16 O[4];
#pragma unroll
        for (int d = 0; d < 4; ++d) O[d] = zero16();
        float carry = 1.0f;
        const int ktd = P0 >> 5;
        u32x4 buf[16];
        { const bf16_t* kq = kbb + (size_t)(rowq0 + r) * 1024 + hd * 128 + 8 * hh;
#pragma unroll
          for (int ks = 0; ks < 8; ++ks) buf[8 + ks] = *(const u32x4*)(kq + 16 * ks); }
        for (int kt = ktd; kt >= 0; --kt) {
            const bool bfs = (b < 0) || (kt == ktd);
            f32x16 S = zero16();
            if (bfs) {
                const bf16_t* vq = vbb + (size_t)(b < 0 ? 32 * kt : rowq0) * 1024 + hd * 128 + vs_g;
#pragma unroll
                for (int i = 0; i < 8; ++i) buf[i] = *(const u32x4*)(vq + 4096 * i);
#pragma unroll
                for (int ks = 0; ks < 8; ++ks) S = MFMA32(__builtin_bit_cast(bf16x8, buf[8 + ks]), qf[ks], S);
            } else {
                const float* vb = cv + ((size_t)b * PAST_LEN + 32 * kt) * 1024 + hd * 128 + st_g;
#pragma unroll
                for (int i = 0; i < 16; ++i) buf[i] = *(const u32x4*)(vb + 2048 * i);
                asm volatile("s_waitcnt lgkmcnt(0)" ::: "memory");
#pragma unroll
                for (int ks = 0; ks < 8; ++ks) S = MFMA32(*(const PG8_LAS bf16x8*)(kl + ka_off + 32 * ks), qf[ks], S);
            }
            const bool diag = (kt == ktd);
            float kp[16], sg[16];
#pragma unroll
            for (int q = 0; q < 16; q += 2) {
                const int key = (q & 3) + 8 * (q >> 2) + 4 * hh;
                const f32x2_t z = (f32x2_t){S[q], S[q + 1]} * scale, e = exp2_2(__builtin_elementwise_abs(z) * (-1.4426950408889634f)), big = rcp_2(e + 1.0f), small = e * big;
                const bool v0 = !diag || key < r, v1 = !diag || key + 1 < r;
                sg[q] = v0 ? (z.x >= 0.f ? big.x : small.x) : 0.f; kp[q] = v0 ? (z.x >= 0.f ? small.x : big.x) : 1.0f;
                sg[q + 1] = v1 ? (z.y >= 0.f ? big.y : small.y) : 0.f; kp[q + 1] = v1 ? (z.y >= 0.f ? small.y : big.y) : 1.0f;
            }
            float T[4], Tp[4];
#pragma unroll
            for (int gi = 0; gi < 4; ++gi) { T[gi] = (kp[4 * gi] * kp[4 * gi + 1]) * (kp[4 * gi + 2] * kp[4 * gi + 3]); Tp[gi] = __shfl_xor(T[gi], 32); }
            float wg[16]; float aft = carry;
#pragma unroll
            for (int gi = 3; gi >= 0; --gi) {
                float suf = aft * (hh == 0 ? Tp[gi] : 1.0f);
#pragma unroll
                for (int j = 3; j >= 0; --j) { wg[4 * gi + j] = sg[4 * gi + j] * suf; suf *= kp[4 * gi + j]; }
                aft *= T[gi] * Tp[gi];
            }
            carry = aft;
            bf16x8 Pf[2];
#pragma unroll
            for (int kk = 0; kk < 2; ++kk) {
                const float w8[8] = {wg[8 * kk], wg[8 * kk + 1], wg[8 * kk + 2], wg[8 * kk + 3], wg[8 * kk + 4], wg[8 * kk + 5], wg[8 * kk + 6], wg[8 * kk + 7]};
                Pf[kk] = pack8f(w8);
            }
            if (bfs) {
#pragma unroll
                for (int i = 0; i < 8; ++i) *(PG8_LAS u32x4*)(vl + vs_l + 4 * AT_PITCH * i) = buf[i];
            } else {
#pragma unroll
                for (int i = 0; i < 16; ++i) { const float4 t = __builtin_bit_cast(float4, buf[i]); *(PG8_LAS u32x2*)(vl + st_l + 2 * AT_PITCH * i) = (u32x2){pk2(t.x, t.y), pk2(t.z, t.w)}; }
            }
            const bool more = (kt > 0) && !__all(carry < ATT_EXIT_P);
            if (more) {
                if (b < 0) { const bf16_t* kq = kbb + (size_t)(32 * (kt - 1) + r) * 1024 + hd * 128 + 8 * hh;
#pragma unroll
                    for (int ks = 0; ks < 8; ++ks) buf[8 + ks] = *(const u32x4*)(kq + 16 * ks); }
                else { const float* kb = ck + ((size_t)b * PAST_LEN + 32 * (kt - 1)) * 1024 + hd * 128 + st_g;
#pragma unroll
                    for (int i = 0; i < 16; ++i) buf[i] = *(const u32x4*)(kb + 2048 * i); }
            }
            asm volatile("s_waitcnt lgkmcnt(0)" ::: "memory");
#pragma unroll
            for (int kk = 0; kk < 2; ++kk)
#pragma unroll
                for (int d = 0; d < 4; ++d) {
                    const bf16x4 lo = __builtin_bit_cast(bf16x4, __builtin_amdgcn_ds_read_tr16_b64_v4i16((PG8_LAS v4i16_t*)(vl + vt_off + kk * 16 * AT_PITCH + d * 64)));
                    const bf16x4 hi = __builtin_bit_cast(bf16x4, __builtin_amdgcn_ds_read_tr16_b64_v4i16((PG8_LAS v4i16_t*)(vl + vt_off + kk * 16 * AT_PITCH + 8 * AT_PITCH + d * 64)));
                    O[d] = MFMA32(Pf[kk], join44(lo, hi), O[d]);
                }
            if (!more) break;
            if (b >= 0) {
#pragma unroll
                for (int i = 0; i < 16; ++i) { const float4 t = __builtin_bit_cast(float4, buf[i]); *(PG8_LAS u32x2*)(kl + st_l + 2 * AT_PITCH * i) = (u32x2){pk2(t.x, t.y), pk2(t.z, t.w)}; }
            }
        }
#pragma unroll
        for (int d = 0; d < 4; ++d)
#pragma unroll
            for (int q = 0; q < 16; ++q) *(PG8_LAS unsigned short*)(kl + ((q & 3) + 8 * (q >> 2) + 4 * hh) * AT_PITCH + (32 * d + r) * 2) = (unsigned short)pk2c(O[d][q], 0.0f);
        asm volatile("s_waitcnt lgkmcnt(0)" ::: "memory");
#pragma unroll
        for (int i = 0; i < 8; ++i) *(u32x4*)(p.att + (size_t)(rowq0 + (lane >> 4) + 4 * i) * 1024 + hd * 128 + (lane & 15) * 8) = *(const PG8_LAS u32x4*)(kl + vs_l + 4 * AT_PITCH * i);
    }
}

constexpr int MEGA_BODY = (ATT_LDS > pg8::STAGE_BYTES ? ATT_LDS : pg8::STAGE_BYTES);
constexpr int MEGA_LDS = MEGA_BODY + 64;
#ifndef WGM_IN
#define WGM_IN 4
#endif
#ifndef WGM_UP
#define WGM_UP 8
#endif
#ifndef PROBE_GBIG
#define PROBE_GBIG 1
#endif
#ifndef PROBE_GSMALL
#define PROBE_GSMALL 1
#endif
#ifndef PROBE_S
#define PROBE_S 1
#endif
#ifndef PROBE_A
#define PROBE_A 1
#endif
#ifndef PROBE_M
#define PROBE_M 1
#endif
#ifndef PROBE_P1
#define PROBE_P1 PROBE_S
#endif
#ifndef PROBE_P3
#define PROBE_P3 PROBE_S
#endif
#ifndef PROBE_P2
#define PROBE_P2 PROBE_M
#endif
#ifndef PROBE_FFN
#define PROBE_FFN PROBE_M
#endif
#ifndef PROBE_PRO
#define PROBE_PRO PROBE_M
#endif
#ifndef PROBE_NORM
#define PROBE_NORM 0
#endif
#ifndef PROBE_BAR
#define PROBE_BAR 1
#endif
#define GRID_BARRIER() do { for (int rb_ = 0; rb_ < PROBE_BAR; ++rb_) xcd_barrier(bar); } while (0)
template <class Epi> __device__ __forceinline__ void gemm_site(LDSP lds, const bf16_t* A, const bf16_t* Bt, int N, int K, const Epi& E) {
    for (int rep_ = 0; rep_ < (N > 1024 ? PROBE_GBIG : PROBE_GSMALL); ++rep_) {
    Gemm g; g.A = A; g.Bt = Bt; g.M = M_ALL; g.N = N; g.K = K;
    StaticOrder S; S.init(M_ALL, N, nblk_opaque(), bid_opaque(), N == 8192 ? WGM_UP : WGM_IN);
    pg8::gemm_phase<Epi, StaticOrder, false>(lds, g, S, E, nullptr);
    }
}
template <bool HALO, class Epi> __device__ __forceinline__ void gemm_small(LDSP lds, const bf16_t* A, const bf16_t* Bt, int K, const Epi& E, int c_ = -1, int G_ = 0) {
    const int tid = tid_opaque(), wid = tid >> 6, lane = tid & 63, r = lane & 31, hh = lane >> 5;
    const int nb = c_ < 0 ? nblk_opaque() : G_;
    for (int t = (c_ < 0 ? bid_opaque() : c_); t < (HALO ? 512 : 256); t += nb) {
        const int m0 = HALO ? (t >> 6) * 64 : M_P + (t >> 4) * 64, n0 = HALO ? (t & 63) * 64 : (t & 15) * 64, kbeg = wid * (K >> 3), nst = K >> 7;
        const int nrow = HALO ? (n0 >> 7) * 256 + (n0 & 127) : n0;
        const bf16_t* ap = A + (size_t)(m0 + r) * K + kbeg + 8 * hh; const bf16_t* bp = Bt + (size_t)(nrow + r) * K + kbeg + 8 * hh;
        const size_t hop = (size_t)32 * K;
        f32x16 acc[2][2];
#pragma unroll
        for (int a = 0; a < 2; ++a)
#pragma unroll
            for (int b = 0; b < 2; ++b) acc[a][b] = zero16();
        bf16x8 fa[4][2], fb[4][2];
#pragma unroll
        for (int s = 0; s < 3; ++s) { const int ko = 16 * (s < nst ? s : 0);
            fa[s][0] = *(const bf16x8*)(ap + ko); fa[s][1] = *(const bf16x8*)(ap + hop + ko); fb[s][0] = *(const bf16x8*)(bp + ko); fb[s][1] = *(const bf16x8*)(bp + hop + ko); }
        for (int st = 0; st < nst; st += 2) {
#pragma unroll
            for (int s2 = 0; s2 < 2; ++s2) {
                const int cur = (st + s2) & 3, nxs = (st + s2 + 3) & 3, nx = st + s2 + 3, ko = 16 * (nx < nst ? nx : 0);
                if (((st >> 1) & 1) == 0) {
                    fa[(s2 + 3) & 3][0] = *(const bf16x8*)(ap + ko); fa[(s2 + 3) & 3][1] = *(const bf16x8*)(ap + hop + ko); fb[(s2 + 3) & 3][0] = *(const bf16x8*)(bp + ko); fb[(s2 + 3) & 3][1] = *(const bf16x8*)(bp + hop + ko);
#pragma unroll
                    for (int a = 0; a < 2; ++a)
#pragma unroll
                        for (int b = 0; b < 2; ++b) acc[a][b] = MFMA32(fa[s2][a], fb[s2][b], acc[a][b]);
                } else {
                    fa[(s2 + 1) & 3][0] = *(const bf16x8*)(ap + ko); fa[(s2 + 1) & 3][1] = *(const bf16x8*)(ap + hop + ko); fb[(s2 + 1) & 3][0] = *(const bf16x8*)(bp + ko); fb[(s2 + 1) & 3][1] = *(const bf16x8*)(bp + hop + ko);
#pragma unroll
                    for (int a = 0; a < 2; ++a)
#pragma unroll
                        for (int b = 0; b < 2; ++b) acc[a][b] = MFMA32(fa[s2 + 2][a], fb[s2 + 2][b], acc[a][b]);
                }
                (void)cur; (void)nxs;
            }
        }
        PG8_LAS float* red = (PG8_LAS float*)lds;
#pragma unroll
        for (int a = 0; a < 2; ++a)
#pragma unroll
            for (int b = 0; b < 2; ++b)
#pragma unroll
                for (int q = 0; q < 16; ++q) red[((wid * 4 + a * 2 + b) * 16 + q) * 64 + lane] = acc[a][b][q];
        __syncthreads();
        { const int blk = wid & 3, q0 = (wid >> 2) * 8, a = blk >> 1, b = blk & 1;
#pragma unroll
          for (int q = 0; q < 8; ++q) { float v = 0.f;
#pragma unroll
              for (int w = 0; w < 8; ++w) v += red[((w * 4 + blk) * 16 + q0 + q) * 64 + lane];
              const int qq = q0 + q; E.elem(m0 + 32 * a + (qq & 3) + 8 * (qq >> 2) + 4 * hh, n0 + 32 * b + r, v); } }
        __syncthreads();
    }
}
template <class Epi> __device__ __forceinline__ void gemm_site_n1024_part(LDSP lds, const bf16_t* A, const bf16_t* Bt, int K, const Epi& E, int G, int c) {
    Gemm g; g.A = A; g.Bt = Bt; g.M = M_P; g.N = 1024; g.K = K;
    StaticOrder S; S.init(M_P, 1024, G, c);
    pg8::gemm_phase<Epi, StaticOrder, false>(lds, g, S, E, nullptr);
    gemm_small<false>(lds, A, Bt, K, E, c, G);
}
template <class Epi> __device__ __forceinline__ void gemm_site_n1024(LDSP lds, const bf16_t* A, const bf16_t* Bt, int K, const Epi& E) {
    for (int rep_ = 0; rep_ < PROBE_GSMALL; ++rep_) {
    Gemm g; g.A = A; g.Bt = Bt; g.M = M_P; g.N = 1024; g.K = K;
    StaticOrder S; S.init(M_P, 1024, nblk_opaque(), bid_opaque());
    pg8::gemm_phase<Epi, StaticOrder, false>(lds, g, S, E, nullptr);
    gemm_small<false>(lds, A, Bt, K, E);
    }
}
__global__ void __launch_bounds__(512, 2) k_mega(Params p_) {
    extern __shared__ __attribute__((aligned(16))) unsigned char shm[];
    LDSP lds = (LDSP)shm;
    volatile LAS unsigned* xbw = (volatile LAS unsigned*)(lds + MEGA_BODY);
    if (threadIdx.x < 4) xbw[threadIdx.x] = 0u;
    __syncthreads();
    XcdBarrier bar = xcd_barrier_post(kargs()->bar, xbw);
    for (int rep_ = 0; rep_ < PROBE_PRO; ++rep_) { { CPR p = *kargs(); ph_wt(p, lds); }
    { CPR p = *kargs(); ph_xprep(p); } }
    GRID_BARRIER();
    for (int l = 0; l < DEPTH; ++l) {
        { CPR p = *kargs(); float* out = p.out; const bf16_t* wl = p.wt + (size_t)l * WT_LAYER; EpiIn E; E.rs = p.rs; E.zb = p.zb; E.xbcb = p.xbcb; E.qb = p.qb; E.kb = p.kb; E.vb = p.vb; E.gb = p.gb; E.dtb = p.dtb; E.dt_bias = p.ssd_dt_bias + l * 32;
          E.kP = out + O_P_K + (size_t)l * M_P * 1024; E.vP = out + O_P_V + (size_t)l * M_P * 1024; E.kS = out + O_S_K + (size_t)l * M_S * 1024; E.vS = out + O_S_V + (size_t)l * M_S * 1024;
          E.convP = out + O_P_CONV + (size_t)l * 3 * 3072; E.convS = out + O_S_CONV + (size_t)l * DEC_BATCH * 3 * 3072;
          gemm_site(lds, p.xb, wl + OW1, N1, 1024, E); }
        GRID_BARRIER();
        for (int rep_ = 0; rep_ < PROBE_P1; ++rep_) { CPR p = *kargs(); ph_ssd_p1(p, l, lds); }
        for (int rep_ = 0; rep_ < PROBE_A; ++rep_) { CPR p = *kargs(); ph_attn(p, l, lds); }
        GRID_BARRIER();
        for (int rep_ = 0; rep_ < PROBE_P2; ++rep_) { CPR p = *kargs(); ph_ssd_p2(p, l); }
        { CPR p = *kargs(); float* out = p.out; const bf16_t* wl = p.wt + (size_t)l * WT_LAYER; EpiBr E; E.gb = p.gb; E.t1in = nullptr; E.dst = p.t1; E.mode = 0; E.pad = 0; gemm_site_n1024(lds, p.att, wl + OW3, 1024, E); }
        GRID_BARRIER();
        for (int rep_ = 0; rep_ < PROBE_P3; ++rep_) { CPR p = *kargs(); ph_ssd_p3(p, l, lds); }
        GRID_BARRIER();
        { CPR p = *kargs(); float* out = p.out; const bf16_t* wl = p.wt + (size_t)l * WT_LAYER; EpiBr E; E.gb = p.gb; E.t1in = p.t1; E.dst = p.mixin; E.mode = 1; E.pad = 0; gemm_site_n1024(lds, p.yn, wl + OW2, 2048, E); }
        GRID_BARRIER();
        { CPR p = *kargs(); float* out = p.out; const bf16_t* wl = p.wt + (size_t)l * WT_LAYER; EpiF32Out E; E.dst = p.mixed; gemm_site_n1024(lds, p.mixin, wl + OW4, 1024, E); }
        GRID_BARRIER();
        { CPR p = *kargs(); float* out = p.out; (void)out; ph_norm(p.mixed, p.norm_post_mix + l * 1024, p.xr, p.xb, nullptr, nullptr, p.xh); }
        GRID_BARRIER();
        { CPR p = *kargs(); const bf16_t* wl = p.wt + (size_t)l * WT_LAYER; EpiHalo E; E.rs = nullptr; E.gh = p.gh; gemm_small<true>(lds, p.xh, wl + OW5, 1024, E); }
        GRID_BARRIER();
        { CPR p = *kargs(); float* out = p.out; const bf16_t* wl = p.wt + (size_t)l * WT_LAYER; EpiUpAct E; E.rs = p.rs2; E.gh = p.gh; E.ffb = p.ffb;
          E.ffnP = out + O_P_FFN + (size_t)l * 2 * D_FF; E.ffnS = out + O_S_FFN + (size_t)l * DEC_BATCH * 2 * D_FF;
          E.cw = p.ffn_conv_w + (size_t)l * 3 * D_FF; E.cb = p.ffn_conv_b + (size_t)l * D_FF; E.hist = p.state_ffn_conv + (size_t)l * DEC_BATCH * 2 * D_FF;
          gemm_site(lds, p.xb, wl + OW5, 8192, 1024, E); }
        if (bid_opaque() >= 128) { CPR p = *kargs(); const bf16_t* wl = p.wt + (size_t)l * WT_LAYER; EpiPlain E; E.dst = p.plea; gemm_site_n1024_part(lds, p.pb + (size_t)l * M_ALL * 256, wl + OW7, 256, E, 128, bid_opaque() - 128); }
        GRID_BARRIER();
        { CPR p = *kargs(); float* out = p.out; const bf16_t* wl = p.wt + (size_t)l * WT_LAYER; EpiF32Out E; E.dst = p.down; gemm_site_n1024(lds, p.ffb, wl + OW6, 4096, E); }
        GRID_BARRIER();
        { CPR p = *kargs(); float* out = p.out; (void)out; ph_norm(p.down, p.norm_post_ffn + l * 1024, p.xr, nullptr, nullptr, nullptr); }
        GRID_BARRIER();
        { CPR p = *kargs(); float* out = p.out; const bf16_t* wl = p.wt + (size_t)l * WT_LAYER; EpiPle E; E.plea = p.plea; E.dst = p.ple; gemm_site_n1024(lds, p.xr, wl + OW8, 1024, E); }
        GRID_BARRIER();
        { CPR p = *kargs(); float* out = p.out; (void)out; ph_norm(p.ple, p.norm_ple + l * 1024, p.xr, p.xb, l == DEPTH - 1 ? out + O_Y_P : nullptr, out + O_Y_S); }
        if (l + 1 < DEPTH) GRID_BARRIER();
    }
}

struct Bump { char* base; size_t off; template <class T> T* take(size_t n) { off = (off + 255) & ~(size_t)255; T* p = (T*)(base + off); off += n * sizeof(T); return p; } };
__global__ void k_fail_code(float* out, float code) { if (threadIdx.x == 0 && blockIdx.x == 0) out[0] = code; }

extern "C" void kernel_launch(void* const* d_in, const int* in_sizes, int n_in, void* d_out, int out_size, void* d_ws, size_t ws_size, hipStream_t stream) {
    Params p; memset(&p, 0, sizeof p);
    p.x_prompt = (const float*)d_in[0]; p.x_sample = (const float*)d_in[1]; p.state_ssd_conv = (const float*)d_in[2]; p.state_ssd = (const float*)d_in[3];
    p.cache_k = (const float*)d_in[4]; p.cache_v = (const float*)d_in[5]; p.state_ffn_conv = (const float*)d_in[6]; p.p_prompt = (const float*)d_in[7]; p.p_sample = (const float*)d_in[8];
    p.norm_pre_mix = (const float*)d_in[9]; p.w_in = (const float*)d_in[10]; p.ssd_conv_w = (const float*)d_in[11]; p.ssd_conv_b = (const float*)d_in[12]; p.ssd_dt_bias = (const float*)d_in[13];
    p.ssd_a_log = (const float*)d_in[14]; p.ssd_d = (const float*)d_in[15]; p.ssd_norm = (const float*)d_in[16]; p.w_br_ssd = (const float*)d_in[17]; p.w_br_sb = (const float*)d_in[18];
    p.w_out = (const float*)d_in[19]; p.norm_post_mix = (const float*)d_in[20]; p.norm_pre_ffn = (const float*)d_in[21]; p.w_up = (const float*)d_in[22]; p.ffn_conv_w = (const float*)d_in[23];
    p.ffn_conv_b = (const float*)d_in[24]; p.w_down = (const float*)d_in[25]; p.norm_post_ffn = (const float*)d_in[26]; p.w_ple = (const float*)d_in[27]; p.w_ple_gate = (const float*)d_in[28];
    p.norm_ple = (const float*)d_in[29];
    float* out = (float*)d_out; p.out = out;

    Bump B{(char*)d_ws, 0};
    const size_t R = M_ALL;
    p.bar = B.take<unsigned>(4096);
    p.wt = B.take<bf16_t>(DEPTH * WT_LAYER);
    p.xr = B.take<bf16_t>(R * 1024); p.xb = B.take<bf16_t>(R * 1024); p.rs = B.take<float>(R); p.rs2 = B.take<float>(R); p.pb = B.take<bf16_t>(DEPTH * R * 256);
    p.zb = B.take<bf16_t>(R * 2048); p.xbcb = B.take<bf16_t>(R * 3072); p.qb = B.take<bf16_t>(R * 1024); p.kb = B.take<bf16_t>(R * 1024); p.vb = B.take<bf16_t>(R * 1024); p.gb = B.take<bf16_t>(R * 2048); p.dtb = B.take<float>(R * 32);
    p.sst = B.take<float>((size_t)NCHUNK * STATE_SZ / 2); p.dec = B.take<float>(NCHUNK * 32); p.hpb = B.take<bf16_t>((size_t)NCHUNK * STATE_SZ);
    p.yn = B.take<bf16_t>(R * 2048); p.att = B.take<bf16_t>(R * 1024); p.t1 = B.take<bf16_t>(R * 1024); p.mixin = B.take<bf16_t>(R * 1024); p.mixed = B.take<bf16_t>(R * 1024);
    p.gh = B.take<bf16_t>((size_t)768 * 4096); p.xh = B.take<bf16_t>((size_t)768 * 1024); p.ffb = B.take<bf16_t>(R * 4096); p.down = B.take<bf16_t>(R * 1024); p.plea = B.take<bf16_t>(R * 1024); p.ple = B.take<bf16_t>(R * 1024);
    if (B.off > ws_size) { k_fail_code<<<1, 64, 0, stream>>>(out, 777000.f); return; }

    (void)hipMemsetAsync(p.bar, 0, 4096 * 4, stream);
    static bool minit = false;
    if (!minit) { (void)hipFuncSetAttribute((const void*)k_mega, hipFuncAttributeMaxDynamicSharedMemorySize, MEGA_LDS); minit = true; }
    hipLaunchKernelGGL(k_mega, dim3(256), dim3(512), MEGA_LDS, stream, p);
}
```

```cpp
#include <hip/hip_runtime.h>
#include <stdint.h>
#include <string.h>

constexpr int D_MODEL = 1024, SEQ = 16384, DEPTH = 2, DEC_BATCH = 32, DEC_SEQ = 32, PAST_LEN = 2048;
constexpr int D_SSM = 2048, SSD_HEAD_DIM = 64, SSD_HEADS = 32, SSD_GROUPS = 4, SSD_STATE = 128, SSD_CONV_DIM = 3072;
constexpr int SB_HEAD_DIM = 128, SB_HEADS = 8, SB_WIDTH = 1024, D_FF = 4096, PLE_DIM = 256;
constexpr int IN_DIM = 10272;
constexpr int M_P = SEQ, M_S = DEC_BATCH * DEC_SEQ, M_ALL = M_P + M_S;
constexpr float EPS = 1e-6f;
constexpr int C_Z = 0, C_XBC = 2048, C_DT = 5120, C_Q = 5152, C_K = 6176, C_V = 7200, C_G = 8224;
constexpr size_t O_Y_P = 0;
constexpr size_t O_Y_S = O_Y_P + (size_t)M_P * D_MODEL;
constexpr size_t O_P_CONV = O_Y_S + (size_t)M_S * D_MODEL;
constexpr size_t O_P_STATE = O_P_CONV + (size_t)DEPTH * 3 * SSD_CONV_DIM;
constexpr size_t O_P_K = O_P_STATE + (size_t)DEPTH * SSD_HEADS * SSD_HEAD_DIM * SSD_STATE;
constexpr size_t O_P_V = O_P_K + (size_t)DEPTH * M_P * SB_WIDTH;
constexpr size_t O_P_FFN = O_P_V + (size_t)DEPTH * M_P * SB_WIDTH;
constexpr size_t O_S_CONV = O_P_FFN + (size_t)DEPTH * 2 * D_FF;
constexpr size_t O_S_STATE = O_S_CONV + (size_t)DEPTH * DEC_BATCH * 3 * SSD_CONV_DIM;
constexpr size_t O_S_K = O_S_STATE + (size_t)DEPTH * DEC_BATCH * SSD_HEADS * SSD_HEAD_DIM * SSD_STATE;
constexpr size_t O_S_V = O_S_K + (size_t)DEPTH * M_S * SB_WIDTH;
constexpr size_t O_S_FFN = O_S_V + (size_t)DEPTH * M_S * SB_WIDTH;
constexpr size_t O_TOTAL = O_S_FFN + (size_t)DEPTH * DEC_BATCH * 2 * D_FF;
constexpr size_t STATE_SZ = (size_t)SSD_HEADS * SSD_HEAD_DIM * SSD_STATE;

typedef unsigned short bf16_t;

__device__ __forceinline__ float wave_sum(float v) {
#pragma unroll
    for (int o = 32; o >= 1; o >>= 1) v += __shfl_xor(v, o);
    return v;
}
__device__ __forceinline__ float sigmoidf_(float x) { return 1.0f / (1.0f + __expf(-x)); }
__device__ __forceinline__ float softplusf_(float x) { return fmaxf(x, 0.f) + log1pf(__expf(-fabsf(x))); }
__device__ __forceinline__ float siluf_(float x) { return x * sigmoidf_(x); }
__device__ __forceinline__ float gelu_tanhf_(float x) { const float u = 0.7978845608028654f * (x + 0.044715f * x * x * x); return 0.5f * x * (1.0f + tanhf(u)); }
__device__ __forceinline__ bf16_t f2bf(float f) { unsigned u = __float_as_uint(f); u += 0x7FFFu + ((u >> 16) & 1u); return (bf16_t)(u >> 16); }
__device__ __forceinline__ float bf2f(bf16_t b) { return __uint_as_float(((unsigned)b) << 16); }
typedef __bf16 bf16x2_t __attribute__((ext_vector_type(2)));
typedef float f32x2_t __attribute__((ext_vector_type(2)));
__device__ __forceinline__ unsigned pk2(float lo, float hi) { unsigned r; asm volatile("v_cvt_pk_bf16_f32 %0, %1, %2" : "=v"(r) : "v"(lo), "v"(hi)); return r; }
__device__ __forceinline__ unsigned pk2c(float lo, float hi) { const f32x2_t v = {lo, hi}; return __builtin_bit_cast(unsigned, __builtin_convertvector(v, bf16x2_t)); }
__device__ __forceinline__ f32x2_t exp2_2(f32x2_t x) { f32x2_t e; e.x = __builtin_amdgcn_exp2f(x.x); e.y = __builtin_amdgcn_exp2f(x.y); return e; }
__device__ __forceinline__ f32x2_t rcp_2(f32x2_t x) { f32x2_t r; r.x = __builtin_amdgcn_rcpf(x.x); r.y = __builtin_amdgcn_rcpf(x.y); return r; }
__device__ __forceinline__ f32x2_t sigmoid2(f32x2_t a) { return rcp_2(exp2_2(a * (-1.4426950408889634f)) + 1.0f); }
__device__ __forceinline__ f32x2_t silu2(f32x2_t a) { return a * sigmoid2(a); }
__device__ __forceinline__ f32x2_t gelu2(f32x2_t x) { const f32x2_t u2 = (x * x * 0.044715f + 1.0f) * x * 1.5957691216057308f; return x * sigmoid2(u2); }
__device__ __forceinline__ float bflo(unsigned w) { return __uint_as_float(w << 16); }
__device__ __forceinline__ float bfhi(unsigned w) { return __uint_as_float(w & 0xffff0000u); }

__device__ __forceinline__ int bid_opaque() { int b = blockIdx.x; asm volatile("" : "+s"(b)); return b; }
__device__ __forceinline__ int nblk_opaque() { int b = gridDim.x; asm volatile("" : "+s"(b)); return b; }
__device__ __forceinline__ int tid_opaque() { int t = threadIdx.x; asm volatile("" : "+v"(t)); return t; }

namespace pg8 {
#define PG8_LAS __attribute__((address_space(3)))
typedef unsigned short bf16_t;
typedef short bf16x8 __attribute__((ext_vector_type(8)));
typedef float f32x4 __attribute__((ext_vector_type(4)));
typedef unsigned u32x4 __attribute__((ext_vector_type(4)));
constexpr int BM = 256, BK = 64, HALF = 128, HTB = HALF * BK * 2  , STAGE_BYTES = 8 * HTB, NXCD = 8, WGM = 8;

__host__ __device__ __forceinline__ int lds_byte(int r, int c) { const int st = (r >> 4) * 2 + (c >> 5), rr = r & 15, cc = c & 31, ob = rr * 64 + cc * 2; return st * 1024 + (ob ^ (((ob >> 9) & 1) << 5)); }
__host__ __device__ __forceinline__ void stage_rc(int b, int& R, int& C) { const int st = b / 1024, sb = b % 1024, swz = sb ^ (((sb >> 9) & 1) << 5); R = (st >> 1) * 16 + swz / 64; C = (st & 1) * 32 + (swz % 64) / 2; }
__host__ __device__ __forceinline__ int perm32(int rho) { const int n = rho >> 4, i = rho & 15; return 8 * (i >> 2) + 4 * n + (i & 3); }

struct Unit { int pm, pn; };
struct Gemm { const bf16_t* A; const bf16_t* Bt; int M, N, K; };

struct StaticOrder {
    int nM, nN, nwg, G, c, wgm;
    __host__ __device__ void init(int M, int N, int G_, int c_, int wgm_ = WGM) { nM = M / BM; nN = N / BM; nwg = nM * nN; G = G_; c = c_; wgm = wgm_; }
    __host__ __device__ bool next(int i, Unit& u) const {
        const long L = (long)i * G + c; if (L >= nwg) return false;
        int wgid = (int)L; { const int q = nwg / NXCD, r = nwg % NXCD, xcd = wgid % NXCD, off = wgid / NXCD; wgid = (xcd < r ? xcd * (q + 1) : r * (q + 1) + (xcd - r) * q) + off; }
        const int nig = wgm * nN, gid = wgid / nig, fm = gid * wgm, gsz = (nM - fm) < wgm ? (nM - fm) : wgm;
        u.pm = fm + ((wgid % nig) % gsz); u.pn = (wgid % nig) / gsz; return true;
    }
    __device__ __forceinline__ void a_ready(const Unit&) const {}
    __device__ __forceinline__ void done(const Unit&) const {}
};
__device__ __forceinline__ unsigned cvt_pk_bf16(float lo, float hi) { unsigned r; asm volatile("v_cvt_pk_bf16_f32 %0, %1, %2" : "=v"(r) : "v"(lo), "v"(hi)); return r; }
typedef float f32x2 __attribute__((ext_vector_type(2)));
__device__ __forceinline__ f32x2 gelu_pk(f32x2 v) {
    const f32x2 av = __builtin_elementwise_abs(v), d = av * 0.2316418882f + 1.0f;
    f32x2 t; t.x = __builtin_amdgcn_rcpf(d.x); t.y = __builtin_amdgcn_rcpf(d.y);
    f32x2 q = t * 0.5307027145f + (-0.7265760135f); q = q * t + 0.7107068705f; q = q * t + (-0.142248368f); q = q * t + 0.127414796f; q = q * t;
    const f32x2 s = (v * v) * (-0.72134752044f);
    f32x2 e; e.x = __builtin_amdgcn_exp2f(s.x); e.y = __builtin_amdgcn_exp2f(s.y);
    const f32x2 m = v * (q * e), r = v - m;
    f32x2 o; o.x = v.x < 0.f ? m.x : r.x; o.y = v.y < 0.f ? m.y : r.y; return o;
}

struct EpiF32 {
    static constexpr bool PERM = false, AFTER_DRAIN = false;
    float* C; int ldc; const float* bias;
    __device__ __forceinline__ void operator()(const f32x4 (&acc)[2][2][4][2], const Unit& u, int wr, int wc, int fr, int fq) const {
        const int row0 = u.pm * BM + wr * 64 + fr, col0 = u.pn * BM + wc * 32 + 4 * fq;
        f32x4 bv[2][2];
#pragma unroll
        for (int bj = 0; bj < 2; ++bj)
#pragma unroll
            for (int n = 0; n < 2; ++n) bv[bj][n] = bias ? *(const f32x4*)(bias + col0 + bj * HALF + n * 16) : (f32x4){0.f, 0.f, 0.f, 0.f};
#pragma unroll
        for (int ai = 0; ai < 2; ++ai)
#pragma unroll
            for (int m = 0; m < 4; ++m) { float* rowp = C + (size_t)(row0 + ai * HALF + m * 16) * ldc + col0;
#pragma unroll
                for (int bj = 0; bj < 2; ++bj)
#pragma unroll
                    for (int n = 0; n < 2; ++n) *(f32x4*)(rowp + bj * HALF + n * 16) = acc[ai][bj][m][n] + bv[bj][n]; }
    }
};
template <int ACT  > struct EpiBf16 {
    static constexpr bool PERM = true, AFTER_DRAIN = false;
    bf16_t* O; int ldc; const float* bias; int split_cols; size_t split_stride;
    __device__ __forceinline__ void operator()(const f32x4 (&acc)[2][2][4][2], const Unit& u, int wr, int wc, int fr, int fq) const {
        const int row0 = u.pm * BM + wr * 64 + fr; int colt = u.pn * BM; bf16_t* base = O;
        if (split_cols) { const int t = colt / split_cols; base += (size_t)t * split_stride; colt -= t * split_cols; }
        const int col0 = colt + wc * 32 + 8 * fq, bcol0 = u.pn * BM + wc * 32 + 8 * fq;
        f32x4 bv[2][2];
#pragma unroll
        for (int bj = 0; bj < 2; ++bj)
#pragma unroll
            for (int n = 0; n < 2; ++n) bv[bj][n] = bias ? *(const f32x4*)(bias + bcol0 + bj * HALF + 4 * n) : (f32x4){0.f, 0.f, 0.f, 0.f};
#pragma unroll
        for (int ai = 0; ai < 2; ++ai)
#pragma unroll
            for (int m = 0; m < 4; ++m) { bf16_t* rowp = base + (size_t)(row0 + ai * HALF + m * 16) * ldc + col0;
#pragma unroll
                for (int bj = 0; bj < 2; ++bj) { f32x4 v0 = acc[ai][bj][m][0] + bv[bj][0], v1 = acc[ai][bj][m][1] + bv[bj][1];
                    if (ACT == 1) { f32x2 a = gelu_pk((f32x2){v0[0], v0[1]}), b = gelu_pk((f32x2){v0[2], v0[3]}), c = gelu_pk((f32x2){v1[0], v1[1]}), d = gelu_pk((f32x2){v1[2], v1[3]});
                        v0 = (f32x4){a.x, a.y, b.x, b.y}; v1 = (f32x4){c.x, c.y, d.x, d.y}; }
                    if (ACT == 2) {
#pragma unroll
                        for (int j = 0; j < 4; ++j) { v0[j] = 0.5f * v0[j] * (1.0f + erff(v0[j] * 0.70710678f)); v1[j] = 0.5f * v1[j] * (1.0f + erff(v1[j] * 0.70710678f)); } }
                    u32x4 w; w.x = cvt_pk_bf16(v0[0], v0[1]); w.y = cvt_pk_bf16(v0[2], v0[3]); w.z = cvt_pk_bf16(v1[0], v1[1]); w.w = cvt_pk_bf16(v1[2], v1[3]);
                    *(u32x4*)(rowp + bj * HALF) = w; } }
    }
};

template <class Epi, class Sched, bool STAMP = false>
__device__ __forceinline__ void gemm_phase(PG8_LAS unsigned char* lds, const Gemm g, const Sched& S, const Epi& E, unsigned long long* stamps) {
    const int tid = tid_opaque(), wid = __builtin_amdgcn_readfirstlane(tid >> 6), lane = tid & 63, wr = wid >> 2, wc = wid & 3, fr = lane & 15, fq = lane >> 4;
    const int K = g.K, nt = K / BK;
    int ts_lo = 0, ts_hi = 0, nts = 0; const unsigned long long rt_entry = STAMP ? (unsigned long long)wall_clock64() : 0ull;
#define PG8_STAMP() do { if (STAMP && wid == 0 && nts < 64) { const unsigned long long _c = (unsigned long long)clock64(); \
        ts_lo = (lane == nts) ? (int)(unsigned)_c : ts_lo; ts_hi = (lane == nts) ? (int)(unsigned)(_c >> 32) : ts_hi; ++nts; } } while (0)
    PG8_STAMP();
    unsigned voffA[2], voffB[2];
#pragma unroll
    for (int i = 0; i < 2; ++i) { int R, C; stage_rc(tid * 16 + i * 8192, R, C); const int Rb = Epi::PERM ? ((R & ~31) + perm32(R & 31)) : R;
        voffA[i] = (unsigned)(R * K + C) * 2u; voffB[i] = (unsigned)(Rb * K + C) * 2u; }
    const size_t kstep = (size_t)(BK * 2);
    const size_t hstep = (size_t)HALF * K * 2;
    const size_t tstep = 2 * hstep;
    const unsigned ldsw = (unsigned)wid * 1024u;
    const int aoff = lds_byte(wr * 64 + fr, fq * 8), boff = lds_byte(wc * 32 + fr, fq * 8);
#define PG8_SA(b, h) (((b) * 2 + (h)) * HTB)
#define PG8_SB(b, h) ((4 + (b) * 2 + (h)) * HTB)
#define PG8_STAGE(bufoff, gbase, voff) do { _Pragma("unroll") for (int _i = 0; _i < 2; ++_i) \
        __builtin_amdgcn_global_load_lds((const unsigned*)((const char*)(gbase) + (voff)[_i]), (PG8_LAS unsigned*)(lds + (bufoff) + ldsw + _i * 8192), 16, 0, 0); } while (0)
#define PG8_LDA(dst, b, h) do { _Pragma("unroll") for (int m = 0; m < 4; ++m) _Pragma("unroll") for (int k = 0; k < 2; ++k) dst[m][k] = *(const PG8_LAS bf16x8*)(lds + PG8_SA(b, h) + aoff + m * 2048 + k * 1024); } while (0)
#define PG8_LDB(dst, b, h) do { _Pragma("unroll") for (int n = 0; n < 2; ++n) _Pragma("unroll") for (int k = 0; k < 2; ++k) dst[n][k] = *(const PG8_LAS bf16x8*)(lds + PG8_SB(b, h) + boff + n * 2048 + k * 1024); } while (0)
#define PG8_MMA(ai, bj, At, Bt) do { __builtin_amdgcn_s_setprio(1); _Pragma("unroll") for (int m = 0; m < 4; ++m) _Pragma("unroll") for (int n = 0; n < 2; ++n) _Pragma("unroll") for (int k = 0; k < 2; ++k) \
        acc[ai][bj][m][n] = __builtin_amdgcn_mfma_f32_16x16x32_bf16(Bt[n][k], At[m][k], acc[ai][bj][m][n], 0, 0, 0); __builtin_amdgcn_s_setprio(0); } while (0)
#define PG8_WAIT_V(n) asm volatile("s_waitcnt vmcnt(" #n ")" ::: "memory")
#define PG8_WAIT_L(n) asm volatile("s_waitcnt lgkmcnt(" #n ")" ::: "memory")
#define PG8_BAR __builtin_amdgcn_s_barrier()
#define PG8_SCHED __builtin_amdgcn_sched_barrier(0)
    Unit cur, nxt; int ui = 0;
    if (!S.next(0, cur)) return;
    f32x4 acc[2][2][4][2];
#pragma unroll
    for (int a = 0; a < 2; ++a)
#pragma unroll
        for (int b = 0; b < 2; ++b)
#pragma unroll
            for (int m = 0; m < 4; ++m)
#pragma unroll
                for (int n = 0; n < 2; ++n) acc[a][b][m][n] = (f32x4){0.f, 0.f, 0.f, 0.f};
    bf16x8 At[4][2], B0[2][2], B1[2][2];
    const char* cA = (const char*)g.A + (size_t)cur.pm * tstep; const char* cB = (const char*)g.Bt + (size_t)cur.pn * tstep;
    S.a_ready(cur);
    PG8_STAGE(PG8_SB(0, 0), cB, voffB); PG8_STAGE(PG8_SA(0, 0), cA, voffA); PG8_STAGE(PG8_SB(0, 1), cB + hstep, voffB); PG8_STAGE(PG8_SA(0, 1), cA + hstep, voffA);
    if (wr == 1) PG8_BAR;
    PG8_WAIT_V(4); PG8_BAR;
    PG8_STAGE(PG8_SB(1, 0), cB + kstep, voffB); PG8_STAGE(PG8_SA(1, 0), cA + kstep, voffA); PG8_STAGE(PG8_SB(1, 1), cB + hstep + kstep, voffB);
    PG8_WAIT_V(6); PG8_BAR;
    PG8_STAMP();
    for (;;) {
        const bool has_next = S.next(ui + 1, nxt);
        const char* nA = has_next ? (const char*)g.A + (size_t)nxt.pm * tstep : cA; const char* nB = has_next ? (const char*)g.Bt + (size_t)nxt.pn * tstep : cB;
        for (int t = 0; t < nt; t += 2) {
            const bool last = (t == nt - 2);
            const char* a1 = cA + (size_t)(t + 1) * kstep;
            const char* a2 = last ? nA : cA + (size_t)(t + 2) * kstep; const char* b2 = last ? nB : cB + (size_t)(t + 2) * kstep;
            const char* a3 = a2 + kstep; const char* b3 = b2 + kstep;
            if (last && has_next) S.a_ready(nxt);
            PG8_LDB(B0, 0, 0); PG8_SCHED; PG8_LDA(At, 0, 0); PG8_STAGE(PG8_SA(1, 1), a1 + hstep, voffA);
            PG8_WAIT_L(8); PG8_BAR; PG8_WAIT_L(0); PG8_MMA(0, 0, At, B0); PG8_BAR; PG8_SCHED;
            PG8_LDB(B1, 0, 1); PG8_STAGE(PG8_SB(0, 0), b2, voffB);
            PG8_BAR; PG8_WAIT_L(0); PG8_MMA(0, 1, At, B1); PG8_BAR;
            PG8_LDA(At, 0, 1); PG8_STAGE(PG8_SA(0, 0), a2, voffA);
            PG8_BAR; PG8_WAIT_L(0); PG8_MMA(1, 0, At, B0); PG8_BAR; PG8_SCHED;
            PG8_STAGE(PG8_SB(0, 1), b2 + hstep, voffB);
            PG8_WAIT_V(6); PG8_BAR; PG8_MMA(1, 1, At, B1); PG8_BAR;
            PG8_LDB(B0, 1, 0); PG8_SCHED; PG8_LDA(At, 1, 0); PG8_STAGE(PG8_SA(0, 1), a2 + hstep, voffA);
            PG8_WAIT_L(8); PG8_BAR; PG8_WAIT_L(0); PG8_MMA(0, 0, At, B0); PG8_BAR; PG8_SCHED;
            PG8_LDB(B1, 1, 1); PG8_STAGE(PG8_SB(1, 0), b3, voffB);
            PG8_BAR; PG8_WAIT_L(0); PG8_MMA(0, 1, At, B1); PG8_BAR;
            PG8_LDA(At, 1, 1); PG8_STAGE(PG8_SA(1, 0), a3, voffA);
            PG8_BAR; PG8_WAIT_L(0); PG8_MMA(1, 0, At, B0); PG8_BAR; PG8_SCHED;
            PG8_STAGE(PG8_SB(1, 1), b3 + hstep, voffB);
            PG8_WAIT_V(6); PG8_BAR; PG8_MMA(1, 1, At, B1); PG8_BAR;
        }
        PG8_STAMP();
        if constexpr (!Epi::AFTER_DRAIN) { E(acc, cur, wr, wc, fr, fq); S.done(cur); }
        PG8_STAMP();
        if (!has_next) break;
#pragma unroll
        for (int a = 0; a < 2; ++a)
#pragma unroll
            for (int b = 0; b < 2; ++b)
#pragma unroll
                for (int m = 0; m < 4; ++m)
#pragma unroll
                    for (int n = 0; n < 2; ++n) acc[a][b][m][n] = (f32x4){0.f, 0.f, 0.f, 0.f};
        cur = nxt; cA = nA; cB = nB; ++ui;
    }
    PG8_WAIT_V(0);
    if (wr == 0) PG8_BAR;
    PG8_BAR;
    if constexpr (Epi::AFTER_DRAIN) { E.fused(acc, cur, wr, wc, fr, fq, lds, wid, lane); S.done(cur); }
    PG8_STAMP();
    if (STAMP && wid == 0) { stamps[lane] = lane < nts ? (((unsigned long long)(unsigned)ts_hi << 32) | (unsigned)ts_lo) : 0ull;
        if (lane == 62) stamps[62] = rt_entry; if (lane == 63) stamps[63] = (unsigned long long)wall_clock64(); }
#undef PG8_STAMP
#undef PG8_SA
#undef PG8_SB
#undef PG8_STAGE
#undef PG8_LDA
#undef PG8_LDB
#undef PG8_MMA
#undef PG8_WAIT_V
#undef PG8_WAIT_L
#undef PG8_BAR
#undef PG8_SCHED
}
}
#define XB_TMO      128
#define XB_XCNT(j)  (256  + 64 * (j))
#define XB_XSUB(j)  (1280 + 64 * (j))
#define XB_XGEN(j)  (2304 + 64 * (j))
#define XB_TOP      3328
#define XB_TOPGEN   3392
#define XCD_BAR_WORDS 3456
#define XB_SPIN_CAP (1u << 18)
#define LAS __attribute__((address_space(3)))

__device__ __forceinline__ unsigned xb_ld(unsigned* p)              { return __hip_atomic_load(p, __ATOMIC_RELAXED, __HIP_MEMORY_SCOPE_AGENT); }
__device__ __forceinline__ unsigned xb_add(unsigned* p, unsigned v) { return __hip_atomic_fetch_add(p, v, __ATOMIC_RELAXED, __HIP_MEMORY_SCOPE_AGENT); }
__device__ __forceinline__ unsigned xb_xcc_id() { return (unsigned)__builtin_amdgcn_s_getreg((3 << 11) | 20) & 0xFu; }
#define XB_SPIN(cond, bar) do { unsigned _sp = 0; while (cond) { __builtin_amdgcn_s_sleep(1); \
    if ((++_sp & 255u) == 0u) { if (xb_ld(&(bar)[XB_TMO])) break; if (_sp > XB_SPIN_CAP) { atomicAdd(&(bar)[XB_TMO], 1u); break; } } } } while (0)

struct XcdBarrier {
    unsigned* bar; unsigned x;
    volatile LAS unsigned* st;
};

__device__ __forceinline__ XcdBarrier xcd_barrier_post(unsigned* bar, volatile LAS unsigned* st) {
    XcdBarrier b; b.bar = bar; b.x = xb_xcc_id(); b.st = st;
    if (threadIdx.x == 0) (void)xb_add(&bar[XB_XCNT(b.x)], 1u);
    return b;
}
__device__ __forceinline__ void xcd_barrier_complete(unsigned* bar, unsigned x, unsigned& nloc, unsigned& nx) {
    const unsigned G = gridDim.x * gridDim.y * gridDim.z;
    unsigned sum, cnt, mine, sp = 0u;
    for (;;) {
        sum = 0u; cnt = 0u; mine = 0u;
#pragma unroll
        for (unsigned j = 0; j < 16; ++j) { const unsigned c = xb_ld(&bar[XB_XCNT(j)]); sum += c; cnt += (c > 0u) ? 1u : 0u; mine = (j == x) ? c : mine; }
        if (sum == G) break;
        __builtin_amdgcn_s_sleep(1);
        if ((++sp & 255u) == 0u) { if (xb_ld(&bar[XB_TMO])) break; if (sp > XB_SPIN_CAP) { atomicAdd(&bar[XB_TMO], 1u); break; } }
    }
    nloc = mine > 0u ? mine : 1u; nx = cnt > 0u ? cnt : 1u;
}

__device__ __forceinline__ void xcd_barrier(const XcdBarrier& b) {
    asm volatile("s_waitcnt vmcnt(0)" ::: "memory");
    __syncthreads();
    if (threadIdx.x == 0) {
        unsigned* bar = b.bar;
        __builtin_amdgcn_s_waitcnt(0);
        unsigned nloc = b.st[0], nx = b.st[1];
        if (nloc == 0u) { xcd_barrier_complete(bar, b.x, nloc, nx); b.st[0] = nloc; b.st[1] = nx; }
        const unsigned old = xb_add(&bar[XB_XSUB(b.x)], 1u);
        const unsigned gen = old / nloc;
        if (old + 1u == (gen + 1u) * nloc) {
            __builtin_amdgcn_fence(__ATOMIC_RELEASE, "agent");
            asm volatile("s_waitcnt vmcnt(0)" ::: "memory");
            const unsigned og = xb_add(&bar[XB_TOP], 1u);
            const unsigned tg = og / nx;
            if (og + 1u == (tg + 1u) * nx) xb_add(&bar[XB_TOPGEN], 1u);
            else XB_SPIN(xb_ld(&bar[XB_TOPGEN]) == tg, bar);
            __builtin_amdgcn_fence(__ATOMIC_ACQUIRE, "agent");
            xb_add(&bar[XB_XGEN(b.x)], 1u);
            asm volatile("s_waitcnt vmcnt(0)" ::: "memory");
        } else {
            XB_SPIN(xb_ld(&bar[XB_XGEN(b.x)]) == gen, bar);
            __builtin_amdgcn_fence(__ATOMIC_ACQUIRE, "agent");
            asm volatile("s_waitcnt vmcnt(0)" ::: "memory");
        }
    }
    __syncthreads();
}


using pg8::f32x4; using pg8::u32x4; using pg8::Unit; using pg8::Gemm; using pg8::StaticOrder;
typedef unsigned u32x2 __attribute__((ext_vector_type(2)));
#define LDSP PG8_LAS unsigned char*

constexpr int N1 = 10496;
constexpr size_t OW1 = 0, OW2 = OW1 + (size_t)N1 * 1024, OW3 = OW2 + (size_t)1024 * 2048, OW4 = OW3 + (size_t)1024 * 1024, OW5 = OW4 + (size_t)1024 * 1024,
                 OW6 = OW5 + (size_t)8192 * 1024, OW7 = OW6 + (size_t)1024 * 4096, OW8 = OW7 + (size_t)1024 * 256, WT_LAYER = OW8 + (size_t)1024 * 1024;
constexpr int NCHUNK = 256 + DEC_BATCH;

struct Params {
    const float *x_prompt, *x_sample, *state_ssd_conv, *state_ssd, *cache_k, *cache_v, *state_ffn_conv, *p_prompt, *p_sample;
    const float *norm_pre_mix, *w_in, *ssd_conv_w, *ssd_conv_b, *ssd_dt_bias, *ssd_a_log, *ssd_d, *ssd_norm, *w_br_ssd, *w_br_sb, *w_out, *norm_post_mix, *norm_pre_ffn,
                *w_up, *ffn_conv_w, *ffn_conv_b, *w_down, *norm_post_ffn, *w_ple, *w_ple_gate, *norm_ple;
    float* out;
    unsigned* bar;
    bf16_t* wt; bf16_t* xr; bf16_t* xb; float* rs; float* rs2; bf16_t* pb;
    bf16_t *zb, *xbcb, *qb, *gb, *kb, *vb; float* dtb;
    float* sst; float* dec; bf16_t* hpb;
    bf16_t *yn, *att, *t1, *mixin; bf16_t* mixed;
    bf16_t *gh, *xh, *ffb; bf16_t* down; bf16_t* plea; bf16_t* ple;
};

typedef const __attribute__((address_space(4))) Params CP;
#define CPR CP&
__device__ __forceinline__ CP* kargs() { CP* q = (CP*)__builtin_amdgcn_kernarg_segment_ptr(); asm volatile("" : "+s"(q)); return q; }

__device__ __forceinline__ void wt_item(const float* __restrict__ W, int K, int ldw, const float* __restrict__ gain, bf16_t* __restrict__ Wt, int nblk, int item, int w1map, PG8_LAS float* scr, int lane) {
    const int kb = item / nblk, nb = item % nblk, k0 = 64 * kb, n0 = 32 * nb;
    int sc0 = n0; if (w1map == 1) sc0 = (n0 < 5120) ? n0 : (n0 < 10240 ? n0 + 32 : (n0 < 10272 ? n0 - 5120 : -1));
    else if (w1map == 2) sc0 = ((n0 & 255) < 128 ? 0 : 4096) + (n0 >> 8) * 128 + (n0 & 127);
    const int kr = lane >> 3, c4 = (lane & 7) * 4;
    float4 v[8];
#pragma unroll
    for (int i = 0; i < 8; ++i) v[i] = (sc0 >= 0) ? *(const float4*)(W + (size_t)(k0 + kr + 8 * i) * ldw + sc0 + c4) : make_float4(0.f, 0.f, 0.f, 0.f);
#pragma unroll
    for (int i = 0; i < 8; ++i) { const int kk = kr + 8 * i; const float gm = gain ? gain[k0 + kk] : 1.0f; PG8_LAS float* d = scr + kk * 33 + c4;
        d[0] = v[i].x * gm; d[1] = v[i].y * gm; d[2] = v[i].z * gm; d[3] = v[i].w * gm; }
    asm volatile("s_waitcnt lgkmcnt(0)" ::: "memory");
    const int c = lane & 7;
#pragma unroll
    for (int j = 0; j < 4; ++j) { const int nn = (lane >> 3) + 8 * j; const PG8_LAS float* s = scr + (8 * c) * 33 + nn;
        *(u32x4*)(Wt + (size_t)(n0 + nn) * K + k0 + 8 * c) = (u32x4){pk2(s[0], s[33]), pk2(s[2 * 33], s[3 * 33]), pk2(s[4 * 33], s[5 * 33]), pk2(s[6 * 33], s[7 * 33])}; }
    asm volatile("s_waitcnt lgkmcnt(0)" ::: "memory");
}
__device__ __forceinline__ void ph_wt(CPR p, LDSP lds) {
    constexpr int U1 = 16 * 328, U2 = U1 + 32 * 32, U3 = U2 + 512, U4 = U3 + 512, U5 = U4 + 16 * 256, U6 = U5 + 64 * 32, U7 = U6 + 4 * 32, U8 = U7 + 512;
    const int tidx = tid_opaque(), lane = tidx & 63, wv = tidx >> 6, gw = bid_opaque() * 8 + wv, NGW = nblk_opaque() * 8;
    PG8_LAS float* scr = (PG8_LAS float*)(lds + wv * (64 * 33 * 4));
    for (int u = gw; u < DEPTH * U8; u += NGW) {
        const int l = u / U8; int v = u % U8; bf16_t* wl = p.wt + (size_t)l * WT_LAYER;
        if (v < U1)      { wt_item(p.w_in + (size_t)l * 1024 * IN_DIM, 1024, IN_DIM, p.norm_pre_mix + l * 1024, wl + OW1, 328, v, 1, scr, lane); }
        else if (v < U2) { v -= U1; wt_item(p.w_br_ssd + (size_t)l * 2048 * 1024, 2048, 1024, p.ssd_norm + l * 2048, wl + OW2, 32, v, 0, scr, lane); }
        else if (v < U3) { v -= U2; wt_item(p.w_br_sb + (size_t)l * 1024 * 1024, 1024, 1024, nullptr, wl + OW3, 32, v, 0, scr, lane); }
        else if (v < U4) { v -= U3; wt_item(p.w_out + (size_t)l * 1024 * 1024, 1024, 1024, nullptr, wl + OW4, 32, v, 0, scr, lane); }
        else if (v < U5) { v -= U4; wt_item(p.w_up + (size_t)l * 1024 * 8192, 1024, 8192, p.norm_pre_ffn + l * 1024, wl + OW5, 256, v, 2, scr, lane); }
        else if (v < U6) { v -= U5; wt_item(p.w_down + (size_t)l * 4096 * 1024, 4096, 1024, nullptr, wl + OW6, 32, v, 0, scr, lane); }
        else if (v < U7) { v -= U6; wt_item(p.w_ple + (size_t)l * 256 * 1024, 256, 1024, nullptr, wl + OW7, 32, v, 0, scr, lane); }
        else             { v -= U7; wt_item(p.w_ple_gate + (size_t)l * 1024 * 1024, 1024, 1024, nullptr, wl + OW8, 32, v, 0, scr, lane); }
    }
    __syncthreads();
}
__device__ __forceinline__ void ph_xprep(CPR p) {
    const int tidx = tid_opaque(); const int lane = tidx & 63, gw = bid_opaque() * 8 + (tidx >> 6), NGW = nblk_opaque() * 8;
    for (int row0 = 2 * gw; row0 < M_ALL; row0 += 2 * NGW) {
        float4 v[2][4]; float ss[2] = {0.f, 0.f};
#pragma unroll
        for (int q = 0; q < 2; ++q) { const int row = row0 + q; const float4* src = (const float4*)(row < M_P ? p.x_prompt + (size_t)row * 1024 : p.x_sample + (size_t)(row - M_P) * 1024);
#pragma unroll
            for (int j = 0; j < 4; ++j) v[q][j] = src[lane + 64 * j]; }
#pragma unroll
        for (int q = 0; q < 2; ++q) { const int row = row0 + q;
#pragma unroll
            for (int j = 0; j < 4; ++j) { ss[q] += v[q][j].x * v[q][j].x + v[q][j].y * v[q][j].y + v[q][j].z * v[q][j].z + v[q][j].w * v[q][j].w;
                ((u32x2*)(p.xr + (size_t)row * 1024))[lane + 64 * j] = (u32x2){pk2(v[q][j].x, v[q][j].y), pk2(v[q][j].z, v[q][j].w)}; }
            const float rn = rsqrtf(wave_sum(ss[q]) * (1.0f / 1024.f) + EPS);
#pragma unroll
            for (int j = 0; j < 4; ++j) ((u32x2*)(p.xb + (size_t)row * 1024))[lane + 64 * j] = (u32x2){pk2(v[q][j].x * rn, v[q][j].y * rn), pk2(v[q][j].z * rn, v[q][j].w * rn)}; }
    }
    for (int r0 = 4 * gw; r0 < DEPTH * M_ALL; r0 += 4 * NGW) {
        float4 v[4];
#pragma unroll
        for (int q = 0; q < 4; ++q) { const int r2 = r0 + q, l = r2 / M_ALL, row = r2 % M_ALL;
            v[q] = ((const float4*)(row < M_P ? p.p_prompt + ((size_t)l * M_P + row) * PLE_DIM : p.p_sample + ((size_t)l * M_S + row - M_P) * PLE_DIM))[lane]; }
#pragma unroll
        for (int q = 0; q < 4; ++q) ((u32x2*)(p.pb + (size_t)(r0 + q) * PLE_DIM))[lane] = (u32x2){pk2(v[q].x, v[q].y), pk2(v[q].z, v[q].w)};
    }
}
__device__ __forceinline__ void ph_norm(const bf16_t* __restrict__ src, const float* __restrict__ gain, bf16_t* xr, bf16_t* xb, float* yP, float* yS, bf16_t* xh = nullptr) {
    const int tidx = tid_opaque(); const int lane = tidx & 63, gw = bid_opaque() * 8 + (tidx >> 6), NGW = nblk_opaque() * 8;
    float4 g[4];
#pragma unroll
    for (int j = 0; j < 4; ++j) g[j] = ((const float4*)gain)[lane + 64 * j];
    for (int row0 = 2 * gw; row0 < M_ALL; row0 += 2 * NGW) {
        u32x2 sv[2][4], xv[2][4];
#pragma unroll
        for (int q = 0; q < 2; ++q)
#pragma unroll
            for (int j = 0; j < 4; ++j) { sv[q][j] = ((const u32x2*)(src + (size_t)(row0 + q) * 1024))[lane + 64 * j]; xv[q][j] = ((const u32x2*)(xr + (size_t)(row0 + q) * 1024))[lane + 64 * j]; }
#pragma unroll
        for (int q = 0; q < 2; ++q) {
            const int row = row0 + q;
            float4 v[4], x[4]; float ss = 0.f;
#pragma unroll
            for (int j = 0; j < 4; ++j) { v[j] = make_float4(bflo(sv[q][j].x), bfhi(sv[q][j].x), bflo(sv[q][j].y), bfhi(sv[q][j].y)); x[j] = make_float4(bflo(xv[q][j].x), bfhi(xv[q][j].x), bflo(xv[q][j].y), bfhi(xv[q][j].y));
                ss += v[j].x * v[j].x + v[j].y * v[j].y + v[j].z * v[j].z + v[j].w * v[j].w; }
            ss = wave_sum(ss);
            const float r = rsqrtf(ss * (1.0f / 1024.f) + EPS); float s2 = 0.f;
#pragma unroll
            for (int j = 0; j < 4; ++j) {
                x[j].x += v[j].x * r * g[j].x; x[j].y += v[j].y * r * g[j].y; x[j].z += v[j].z * r * g[j].z; x[j].w += v[j].w * r * g[j].w;
                s2 += x[j].x * x[j].x + x[j].y * x[j].y + x[j].z * x[j].z + x[j].w * x[j].w;
                ((u32x2*)(xr + (size_t)row * 1024))[lane + 64 * j] = (u32x2){pk2(x[j].x, x[j].y), pk2(x[j].z, x[j].w)};
            }
            if (xb) {
                const float rn = rsqrtf(wave_sum(s2) * (1.0f / 1024.f) + EPS);
#pragma unroll
                for (int j = 0; j < 4; ++j) {
                    const u32x2 wq = (u32x2){pk2(x[j].x * rn, x[j].y * rn), pk2(x[j].z * rn, x[j].w * rn)};
                    ((u32x2*)(xb + (size_t)row * 1024))[lane + 64 * j] = wq;
                    if (xh && (row & 63) >= 62) ((u32x2*)(xh + (size_t)(2 * ((row >> 6) + 1) + (row & 63) - 62) * 1024))[lane + 64 * j] = wq;
                }
            }
            if (yP) { float4* y4 = (float4*)(row < M_P ? yP + (size_t)row * 1024 : yS + (size_t)(row - M_P) * 1024);
#pragma unroll
                for (int j = 0; j < 4; ++j) y4[lane + 64 * j] = x[j]; }
        }
    }
}
__device__ __forceinline__ void unpack8(const u32x4 w, float (&v)[8]) {
    v[0] = bflo(w.x); v[1] = bfhi(w.x); v[2] = bflo(w.y); v[3] = bfhi(w.y); v[4] = bflo(w.z); v[5] = bfhi(w.z); v[6] = bflo(w.w); v[7] = bfhi(w.w);
}
__device__ __forceinline__ void load8f(const float* p, float (&v)[8]) { const float4 a = ((const float4*)p)[0], b = ((const float4*)p)[1]; v[0] = a.x; v[1] = a.y; v[2] = a.z; v[3] = a.w; v[4] = b.x; v[5] = b.y; v[6] = b.z; v[7] = b.w; }
__device__ __forceinline__ float gelu_fast(float x) { const float u2 = 1.5957691216057308f * (x + 0.044715f * x * x * x); return x * __builtin_amdgcn_rcpf(1.0f + __expf(-u2)); }
struct EpiIn {
    static constexpr bool PERM = true, AFTER_DRAIN = false;
    const float* rs; bf16_t *zb, *xbcb, *qb, *gb, *kb, *vb; float* dtb; const float* dt_bias; float *kP, *vP, *kS, *vS, *convP, *convS;
    __device__ __forceinline__ void operator()(const f32x4 (&acc)[2][2][4][2], const Unit& u, int wr, int wc, int fr, int fq) const {
        const int row0 = u.pm * 256 + wr * 64 + fr, seg = u.pn, cl = wc * 32 + 8 * fq;
#pragma unroll
        for (int ai = 0; ai < 2; ++ai)
#pragma unroll
            for (int m = 0; m < 4; ++m) {
                const int r = row0 + ai * 128 + m * 16;
#pragma unroll
                for (int bj = 0; bj < 2; ++bj) {
                    const int ct = cl + bj * 128; const f32x4 v0 = acc[ai][bj][m][0], v1 = acc[ai][bj][m][1];
                    const u32x4 w = (u32x4){pk2c(v0[0], v0[1]), pk2c(v0[2], v0[3]), pk2c(v1[0], v1[1]), pk2c(v1[2], v1[3])};
                    if (seg < 8) { *(u32x4*)(zb + (size_t)r * 2048 + seg * 256 + ct) = w; }
                    else if (seg < 20) {
                        const int c = (seg - 8) * 256 + ct; *(u32x4*)(xbcb + (size_t)r * 3072 + c) = w;
                        float* dst = nullptr;
                        if (r < M_P) { if (r >= M_P - 3) dst = convP + (size_t)(r - (M_P - 3)) * 3072; }
                        else { const int t = (r - M_P) & 31, b = (r - M_P) >> 5; if (t >= 29) dst = convS + ((size_t)b * 3 + (t - 29)) * 3072; }
                        if (dst) { *(f32x4*)(dst + c) = v0; *(f32x4*)(dst + c + 4) = v1; }
                    }
                    else if (seg < 24) { *(u32x4*)(qb + (size_t)r * 1024 + (seg - 20) * 256 + ct) = w; }
                    else if (seg < 32) {
                        const int c = ((seg - 24) & 3) * 256 + ct; const bool isk = seg < 28;
                        float* dst = (r < M_P) ? (isk ? kP : vP) + (size_t)r * 1024 : (isk ? kS : vS) + (size_t)(r - M_P) * 1024;
                        *(f32x4*)(dst + c) = v0; *(f32x4*)(dst + c + 4) = v1;
                        *(u32x4*)((isk ? kb : vb) + (size_t)r * 1024 + c) = w;
                    }
                    else if (seg < 40) {
                        const f32x2_t s0 = sigmoid2((f32x2_t){v0[0], v0[1]}), s1 = sigmoid2((f32x2_t){v0[2], v0[3]}), s2 = sigmoid2((f32x2_t){v1[0], v1[1]}), s3 = sigmoid2((f32x2_t){v1[2], v1[3]});
                        *(u32x4*)(gb + (size_t)r * 2048 + (seg - 32) * 256 + ct) = (u32x4){pk2(s0.x, s0.y), pk2(s1.x, s1.y), pk2(s2.x, s2.y), pk2(s3.x, s3.y)};
                    }
                    else if (wc == 0 && bj == 0) {
                        const f32x4 b0 = *(const f32x4*)(dt_bias + 8 * fq), b1 = *(const f32x4*)(dt_bias + 8 * fq + 4);
                        f32x4 o0, o1;
#pragma unroll
                        for (int j = 0; j < 4; ++j) { o0[j] = softplusf_(v0[j] + b0[j]); o1[j] = softplusf_(v1[j] + b1[j]); }
                        *(f32x4*)(dtb + (size_t)r * 32 + 8 * fq) = o0; *(f32x4*)(dtb + (size_t)r * 32 + 8 * fq + 4) = o1;
                    }
                }
            }
    }
};
struct EpiHalo {
    static constexpr bool PERM = true, AFTER_DRAIN = false;
    const float* rs; bf16_t* gh;
    __device__ __forceinline__ void elem(int hi, int ch, float v) const { gh[(size_t)hi * D_FF + ch] = f2bf(v); }
    __device__ __forceinline__ void operator()(const f32x4 (&acc)[2][2][4][2], const Unit& u, int wr, int wc, int fr, int fq) const {
        const int row0 = u.pm * 256 + wr * 64 + fr, c0 = u.pn * 128 + wc * 32 + 8 * fq;
#pragma unroll
        for (int ai = 0; ai < 2; ++ai)
#pragma unroll
            for (int m = 0; m < 4; ++m) {
                const int hi = row0 + ai * 128 + m * 16;
                const f32x4 v0 = acc[ai][0][m][0], v1 = acc[ai][0][m][1];
                *(u32x4*)(gh + (size_t)hi * D_FF + c0) = (u32x4){pk2c(v0[0], v0[1]), pk2c(v0[2], v0[3]), pk2c(v1[0], v1[1]), pk2c(v1[2], v1[3])};
            }
    }
};
struct EpiUpAct {
    static constexpr bool PERM = true, AFTER_DRAIN = false;
    const float* rs; const bf16_t* gh; bf16_t* ffb; float *ffnP, *ffnS; const float* cw; const float* cb; const float* hist;
    __device__ __forceinline__ void operator()(const f32x4 (&acc)[2][2][4][2], const Unit& u, int wr, int wc, int fr, int fq) const {
        const int c0 = u.pn * 128 + wc * 32 + 8 * fq;
        float w0[8], w1[8], w2[8], bb[8];
        load8f(cw + c0, w0); load8f(cw + D_FF + c0, w1); load8f(cw + 2 * D_FF + c0, w2); load8f(cb + c0, bb);
#pragma unroll
        for (int ai = 0; ai < 2; ++ai) {
            const int strip = 4 * u.pm + 2 * ai + wr;
            float gprev[8];
#pragma unroll
            for (int m = 0; m < 4; ++m) {
                const int r = strip * 64 + 16 * m + fr;
                float g[8], uv[8], p1[8], p2[8];
#pragma unroll
                for (int j = 0; j < 4; ++j) { g[j] = acc[ai][0][m][0][j]; g[4 + j] = acc[ai][0][m][1][j]; uv[j] = acc[ai][1][m][0][j]; uv[4 + j] = acc[ai][1][m][1][j]; }
                if (m == 0) { float e14[8], e15[8]; unpack8(*(const u32x4*)(gh + (size_t)(2 * strip) * D_FF + c0), e14); unpack8(*(const u32x4*)(gh + (size_t)(2 * strip + 1) * D_FF + c0), e15);
#pragma unroll
                    for (int j = 0; j < 8; ++j) gprev[j] = (fr == 15) ? e15[j] : e14[j]; }
#pragma unroll
                for (int j = 0; j < 8; ++j) {
                    const float c1 = (fr == 15) ? gprev[j] : g[j], c2 = (fr >= 14) ? gprev[j] : g[j];
                    p1[j] = __builtin_bit_cast(float, __builtin_amdgcn_update_dpp(0, __builtin_bit_cast(int, c1), 0x121, 0xf, 0xf, false));
                    p2[j] = __builtin_bit_cast(float, __builtin_amdgcn_update_dpp(0, __builtin_bit_cast(int, c2), 0x122, 0xf, 0xf, false));
                }
                const int t = (r < M_P) ? r : ((r - M_P) & 31);
                if (t < 2) {
                    float h0[8], h1[8];
                    if (r >= M_P) { const float* hp = hist + (size_t)((r - M_P) >> 5) * 2 * D_FF + c0; load8f(hp, h0); load8f(hp + D_FF, h1); }
                    else {
#pragma unroll
                        for (int j = 0; j < 8; ++j) { h0[j] = 0.f; h1[j] = 0.f; } }
#pragma unroll
                    for (int j = 0; j < 8; ++j) { if (t == 0) { p2[j] = h0[j]; p1[j] = h1[j]; } else { p2[j] = h1[j]; } }
                }
                float o[8];
#pragma unroll
                for (int j = 0; j < 8; j += 2) {
                    const f32x2_t a = (f32x2_t){bb[j], bb[j + 1]} + (f32x2_t){w0[j], w0[j + 1]} * (f32x2_t){p2[j], p2[j + 1]} + (f32x2_t){w1[j], w1[j + 1]} * (f32x2_t){p1[j], p1[j + 1]} + (f32x2_t){w2[j], w2[j + 1]} * (f32x2_t){g[j], g[j + 1]};
                    const f32x2_t ov = gelu2(a) * (f32x2_t){uv[j], uv[j + 1]}; o[j] = ov.x; o[j + 1] = ov.y; }
                *(u32x4*)(ffb + (size_t)r * D_FF + c0) = (u32x4){pk2(o[0], o[1]), pk2(o[2], o[3]), pk2(o[4], o[5]), pk2(o[6], o[7])};
                float* dst = nullptr;
                if (r < M_P) { if (r >= M_P - 2) dst = ffnP + (size_t)(r - (M_P - 2)) * D_FF; }
                else { const int b = (r - M_P) >> 5; if (t >= 30) dst = ffnS + ((size_t)b * 2 + (t - 30)) * D_FF; }
                if (dst) { *(f32x4*)(dst + c0) = (f32x4){g[0], g[1], g[2], g[3]}; *(f32x4*)(dst + c0 + 4) = (f32x4){g[4], g[5], g[6], g[7]}; }
#pragma unroll
                for (int j = 0; j < 8; ++j) gprev[j] = g[j];
            }
        }
    }
};
struct EpiBr {
    static constexpr bool PERM = true, AFTER_DRAIN = false;
    const bf16_t* gb; const bf16_t* t1in; bf16_t* dst; int mode; int pad;
    __device__ __forceinline__ void elem(int r, int c, float v) const {
        float o = bf2f(gb[(size_t)r * 2048 + (mode == 0 ? 1024 : 0) + c]) * v; if (mode == 1) o += bf2f(t1in[(size_t)r * 1024 + c]);
        dst[(size_t)r * 1024 + c] = f2bf(o); }
    __device__ __forceinline__ void operator()(const f32x4 (&acc)[2][2][4][2], const Unit& u, int wr, int wc, int fr, int fq) const {
        const int row0 = u.pm * 256 + wr * 64 + fr, cl = u.pn * 256 + wc * 32 + 8 * fq;
#pragma unroll
        for (int ai = 0; ai < 2; ++ai)
#pragma unroll
            for (int m = 0; m < 4; ++m) {
                const int r = row0 + ai * 128 + m * 16;
#pragma unroll
                for (int bj = 0; bj < 2; ++bj) {
                    const int c = cl + bj * 128; float g[8], o[8];
                    unpack8(*(const u32x4*)(gb + (size_t)r * 2048 + (mode == 0 ? 1024 : 0) + c), g);
                    const f32x4 v0 = acc[ai][bj][m][0], v1 = acc[ai][bj][m][1];
                    float tv[8];
                    if (mode == 1) unpack8(*(const u32x4*)(t1in + (size_t)r * 1024 + c), tv);
                    else {
#pragma unroll
                        for (int j = 0; j < 8; ++j) tv[j] = 0.f; }
#pragma unroll
                    for (int j = 0; j < 4; j += 2) {
                        const f32x2_t oa = (f32x2_t){g[j], g[j + 1]} * (f32x2_t){v0[j], v0[j + 1]} + (f32x2_t){tv[j], tv[j + 1]}, ob = (f32x2_t){g[4 + j], g[5 + j]} * (f32x2_t){v1[j], v1[j + 1]} + (f32x2_t){tv[4 + j], tv[5 + j]};
                        o[j] = oa.x; o[j + 1] = oa.y; o[4 + j] = ob.x; o[5 + j] = ob.y; }
                    *(u32x4*)(dst + (size_t)r * 1024 + c) = (u32x4){pk2(o[0], o[1]), pk2(o[2], o[3]), pk2(o[4], o[5]), pk2(o[6], o[7])};
                }
            }
    }
};
struct EpiPlain {
    static constexpr bool PERM = true, AFTER_DRAIN = false;
    bf16_t* dst;
    __device__ __forceinline__ void elem(int r, int c, float v) const { dst[(size_t)r * 1024 + c] = f2bf(v); }
    __device__ __forceinline__ void operator()(const f32x4 (&acc)[2][2][4][2], const Unit& u, int wr, int wc, int fr, int fq) const {
        const int row0 = u.pm * 256 + wr * 64 + fr, cl = u.pn * 256 + wc * 32 + 8 * fq;
#pragma unroll
        for (int ai = 0; ai < 2; ++ai)
#pragma unroll
            for (int m = 0; m < 4; ++m) {
                const int r = row0 + ai * 128 + m * 16;
#pragma unroll
                for (int bj = 0; bj < 2; ++bj) { const f32x4 v0 = acc[ai][bj][m][0], v1 = acc[ai][bj][m][1];
                    *(u32x4*)(dst + (size_t)r * 1024 + cl + bj * 128) = (u32x4){pk2c(v0[0], v0[1]), pk2c(v0[2], v0[3]), pk2c(v1[0], v1[1]), pk2c(v1[2], v1[3])}; }
            }
    }
};
struct EpiF32Out {
    static constexpr bool PERM = true, AFTER_DRAIN = false;
    bf16_t* dst;
    __device__ __forceinline__ void elem(int r, int c, float v) const { dst[(size_t)r * 1024 + c] = f2bf(v); }
    __device__ __forceinline__ void operator()(const f32x4 (&acc)[2][2][4][2], const Unit& u, int wr, int wc, int fr, int fq) const {
        const int row0 = u.pm * 256 + wr * 64 + fr, cl = u.pn * 256 + wc * 32 + 8 * fq;
#pragma unroll
        for (int ai = 0; ai < 2; ++ai)
#pragma unroll
            for (int m = 0; m < 4; ++m) {
                const int r = row0 + ai * 128 + m * 16;
#pragma unroll
                for (int bj = 0; bj < 2; ++bj) { const f32x4 v0 = acc[ai][bj][m][0], v1 = acc[ai][bj][m][1];
                    *(u32x4*)(dst + (size_t)r * 1024 + cl + bj * 128) = (u32x4){pk2c(v0[0], v0[1]), pk2c(v0[2], v0[3]), pk2c(v1[0], v1[1]), pk2c(v1[2], v1[3])}; }
            }
    }
};
struct EpiPle {
    static constexpr bool PERM = false, AFTER_DRAIN = false;
    const bf16_t* plea; bf16_t* dst;
    __device__ __forceinline__ void elem(int r, int c, float v) const { dst[(size_t)r * 1024 + c] = f2bf(bf2f(plea[(size_t)r * 1024 + c]) * sigmoidf_(v)); }
    __device__ __forceinline__ void operator()(const f32x4 (&acc)[2][2][4][2], const Unit& u, int wr, int wc, int fr, int fq) const {
        const int row0 = u.pm * 256 + wr * 64 + fr, col0 = u.pn * 256 + wc * 32 + 4 * fq;
#pragma unroll
        for (int ai = 0; ai < 2; ++ai)
#pragma unroll
            for (int m = 0; m < 4; ++m) { const size_t ro = (size_t)(row0 + ai * 128 + m * 16) * 1024 + col0;
#pragma unroll
                for (int bj = 0; bj < 2; ++bj)
#pragma unroll
                    for (int n = 0; n < 2; ++n) { const u32x2 a = *(const u32x2*)(plea + ro + bj * 128 + n * 16); const f32x4 v = acc[ai][bj][m][n];
                        const f32x2_t o0 = (f32x2_t){bflo(a.x), bfhi(a.x)} * sigmoid2((f32x2_t){v[0], v[1]}), o1 = (f32x2_t){bflo(a.y), bfhi(a.y)} * sigmoid2((f32x2_t){v[2], v[3]});
                        *(u32x2*)(dst + ro + bj * 128 + n * 16) = (u32x2){pk2(o0.x, o0.y), pk2(o1.x, o1.y)}; } }
    }
};

typedef short bf16x8 __attribute__((ext_vector_type(8)));
typedef float f32x16 __attribute__((ext_vector_type(16)));
typedef short bf16x4 __attribute__((ext_vector_type(4)));
#define MFMA32(a, b, c) __builtin_amdgcn_mfma_f32_32x32x16_bf16((a), (b), (c), 0, 0, 0)
__device__ __forceinline__ f32x16 zero16() { f32x16 z;
#pragma unroll
    for (int i = 0; i < 16; ++i) z[i] = 0.f; return z; }
__device__ __forceinline__ bf16x8 pack8f(const float (&v)[8]) { const u32x4 w = (u32x4){pk2(v[0], v[1]), pk2(v[2], v[3]), pk2(v[4], v[5]), pk2(v[6], v[7])}; return __builtin_bit_cast(bf16x8, w); }
__device__ __forceinline__ bf16x8 join44(bf16x4 lo, bf16x4 hi) { return __builtin_shufflevector(lo, hi, 0, 1, 2, 3, 4, 5, 6, 7); }

constexpr int PX = 72;
constexpr int PR = 136;
constexpr int L_XT = 0;
constexpr int L_B = L_XT + 8 * 64 * PX * 2;
constexpr int L_C = L_B + 128 * PX * 2;
constexpr int L_AC = L_C + 64 * PR * 2;
constexpr int L_DT = L_AC + 2048;
constexpr int L_WS = L_DT + 2048;
constexpr int ZP = 1040;
constexpr int SSD_LDS = L_WS + 2048;

struct ChunkInfo { int seqbase, row0, t0, nvalid; const float* hist; };
__device__ __forceinline__ ChunkInfo chunk_info(CPR p, int l, int ck) {
    ChunkInfo c;
    if (ck < 256) { c.seqbase = 0; c.row0 = 64 * ck; c.t0 = 64 * ck; c.nvalid = 64; c.hist = nullptr; }
    else { const int b = ck - 256; c.seqbase = M_P + 32 * b; c.row0 = c.seqbase; c.t0 = 0; c.nvalid = 32; c.hist = p.state_ssd_conv + ((size_t)l * DEC_BATCH + b) * 3 * 3072; }
    return c;
}
template <int NP> __device__ __forceinline__ void xbc_pad_raw(const bf16_t* __restrict__ xbcb, const float* __restrict__ hist, int rowbase, int hj, int c, unsigned (&d)[NP]) {
    if (hj >= 3) { const bf16_t* q = xbcb + (size_t)(rowbase + hj - 3) * 3072 + c;
        if (NP == 4) { const u32x4 t = *(const u32x4*)q; d[0] = t.x; d[1 % NP] = t.y; d[2 % NP] = t.z; d[3 % NP] = t.w; }
        else if (NP == 2) { const u32x2 t = *(const u32x2*)q; d[0] = t.x; d[1 % NP] = t.y; }
        else d[0] = *(const unsigned*)q; }
    else if (hist) {
#pragma unroll
        for (int k = 0; k < NP; ++k) { const float2 t = *(const float2*)(hist + (size_t)hj * 3072 + c + 2 * k); d[k] = pk2(t.x, t.y); } }
    else {
#pragma unroll
        for (int k = 0; k < NP; ++k) d[k] = 0u; }
}
__device__ __forceinline__ int xt_off(int R, int g) { return R * (PX * 2) + ((g ^ ((R >> 3) & 7)) << 4); }
template <int NP, class F> __device__ __forceinline__ void conv8(CPR p, int l, const ChunkInfo& ci, int s0, int c, F emit) {
    if (s0 >= ci.nvalid) {
        const float z[8] = {0.f, 0.f, 0.f, 0.f, 0.f, 0.f, 0.f, 0.f};
#pragma unroll
        for (int jp = 0; jp < NP; ++jp) emit(jp, z, z);
        return;
    }
    const float* cw = p.ssd_conv_w + (size_t)l * 4 * 3072 + c; const float* cb = p.ssd_conv_b + (size_t)l * 3072 + c;
    const int t = ci.t0 + s0;
    unsigned raw[11][NP];
#pragma unroll
    for (int k = 0; k < 11; ++k) xbc_pad_raw<NP>(p.xbcb, ci.hist, ci.seqbase, t + k, c, raw[k]);
#pragma unroll
    for (int jp = 0; jp < NP; ++jp) {
        const f32x2_t w0 = *(const f32x2_t*)(cw + 2 * jp), w1 = *(const f32x2_t*)(cw + 3072 + 2 * jp), w2 = *(const f32x2_t*)(cw + 2 * 3072 + 2 * jp), w3 = *(const f32x2_t*)(cw + 3 * 3072 + 2 * jp), bb = *(const f32x2_t*)(cb + 2 * jp);
        f32x2_t rv[11];
#pragma unroll
        for (int k = 0; k < 11; ++k) rv[k] = (f32x2_t){bflo(raw[k][jp]), bfhi(raw[k][jp])};
        float lo[8], hi[8];
#pragma unroll
        for (int i = 0; i < 8; ++i) {
            const f32x2_t a = bb + w0 * rv[i] + w1 * rv[i + 1] + w2 * rv[i + 2] + w3 * rv[i + 3];
            const f32x2_t sv = silu2(a);
            lo[i] = sv.x; hi[i] = sv.y;
        }
        emit(jp, lo, hi);
    }
}
__device__ __forceinline__ float unit_dt(CPR p, int l, int u, int wid, int lane) {
    const ChunkInfo ci = chunk_info(p, l, u >> 2);
    return (lane < ci.nvalid) ? p.dtb[(size_t)(ci.row0 + lane) * 32 + (u & 3) * 8 + wid] : 0.f;
}
__device__ __forceinline__ void head_scan(CPR p, int l, int h, int lane, float dtv, float& ac, float& aclast) {
    const float a = -__expf(p.ssd_a_log[l * 32 + h]);
    ac = dtv * a;
#pragma unroll
    for (int o = 1; o < 64; o <<= 1) { const float t = __shfl_up(ac, o); if (lane >= o) ac += t; }
    aclast = __shfl(ac, 63);
}
__device__ __forceinline__ void ph_ssd_p1(CPR p, int l, LDSP lds) {
    const int tid = tid_opaque(), wid = tid >> 6, lane = tid & 63, r = lane & 31, hh = lane >> 5;
    PG8_LAS float* acS = (PG8_LAS float*)(lds + L_AC); PG8_LAS float* wS = (PG8_LAS float*)(lds + L_WS);
    PG8_LAS bf16_t* xT = (PG8_LAS bf16_t*)(lds + L_XT); PG8_LAS bf16_t* BT = (PG8_LAS bf16_t*)(lds + L_B);
    const int u0 = bid_opaque(), nb = nblk_opaque();
    float dt_nx = (u0 < NCHUNK * 4) ? unit_dt(p, l, u0, wid, lane) : 0.f;
    for (int u = u0; u < NCHUNK * 4; u += nb) {
        const int ck = u >> 2, g = u & 3, h = g * 8 + wid;
        const ChunkInfo ci = chunk_info(p, l, ck);
        const float dtv = dt_nx; float ac, aclast; head_scan(p, l, h, lane, dtv, ac, aclast);
        dt_nx = (u + nb < NCHUNK * 4) ? unit_dt(p, l, u + nb, wid, lane) : 0.f;
        wS[wid * 64 + lane] = __expf(aclast - ac) * dtv;
        if (lane == 63) p.dec[ck * 32 + h] = __expf(aclast);
        __syncthreads();
        { const int cc = tid & 63, s0 = (tid >> 6) * 8, g8 = s0 >> 3, hl = cc >> 3, p0 = (cc & 7) * 8;
          float wv[8];
#pragma unroll
          for (int i = 0; i < 8; ++i) wv[i] = wS[hl * 64 + s0 + i];
          conv8<4>(p, l, ci, s0, g * 512 + cc * 8, [&](int jp, const float (&lo)[8], const float (&hi)[8]) {
              const int R = hl * 64 + p0 + 2 * jp;
              *(PG8_LAS u32x4*)(lds + L_XT + xt_off(R, g8)) = (u32x4){pk2(lo[0] * wv[0], lo[1] * wv[1]), pk2(lo[2] * wv[2], lo[3] * wv[3]), pk2(lo[4] * wv[4], lo[5] * wv[5]), pk2(lo[6] * wv[6], lo[7] * wv[7])};
              *(PG8_LAS u32x4*)(lds + L_XT + xt_off(R + 1, g8)) = (u32x4){pk2(hi[0] * wv[0], hi[1] * wv[1]), pk2(hi[2] * wv[2], hi[3] * wv[3]), pk2(hi[4] * wv[4], hi[5] * wv[5]), pk2(hi[6] * wv[6], hi[7] * wv[7])}; }); }
        { const int q = tid & 63, s0 = (tid >> 6) * 8, g8 = s0 >> 3, n0 = 2 * q;
          conv8<1>(p, l, ci, s0, 2048 + g * 128 + n0, [&](int jp, const float (&lo)[8], const float (&hi)[8]) {
              *(PG8_LAS u32x4*)(lds + L_B + xt_off(n0, g8)) = (u32x4){pk2(lo[0], lo[1]), pk2(lo[2], lo[3]), pk2(lo[4], lo[5]), pk2(lo[6], lo[7])};
              *(PG8_LAS u32x4*)(lds + L_B + xt_off(n0 + 1, g8)) = (u32x4){pk2(hi[0], hi[1]), pk2(hi[2], hi[3]), pk2(hi[4], hi[5]), pk2(hi[6], hi[7])}; }); }
        __syncthreads();
        f32x16 acc[4][2];
#pragma unroll
        for (int a = 0; a < 4; ++a)
#pragma unroll
            for (int b = 0; b < 2; ++b) acc[a][b] = zero16();
#pragma unroll
        for (int ks = 0; ks < 4; ++ks) {
            bf16x8 A[2], Bf[4];
#pragma unroll
            for (int pt = 0; pt < 2; ++pt) A[pt] = *(const PG8_LAS bf16x8*)(lds + L_XT + xt_off(wid * 64 + 32 * pt + r, 2 * ks + hh));
#pragma unroll
            for (int nt = 0; nt < 4; ++nt) Bf[nt] = *(const PG8_LAS bf16x8*)(lds + L_B + xt_off(32 * nt + r, 2 * ks + hh));
#pragma unroll
            for (int nt = 0; nt < 4; ++nt)
#pragma unroll
                for (int pt = 0; pt < 2; ++pt) acc[nt][pt] = MFMA32(Bf[nt], A[pt], acc[nt][pt]);
        }
        bf16_t* dst = (bf16_t*)p.sst + ((size_t)ck * 32 + h) * 8192 + lane * 16;
#pragma unroll
        for (int nt = 0; nt < 4; ++nt)
#pragma unroll
            for (int pt = 0; pt < 2; ++pt) {
                const f32x16& a = acc[nt][pt];
                *(u32x4*)(dst + (nt * 2 + pt) * 1024) = (u32x4){pk2c(a[0], a[1]), pk2c(a[2], a[3]), pk2c(a[4], a[5]), pk2c(a[6], a[7])};
                *(u32x4*)(dst + (nt * 2 + pt) * 1024 + 8) = (u32x4){pk2c(a[8], a[9]), pk2c(a[10], a[11]), pk2c(a[12], a[13]), pk2c(a[14], a[15])};
            }
        __syncthreads();
    }
}
__device__ __forceinline__ int frag_to_logical(int x) {
    const int h = x >> 13, y = x & 8191, T = y >> 10, L = (y >> 4) & 63, q = y & 15;
    const int p = 32 * (T & 1) + (L & 31), n = 32 * (T >> 1) + (q & 3) + 8 * (q >> 2) + 4 * (L >> 5);
    return h * 8192 + p * 128 + n;
}
__device__ __forceinline__ void ph_ssd_p2(CPR p, int l) {
    const int gtid = bid_opaque() * 512 + tid_opaque(), gsz = nblk_opaque() * 512;
    const unsigned* sst2 = (const unsigned*)p.sst; unsigned* hp2 = (unsigned*)p.hpb;
    for (int e = gtid; e < 131072; e += gsz) {
        const int h = e >> 12; float2 hc = make_float2(0.f, 0.f);
        for (int c0 = 0; c0 < 256; c0 += 32) {
            unsigned S[32]; float d[32];
#pragma unroll
            for (int i = 0; i < 32; ++i) { S[i] = sst2[(size_t)(c0 + i) * 131072 + e]; d[i] = p.dec[(c0 + i) * 32 + h]; }
#pragma unroll
            for (int i = 0; i < 32; ++i) { hp2[(size_t)(c0 + i) * 131072 + e] = pk2(hc.x, hc.y); const f32x2_t hn = (f32x2_t){hc.x, hc.y} * d[i] + (f32x2_t){bflo(S[i]), bfhi(S[i])}; hc.x = hn.x; hc.y = hn.y; }
        }
        ((float2*)(p.out + O_P_STATE + (size_t)l * STATE_SZ))[frag_to_logical(2 * e) >> 1] = hc;
    }
    for (int i = gtid; i < DEC_BATCH * 131072; i += gsz) {
        const int b = i >> 17, e = i & 131071, h = e >> 12, ck = 256 + b;
        const int el = frag_to_logical(2 * e) >> 1;
        const float2 h0 = ((const float2*)(p.state_ssd + ((size_t)l * DEC_BATCH + b) * STATE_SZ))[el]; const unsigned Sw = sst2[(size_t)ck * 131072 + e]; const float2 S = make_float2(bflo(Sw), bfhi(Sw)); const float d = p.dec[ck * 32 + h];
        hp2[(size_t)ck * 131072 + e] = pk2(h0.x, h0.y);
        ((float2*)(p.out + O_S_STATE + ((size_t)l * DEC_BATCH + b) * STATE_SZ))[el] = make_float2(fmaf(d, h0.x, S.x), fmaf(d, h0.y, S.y));
    }
}
__device__ __forceinline__ void ph_ssd_p3(CPR p, int l, LDSP lds) {
    const int tid = tid_opaque(), wid = tid >> 6, lane = tid & 63, r = lane & 31, hh = lane >> 5;
    PG8_LAS float* acS = (PG8_LAS float*)(lds + L_AC); PG8_LAS float* dtS = (PG8_LAS float*)(lds + L_DT); PG8_LAS float* red = (PG8_LAS float*)(lds + L_WS);
    PG8_LAS bf16_t* xT = (PG8_LAS bf16_t*)(lds + L_XT);
    const int u0 = bid_opaque(), nb = nblk_opaque();
    float dt_nx = (u0 < NCHUNK * 4) ? unit_dt(p, l, u0, wid, lane) : 0.f;
    for (int u = u0; u < NCHUNK * 4; u += nb) {
        const int ck = u >> 2, g = u & 3, h = g * 8 + wid;
        const ChunkInfo ci = chunk_info(p, l, ck);
        const float Dh = p.ssd_d[l * 32 + h];
        { const float dtv = dt_nx; float ac, aclast; head_scan(p, l, h, lane, dtv, ac, aclast); acS[wid * 64 + lane] = ac; dtS[wid * 64 + lane] = dtv; }
        dt_nx = (u + nb < NCHUNK * 4) ? unit_dt(p, l, u + nb, wid, lane) : 0.f;
        bf16x8 HA[8][2];
        const bf16_t* hp = p.hpb + ((size_t)ck * 32 + h) * 8192;
        { const int cc = tid & 63, s0 = (tid >> 6) * 8, g8 = s0 >> 3, hl = cc >> 3, p0 = (cc & 7) * 8;
          conv8<4>(p, l, ci, s0, g * 512 + cc * 8, [&](int jp, const float (&lo)[8], const float (&hi)[8]) {
              const int R = hl * 64 + p0 + 2 * jp;
              *(PG8_LAS u32x4*)(lds + L_XT + xt_off(R, g8)) = (u32x4){pk2(lo[0], lo[1]), pk2(lo[2], lo[3]), pk2(lo[4], lo[5]), pk2(lo[6], lo[7])};
              *(PG8_LAS u32x4*)(lds + L_XT + xt_off(R + 1, g8)) = (u32x4){pk2(hi[0], hi[1]), pk2(hi[2], hi[3]), pk2(hi[4], hi[5]), pk2(hi[6], hi[7])}; }); }
        { const int q = tid & 63, s0 = (tid >> 6) * 8, n4 = 4 * (q & 31), off = (q < 32 ? L_B : L_C) + n4 * 2;
          conv8<2>(p, l, ci, s0, (q < 32 ? 2048 : 2560) + g * 128 + n4, [&](int jp, const float (&lo)[8], const float (&hi)[8]) {
#pragma unroll
              for (int i = 0; i < 8; ++i) *(PG8_LAS unsigned*)(lds + off + jp * 4 + (s0 + i) * PR * 2) = pk2(lo[i], hi[i]); }); }
#pragma unroll
        for (int ks = 0; ks < 8; ++ks) { HA[ks][0] = *(const bf16x8*)(hp + ((ks >> 1) * 2 + 0) * 1024 + lane * 16 + 8 * (ks & 1)); HA[ks][1] = *(const bf16x8*)(hp + ((ks >> 1) * 2 + 1) * 1024 + lane * 16 + 8 * (ks & 1)); }
        __syncthreads();
        f32x16 yd[2][2];
#pragma unroll
        for (int a = 0; a < 2; ++a)
#pragma unroll
            for (int b = 0; b < 2; ++b) yd[a][b] = zero16();
#pragma unroll
        for (int ks = 0; ks < 8; ++ks) {
            bf16x8 Bf[2];
#pragma unroll
            for (int lt = 0; lt < 2; ++lt) { const int eo = ((32 * lt + r) * PR + 16 * ks + 4 * hh) * 2;
                Bf[lt] = join44(*(const PG8_LAS bf16x4*)(lds + L_C + eo), *(const PG8_LAS bf16x4*)(lds + L_C + eo + 16)); }
#pragma unroll
            for (int pt = 0; pt < 2; ++pt)
#pragma unroll
                for (int lt = 0; lt < 2; ++lt) yd[pt][lt] = MFMA32(HA[ks][pt], Bf[lt], yd[pt][lt]);
        }
#pragma unroll
        for (int lt = 0; lt < 2; ++lt) { const float eal = __expf(acS[wid * 64 + 32 * lt + r]);
#pragma unroll
            for (int pt = 0; pt < 2; ++pt)
#pragma unroll
                for (int q = 0; q < 16; q += 2) { const f32x2_t t = (f32x2_t){yd[pt][lt][q], yd[pt][lt][q + 1]} * eal; yd[pt][lt][q] = t.x; yd[pt][lt][q + 1] = t.y; } }
        u32x4 zraw[8];
#pragma unroll
        for (int i = 0; i < 8; ++i) { const int e = tid + 512 * i, tok = e >> 6; zraw[i] = *(const u32x4*)(p.zb + (size_t)(ci.row0 + (tok < ci.nvalid ? tok : 0)) * 2048 + g * 512 + (e & 63) * 8); }
#pragma unroll
        for (int tix = 0; tix < 3; ++tix) {
            const int st = (tix == 2) ? 1 : 0, lt = (tix == 0) ? 0 : 1;
            f32x16 G = zero16();
#pragma unroll
            for (int ks = 0; ks < 8; ++ks) {
                const bf16x8 A = *(const PG8_LAS bf16x8*)(lds + L_B + ((32 * st + r) * PR + 16 * ks + 8 * hh) * 2);
                const bf16x8 Bf = *(const PG8_LAS bf16x8*)(lds + L_C + ((32 * lt + r) * PR + 16 * ks + 8 * hh) * 2);
                G = MFMA32(A, Bf, G);
            }
            const int lcol = 32 * lt + r; const float acl = acS[wid * 64 + lcol];
            float mv[16];
#pragma unroll
            for (int q = 0; q < 16; q += 2) {
                const int s = 32 * st + (q & 3) + 8 * (q >> 2) + 4 * hh;
                const f32x2_t acs = *(const PG8_LAS f32x2_t*)(acS + wid * 64 + s), dts = *(const PG8_LAS f32x2_t*)(dtS + wid * 64 + s);
                const f32x2_t dd = __builtin_elementwise_min((f32x2_t){acl, acl} - acs, (f32x2_t){0.f, 0.f}) * 1.4426950408889634f;
                const f32x2_t v2 = (f32x2_t){G[q], G[q + 1]} * exp2_2(dd) * dts;
                float va = (s <= lcol) ? v2.x : 0.f, vb = (s + 1 <= lcol) ? v2.y : 0.f;
                if (s == lcol) va += Dh; if (s + 1 == lcol) vb += Dh;
                mv[q] = va; mv[q + 1] = vb;
            }
#pragma unroll
            for (int kk = 0; kk < 2; ++kk) {
                const float m8[8] = {mv[8 * kk], mv[8 * kk + 1], mv[8 * kk + 2], mv[8 * kk + 3], mv[8 * kk + 4], mv[8 * kk + 5], mv[8 * kk + 6], mv[8 * kk + 7]};
                const bf16x8 Bm = pack8f(m8);
#pragma unroll
                for (int pt = 0; pt < 2; ++pt) {
                    const int R = wid * 64 + 32 * pt + r, g = 4 * st + 2 * kk;
                    const bf16x4 lo = *(const PG8_LAS bf16x4*)(lds + L_XT + xt_off(R, g) + 8 * hh), hi = *(const PG8_LAS bf16x4*)(lds + L_XT + xt_off(R, g + 1) + 8 * hh);
                    yd[pt][lt] = MFMA32(join44(lo, hi), Bm, yd[pt][lt]);
                }
            }
        }
        __syncthreads();
#pragma unroll
        for (int i = 0; i < 8; ++i) { const int e = tid + 512 * i; *(PG8_LAS u32x4*)(lds + L_XT + (e >> 6) * ZP + (e & 63) * 16) = zraw[i]; }
        __syncthreads();
        float ssl[2];
#pragma unroll
        for (int lt = 0; lt < 2; ++lt) {
            const int lcol = 32 * lt + r;
            float ss = 0.f;
#pragma unroll
            for (int pt = 0; pt < 2; ++pt)
#pragma unroll
                for (int i = 0; i < 4; ++i) {
                    const u32x2 zw = *(const PG8_LAS u32x2*)(lds + L_XT + lcol * ZP + (wid * 64 + 32 * pt + 8 * i + 4 * hh) * 2);
                    const f32x2_t za = (f32x2_t){bflo(zw.x), bfhi(zw.x)}, zb2 = (f32x2_t){bflo(zw.y), bfhi(zw.y)};
                    const f32x2_t ga = (f32x2_t){yd[pt][lt][4 * i], yd[pt][lt][4 * i + 1]} * silu2(za), gb2 = (f32x2_t){yd[pt][lt][4 * i + 2], yd[pt][lt][4 * i + 3]} * silu2(zb2);
                    yd[pt][lt][4 * i] = ga.x; yd[pt][lt][4 * i + 1] = ga.y; yd[pt][lt][4 * i + 2] = gb2.x; yd[pt][lt][4 * i + 3] = gb2.y;
                    const f32x2_t sq = ga * ga + gb2 * gb2; ss += sq.x + sq.y;
                }
            ss += __shfl_xor(ss, 32);
            ssl[lt] = ss;
        }
        if (hh == 0) { red[wid * 64 + r] = ssl[0]; red[wid * 64 + 32 + r] = ssl[1]; }
        __syncthreads();
#pragma unroll
        for (int lt = 0; lt < 2; ++lt) {
            const int lcol = 32 * lt + r;
            float tot = 0.f;
#pragma unroll
            for (int w = 0; w < 8; ++w) tot += red[w * 64 + lcol];
            const float rstd = rsqrtf(tot * (1.0f / 512.f) + EPS);
#pragma unroll
            for (int pt = 0; pt < 2; ++pt)
#pragma unroll
                for (int i = 0; i < 4; ++i)
                { const f32x2_t a = (f32x2_t){yd[pt][lt][4 * i], yd[pt][lt][4 * i + 1]} * rstd, b = (f32x2_t){yd[pt][lt][4 * i + 2], yd[pt][lt][4 * i + 3]} * rstd;
                    *(PG8_LAS u32x2*)(lds + L_XT + lcol * ZP + (wid * 64 + 32 * pt + 8 * i + 4 * hh) * 2) = (u32x2){pk2(a.x, a.y), pk2(b.x, b.y)}; }
        }
        __syncthreads();
#pragma unroll
        for (int i = 0; i < 8; ++i) { const int e = tid + 512 * i, tok = e >> 6;
            if (tok < ci.nvalid) *(u32x4*)(p.yn + (size_t)(ci.row0 + tok) * 2048 + g * 512 + (e & 63) * 8) = *(const PG8_LAS u32x4*)(lds + L_XT + tok * ZP + (e & 63) * 16); }
        __syncthreads();
    }
}
#ifndef ATT_EXIT_P
#define ATT_EXIT_P 1e-20f
#endif
typedef short v4i16_t __attribute__((ext_vector_type(4)));
constexpr int AT_PITCH = 272;
constexpr int AT_TILE = 32 * AT_PITCH;
constexpr int ATT_LDS = 8 * 2 * AT_TILE;
__device__ __forceinline__ void ph_attn(CPR p, int l, LDSP lds) {
    const int tidx = tid_opaque(); const int lane = tidx & 63, r = lane & 31, hh = lane >> 5, wv = tidx >> 6, NGW = nblk_opaque() * 8, gw = (bid_opaque() * 8 + wv + (NGW >> 1)) % NGW;
    const bf16_t* kbb = p.kb; const bf16_t* vbb = p.vb;
    const float* ck = p.cache_k + (size_t)l * DEC_BATCH * PAST_LEN * 1024; const float* cv = p.cache_v + (size_t)l * DEC_BATCH * PAST_LEN * 1024;
    const float scale = 0.08838834764831845f;
    LDSP kl = lds + wv * (2 * AT_TILE); LDSP vl = kl + AT_TILE;
    const int st_g = (lane >> 5) * 1024 + (lane & 31) * 4;
    const int st_l = (lane >> 5) * AT_PITCH + (lane & 31) * 8;
    const int vs_g = (lane >> 4) * 1024 + (lane & 15) * 8;
    const int vs_l = (lane >> 4) * AT_PITCH + (lane & 15) * 16;
    const int ka_off = r * AT_PITCH + 16 * hh;
    const int vt_off = (4 * hh + ((lane & 15) >> 2)) * AT_PITCH + (16 * ((lane >> 4) & 1) + 4 * (lane & 3)) * 2;
    const int nwg = NGW >> 3, wgr = gw >> 3;
    for (int U = wgr; U < 512 + 32; U += nwg) {
        int hd, b, rowq0, P0;
        if (U < 512) { hd = U & 7; const int qt = 8 * (U >> 3) + wv; b = -1; rowq0 = 32 * qt; P0 = 32 * qt; }
        else { hd = wv; b = U - 512; rowq0 = M_P + 32 * b; P0 = PAST_LEN; }
        const bf16_t* qrow = p.qb + (size_t)(rowq0 + r) * 1024 + hd * 128 + 8 * hh;
        bf16x8 qf[8];
#pragma unroll
        for (int ks = 0; ks < 8; ++ks) qf[ks] = *(const bf16x8*)(qrow + 16 * ks);
        f32x16 O[4];
#pragma unroll
        for (int d = 0; d < 4; ++d) O[d] = zero16();
        float carry = 1.0f;
        const int ktd = P0 >> 5;
        u32x4 buf[16];
        { const bf16_t* kq = kbb + (size_t)(rowq0 + r) * 1024 + hd * 128 + 8 * hh;
#pragma unroll
          for (int ks = 0; ks < 8; ++ks) buf[8 + ks] = *(const u32x4*)(kq + 16 * ks); }
        for (int kt = ktd; kt >= 0; --kt) {
            const bool bfs = (b < 0) || (kt == ktd);
            f32x16 S = zero16();
            if (bfs) {
                const bf16_t* vq = vbb + (size_t)(b < 0 ? 32 * kt : rowq0) * 1024 + hd * 128 + vs_g;
#pragma unroll
                for (int i = 0; i < 8; ++i) buf[i] = *(const u32x4*)(vq + 4096 * i);
#pragma unroll
                for (int ks = 0; ks < 8; ++ks) S = MFMA32(__builtin_bit_cast(bf16x8, buf[8 + ks]), qf[ks], S);
            } else {
                const float* vb = cv + ((size_t)b * PAST_LEN + 32 * kt) * 1024 + hd * 128 + st_g;
#pragma unroll
                for (int i = 0; i < 16; ++i) buf[i] = *(const u32x4*)(vb + 2048 * i);
                asm volatile("s_waitcnt lgkmcnt(0)" ::: "memory");
#pragma unroll
                for (int ks = 0; ks < 8; ++ks) S = MFMA32(*(const PG8_LAS bf16x8*)(kl + ka_off + 32 * ks), qf[ks], S);
            }
            const bool diag = (kt == ktd);
            float kp[16], sg[16];
#pragma unroll
            for (int q = 0; q < 16; q += 2) {
                const int key = (q & 3) + 8 * (q >> 2) + 4 * hh;
                const f32x2_t z = (f32x2_t){S[q], S[q + 1]} * scale, e = exp2_2(__builtin_elementwise_abs(z) * (-1.4426950408889634f)), big = rcp_2(e + 1.0f), small = e * big;
                const bool v0 = !diag || key < r, v1 = !diag || key + 1 < r;
                sg[q] = v0 ? (z.x >= 0.f ? big.x : small.x) : 0.f; kp[q] = v0 ? (z.x >= 0.f ? small.x : big.x) : 1.0f;
                sg[q + 1] = v1 ? (z.y >= 0.f ? big.y : small.y) : 0.f; kp[q + 1] = v1 ? (z.y >= 0.f ? small.y : big.y) : 1.0f;
            }
            float T[4], Tp[4];
#pragma unroll
            for (int gi = 0; gi < 4; ++gi) { T[gi] = (kp[4 * gi] * kp[4 * gi + 1]) * (kp[4 * gi + 2] * kp[4 * gi + 3]); Tp[gi] = __shfl_xor(T[gi], 32); }
            float wg[16]; float aft = carry;
#pragma unroll
            for (int gi = 3; gi >= 0; --gi) {
                float suf = aft * (hh == 0 ? Tp[gi] : 1.0f);
#pragma unroll
                for (int j = 3; j >= 0; --j) { wg[4 * gi + j] = sg[4 * gi + j] * suf; suf *= kp[4 * gi + j]; }
                aft *= T[gi] * Tp[gi];
            }
            carry = aft;
            bf16x8 Pf[2];
#pragma unroll
            for (int kk = 0; kk < 2; ++kk) {
                const float w8[8] = {wg[8 * kk], wg[8 * kk + 1], wg[8 * kk + 2], wg[8 * kk + 3], wg[8 * kk + 4], wg[8 * kk + 5], wg[8 * kk + 6], wg[8 * kk + 7]};
                Pf[kk] = pack8f(w8);
            }
            if (bfs) {
#pragma unroll
                for (int i = 0; i < 8; ++i) *(PG8_LAS u32x4*)(vl + vs_l + 4 * AT_PITCH * i) = buf[i];
            } else {
#pragma unroll
                for (int i = 0; i < 16; ++i) { const float4 t = __builtin_bit_cast(float4, buf[i]); *(PG8_LAS u32x2*)(vl + st_l + 2 * AT_PITCH * i) = (u32x2){pk2(t.x, t.y), pk2(t.z, t.w)}; }
            }
            const bool more = (kt > 0) && !__all(carry < ATT_EXIT_P);
            if (more) {
                if (b < 0) { const bf16_t* kq = kbb + (size_t)(32 * (kt - 1) + r) * 1024 + hd * 128 + 8 * hh;
#pragma unroll
                    for (int ks = 0; ks < 8; ++ks) buf[8 + ks] = *(const u32x4*)(kq + 16 * ks); }
                else { const float* kb = ck + ((size_t)b * PAST_LEN + 32 * (kt - 1)) * 1024 + hd * 128 + st_g;
#pragma unroll
                    for (int i = 0; i < 16; ++i) buf[i] = *(const u32x4*)(kb + 2048 * i); }
            }
            asm volatile("s_waitcnt lgkmcnt(0)" ::: "memory");
#pragma unroll
            for (int kk = 0; kk < 2; ++kk)
#pragma unroll
                for (int d = 0; d < 4; ++d) {
                    const bf16x4 lo = __builtin_bit_cast(bf16x4, __builtin_amdgcn_ds_read_tr16_b64_v4i16((PG8_LAS v4i16_t*)(vl + vt_off + kk * 16 * AT_PITCH + d * 64)));
                    const bf16x4 hi = __builtin_bit_cast(bf16x4, __builtin_amdgcn_ds_read_tr16_b64_v4i16((PG8_LAS v4i16_t*)(vl + vt_off + kk * 16 * AT_PITCH + 8 * AT_PITCH + d * 64)));
                    O[d] = MFMA32(Pf[kk], join44(lo, hi), O[d]);
                }
            if (!more) break;
            if (b >= 0) {
#pragma unroll
                for (int i = 0; i < 16; ++i) { const float4 t = __builtin_bit_cast(float4, buf[i]); *(PG8_LAS u32x2*)(kl + st_l + 2 * AT_PITCH * i) = (u32x2){pk2(t.x, t.y), pk2(t.z, t.w)}; }
            }
        }
#pragma unroll
        for (int d = 0; d < 4; ++d)
#pragma unroll
            for (int q = 0; q < 16; ++q) *(PG8_LAS unsigned short*)(kl + ((q & 3) + 8 * (q >> 2) + 4 * hh) * AT_PITCH + (32 * d + r) * 2) = (unsigned short)pk2c(O[d][q], 0.0f);
        asm volatile("s_waitcnt lgkmcnt(0)" ::: "memory");
#pragma unroll
        for (int i = 0; i < 8; ++i) *(u32x4*)(p.att + (size_t)(rowq0 + (lane >> 4) + 4 * i) * 1024 + hd * 128 + (lane & 15) * 8) = *(const PG8_LAS u32x4*)(kl + vs_l + 4 * AT_PITCH * i);
    }
}

constexpr int MEGA_BODY = (ATT_LDS > pg8::STAGE_BYTES ? ATT_LDS : pg8::STAGE_BYTES);
constexpr int MEGA_LDS = MEGA_BODY + 64;
#ifndef WGM_IN
#define WGM_IN 4
#endif
#ifndef WGM_UP
#define WGM_UP 8
#endif
#ifndef PROBE_GBIG
#define PROBE_GBIG 1
#endif
#ifndef PROBE_GSMALL
#define PROBE_GSMALL 1
#endif
#ifndef PROBE_S
#define PROBE_S 1
#endif
#ifndef PROBE_A
#define PROBE_A 1
#endif
#ifndef PROBE_M
#define PROBE_M 1
#endif
#ifndef PROBE_P1
#define PROBE_P1 PROBE_S
#endif
#ifndef PROBE_P3
#define PROBE_P3 PROBE_S
#endif
#ifndef PROBE_P2
#define PROBE_P2 PROBE_M
#endif
#ifndef PROBE_FFN
#define PROBE_FFN PROBE_M
#endif
#ifndef PROBE_PRO
#define PROBE_PRO PROBE_M
#endif
#ifndef PROBE_NORM
#define PROBE_NORM 0
#endif
#ifndef PROBE_BAR
#define PROBE_BAR 1
#endif
#define GRID_BARRIER() do { for (int rb_ = 0; rb_ < PROBE_BAR; ++rb_) xcd_barrier(bar); } while (0)
template <class Epi> __device__ __forceinline__ void gemm_site(LDSP lds, const bf16_t* A, const bf16_t* Bt, int N, int K, const Epi& E) {
    for (int rep_ = 0; rep_ < (N > 1024 ? PROBE_GBIG : PROBE_GSMALL); ++rep_) {
    Gemm g; g.A = A; g.Bt = Bt; g.M = M_ALL; g.N = N; g.K = K;
    StaticOrder S; S.init(M_ALL, N, nblk_opaque(), bid_opaque(), N == 8192 ? WGM_UP : WGM_IN);
    pg8::gemm_phase<Epi, StaticOrder, false>(lds, g, S, E, nullptr);
    }
}
template <bool HALO, class Epi> __device__ __forceinline__ void gemm_small(LDSP lds, const bf16_t* A, const bf16_t* Bt, int K, const Epi& E, int c_ = -1, int G_ = 0) {
    const int tid = tid_opaque(), wid = tid >> 6, lane = tid & 63, r = lane & 31, hh = lane >> 5;
    const int nb = c_ < 0 ? nblk_opaque() : G_;
    for (int t = (c_ < 0 ? bid_opaque() : c_); t < (HALO ? 512 : 256); t += nb) {
        const int m0 = HALO ? (t >> 6) * 64 : M_P + (t >> 4) * 64, n0 = HALO ? (t & 63) * 64 : (t & 15) * 64, kbeg = wid * (K >> 3), nst = K >> 7;
        const int nrow = HALO ? (n0 >> 7) * 256 + (n0 & 127) : n0;
        const bf16_t* ap = A + (size_t)(m0 + r) * K + kbeg + 8 * hh; const bf16_t* bp = Bt + (size_t)(nrow + r) * K + kbeg + 8 * hh;
        const size_t hop = (size_t)32 * K;
        f32x16 acc[2][2];
#pragma unroll
        for (int a = 0; a < 2; ++a)
#pragma unroll
            for (int b = 0; b < 2; ++b) acc[a][b] = zero16();
        bf16x8 fa[4][2], fb[4][2];
#pragma unroll
        for (int s = 0; s < 3; ++s) { const int ko = 16 * (s < nst ? s : 0);
            fa[s][0] = *(const bf16x8*)(ap + ko); fa[s][1] = *(const bf16x8*)(ap + hop + ko); fb[s][0] = *(const bf16x8*)(bp + ko); fb[s][1] = *(const bf16x8*)(bp + hop + ko); }
        for (int st = 0; st < nst; st += 2) {
#pragma unroll
            for (int s2 = 0; s2 < 2; ++s2) {
                const int cur = (st + s2) & 3, nxs = (st + s2 + 3) & 3, nx = st + s2 + 3, ko = 16 * (nx < nst ? nx : 0);
                if (((st >> 1) & 1) == 0) {
                    fa[(s2 + 3) & 3][0] = *(const bf16x8*)(ap + ko); fa[(s2 + 3) & 3][1] = *(const bf16x8*)(ap + hop + ko); fb[(s2 + 3) & 3][0] = *(const bf16x8*)(bp + ko); fb[(s2 + 3) & 3][1] = *(const bf16x8*)(bp + hop + ko);
#pragma unroll
                    for (int a = 0; a < 2; ++a)
#pragma unroll
                        for (int b = 0; b < 2; ++b) acc[a][b] = MFMA32(fa[s2][a], fb[s2][b], acc[a][b]);
                } else {
                    fa[(s2 + 1) & 3][0] = *(const bf16x8*)(ap + ko); fa[(s2 + 1) & 3][1] = *(const bf16x8*)(ap + hop + ko); fb[(s2 + 1) & 3][0] = *(const bf16x8*)(bp + ko); fb[(s2 + 1) & 3][1] = *(const bf16x8*)(bp + hop + ko);
#pragma unroll
                    for (int a = 0; a < 2; ++a)
#pragma unroll
                        for (int b = 0; b < 2; ++b) acc[a][b] = MFMA32(fa[s2 + 2][a], fb[s2 + 2][b], acc[a][b]);
                }
                (void)cur; (void)nxs;
            }
        }
        PG8_LAS float* red = (PG8_LAS float*)lds;
#pragma unroll
        for (int a = 0; a < 2; ++a)
#pragma unroll
            for (int b = 0; b < 2; ++b)
#pragma unroll
                for (int q = 0; q < 16; ++q) red[((wid * 4 + a * 2 + b) * 16 + q) * 64 + lane] = acc[a][b][q];
        __syncthreads();
        { const int blk = wid & 3, q0 = (wid >> 2) * 8, a = blk >> 1, b = blk & 1;
#pragma unroll
          for (int q = 0; q < 8; ++q) { float v = 0.f;
#pragma unroll
              for (int w = 0; w < 8; ++w) v += red[((w * 4 + blk) * 16 + q0 + q) * 64 + lane];
              const int qq = q0 + q; E.elem(m0 + 32 * a + (qq & 3) + 8 * (qq >> 2) + 4 * hh, n0 + 32 * b + r, v); } }
        __syncthreads();
    }
}
template <class Epi> __device__ __forceinline__ void gemm_site_n1024_part(LDSP lds, const bf16_t* A, const bf16_t* Bt, int K, const Epi& E, int G, int c) {
    Gemm g; g.A = A; g.Bt = Bt; g.M = M_P; g.N = 1024; g.K = K;
    StaticOrder S; S.init(M_P, 1024, G, c);
    pg8::gemm_phase<Epi, StaticOrder, false>(lds, g, S, E, nullptr);
    gemm_small<false>(lds, A, Bt, K, E, c, G);
}
template <class Epi> __device__ __forceinline__ void gemm_site_n1024_prompt(LDSP lds, const bf16_t* A, const bf16_t* Bt, int K, const Epi& E) {
    Gemm g; g.A = A; g.Bt = Bt; g.M = M_P; g.N = 1024; g.K = K;
    StaticOrder S; S.init(M_P, 1024, nblk_opaque(), bid_opaque());
    pg8::gemm_phase<Epi, StaticOrder, false>(lds, g, S, E, nullptr);
}
template <class Epi> __device__ __forceinline__ void gemm_site_n1024(LDSP lds, const bf16_t* A, const bf16_t* Bt, int K, const Epi& E) {
    for (int rep_ = 0; rep_ < PROBE_GSMALL; ++rep_) {
    Gemm g; g.A = A; g.Bt = Bt; g.M = M_P; g.N = 1024; g.K = K;
    StaticOrder S; S.init(M_P, 1024, nblk_opaque(), bid_opaque());
    pg8::gemm_phase<Epi, StaticOrder, false>(lds, g, S, E, nullptr);
    gemm_small<false>(lds, A, Bt, K, E);
    }
}
__global__ void __launch_bounds__(512, 2) k_mega(Params p_) {
    extern __shared__ __attribute__((aligned(16))) unsigned char shm[];
    LDSP lds = (LDSP)shm;
    volatile LAS unsigned* xbw = (volatile LAS unsigned*)(lds + MEGA_BODY);
    if (threadIdx.x < 4) xbw[threadIdx.x] = 0u;
    __syncthreads();
    XcdBarrier bar = xcd_barrier_post(kargs()->bar, xbw);
    for (int rep_ = 0; rep_ < PROBE_PRO; ++rep_) { { CPR p = *kargs(); ph_wt(p, lds); }
    { CPR p = *kargs(); ph_xprep(p); } }
    GRID_BARRIER();
    for (int l = 0; l < DEPTH; ++l) {
        { CPR p = *kargs(); float* out = p.out; const bf16_t* wl = p.wt + (size_t)l * WT_LAYER; EpiIn E; E.rs = p.rs; E.zb = p.zb; E.xbcb = p.xbcb; E.qb = p.qb; E.kb = p.kb; E.vb = p.vb; E.gb = p.gb; E.dtb = p.dtb; E.dt_bias = p.ssd_dt_bias + l * 32;
          E.kP = out + O_P_K + (size_t)l * M_P * 1024; E.vP = out + O_P_V + (size_t)l * M_P * 1024; E.kS = out + O_S_K + (size_t)l * M_S * 1024; E.vS = out + O_S_V + (size_t)l * M_S * 1024;
          E.convP = out + O_P_CONV + (size_t)l * 3 * 3072; E.convS = out + O_S_CONV + (size_t)l * DEC_BATCH * 3 * 3072;
          gemm_site(lds, p.xb, wl + OW1, N1, 1024, E); }
        GRID_BARRIER();
        for (int rep_ = 0; rep_ < PROBE_P1; ++rep_) { CPR p = *kargs(); ph_ssd_p1(p, l, lds); }
        for (int rep_ = 0; rep_ < PROBE_A; ++rep_) { CPR p = *kargs(); ph_attn(p, l, lds); }
        GRID_BARRIER();
        for (int rep_ = 0; rep_ < PROBE_P2; ++rep_) { CPR p = *kargs(); ph_ssd_p2(p, l); }
        { CPR p = *kargs(); float* out = p.out; const bf16_t* wl = p.wt + (size_t)l * WT_LAYER; EpiBr E; E.gb = p.gb; E.t1in = nullptr; E.dst = p.t1; E.mode = 0; E.pad = 0; gemm_site_n1024_prompt(lds, p.att, wl + OW3, 1024, E); }
        GRID_BARRIER();
        for (int rep_ = 0; rep_ < PROBE_P3; ++rep_) { CPR p = *kargs(); ph_ssd_p3(p, l, lds); }
        if (bid_opaque() >= 128) { __syncthreads(); CPR p = *kargs(); const bf16_t* wl = p.wt + (size_t)l * WT_LAYER; EpiBr E; E.gb = p.gb; E.t1in = nullptr; E.dst = p.t1; E.mode = 0; E.pad = 0; gemm_small<false>(lds, p.att, wl + OW3, 1024, E, bid_opaque() - 128, 128); }
        GRID_BARRIER();
        { CPR p = *kargs(); float* out = p.out; const bf16_t* wl = p.wt + (size_t)l * WT_LAYER; EpiBr E; E.gb = p.gb; E.t1in = p.t1; E.dst = p.mixin; E.mode = 1; E.pad = 0; gemm_site_n1024(lds, p.yn, wl + OW2, 2048, E); }
        GRID_BARRIER();
        { CPR p = *kargs(); float* out = p.out; const bf16_t* wl = p.wt + (size_t)l * WT_LAYER; EpiF32Out E; E.dst = p.mixed; gemm_site_n1024(lds, p.mixin, wl + OW4, 1024, E); }
        GRID_BARRIER();
        { CPR p = *kargs(); float* out = p.out; (void)out; ph_norm(p.mixed, p.norm_post_mix + l * 1024, p.xr, p.xb, nullptr, nullptr, p.xh); }
        GRID_BARRIER();
        { CPR p = *kargs(); const bf16_t* wl = p.wt + (size_t)l * WT_LAYER; EpiHalo E; E.rs = nullptr; E.gh = p.gh; gemm_small<true>(lds, p.xh, wl + OW5, 1024, E); }
        GRID_BARRIER();
        { CPR p = *kargs(); float* out = p.out; const bf16_t* wl = p.wt + (size_t)l * WT_LAYER; EpiUpAct E; E.rs = p.rs2; E.gh = p.gh; E.ffb = p.ffb;
          E.ffnP = out + O_P_FFN + (size_t)l * 2 * D_FF; E.ffnS = out + O_S_FFN + (size_t)l * DEC_BATCH * 2 * D_FF;
          E.cw = p.ffn_conv_w + (size_t)l * 3 * D_FF; E.cb = p.ffn_conv_b + (size_t)l * D_FF; E.hist = p.state_ffn_conv + (size_t)l * DEC_BATCH * 2 * D_FF;
          gemm_site(lds, p.xb, wl + OW5, 8192, 1024, E); }
        if (bid_opaque() >= 128) { CPR p = *kargs(); const bf16_t* wl = p.wt + (size_t)l * WT_LAYER; EpiPlain E; E.dst = p.plea; gemm_site_n1024_part(lds, p.pb + (size_t)l * M_ALL * 256, wl + OW7, 256, E, 128, bid_opaque() - 128); }
        GRID_BARRIER();
        { CPR p = *kargs(); float* out = p.out; const bf16_t* wl = p.wt + (size_t)l * WT_LAYER; EpiF32Out E; E.dst = p.down; gemm_site_n1024(lds, p.ffb, wl + OW6, 4096, E); }
        GRID_BARRIER();
        { CPR p = *kargs(); float* out = p.out; (void)out; ph_norm(p.down, p.norm_post_ffn + l * 1024, p.xr, nullptr, nullptr, nullptr); }
        GRID_BARRIER();
        { CPR p = *kargs(); float* out = p.out; const bf16_t* wl = p.wt + (size_t)l * WT_LAYER; EpiPle E; E.plea = p.plea; E.dst = p.ple; gemm_site_n1024(lds, p.xr, wl + OW8, 1024, E); }
        GRID_BARRIER();
        { CPR p = *kargs(); float* out = p.out; (void)out; ph_norm(p.ple, p.norm_ple + l * 1024, p.xr, p.xb, l == DEPTH - 1 ? out + O_Y_P : nullptr, out + O_Y_S); }
        if (l + 1 < DEPTH) GRID_BARRIER();
    }
}

struct Bump { char* base; size_t off; template <class T> T* take(size_t n) { off = (off + 255) & ~(size_t)255; T* p = (T*)(base + off); off += n * sizeof(T); return p; } };
__global__ void k_fail_code(float* out, float code) { if (threadIdx.x == 0 && blockIdx.x == 0) out[0] = code; }

extern "C" void kernel_launch(void* const* d_in, const int* in_sizes, int n_in, void* d_out, int out_size, void* d_ws, size_t ws_size, hipStream_t stream) {
    Params p; memset(&p, 0, sizeof p);
    p.x_prompt = (const float*)d_in[0]; p.x_sample = (const float*)d_in[1]; p.state_ssd_conv = (const float*)d_in[2]; p.state_ssd = (const float*)d_in[3];
    p.cache_k = (const float*)d_in[4]; p.cache_v = (const float*)d_in[5]; p.state_ffn_conv = (const float*)d_in[6]; p.p_prompt = (const float*)d_in[7]; p.p_sample = (const float*)d_in[8];
    p.norm_pre_mix = (const float*)d_in[9]; p.w_in = (const float*)d_in[10]; p.ssd_conv_w = (const float*)d_in[11]; p.ssd_conv_b = (const float*)d_in[12]; p.ssd_dt_bias = (const float*)d_in[13];
    p.ssd_a_log = (const float*)d_in[14]; p.ssd_d = (const float*)d_in[15]; p.ssd_norm = (const float*)d_in[16]; p.w_br_ssd = (const float*)d_in[17]; p.w_br_sb = (const float*)d_in[18];
    p.w_out = (const float*)d_in[19]; p.norm_post_mix = (const float*)d_in[20]; p.norm_pre_ffn = (const float*)d_in[21]; p.w_up = (const float*)d_in[22]; p.ffn_conv_w = (const float*)d_in[23];
    p.ffn_conv_b = (const float*)d_in[24]; p.w_down = (const float*)d_in[25]; p.norm_post_ffn = (const float*)d_in[26]; p.w_ple = (const float*)d_in[27]; p.w_ple_gate = (const float*)d_in[28];
    p.norm_ple = (const float*)d_in[29];
    float* out = (float*)d_out; p.out = out;

    Bump B{(char*)d_ws, 0};
    const size_t R = M_ALL;
    p.bar = B.take<unsigned>(4096);
    p.wt = B.take<bf16_t>(DEPTH * WT_LAYER);
    p.xr = B.take<bf16_t>(R * 1024); p.xb = B.take<bf16_t>(R * 1024); p.rs = B.take<float>(R); p.rs2 = B.take<float>(R); p.pb = B.take<bf16_t>(DEPTH * R * 256);
    p.zb = B.take<bf16_t>(R * 2048); p.xbcb = B.take<bf16_t>(R * 3072); p.qb = B.take<bf16_t>(R * 1024); p.kb = B.take<bf16_t>(R * 1024); p.vb = B.take<bf16_t>(R * 1024); p.gb = B.take<bf16_t>(R * 2048); p.dtb = B.take<float>(R * 32);
    p.sst = B.take<float>((size_t)NCHUNK * STATE_SZ / 2); p.dec = B.take<float>(NCHUNK * 32); p.hpb = B.take<bf16_t>((size_t)NCHUNK * STATE_SZ);
    p.yn = B.take<bf16_t>(R * 2048); p.att = B.take<bf16_t>(R * 1024); p.t1 = B.take<bf16_t>(R * 1024); p.mixin = B.take<bf16_t>(R * 1024); p.mixed = B.take<bf16_t>(R * 1024);
    p.gh = B.take<bf16_t>((size_t)768 * 4096); p.xh = B.take<bf16_t>((size_t)768 * 1024); p.ffb = B.take<bf16_t>(R * 4096); p.down = B.take<bf16_t>(R * 1024); p.plea = B.take<bf16_t>(R * 1024); p.ple = B.take<bf16_t>(R * 1024);
    if (B.off > ws_size) { k_fail_code<<<1, 64, 0, stream>>>(out, 777000.f); return; }

    (void)hipMemsetAsync(p.bar, 0, 4096 * 4, stream);
    static bool minit = false;
    if (!minit) { (void)hipFuncSetAttribute((const void*)k_mega, hipFuncAttributeMaxDynamicSharedMemorySize, MEGA_LDS); minit = true; }
    hipLaunchKernelGGL(k_mega, dim3(256), dim3(512), MEGA_LDS, stream, p);
}
```

```cpp
#include <hip/hip_runtime.h>
#include <stdint.h>
#include <string.h>

constexpr int D_MODEL = 1024, SEQ = 16384, DEPTH = 2, DEC_BATCH = 32, DEC_SEQ = 32, PAST_LEN = 2048;
constexpr int D_SSM = 2048, SSD_HEAD_DIM = 64, SSD_HEADS = 32, SSD_GROUPS = 4, SSD_STATE = 128, SSD_CONV_DIM = 3072;
constexpr int SB_HEAD_DIM = 128, SB_HEADS = 8, SB_WIDTH = 1024, D_FF = 4096, PLE_DIM = 256;
constexpr int IN_DIM = 10272;
constexpr int M_P = SEQ, M_S = DEC_BATCH * DEC_SEQ, M_ALL = M_P + M_S;
constexpr float EPS = 1e-6f;
constexpr int C_Z = 0, C_XBC = 2048, C_DT = 5120, C_Q = 5152, C_K = 6176, C_V = 7200, C_G = 8224;
constexpr size_t O_Y_P = 0;
constexpr size_t O_Y_S = O_Y_P + (size_t)M_P * D_MODEL;
constexpr size_t O_P_CONV = O_Y_S + (size_t)M_S * D_MODEL;
constexpr size_t O_P_STATE = O_P_CONV + (size_t)DEPTH * 3 * SSD_CONV_DIM;
constexpr size_t O_P_K = O_P_STATE + (size_t)DEPTH * SSD_HEADS * SSD_HEAD_DIM * SSD_STATE;
constexpr size_t O_P_V = O_P_K + (size_t)DEPTH * M_P * SB_WIDTH;
constexpr size_t O_P_FFN = O_P_V + (size_t)DEPTH * M_P * SB_WIDTH;
constexpr size_t O_S_CONV = O_P_FFN + (size_t)DEPTH * 2 * D_FF;
constexpr size_t O_S_STATE = O_S_CONV + (size_t)DEPTH * DEC_BATCH * 3 * SSD_CONV_DIM;
constexpr size_t O_S_K = O_S_STATE + (size_t)DEPTH * DEC_BATCH * SSD_HEADS * SSD_HEAD_DIM * SSD_STATE;
constexpr size_t O_S_V = O_S_K + (size_t)DEPTH * M_S * SB_WIDTH;
constexpr size_t O_S_FFN = O_S_V + (size_t)DEPTH * M_S * SB_WIDTH;
constexpr size_t O_TOTAL = O_S_FFN + (size_t)DEPTH * DEC_BATCH * 2 * D_FF;
constexpr size_t STATE_SZ = (size_t)SSD_HEADS * SSD_HEAD_DIM * SSD_STATE;

typedef unsigned short bf16_t;

__device__ __forceinline__ float wave_sum(float v) {
#pragma unroll
    for (int o = 32; o >= 1; o >>= 1) v += __shfl_xor(v, o);
    return v;
}
__device__ __forceinline__ float sigmoidf_(float x) { return 1.0f / (1.0f + __expf(-x)); }
__device__ __forceinline__ float softplusf_(float x) { return fmaxf(x, 0.f) + log1pf(__expf(-fabsf(x))); }
__device__ __forceinline__ float siluf_(float x) { return x * sigmoidf_(x); }
__device__ __forceinline__ float gelu_tanhf_(float x) { const float u = 0.7978845608028654f * (x + 0.044715f * x * x * x); return 0.5f * x * (1.0f + tanhf(u)); }
__device__ __forceinline__ bf16_t f2bf(float f) { unsigned u = __float_as_uint(f); u += 0x7FFFu + ((u >> 16) & 1u); return (bf16_t)(u >> 16); }
__device__ __forceinline__ float bf2f(bf16_t b) { return __uint_as_float(((unsigned)b) << 16); }
typedef __bf16 bf16x2_t __attribute__((ext_vector_type(2)));
typedef float f32x2_t __attribute__((ext_vector_type(2)));
__device__ __forceinline__ unsigned pk2(float lo, float hi) { unsigned r; asm volatile("v_cvt_pk_bf16_f32 %0, %1, %2" : "=v"(r) : "v"(lo), "v"(hi)); return r; }
__device__ __forceinline__ unsigned pk2c(float lo, float hi) { const f32x2_t v = {lo, hi}; return __builtin_bit_cast(unsigned, __builtin_convertvector(v, bf16x2_t)); }
__device__ __forceinline__ f32x2_t exp2_2(f32x2_t x) { f32x2_t e; e.x = __builtin_amdgcn_exp2f(x.x); e.y = __builtin_amdgcn_exp2f(x.y); return e; }
__device__ __forceinline__ f32x2_t rcp_2(f32x2_t x) { f32x2_t r; r.x = __builtin_amdgcn_rcpf(x.x); r.y = __builtin_amdgcn_rcpf(x.y); return r; }
__device__ __forceinline__ f32x2_t sigmoid2(f32x2_t a) { return rcp_2(exp2_2(a * (-1.4426950408889634f)) + 1.0f); }
__device__ __forceinline__ f32x2_t silu2(f32x2_t a) { return a * sigmoid2(a); }
__device__ __forceinline__ f32x2_t gelu2(f32x2_t x) { const f32x2_t u2 = (x * x * 0.044715f + 1.0f) * x * 1.5957691216057308f; return x * sigmoid2(u2); }
__device__ __forceinline__ float bflo(unsigned w) { return __uint_as_float(w << 16); }
__device__ __forceinline__ float bfhi(unsigned w) { return __uint_as_float(w & 0xffff0000u); }

__device__ __forceinline__ int bid_opaque() { int b = blockIdx.x; asm volatile("" : "+s"(b)); return b; }
__device__ __forceinline__ int nblk_opaque() { int b = gridDim.x; asm volatile("" : "+s"(b)); return b; }
__device__ __forceinline__ int tid_opaque() { int t = threadIdx.x; asm volatile("" : "+v"(t)); return t; }

namespace pg8 {
#define PG8_LAS __attribute__((address_space(3)))
typedef unsigned short bf16_t;
typedef short bf16x8 __attribute__((ext_vector_type(8)));
typedef float f32x4 __attribute__((ext_vector_type(4)));
typedef unsigned u32x4 __attribute__((ext_vector_type(4)));
constexpr int BM = 256, BK = 64, HALF = 128, HTB = HALF * BK * 2  , STAGE_BYTES = 8 * HTB, NXCD = 8, WGM = 8;

__host__ __device__ __forceinline__ int lds_byte(int r, int c) { const int st = (r >> 4) * 2 + (c >> 5), rr = r & 15, cc = c & 31, ob = rr * 64 + cc * 2; return st * 1024 + (ob ^ (((ob >> 9) & 1) << 5)); }
__host__ __device__ __forceinline__ void stage_rc(int b, int& R, int& C) { const int st = b / 1024, sb = b % 1024, swz = sb ^ (((sb >> 9) & 1) << 5); R = (st >> 1) * 16 + swz / 64; C = (st & 1) * 32 + (swz % 64) / 2; }
__host__ __device__ __forceinline__ int perm32(int rho) { const int n = rho >> 4, i = rho & 15; return 8 * (i >> 2) + 4 * n + (i & 3); }

struct Unit { int pm, pn; };
struct Gemm { const bf16_t* A; const bf16_t* Bt; int M, N, K; };

struct StaticOrder {
    int nM, nN, nwg, G, c, wgm;
    __host__ __device__ void init(int M, int N, int G_, int c_, int wgm_ = WGM) { nM = M / BM; nN = N / BM; nwg = nM * nN; G = G_; c = c_; wgm = wgm_; }
    __host__ __device__ bool next(int i, Unit& u) const {
        const long L = (long)i * G + c; if (L >= nwg) return false;
        int wgid = (int)L; { const int q = nwg / NXCD, r = nwg % NXCD, xcd = wgid % NXCD, off = wgid / NXCD; wgid = (xcd < r ? xcd * (q + 1) : r * (q + 1) + (xcd - r) * q) + off; }
        const int nig = wgm * nN, gid = wgid / nig, fm = gid * wgm, gsz = (nM - fm) < wgm ? (nM - fm) : wgm;
        u.pm = fm + ((wgid % nig) % gsz); u.pn = (wgid % nig) / gsz; return true;
    }
    __device__ __forceinline__ void a_ready(const Unit&) const {}
    __device__ __forceinline__ void done(const Unit&) const {}
};
__device__ __forceinline__ unsigned cvt_pk_bf16(float lo, float hi) { unsigned r; asm volatile("v_cvt_pk_bf16_f32 %0, %1, %2" : "=v"(r) : "v"(lo), "v"(hi)); return r; }
typedef float f32x2 __attribute__((ext_vector_type(2)));
__device__ __forceinline__ f32x2 gelu_pk(f32x2 v) {
    const f32x2 av = __builtin_elementwise_abs(v), d = av * 0.2316418882f + 1.0f;
    f32x2 t; t.x = __builtin_amdgcn_rcpf(d.x); t.y = __builtin_amdgcn_rcpf(d.y);
    f32x2 q = t * 0.5307027145f + (-0.7265760135f); q = q * t + 0.7107068705f; q = q * t + (-0.142248368f); q = q * t + 0.127414796f; q = q * t;
    const f32x2 s = (v * v) * (-0.72134752044f);
    f32x2 e; e.x = __builtin_amdgcn_exp2f(s.x); e.y = __builtin_amdgcn_exp2f(s.y);
    const f32x2 m = v * (q * e), r = v - m;
    f32x2 o; o.x = v.x < 0.f ? m.x : r.x; o.y = v.y < 0.f ? m.y : r.y; return o;
}

struct EpiF32 {
    static constexpr bool PERM = false, AFTER_DRAIN = false;
    float* C; int ldc; const float* bias;
    __device__ __forceinline__ void operator()(const f32x4 (&acc)[2][2][4][2], const Unit& u, int wr, int wc, int fr, int fq) const {
        const int row0 = u.pm * BM + wr * 64 + fr, col0 = u.pn * BM + wc * 32 + 4 * fq;
        f32x4 bv[2][2];
#pragma unroll
        for (int bj = 0; bj < 2; ++bj)
#pragma unroll
            for (int n = 0; n < 2; ++n) bv[bj][n] = bias ? *(const f32x4*)(bias + col0 + bj * HALF + n * 16) : (f32x4){0.f, 0.f, 0.f, 0.f};
#pragma unroll
        for (int ai = 0; ai < 2; ++ai)
#pragma unroll
            for (int m = 0; m < 4; ++m) { float* rowp = C + (size_t)(row0 + ai * HALF + m * 16) * ldc + col0;
#pragma unroll
                for (int bj = 0; bj < 2; ++bj)
#pragma unroll
                    for (int n = 0; n < 2; ++n) *(f32x4*)(rowp + bj * HALF + n * 16) = acc[ai][bj][m][n] + bv[bj][n]; }
    }
};
template <int ACT  > struct EpiBf16 {
    static constexpr bool PERM = true, AFTER_DRAIN = false;
    bf16_t* O; int ldc; const float* bias; int split_cols; size_t split_stride;
    __device__ __forceinline__ void operator()(const f32x4 (&acc)[2][2][4][2], const Unit& u, int wr, int wc, int fr, int fq) const {
        const int row0 = u.pm * BM + wr * 64 + fr; int colt = u.pn * BM; bf16_t* base = O;
        if (split_cols) { const int t = colt / split_cols; base += (size_t)t * split_stride; colt -= t * split_cols; }
        const int col0 = colt + wc * 32 + 8 * fq, bcol0 = u.pn * BM + wc * 32 + 8 * fq;
        f32x4 bv[2][2];
#pragma unroll
        for (int bj = 0; bj < 2; ++bj)
#pragma unroll
            for (int n = 0; n < 2; ++n) bv[bj][n] = bias ? *(const f32x4*)(bias + bcol0 + bj * HALF + 4 * n) : (f32x4){0.f, 0.f, 0.f, 0.f};
#pragma unroll
        for (int ai = 0; ai < 2; ++ai)
#pragma unroll
            for (int m = 0; m < 4; ++m) { bf16_t* rowp = base + (size_t)(row0 + ai * HALF + m * 16) * ldc + col0;
#pragma unroll
                for (int bj = 0; bj < 2; ++bj) { f32x4 v0 = acc[ai][bj][m][0] + bv[bj][0], v1 = acc[ai][bj][m][1] + bv[bj][1];
                    if (ACT == 1) { f32x2 a = gelu_pk((f32x2){v0[0], v0[1]}), b = gelu_pk((f32x2){v0[2], v0[3]}), c = gelu_pk((f32x2){v1[0], v1[1]}), d = gelu_pk((f32x2){v1[2], v1[3]});
                        v0 = (f32x4){a.x, a.y, b.x, b.y}; v1 = (f32x4){c.x, c.y, d.x, d.y}; }
                    if (ACT == 2) {
#pragma unroll
                        for (int j = 0; j < 4; ++j) { v0[j] = 0.5f * v0[j] * (1.0f + erff(v0[j] * 0.70710678f)); v1[j] = 0.5f * v1[j] * (1.0f + erff(v1[j] * 0.70710678f)); } }
                    u32x4 w; w.x = cvt_pk_bf16(v0[0], v0[1]); w.y = cvt_pk_bf16(v0[2], v0[3]); w.z = cvt_pk_bf16(v1[0], v1[1]); w.w = cvt_pk_bf16(v1[2], v1[3]);
                    *(u32x4*)(rowp + bj * HALF) = w; } }
    }
};

template <class Epi, class Sched, bool STAMP = false>
__device__ __forceinline__ void gemm_phase(PG8_LAS unsigned char* lds, const Gemm g, const Sched& S, const Epi& E, unsigned long long* stamps) {
    const int tid = tid_opaque(), wid = __builtin_amdgcn_readfirstlane(tid >> 6), lane = tid & 63, wr = wid >> 2, wc = wid & 3, fr = lane & 15, fq = lane >> 4;
    const int K = g.K, nt = K / BK;
    int ts_lo = 0, ts_hi = 0, nts = 0; const unsigned long long rt_entry = STAMP ? (unsigned long long)wall_clock64() : 0ull;
#define PG8_STAMP() do { if (STAMP && wid == 0 && nts < 64) { const unsigned long long _c = (unsigned long long)clock64(); \
        ts_lo = (lane == nts) ? (int)(unsigned)_c : ts_lo; ts_hi = (lane == nts) ? (int)(unsigned)(_c >> 32) : ts_hi; ++nts; } } while (0)
    PG8_STAMP();
    unsigned voffA[2], voffB[2];
#pragma unroll
    for (int i = 0; i < 2; ++i) { int R, C; stage_rc(tid * 16 + i * 8192, R, C); const int Rb = Epi::PERM ? ((R & ~31) + perm32(R & 31)) : R;
        voffA[i] = (unsigned)(R * K + C) * 2u; voffB[i] = (unsigned)(Rb * K + C) * 2u; }
    const size_t kstep = (size_t)(BK * 2);
    const size_t hstep = (size_t)HALF * K * 2;
    const size_t tstep = 2 * hstep;
    const unsigned ldsw = (unsigned)wid * 1024u;
    const int aoff = lds_byte(wr * 64 + fr, fq * 8), boff = lds_byte(wc * 32 + fr, fq * 8);
#define PG8_SA(b, h) (((b) * 2 + (h)) * HTB)
#define PG8_SB(b, h) ((4 + (b) * 2 + (h)) * HTB)
#define PG8_STAGE(bufoff, gbase, voff) do { _Pragma("unroll") for (int _i = 0; _i < 2; ++_i) \
        __builtin_amdgcn_global_load_lds((const unsigned*)((const char*)(gbase) + (voff)[_i]), (PG8_LAS unsigned*)(lds + (bufoff) + ldsw + _i * 8192), 16, 0, 0); } while (0)
#define PG8_LDA(dst, b, h) do { _Pragma("unroll") for (int m = 0; m < 4; ++m) _Pragma("unroll") for (int k = 0; k < 2; ++k) dst[m][k] = *(const PG8_LAS bf16x8*)(lds + PG8_SA(b, h) + aoff + m * 2048 + k * 1024); } while (0)
#define PG8_LDB(dst, b, h) do { _Pragma("unroll") for (int n = 0; n < 2; ++n) _Pragma("unroll") for (int k = 0; k < 2; ++k) dst[n][k] = *(const PG8_LAS bf16x8*)(lds + PG8_SB(b, h) + boff + n * 2048 + k * 1024); } while (0)
#define PG8_MMA(ai, bj, At, Bt) do { __builtin_amdgcn_s_setprio(1); _Pragma("unroll") for (int m = 0; m < 4; ++m) _Pragma("unroll") for (int n = 0; n < 2; ++n) _Pragma("unroll") for (int k = 0; k < 2; ++k) \
        acc[ai][bj][m][n] = __builtin_amdgcn_mfma_f32_16x16x32_bf16(Bt[n][k], At[m][k], acc[ai][bj][m][n], 0, 0, 0); __builtin_amdgcn_s_setprio(0); } while (0)
#define PG8_WAIT_V(n) asm volatile("s_waitcnt vmcnt(" #n ")" ::: "memory")
#define PG8_WAIT_L(n) asm volatile("s_waitcnt lgkmcnt(" #n ")" ::: "memory")
#define PG8_BAR __builtin_amdgcn_s_barrier()
#define PG8_SCHED __builtin_amdgcn_sched_barrier(0)
    Unit cur, nxt; int ui = 0;
    if (!S.next(0, cur)) return;
    f32x4 acc[2][2][4][2];
#pragma unroll
    for (int a = 0; a < 2; ++a)
#pragma unroll
        for (int b = 0; b < 2; ++b)
#pragma unroll
            for (int m = 0; m < 4; ++m)
#pragma unroll
                for (int n = 0; n < 2; ++n) acc[a][b][m][n] = (f32x4){0.f, 0.f, 0.f, 0.f};
    bf16x8 At[4][2], B0[2][2], B1[2][2];
    const char* cA = (const char*)g.A + (size_t)cur.pm * tstep; const char* cB = (const char*)g.Bt + (size_t)cur.pn * tstep;
    S.a_ready(cur);
    PG8_STAGE(PG8_SB(0, 0), cB, voffB); PG8_STAGE(PG8_SA(0, 0), cA, voffA); PG8_STAGE(PG8_SB(0, 1), cB + hstep, voffB); PG8_STAGE(PG8_SA(0, 1), cA + hstep, voffA);
    if (wr == 1) PG8_BAR;
    PG8_WAIT_V(4); PG8_BAR;
    PG8_STAGE(PG8_SB(1, 0), cB + kstep, voffB); PG8_STAGE(PG8_SA(1, 0), cA + kstep, voffA); PG8_STAGE(PG8_SB(1, 1), cB + hstep + kstep, voffB);
    PG8_WAIT_V(6); PG8_BAR;
    PG8_STAMP();
    for (;;) {
        const bool has_next = S.next(ui + 1, nxt);
        const char* nA = has_next ? (const char*)g.A + (size_t)nxt.pm * tstep : cA; const char* nB = has_next ? (const char*)g.Bt + (size_t)nxt.pn * tstep : cB;
        for (int t = 0; t < nt; t += 2) {
            const bool last = (t == nt - 2);
            const char* a1 = cA + (size_t)(t + 1) * kstep;
            const char* a2 = last ? nA : cA + (size_t)(t + 2) * kstep; const char* b2 = last ? nB : cB + (size_t)(t + 2) * kstep;
            const char* a3 = a2 + kstep; const char* b3 = b2 + kstep;
            if (last && has_next) S.a_ready(nxt);
            PG8_LDB(B0, 0, 0); PG8_SCHED; PG8_LDA(At, 0, 0); PG8_STAGE(PG8_SA(1, 1), a1 + hstep, voffA);
            PG8_WAIT_L(8); PG8_BAR; PG8_WAIT_L(0); PG8_MMA(0, 0, At, B0); PG8_BAR; PG8_SCHED;
            PG8_LDB(B1, 0, 1); PG8_STAGE(PG8_SB(0, 0), b2, voffB);
            PG8_BAR; PG8_WAIT_L(0); PG8_MMA(0, 1, At, B1); PG8_BAR;
            PG8_LDA(At, 0, 1); PG8_STAGE(PG8_SA(0, 0), a2, voffA);
            PG8_BAR; PG8_WAIT_L(0); PG8_MMA(1, 0, At, B0); PG8_BAR; PG8_SCHED;
            PG8_STAGE(PG8_SB(0, 1), b2 + hstep, voffB);
            PG8_WAIT_V(6); PG8_BAR; PG8_MMA(1, 1, At, B1); PG8_BAR;
            PG8_LDB(B0, 1, 0); PG8_SCHED; PG8_LDA(At, 1, 0); PG8_STAGE(PG8_SA(0, 1), a2 + hstep, voffA);
            PG8_WAIT_L(8); PG8_BAR; PG8_WAIT_L(0); PG8_MMA(0, 0, At, B0); PG8_BAR; PG8_SCHED;
            PG8_LDB(B1, 1, 1); PG8_STAGE(PG8_SB(1, 0), b3, voffB);
            PG8_BAR; PG8_WAIT_L(0); PG8_MMA(0, 1, At, B1); PG8_BAR;
            PG8_LDA(At, 1, 1); PG8_STAGE(PG8_SA(1, 0), a3, voffA);
            PG8_BAR; PG8_WAIT_L(0); PG8_MMA(1, 0, At, B0); PG8_BAR; PG8_SCHED;
            PG8_STAGE(PG8_SB(1, 1), b3 + hstep, voffB);
            PG8_WAIT_V(6); PG8_BAR; PG8_MMA(1, 1, At, B1); PG8_BAR;
        }
        PG8_STAMP();
        if constexpr (!Epi::AFTER_DRAIN) { E(acc, cur, wr, wc, fr, fq); S.done(cur); }
        PG8_STAMP();
        if (!has_next) break;
#pragma unroll
        for (int a = 0; a < 2; ++a)
#pragma unroll
            for (int b = 0; b < 2; ++b)
#pragma unroll
                for (int m = 0; m < 4; ++m)
#pragma unroll
                    for (int n = 0; n < 2; ++n) acc[a][b][m][n] = (f32x4){0.f, 0.f, 0.f, 0.f};
        cur = nxt; cA = nA; cB = nB; ++ui;
    }
    PG8_WAIT_V(0);
    if (wr == 0) PG8_BAR;
    PG8_BAR;
    if constexpr (Epi::AFTER_DRAIN) { E.fused(acc, cur, wr, wc, fr, fq, lds, wid, lane); S.done(cur); }
    PG8_STAMP();
    if (STAMP && wid == 0) { stamps[lane] = lane < nts ? (((unsigned long long)(unsigned)ts_hi << 32) | (unsigned)ts_lo) : 0ull;
        if (lane == 62) stamps[62] = rt_entry; if (lane == 63) stamps[63] = (unsigned long long)wall_clock64(); }
#undef PG8_STAMP
#undef PG8_SA
#undef PG8_SB
#undef PG8_STAGE
#undef PG8_LDA
#undef PG8_LDB
#undef PG8_MMA
#undef PG8_WAIT_V
#undef PG8_WAIT_L
#undef PG8_BAR
#undef PG8_SCHED
}
}
#define XB_TMO      128
#define XB_XCNT(j)  (256  + 64 * (j))
#define XB_XSUB(j)  (1280 + 64 * (j))
#define XB_XGEN(j)  (2304 + 64 * (j))
#define XB_TOP      3328
#define XB_TOPGEN   3392
#define XCD_BAR_WORDS 3456
#define XB_SPIN_CAP (1u << 18)
#define LAS __attribute__((address_space(3)))

__device__ __forceinline__ unsigned xb_ld(unsigned* p)              { return __hip_atomic_load(p, __ATOMIC_RELAXED, __HIP_MEMORY_SCOPE_AGENT); }
__device__ __forceinline__ unsigned xb_add(unsigned* p, unsigned v) { return __hip_atomic_fetch_add(p, v, __ATOMIC_RELAXED, __HIP_MEMORY_SCOPE_AGENT); }
__device__ __forceinline__ unsigned xb_xcc_id() { return (unsigned)__builtin_amdgcn_s_getreg((3 << 11) | 20) & 0xFu; }
#define XB_SPIN(cond, bar) do { unsigned _sp = 0; while (cond) { __builtin_amdgcn_s_sleep(1); \
    if ((++_sp & 255u) == 0u) { if (xb_ld(&(bar)[XB_TMO])) break; if (_sp > XB_SPIN_CAP) { atomicAdd(&(bar)[XB_TMO], 1u); break; } } } } while (0)

struct XcdBarrier {
    unsigned* bar; unsigned x;
    volatile LAS unsigned* st;
};

__device__ __forceinline__ XcdBarrier xcd_barrier_post(unsigned* bar, volatile LAS unsigned* st) {
    XcdBarrier b; b.bar = bar; b.x = xb_xcc_id(); b.st = st;
    if (threadIdx.x == 0) (void)xb_add(&bar[XB_XCNT(b.x)], 1u);
    return b;
}
__device__ __forceinline__ void xcd_barrier_complete(unsigned* bar, unsigned x, unsigned& nloc, unsigned& nx) {
    const unsigned G = gridDim.x * gridDim.y * gridDim.z;
    unsigned sum, cnt, mine, sp = 0u;
    for (;;) {
        sum = 0u; cnt = 0u; mine = 0u;
#pragma unroll
        for (unsigned j = 0; j < 16; ++j) { const unsigned c = xb_ld(&bar[XB_XCNT(j)]); sum += c; cnt += (c > 0u) ? 1u : 0u; mine = (j == x) ? c : mine; }
        if (sum == G) break;
        __builtin_amdgcn_s_sleep(1);
        if ((++sp & 255u) == 0u) { if (xb_ld(&bar[XB_TMO])) break; if (sp > XB_SPIN_CAP) { atomicAdd(&bar[XB_TMO], 1u); break; } }
    }
    nloc = mine > 0u ? mine : 1u; nx = cnt > 0u ? cnt : 1u;
}

__device__ __forceinline__ void xcd_barrier(const XcdBarrier& b) {
    asm volatile("s_waitcnt vmcnt(0)" ::: "memory");
    __syncthreads();
    if (threadIdx.x == 0) {
        unsigned* bar = b.bar;
        __builtin_amdgcn_s_waitcnt(0);
        unsigned nloc = b.st[0], nx = b.st[1];
        if (nloc == 0u) { xcd_barrier_complete(bar, b.x, nloc, nx); b.st[0] = nloc; b.st[1] = nx; }
        const unsigned old = xb_add(&bar[XB_XSUB(b.x)], 1u);
        const unsigned gen = old / nloc;
        if (old + 1u == (gen + 1u) * nloc) {
            __builtin_amdgcn_fence(__ATOMIC_RELEASE, "agent");
            asm volatile("s_waitcnt vmcnt(0)" ::: "memory");
            const unsigned og = xb_add(&bar[XB_TOP], 1u);
            const unsigned tg = og / nx;
            if (og + 1u == (tg + 1u) * nx) xb_add(&bar[XB_TOPGEN], 1u);
            else XB_SPIN(xb_ld(&bar[XB_TOPGEN]) == tg, bar);
            __builtin_amdgcn_fence(__ATOMIC_ACQUIRE, "agent");
            xb_add(&bar[XB_XGEN(b.x)], 1u);
            asm volatile("s_waitcnt vmcnt(0)" ::: "memory");
        } else {
            XB_SPIN(xb_ld(&bar[XB_XGEN(b.x)]) == gen, bar);
            __builtin_amdgcn_fence(__ATOMIC_ACQUIRE, "agent");
            asm volatile("s_waitcnt vmcnt(0)" ::: "memory");
        }
    }
    __syncthreads();
}


using pg8::f32x4; using pg8::u32x4; using pg8::Unit; using pg8::Gemm; using pg8::StaticOrder;
typedef unsigned u32x2 __attribute__((ext_vector_type(2)));
#define LDSP PG8_LAS unsigned char*

constexpr int N1 = 10496;
constexpr size_t OW1 = 0, OW2 = OW1 + (size_t)N1 * 1024, OW3 = OW2 + (size_t)1024 * 2048, OW4 = OW3 + (size_t)1024 * 1024, OW5 = OW4 + (size_t)1024 * 1024,
                 OW6 = OW5 + (size_t)8192 * 1024, OW7 = OW6 + (size_t)1024 * 4096, OW8 = OW7 + (size_t)1024 * 256, WT_LAYER = OW8 + (size_t)1024 * 1024;
constexpr int NCHUNK = 256 + DEC_BATCH;

struct Params {
    const float *x_prompt, *x_sample, *state_ssd_conv, *state_ssd, *cache_k, *cache_v, *state_ffn_conv, *p_prompt, *p_sample;
    const float *norm_pre_mix, *w_in, *ssd_conv_w, *ssd_conv_b, *ssd_dt_bias, *ssd_a_log, *ssd_d, *ssd_norm, *w_br_ssd, *w_br_sb, *w_out, *norm_post_mix, *norm_pre_ffn,
                *w_up, *ffn_conv_w, *ffn_conv_b, *w_down, *norm_post_ffn, *w_ple, *w_ple_gate, *norm_ple;
    float* out;
    unsigned* bar;
    bf16_t* wt; bf16_t* xr; bf16_t* xb; float* rs; float* rs2; bf16_t* pb;
    bf16_t *zb, *xbcb, *qb, *gb, *kb, *vb; float* dtb;
    float* sst; float* dec; bf16_t* hpb;
    bf16_t *yn, *att, *t1, *mixin; bf16_t* mixed;
    bf16_t *gh, *xh, *ffb; bf16_t* down; bf16_t* plea; bf16_t* ple;
};

typedef const __attribute__((address_space(4))) Params CP;
#define CPR CP&
__device__ __forceinline__ CP* kargs() { CP* q = (CP*)__builtin_amdgcn_kernarg_segment_ptr(); asm volatile("" : "+s"(q)); return q; }

__device__ __forceinline__ void wt_item(const float* __restrict__ W, int K, int ldw, const float* __restrict__ gain, bf16_t* __restrict__ Wt, int nblk, int item, int w1map, PG8_LAS float* scr, int lane) {
    const int kb = item / nblk, nb = item % nblk, k0 = 64 * kb, n0 = 32 * nb;
    int sc0 = n0; if (w1map == 1) sc0 = (n0 < 5120) ? n0 : (n0 < 10240 ? n0 + 32 : (n0 < 10272 ? n0 - 5120 : -1));
    else if (w1map == 2) sc0 = ((n0 & 255) < 128 ? 0 : 4096) + (n0 >> 8) * 128 + (n0 & 127);
    const int kr = lane >> 3, c4 = (lane & 7) * 4;
    float4 v[8];
#pragma unroll
    for (int i = 0; i < 8; ++i) v[i] = (sc0 >= 0) ? *(const float4*)(W + (size_t)(k0 + kr + 8 * i) * ldw + sc0 + c4) : make_float4(0.f, 0.f, 0.f, 0.f);
#pragma unroll
    for (int i = 0; i < 8; ++i) { const int kk = kr + 8 * i; const float gm = gain ? gain[k0 + kk] : 1.0f; PG8_LAS float* d = scr + kk * 33 + c4;
        d[0] = v[i].x * gm; d[1] = v[i].y * gm; d[2] = v[i].z * gm; d[3] = v[i].w * gm; }
    asm volatile("s_waitcnt lgkmcnt(0)" ::: "memory");
    const int c = lane & 7;
#pragma unroll
    for (int j = 0; j < 4; ++j) { const int nn = (lane >> 3) + 8 * j; const PG8_LAS float* s = scr + (8 * c) * 33 + nn;
        *(u32x4*)(Wt + (size_t)(n0 + nn) * K + k0 + 8 * c) = (u32x4){pk2(s[0], s[33]), pk2(s[2 * 33], s[3 * 33]), pk2(s[4 * 33], s[5 * 33]), pk2(s[6 * 33], s[7 * 33])}; }
    asm volatile("s_waitcnt lgkmcnt(0)" ::: "memory");
}
__device__ __forceinline__ void ph_wt(CPR p, LDSP lds) {
    constexpr int U1 = 16 * 328, U2 = U1 + 32 * 32, U3 = U2 + 512, U4 = U3 + 512, U5 = U4 + 16 * 256, U6 = U5 + 64 * 32, U7 = U6 + 4 * 32, U8 = U7 + 512;
    const int tidx = tid_opaque(), lane = tidx & 63, wv = tidx >> 6, gw = bid_opaque() * 8 + wv, NGW = nblk_opaque() * 8;
    PG8_LAS float* scr = (PG8_LAS float*)(lds + wv * (64 * 33 * 4));
    for (int u = gw; u < DEPTH * U8; u += NGW) {
        const int l = u / U8; int v = u % U8; bf16_t* wl = p.wt + (size_t)l * WT_LAYER;
        if (v < U1)      { wt_item(p.w_in + (size_t)l * 1024 * IN_DIM, 1024, IN_DIM, p.norm_pre_mix + l * 1024, wl + OW1, 328, v, 1, scr, lane); }
        else if (v < U2) { v -= U1; wt_item(p.w_br_ssd + (size_t)l * 2048 * 1024, 2048, 1024, p.ssd_norm + l * 2048, wl + OW2, 32, v, 0, scr, lane); }
        else if (v < U3) { v -= U2; wt_item(p.w_br_sb + (size_t)l * 1024 * 1024, 1024, 1024, nullptr, wl + OW3, 32, v, 0, scr, lane); }
        else if (v < U4) { v -= U3; wt_item(p.w_out + (size_t)l * 1024 * 1024, 1024, 1024, nullptr, wl + OW4, 32, v, 0, scr, lane); }
        else if (v < U5) { v -= U4; wt_item(p.w_up + (size_t)l * 1024 * 8192, 1024, 8192, p.norm_pre_ffn + l * 1024, wl + OW5, 256, v, 2, scr, lane); }
        else if (v < U6) { v -= U5; wt_item(p.w_down + (size_t)l * 4096 * 1024, 4096, 1024, nullptr, wl + OW6, 32, v, 0, scr, lane); }
        else if (v < U7) { v -= U6; wt_item(p.w_ple + (size_t)l * 256 * 1024, 256, 1024, nullptr, wl + OW7, 32, v, 0, scr, lane); }
        else             { v -= U7; wt_item(p.w_ple_gate + (size_t)l * 1024 * 1024, 1024, 1024, nullptr, wl + OW8, 32, v, 0, scr, lane); }
    }
    __syncthreads();
}
__device__ __forceinline__ void ph_xprep(CPR p) {
    const int tidx = tid_opaque(); const int lane = tidx & 63, gw = bid_opaque() * 8 + (tidx >> 6), NGW = nblk_opaque() * 8;
    for (int row0 = 2 * gw; row0 < M_ALL; row0 += 2 * NGW) {
        float4 v[2][4]; float ss[2] = {0.f, 0.f};
#pragma unroll
        for (int q = 0; q < 2; ++q) { const int row = row0 + q; const float4* src = (const float4*)(row < M_P ? p.x_prompt + (size_t)row * 1024 : p.x_sample + (size_t)(row - M_P) * 1024);
#pragma unroll
            for (int j = 0; j < 4; ++j) v[q][j] = src[lane + 64 * j]; }
#pragma unroll
        for (int q = 0; q < 2; ++q) { const int row = row0 + q;
#pragma unroll
            for (int j = 0; j < 4; ++j) { ss[q] += v[q][j].x * v[q][j].x + v[q][j].y * v[q][j].y + v[q][j].z * v[q][j].z + v[q][j].w * v[q][j].w;
                ((u32x2*)(p.xr + (size_t)row * 1024))[lane + 64 * j] = (u32x2){pk2(v[q][j].x, v[q][j].y), pk2(v[q][j].z, v[q][j].w)}; }
            const float rn = rsqrtf(wave_sum(ss[q]) * (1.0f / 1024.f) + EPS);
#pragma unroll
            for (int j = 0; j < 4; ++j) ((u32x2*)(p.xb + (size_t)row * 1024))[lane + 64 * j] = (u32x2){pk2(v[q][j].x * rn, v[q][j].y * rn), pk2(v[q][j].z * rn, v[q][j].w * rn)}; }
    }
    for (int r0 = 4 * gw; r0 < DEPTH * M_ALL; r0 += 4 * NGW) {
        float4 v[4];
#pragma unroll
        for (int q = 0; q < 4; ++q) { const int r2 = r0 + q, l = r2 / M_ALL, row = r2 % M_ALL;
            v[q] = ((const float4*)(row < M_P ? p.p_prompt + ((size_t)l * M_P + row) * PLE_DIM : p.p_sample + ((size_t)l * M_S + row - M_P) * PLE_DIM))[lane]; }
#pragma unroll
        for (int q = 0; q < 4; ++q) ((u32x2*)(p.pb + (size_t)(r0 + q) * PLE_DIM))[lane] = (u32x2){pk2(v[q].x, v[q].y), pk2(v[q].z, v[q].w)};
    }
}
__device__ __forceinline__ void ph_norm(const bf16_t* __restrict__ src, const float* __restrict__ gain, bf16_t* xr, bf16_t* xb, float* yP, float* yS, bf16_t* xh = nullptr) {
    const int tidx = tid_opaque(); const int lane = tidx & 63, gw = bid_opaque() * 8 + (tidx >> 6), NGW = nblk_opaque() * 8;
    float4 g[4];
#pragma unroll
    for (int j = 0; j < 4; ++j) g[j] = ((const float4*)gain)[lane + 64 * j];
    for (int row0 = 2 * gw; row0 < M_ALL; row0 += 2 * NGW) {
        u32x2 sv[2][4], xv[2][4];
#pragma unroll
        for (int q = 0; q < 2; ++q)
#pragma unroll
            for (int j = 0; j < 4; ++j) { sv[q][j] = ((const u32x2*)(src + (size_t)(row0 + q) * 1024))[lane + 64 * j]; xv[q][j] = ((const u32x2*)(xr + (size_t)(row0 + q) * 1024))[lane + 64 * j]; }
#pragma unroll
        for (int q = 0; q < 2; ++q) {
            const int row = row0 + q;
            float4 v[4], x[4]; float ss = 0.f;
#pragma unroll
            for (int j = 0; j < 4; ++j) { v[j] = make_float4(bflo(sv[q][j].x), bfhi(sv[q][j].x), bflo(sv[q][j].y), bfhi(sv[q][j].y)); x[j] = make_float4(bflo(xv[q][j].x), bfhi(xv[q][j].x), bflo(xv[q][j].y), bfhi(xv[q][j].y));
                ss += v[j].x * v[j].x + v[j].y * v[j].y + v[j].z * v[j].z + v[j].w * v[j].w; }
            ss = wave_sum(ss);
            const float r = rsqrtf(ss * (1.0f / 1024.f) + EPS); float s2 = 0.f;
#pragma unroll
            for (int j = 0; j < 4; ++j) {
                x[j].x += v[j].x * r * g[j].x; x[j].y += v[j].y * r * g[j].y; x[j].z += v[j].z * r * g[j].z; x[j].w += v[j].w * r * g[j].w;
                s2 += x[j].x * x[j].x + x[j].y * x[j].y + x[j].z * x[j].z + x[j].w * x[j].w;
                ((u32x2*)(xr + (size_t)row * 1024))[lane + 64 * j] = (u32x2){pk2(x[j].x, x[j].y), pk2(x[j].z, x[j].w)};
            }
            if (xb) {
                const float rn = rsqrtf(wave_sum(s2) * (1.0f / 1024.f) + EPS);
#pragma unroll
                for (int j = 0; j < 4; ++j) {
                    const u32x2 wq = (u32x2){pk2(x[j].x * rn, x[j].y * rn), pk2(x[j].z * rn, x[j].w * rn)};
                    ((u32x2*)(xb + (size_t)row * 1024))[lane + 64 * j] = wq;
                    if (xh && (row & 63) >= 62) ((u32x2*)(xh + (size_t)(2 * ((row >> 6) + 1) + (row & 63) - 62) * 1024))[lane + 64 * j] = wq;
                }
            }
            if (yP) { float4* y4 = (float4*)(row < M_P ? yP + (size_t)row * 1024 : yS + (size_t)(row - M_P) * 1024);
#pragma unroll
                for (int j = 0; j < 4; ++j) y4[lane + 64 * j] = x[j]; }
        }
    }
}
__device__ __forceinline__ void unpack8(const u32x4 w, float (&v)[8]) {
    v[0] = bflo(w.x); v[1] = bfhi(w.x); v[2] = bflo(w.y); v[3] = bfhi(w.y); v[4] = bflo(w.z); v[5] = bfhi(w.z); v[6] = bflo(w.w); v[7] = bfhi(w.w);
}
__device__ __forceinline__ void load8f(const float* p, float (&v)[8]) { const float4 a = ((const float4*)p)[0], b = ((const float4*)p)[1]; v[0] = a.x; v[1] = a.y; v[2] = a.z; v[3] = a.w; v[4] = b.x; v[5] = b.y; v[6] = b.z; v[7] = b.w; }
__device__ __forceinline__ float gelu_fast(float x) { const float u2 = 1.5957691216057308f * (x + 0.044715f * x * x * x); return x * __builtin_amdgcn_rcpf(1.0f + __expf(-u2)); }
struct EpiIn {
    static constexpr bool PERM = true, AFTER_DRAIN = false;
    const float* rs; bf16_t *zb, *xbcb, *qb, *gb, *kb, *vb; float* dtb; const float* dt_bias; float *kP, *vP, *kS, *vS, *convP, *convS;
    __device__ __forceinline__ void operator()(const f32x4 (&acc)[2][2][4][2], const Unit& u, int wr, int wc, int fr, int fq) const {
        const int row0 = u.pm * 256 + wr * 64 + fr, seg = u.pn, cl = wc * 32 + 8 * fq;
#pragma unroll
        for (int ai = 0; ai < 2; ++ai)
#pragma unroll
            for (int m = 0; m < 4; ++m) {
                const int r = row0 + ai * 128 + m * 16;
#pragma unroll
                for (int bj = 0; bj < 2; ++bj) {
                    const int ct = cl + bj * 128; const f32x4 v0 = acc[ai][bj][m][0], v1 = acc[ai][bj][m][1];
                    const u32x4 w = (u32x4){pk2c(v0[0], v0[1]), pk2c(v0[2], v0[3]), pk2c(v1[0], v1[1]), pk2c(v1[2], v1[3])};
                    if (seg < 8) { *(u32x4*)(zb + (size_t)r * 2048 + seg * 256 + ct) = w; }
                    else if (seg < 20) {
                        const int c = (seg - 8) * 256 + ct; *(u32x4*)(xbcb + (size_t)r * 3072 + c) = w;
                        float* dst = nullptr;
                        if (r < M_P) { if (r >= M_P - 3) dst = convP + (size_t)(r - (M_P - 3)) * 3072; }
                        else { const int t = (r - M_P) & 31, b = (r - M_P) >> 5; if (t >= 29) dst = convS + ((size_t)b * 3 + (t - 29)) * 3072; }
                        if (dst) { *(f32x4*)(dst + c) = v0; *(f32x4*)(dst + c + 4) = v1; }
                    }
                    else if (seg < 24) { *(u32x4*)(qb + (size_t)r * 1024 + (seg - 20) * 256 + ct) = w; }
                    else if (seg < 32) {
                        const int c = ((seg - 24) & 3) * 256 + ct; const bool isk = seg < 28;
                        float* dst = (r < M_P) ? (isk ? kP : vP) + (size_t)r * 1024 : (isk ? kS : vS) + (size_t)(r - M_P) * 1024;
                        *(f32x4*)(dst + c) = v0; *(f32x4*)(dst + c + 4) = v1;
                        *(u32x4*)((isk ? kb : vb) + (size_t)r * 1024 + c) = w;
                    }
                    else if (seg < 40) {
                        const f32x2_t s0 = sigmoid2((f32x2_t){v0[0], v0[1]}), s1 = sigmoid2((f32x2_t){v0[2], v0[3]}), s2 = sigmoid2((f32x2_t){v1[0], v1[1]}), s3 = sigmoid2((f32x2_t){v1[2], v1[3]});
                        *(u32x4*)(gb + (size_t)r * 2048 + (seg - 32) * 256 + ct) = (u32x4){pk2(s0.x, s0.y), pk2(s1.x, s1.y), pk2(s2.x, s2.y), pk2(s3.x, s3.y)};
                    }
                    else if (wc == 0 && bj == 0) {
                        const f32x4 b0 = *(const f32x4*)(dt_bias + 8 * fq), b1 = *(const f32x4*)(dt_bias + 8 * fq + 4);
                        f32x4 o0, o1;
#pragma unroll
                        for (int j = 0; j < 4; ++j) { o0[j] = softplusf_(v0[j] + b0[j]); o1[j] = softplusf_(v1[j] + b1[j]); }
                        *(f32x4*)(dtb + (size_t)r * 32 + 8 * fq) = o0; *(f32x4*)(dtb + (size_t)r * 32 + 8 * fq + 4) = o1;
                    }
                }
            }
    }
};
struct EpiHalo {
    static constexpr bool PERM = true, AFTER_DRAIN = false;
    const float* rs; bf16_t* gh;
    __device__ __forceinline__ void elem(int hi, int ch, float v) const { gh[(size_t)hi * D_FF + ch] = f2bf(v); }
    __device__ __forceinline__ void operator()(const f32x4 (&acc)[2][2][4][2], const Unit& u, int wr, int wc, int fr, int fq) const {
        const int row0 = u.pm * 256 + wr * 64 + fr, c0 = u.pn * 128 + wc * 32 + 8 * fq;
#pragma unroll
        for (int ai = 0; ai < 2; ++ai)
#pragma unroll
            for (int m = 0; m < 4; ++m) {
                const int hi = row0 + ai * 128 + m * 16;
                const f32x4 v0 = acc[ai][0][m][0], v1 = acc[ai][0][m][1];
                *(u32x4*)(gh + (size_t)hi * D_FF + c0) = (u32x4){pk2c(v0[0], v0[1]), pk2c(v0[2], v0[3]), pk2c(v1[0], v1[1]), pk2c(v1[2], v1[3])};
            }
    }
};
struct EpiUpAct {
    static constexpr bool PERM = true, AFTER_DRAIN = false;
    const float* rs; const bf16_t* gh; bf16_t* ffb; float *ffnP, *ffnS; const float* cw; const float* cb; const float* hist;
    __device__ __forceinline__ void operator()(const f32x4 (&acc)[2][2][4][2], const Unit& u, int wr, int wc, int fr, int fq) const {
        const int c0 = u.pn * 128 + wc * 32 + 8 * fq;
        float w0[8], w1[8], w2[8], bb[8];
        load8f(cw + c0, w0); load8f(cw + D_FF + c0, w1); load8f(cw + 2 * D_FF + c0, w2); load8f(cb + c0, bb);
#pragma unroll
        for (int ai = 0; ai < 2; ++ai) {
            const int strip = 4 * u.pm + 2 * ai + wr;
            float gprev[8];
#pragma unroll
            for (int m = 0; m < 4; ++m) {
                const int r = strip * 64 + 16 * m + fr;
                float g[8], uv[8], p1[8], p2[8];
#pragma unroll
                for (int j = 0; j < 4; ++j) { g[j] = acc[ai][0][m][0][j]; g[4 + j] = acc[ai][0][m][1][j]; uv[j] = acc[ai][1][m][0][j]; uv[4 + j] = acc[ai][1][m][1][j]; }
                if (m == 0) { float e14[8], e15[8]; unpack8(*(const u32x4*)(gh + (size_t)(2 * strip) * D_FF + c0), e14); unpack8(*(const u32x4*)(gh + (size_t)(2 * strip + 1) * D_FF + c0), e15);
#pragma unroll
                    for (int j = 0; j < 8; ++j) gprev[j] = (fr == 15) ? e15[j] : e14[j]; }
#pragma unroll
                for (int j = 0; j < 8; ++j) {
                    const float c1 = (fr == 15) ? gprev[j] : g[j], c2 = (fr >= 14) ? gprev[j] : g[j];
                    p1[j] = __builtin_bit_cast(float, __builtin_amdgcn_update_dpp(0, __builtin_bit_cast(int, c1), 0x121, 0xf, 0xf, false));
                    p2[j] = __builtin_bit_cast(float, __builtin_amdgcn_update_dpp(0, __builtin_bit_cast(int, c2), 0x122, 0xf, 0xf, false));
                }
                const int t = (r < M_P) ? r : ((r - M_P) & 31);
                if (t < 2) {
                    float h0[8], h1[8];
                    if (r >= M_P) { const float* hp = hist + (size_t)((r - M_P) >> 5) * 2 * D_FF + c0; load8f(hp, h0); load8f(hp + D_FF, h1); }
                    else {
#pragma unroll
                        for (int j = 0; j < 8; ++j) { h0[j] = 0.f; h1[j] = 0.f; } }
#pragma unroll
                    for (int j = 0; j < 8; ++j) { if (t == 0) { p2[j] = h0[j]; p1[j] = h1[j]; } else { p2[j] = h1[j]; } }
                }
                float o[8];
#pragma unroll
                for (int j = 0; j < 8; j += 2) {
                    const f32x2_t a = (f32x2_t){bb[j], bb[j + 1]} + (f32x2_t){w0[j], w0[j + 1]} * (f32x2_t){p2[j], p2[j + 1]} + (f32x2_t){w1[j], w1[j + 1]} * (f32x2_t){p1[j], p1[j + 1]} + (f32x2_t){w2[j], w2[j + 1]} * (f32x2_t){g[j], g[j + 1]};
                    const f32x2_t ov = gelu2(a) * (f32x2_t){uv[j], uv[j + 1]}; o[j] = ov.x; o[j + 1] = ov.y; }
                *(u32x4*)(ffb + (size_t)r * D_FF + c0) = (u32x4){pk2(o[0], o[1]), pk2(o[2], o[3]), pk2(o[4], o[5]), pk2(o[6], o[7])};
                float* dst = nullptr;
                if (r < M_P) { if (r >= M_P - 2) dst = ffnP + (size_t)(r - (M_P - 2)) * D_FF; }
                else { const int b = (r - M_P) >> 5; if (t >= 30) dst = ffnS + ((size_t)b * 2 + (t - 30)) * D_FF; }
                if (dst) { *(f32x4*)(dst + c0) = (f32x4){g[0], g[1], g[2], g[3]}; *(f32x4*)(dst + c0 + 4) = (f32x4){g[4], g[5], g[6], g[7]}; }
#pragma unroll
                for (int j = 0; j < 8; ++j) gprev[j] = g[j];
            }
        }
    }
};
struct EpiBr {
    static constexpr bool PERM = true, AFTER_DRAIN = false;
    const bf16_t* gb; const bf16_t* t1in; bf16_t* dst; int mode; int pad;
    __device__ __forceinline__ void elem(int r, int c, float v) const {
        float o = bf2f(gb[(size_t)r * 2048 + (mode == 0 ? 1024 : 0) + c]) * v; if (mode == 1) o += bf2f(t1in[(size_t)r * 1024 + c]);
        dst[(size_t)r * 1024 + c] = f2bf(o); }
    __device__ __forceinline__ void operator()(const f32x4 (&acc)[2][2][4][2], const Unit& u, int wr, int wc, int fr, int fq) const {
        const int row0 = u.pm * 256 + wr * 64 + fr, cl = u.pn * 256 + wc * 32 + 8 * fq;
#pragma unroll
        for (int ai = 0; ai < 2; ++ai)
#pragma unroll
            for (int m = 0; m < 4; ++m) {
                const int r = row0 + ai * 128 + m * 16;
#pragma unroll
                for (int bj = 0; bj < 2; ++bj) {
                    const int c = cl + bj * 128; float g[8], o[8];
                    unpack8(*(const u32x4*)(gb + (size_t)r * 2048 + (mode == 0 ? 1024 : 0) + c), g);
                    const f32x4 v0 = acc[ai][bj][m][0], v1 = acc[ai][bj][m][1];
                    float tv[8];
                    if (mode == 1) unpack8(*(const u32x4*)(t1in + (size_t)r * 1024 + c), tv);
                    else {
#pragma unroll
                        for (int j = 0; j < 8; ++j) tv[j] = 0.f; }
#pragma unroll
                    for (int j = 0; j < 4; j += 2) {
                        const f32x2_t oa = (f32x2_t){g[j], g[j + 1]} * (f32x2_t){v0[j], v0[j + 1]} + (f32x2_t){tv[j], tv[j + 1]}, ob = (f32x2_t){g[4 + j], g[5 + j]} * (f32x2_t){v1[j], v1[j + 1]} + (f32x2_t){tv[4 + j], tv[5 + j]};
                        o[j] = oa.x; o[j + 1] = oa.y; o[4 + j] = ob.x; o[5 + j] = ob.y; }
                    *(u32x4*)(dst + (size_t)r * 1024 + c) = (u32x4){pk2(o[0], o[1]), pk2(o[2], o[3]), pk2(o[4], o[5]), pk2(o[6], o[7])};
                }
            }
    }
};
struct EpiPlain {
    static constexpr bool PERM = true, AFTER_DRAIN = false;
    bf16_t* dst;
    __device__ __forceinline__ void elem(int r, int c, float v) const { dst[(size_t)r * 1024 + c] = f2bf(v); }
    __device__ __forceinline__ void operator()(const f32x4 (&acc)[2][2][4][2], const Unit& u, int wr, int wc, int fr, int fq) const {
        const int row0 = u.pm * 256 + wr * 64 + fr, cl = u.pn * 256 + wc * 32 + 8 * fq;
#pragma unroll
        for (int ai = 0; ai < 2; ++ai)
#pragma unroll
            for (int m = 0; m < 4; ++m) {
                const int r = row0 + ai * 128 + m * 16;
#pragma unroll
                for (int bj = 0; bj < 2; ++bj) { const f32x4 v0 = acc[ai][bj][m][0], v1 = acc[ai][bj][m][1];
                    *(u32x4*)(dst + (size_t)r * 1024 + cl + bj * 128) = (u32x4){pk2c(v0[0], v0[1]), pk2c(v0[2], v0[3]), pk2c(v1[0], v1[1]), pk2c(v1[2], v1[3])}; }
            }
    }
};
struct EpiF32Out {
    static constexpr bool PERM = true, AFTER_DRAIN = false;
    bf16_t* dst;
    __device__ __forceinline__ void elem(int r, int c, float v) const { dst[(size_t)r * 1024 + c] = f2bf(v); }
    __device__ __forceinline__ void operator()(const f32x4 (&acc)[2][2][4][2], const Unit& u, int wr, int wc, int fr, int fq) const {
        const int row0 = u.pm * 256 + wr * 64 + fr, cl = u.pn * 256 + wc * 32 + 8 * fq;
#pragma unroll
        for (int ai = 0; ai < 2; ++ai)
#pragma unroll
            for (int m = 0; m < 4; ++m) {
                const int r = row0 + ai * 128 + m * 16;
#pragma unroll
                for (int bj = 0; bj < 2; ++bj) { const f32x4 v0 = acc[ai][bj][m][0], v1 = acc[ai][bj][m][1];
                    *(u32x4*)(dst + (size_t)r * 1024 + cl + bj * 128) = (u32x4){pk2c(v0[0], v0[1]), pk2c(v0[2], v0[3]), pk2c(v1[0], v1[1]), pk2c(v1[2], v1[3])}; }
            }
    }
};
struct EpiPle {
    static constexpr bool PERM = false, AFTER_DRAIN = false;
    const bf16_t* plea; bf16_t* dst;
    __device__ __forceinline__ void elem(int r, int c, float v) const { dst[(size_t)r * 1024 + c] = f2bf(bf2f(plea[(size_t)r * 1024 + c]) * sigmoidf_(v)); }
    __device__ __forceinline__ void operator()(const f32x4 (&acc)[2][2][4][2], const Unit& u, int wr, int wc, int fr, int fq) const {
        const int row0 = u.pm * 256 + wr * 64 + fr, col0 = u.pn * 256 + wc * 32 + 4 * fq;
#pragma unroll
        for (int ai = 0; ai < 2; ++ai)
#pragma unroll
            for (int m = 0; m < 4; ++m) { const size_t ro = (size_t)(row0 + ai * 128 + m * 16) * 1024 + col0;
#pragma unroll
                for (int bj = 0; bj < 2; ++bj)
#pragma unroll
                    for (int n = 0; n < 2; ++n) { const u32x2 a = *(const u32x2*)(plea + ro + bj * 128 + n * 16); const f32x4 v = acc[ai][bj][m][n];
                        const f32x2_t o0 = (f32x2_t){bflo(a.x), bfhi(a.x)} * sigmoid2((f32x2_t){v[0], v[1]}), o1 = (f32x2_t){bflo(a.y), bfhi(a.y)} * sigmoid2((f32x2_t){v[2], v[3]});
                        *(u32x2*)(dst + ro + bj * 128 + n * 16) = (u32x2){pk2(o0.x, o0.y), pk2(o1.x, o1.y)}; } }
    }
};

typedef short bf16x8 __attribute__((ext_vector_type(8)));
typedef float f32x16 __attribute__((ext_vector_type(16)));
typedef short bf16x4 __attribute__((ext_vector_type(4)));
#define MFMA32(a, b, c) __builtin_amdgcn_mfma_f32_32x32x16_bf16((a), (b), (c), 0, 0, 0)
__device__ __forceinline__ f32x16 zero16() { f32x16 z;
#pragma unroll
    for (int i = 0; i < 16; ++i) z[i] = 0.f; return z; }
__device__ __forceinline__ bf16x8 pack8f(const float (&v)[8]) { const u32x4 w = (u32x4){pk2(v[0], v[1]), pk2(v[2], v[3]), pk2(v[4], v[5]), pk2(v[6], v[7])}; return __builtin_bit_cast(bf16x8, w); }
__device__ __forceinline__ bf16x8 join44(bf16x4 lo, bf16x4 hi) { return __builtin_shufflevector(lo, hi, 0, 1, 2, 3, 4, 5, 6, 7); }

constexpr int PX = 72;
constexpr int PR = 136;
constexpr int L_XT = 0;
constexpr int L_B = L_XT + 8 * 64 * PX * 2;
constexpr int L_C = L_B + 128 * PX * 2;
constexpr int L_AC = L_C + 64 * PR * 2;
constexpr int L_DT = L_AC + 2048;
constexpr int L_WS = L_DT + 2048;
constexpr int ZP = 1040;
constexpr int SSD_LDS = L_WS + 2048;

struct ChunkInfo { int seqbase, row0, t0, nvalid; const float* hist; };
__device__ __forceinline__ ChunkInfo chunk_info(CPR p, int l, int ck) {
    ChunkInfo c;
    if (ck < 256) { c.seqbase = 0; c.row0 = 64 * ck; c.t0 = 64 * ck; c.nvalid = 64; c.hist = nullptr; }
    else { const int b = ck - 256; c.seqbase = M_P + 32 * b; c.row0 = c.seqbase; c.t0 = 0; c.nvalid = 32; c.hist = p.state_ssd_conv + ((size_t)l * DEC_BATCH + b) * 3 * 3072; }
    return c;
}
template <int NP> __device__ __forceinline__ void xbc_pad_raw(const bf16_t* __restrict__ xbcb, const float* __restrict__ hist, int rowbase, int hj, int c, unsigned (&d)[NP]) {
    if (hj >= 3) { const bf16_t* q = xbcb + (size_t)(rowbase + hj - 3) * 3072 + c;
        if (NP == 4) { const u32x4 t = *(const u32x4*)q; d[0] = t.x; d[1 % NP] = t.y; d[2 % NP] = t.z; d[3 % NP] = t.w; }
        else if (NP == 2) { const u32x2 t = *(const u32x2*)q; d[0] = t.x; d[1 % NP] = t.y; }
        else d[0] = *(const unsigned*)q; }
    else if (hist) {
#pragma unroll
        for (int k = 0; k < NP; ++k) { const float2 t = *(const float2*)(hist + (size_t)hj * 3072 + c + 2 * k); d[k] = pk2(t.x, t.y); } }
    else {
#pragma unroll
        for (int k = 0; k < NP; ++k) d[k] = 0u; }
}
__device__ __forceinline__ int xt_off(int R, int g) { return R * (PX * 2) + ((g ^ ((R >> 3) & 7)) << 4); }
template <int NP, class F> __device__ __forceinline__ void conv8(CPR p, int l, const ChunkInfo& ci, int s0, int c, F emit) {
    if (s0 >= ci.nvalid) {
        const float z[8] = {0.f, 0.f, 0.f, 0.f, 0.f, 0.f, 0.f, 0.f};
#pragma unroll
        for (int jp = 0; jp < NP; ++jp) emit(jp, z, z);
        return;
    }
    const float* cw = p.ssd_conv_w + (size_t)l * 4 * 3072 + c; const float* cb = p.ssd_conv_b + (size_t)l * 3072 + c;
    const int t = ci.t0 + s0;
    unsigned raw[11][NP];
#pragma unroll
    for (int k = 0; k < 11; ++k) xbc_pad_raw<NP>(p.xbcb, ci.hist, ci.seqbase, t + k, c, raw[k]);
#pragma unroll
    for (int jp = 0; jp < NP; ++jp) {
        const f32x2_t w0 = *(const f32x2_t*)(cw + 2 * jp), w1 = *(const f32x2_t*)(cw + 3072 + 2 * jp), w2 = *(const f32x2_t*)(cw + 2 * 3072 + 2 * jp), w3 = *(const f32x2_t*)(cw + 3 * 3072 + 2 * jp), bb = *(const f32x2_t*)(cb + 2 * jp);
        f32x2_t rv[11];
#pragma unroll
        for (int k = 0; k < 11; ++k) rv[k] = (f32x2_t){bflo(raw[k][jp]), bfhi(raw[k][jp])};
        float lo[8], hi[8];
#pragma unroll
        for (int i = 0; i < 8; ++i) {
            const f32x2_t a = bb + w0 * rv[i] + w1 * rv[i + 1] + w2 * rv[i + 2] + w3 * rv[i + 3];
            const f32x2_t sv = silu2(a);
            lo[i] = sv.x; hi[i] = sv.y;
        }
        emit(jp, lo, hi);
    }
}
__device__ __forceinline__ float unit_dt(CPR p, int l, int u, int wid, int lane) {
    const ChunkInfo ci = chunk_info(p, l, u >> 2);
    return (lane < ci.nvalid) ? p.dtb[(size_t)(ci.row0 + lane) * 32 + (u & 3) * 8 + wid] : 0.f;
}
__device__ __forceinline__ void head_scan(CPR p, int l, int h, int lane, float dtv, float& ac, float& aclast) {
    const float a = -__expf(p.ssd_a_log[l * 32 + h]);
    ac = dtv * a;
#pragma unroll
    for (int o = 1; o < 64; o <<= 1) { const float t = __shfl_up(ac, o); if (lane >= o) ac += t; }
    aclast = __shfl(ac, 63);
}
__device__ __forceinline__ void ph_ssd_p1(CPR p, int l, LDSP lds) {
    const int tid = tid_opaque(), wid = tid >> 6, lane = tid & 63, r = lane & 31, hh = lane >> 5;
    PG8_LAS float* acS = (PG8_LAS float*)(lds + L_AC); PG8_LAS float* wS = (PG8_LAS float*)(lds + L_WS);
    PG8_LAS bf16_t* xT = (PG8_LAS bf16_t*)(lds + L_XT); PG8_LAS bf16_t* BT = (PG8_LAS bf16_t*)(lds + L_B);
    const int u0 = bid_opaque(), nb = nblk_opaque();
    float dt_nx = (u0 < NCHUNK * 4) ? unit_dt(p, l, u0, wid, lane) : 0.f;
    for (int u = u0; u < NCHUNK * 4; u += nb) {
        const int ck = u >> 2, g = u & 3, h = g * 8 + wid;
        const ChunkInfo ci = chunk_info(p, l, ck);
        const float dtv = dt_nx; float ac, aclast; head_scan(p, l, h, lane, dtv, ac, aclast);
        dt_nx = (u + nb < NCHUNK * 4) ? unit_dt(p, l, u + nb, wid, lane) : 0.f;
        wS[wid * 64 + lane] = __expf(aclast - ac) * dtv;
        if (lane == 63) p.dec[ck * 32 + h] = __expf(aclast);
        __syncthreads();
        { const int cc = tid & 63, s0 = (tid >> 6) * 8, g8 = s0 >> 3, hl = cc >> 3, p0 = (cc & 7) * 8;
          float wv[8];
#pragma unroll
          for (int i = 0; i < 8; ++i) wv[i] = wS[hl * 64 + s0 + i];
          conv8<4>(p, l, ci, s0, g * 512 + cc * 8, [&](int jp, const float (&lo)[8], const float (&hi)[8]) {
              const int R = hl * 64 + p0 + 2 * jp;
              *(PG8_LAS u32x4*)(lds + L_XT + xt_off(R, g8)) = (u32x4){pk2(lo[0] * wv[0], lo[1] * wv[1]), pk2(lo[2] * wv[2], lo[3] * wv[3]), pk2(lo[4] * wv[4], lo[5] * wv[5]), pk2(lo[6] * wv[6], lo[7] * wv[7])};
              *(PG8_LAS u32x4*)(lds + L_XT + xt_off(R + 1, g8)) = (u32x4){pk2(hi[0] * wv[0], hi[1] * wv[1]), pk2(hi[2] * wv[2], hi[3] * wv[3]), pk2(hi[4] * wv[4], hi[5] * wv[5]), pk2(hi[6] * wv[6], hi[7] * wv[7])}; }); }
        { const int q = tid & 63, s0 = (tid >> 6) * 8, g8 = s0 >> 3, n0 = 2 * q;
          conv8<1>(p, l, ci, s0, 2048 + g * 128 + n0, [&](int jp, const float (&lo)[8], const float (&hi)[8]) {
              *(PG8_LAS u32x4*)(lds + L_B + xt_off(n0, g8)) = (u32x4){pk2(lo[0], lo[1]), pk2(lo[2], lo[3]), pk2(lo[4], lo[5]), pk2(lo[6], lo[7])};
              *(PG8_LAS u32x4*)(lds + L_B + xt_off(n0 + 1, g8)) = (u32x4){pk2(hi[0], hi[1]), pk2(hi[2], hi[3]), pk2(hi[4], hi[5]), pk2(hi[6], hi[7])}; }); }
        __syncthreads();
        f32x16 acc[4][2];
#pragma unroll
        for (int a = 0; a < 4; ++a)
#pragma unroll
            for (int b = 0; b < 2; ++b) acc[a][b] = zero16();
#pragma unroll
        for (int ks = 0; ks < 4; ++ks) {
            bf16x8 A[2], Bf[4];
#pragma unroll
            for (int pt = 0; pt < 2; ++pt) A[pt] = *(const PG8_LAS bf16x8*)(lds + L_XT + xt_off(wid * 64 + 32 * pt + r, 2 * ks + hh));
#pragma unroll
            for (int nt = 0; nt < 4; ++nt) Bf[nt] = *(const PG8_LAS bf16x8*)(lds + L_B + xt_off(32 * nt + r, 2 * ks + hh));
#pragma unroll
            for (int nt = 0; nt < 4; ++nt)
#pragma unroll
                for (int pt = 0; pt < 2; ++pt) acc[nt][pt] = MFMA32(Bf[nt], A[pt], acc[nt][pt]);
        }
        bf16_t* dst = (bf16_t*)p.sst + ((size_t)ck * 32 + h) * 8192 + lane * 16;
#pragma unroll
        for (int nt = 0; nt < 4; ++nt)
#pragma unroll
            for (int pt = 0; pt < 2; ++pt) {
                const f32x16& a = acc[nt][pt];
                *(u32x4*)(dst + (nt * 2 + pt) * 1024) = (u32x4){pk2c(a[0], a[1]), pk2c(a[2], a[3]), pk2c(a[4], a[5]), pk2c(a[6], a[7])};
                *(u32x4*)(dst + (nt * 2 + pt) * 1024 + 8) = (u32x4){pk2c(a[8], a[9]), pk2c(a[10], a[11]), pk2c(a[12], a[13]), pk2c(a[14], a[15])};
            }
        __syncthreads();
    }
}
__device__ __forceinline__ int frag_to_logical(int x) {
    const int h = x >> 13, y = x & 8191, T = y >> 10, L = (y >> 4) & 63, q = y & 15;
    const int p = 32 * (T & 1) + (L & 31), n = 32 * (T >> 1) + (q & 3) + 8 * (q >> 2) + 4 * (L >> 5);
    return h * 8192 + p * 128 + n;
}
__device__ __forceinline__ void ph_ssd_p2(CPR p, int l) {
    const int gtid = bid_opaque() * 512 + tid_opaque(), gsz = nblk_opaque() * 512;
    const unsigned* sst2 = (const unsigned*)p.sst; unsigned* hp2 = (unsigned*)p.hpb;
    for (int e = gtid; e < 131072; e += gsz) {
        const int h = e >> 12; float2 hc = make_float2(0.f, 0.f);
        for (int c0 = 0; c0 < 256; c0 += 32) {
            unsigned S[32]; float d[32];
#pragma unroll
            for (int i = 0; i < 32; ++i) { S[i] = sst2[(size_t)(c0 + i) * 131072 + e]; d[i] = p.dec[(c0 + i) * 32 + h]; }
#pragma unroll
            for (int i = 0; i < 32; ++i) { hp2[(size_t)(c0 + i) * 131072 + e] = pk2(hc.x, hc.y); const f32x2_t hn = (f32x2_t){hc.x, hc.y} * d[i] + (f32x2_t){bflo(S[i]), bfhi(S[i])}; hc.x = hn.x; hc.y = hn.y; }
        }
        ((float2*)(p.out + O_P_STATE + (size_t)l * STATE_SZ))[frag_to_logical(2 * e) >> 1] = hc;
    }
    for (int i = gtid; i < DEC_BATCH * 131072; i += gsz) {
        const int b = i >> 17, e = i & 131071, h = e >> 12, ck = 256 + b;
        const int el = frag_to_logical(2 * e) >> 1;
        const float2 h0 = ((const float2*)(p.state_ssd + ((size_t)l * DEC_BATCH + b) * STATE_SZ))[el]; const unsigned Sw = sst2[(size_t)ck * 131072 + e]; const float2 S = make_float2(bflo(Sw), bfhi(Sw)); const float d = p.dec[ck * 32 + h];
        hp2[(size_t)ck * 131072 + e] = pk2(h0.x, h0.y);
        ((float2*)(p.out + O_S_STATE + ((size_t)l * DEC_BATCH + b) * STATE_SZ))[el] = make_float2(fmaf(d, h0.x, S.x), fmaf(d, h0.y, S.y));
    }
}
__device__ __forceinline__ void ph_ssd_p3(CPR p, int l, LDSP lds) {
    const int tid = tid_opaque(), wid = tid >> 6, lane = tid & 63, r = lane & 31, hh = lane >> 5;
    PG8_LAS float* acS = (PG8_LAS float*)(lds + L_AC); PG8_LAS float* dtS = (PG8_LAS float*)(lds + L_DT); PG8_LAS float* red = (PG8_LAS float*)(lds + L_WS);
    PG8_LAS bf16_t* xT = (PG8_LAS bf16_t*)(lds + L_XT);
    const int u0 = bid_opaque(), nb = nblk_opaque();
    float dt_nx = (u0 < NCHUNK * 4) ? unit_dt(p, l, u0, wid, lane) : 0.f;
    for (int u = u0; u < NCHUNK * 4; u += nb) {
        const int ck = u >> 2, g = u & 3, h = g * 8 + wid;
        const ChunkInfo ci = chunk_info(p, l, ck);
        const float Dh = p.ssd_d[l * 32 + h];
        { const float dtv = dt_nx; float ac, aclast; head_scan(p, l, h, lane, dtv, ac, aclast); acS[wid * 64 + lane] = ac; dtS[wid * 64 + lane] = dtv; }
        dt_nx = (u + nb < NCHUNK * 4) ? unit_dt(p, l, u + nb, wid, lane) : 0.f;
        bf16x8 HA[8][2];
        const bf16_t* hp = p.hpb + ((size_t)ck * 32 + h) * 8192;
        { const int cc = tid & 63, s0 = (tid >> 6) * 8, g8 = s0 >> 3, hl = cc >> 3, p0 = (cc & 7) * 8;
          conv8<4>(p, l, ci, s0, g * 512 + cc * 8, [&](int jp, const float (&lo)[8], const float (&hi)[8]) {
              const int R = hl * 64 + p0 + 2 * jp;
              *(PG8_LAS u32x4*)(lds + L_XT + xt_off(R, g8)) = (u32x4){pk2(lo[0], lo[1]), pk2(lo[2], lo[3]), pk2(lo[4], lo[5]), pk2(lo[6], lo[7])};
              *(PG8_LAS u32x4*)(lds + L_XT + xt_off(R + 1, g8)) = (u32x4){pk2(hi[0], hi[1]), pk2(hi[2], hi[3]), pk2(hi[4], hi[5]), pk2(hi[6], hi[7])}; }); }
        { const int q = tid & 63, s0 = (tid >> 6) * 8, n4 = 4 * (q & 31), off = (q < 32 ? L_B : L_C) + n4 * 2;
          conv8<2>(p, l, ci, s0, (q < 32 ? 2048 : 2560) + g * 128 + n4, [&](int jp, const float (&lo)[8], const float (&hi)[8]) {
#pragma unroll
              for (int i = 0; i < 8; ++i) *(PG8_LAS unsigned*)(lds + off + jp * 4 + (s0 + i) * PR * 2) = pk2(lo[i], hi[i]); }); }
#pragma unroll
        for (int ks = 0; ks < 8; ++ks) { HA[ks][0] = *(const bf16x8*)(hp + ((ks >> 1) * 2 + 0) * 1024 + lane * 16 + 8 * (ks & 1)); HA[ks][1] = *(const bf16x8*)(hp + ((ks >> 1) * 2 + 1) * 1024 + lane * 16 + 8 * (ks & 1)); }
        __syncthreads();
        f32x16 yd[2][2];
#pragma unroll
        for (int a = 0; a < 2; ++a)
#pragma unroll
            for (int b = 0; b < 2; ++b) yd[a][b] = zero16();
#pragma unroll
        for (int ks = 0; ks < 8; ++ks) {
            bf16x8 Bf[2];
#pragma unroll
            for (int lt = 0; lt < 2; ++lt) { const int eo = ((32 * lt + r) * PR + 16 * ks + 4 * hh) * 2;
                Bf[lt] = join44(*(const PG8_LAS bf16x4*)(lds + L_C + eo), *(const PG8_LAS bf16x4*)(lds + L_C + eo + 16)); }
#pragma unroll
            for (int pt = 0; pt < 2; ++pt)
#pragma unroll
                for (int lt = 0; lt < 2; ++lt) yd[pt][lt] = MFMA32(HA[ks][pt], Bf[lt], yd[pt][lt]);
        }
#pragma unroll
        for (int lt = 0; lt < 2; ++lt) { const float eal = __expf(acS[wid * 64 + 32 * lt + r]);
#pragma unroll
            for (int pt = 0; pt < 2; ++pt)
#pragma unroll
                for (int q = 0; q < 16; q += 2) { const f32x2_t t = (f32x2_t){yd[pt][lt][q], yd[pt][lt][q + 1]} * eal; yd[pt][lt][q] = t.x; yd[pt][lt][q + 1] = t.y; } }
        u32x4 zraw[8];
#pragma unroll
        for (int i = 0; i < 8; ++i) { const int e = tid + 512 * i, tok = e >> 6; zraw[i] = *(const u32x4*)(p.zb + (size_t)(ci.row0 + (tok < ci.nvalid ? tok : 0)) * 2048 + g * 512 + (e & 63) * 8); }
#pragma unroll
        for (int tix = 0; tix < 3; ++tix) {
            const int st = (tix == 2) ? 1 : 0, lt = (tix == 0) ? 0 : 1;
            f32x16 G = zero16();
#pragma unroll
            for (int ks = 0; ks < 8; ++ks) {
                const bf16x8 A = *(const PG8_LAS bf16x8*)(lds + L_B + ((32 * st + r) * PR + 16 * ks + 8 * hh) * 2);
                const bf16x8 Bf = *(const PG8_LAS bf16x8*)(lds + L_C + ((32 * lt + r) * PR + 16 * ks + 8 * hh) * 2);
                G = MFMA32(A, Bf, G);
            }
            const int lcol = 32 * lt + r; const float acl = acS[wid * 64 + lcol];
            float mv[16];
#pragma unroll
            for (int q = 0; q < 16; q += 2) {
                const int s = 32 * st + (q & 3) + 8 * (q >> 2) + 4 * hh;
                const f32x2_t acs = *(const PG8_LAS f32x2_t*)(acS + wid * 64 + s), dts = *(const PG8_LAS f32x2_t*)(dtS + wid * 64 + s);
                const f32x2_t dd = __builtin_elementwise_min((f32x2_t){acl, acl} - acs, (f32x2_t){0.f, 0.f}) * 1.4426950408889634f;
                const f32x2_t v2 = (f32x2_t){G[q], G[q + 1]} * exp2_2(dd) * dts;
                float va = (s <= lcol) ? v2.x : 0.f, vb = (s + 1 <= lcol) ? v2.y : 0.f;
                if (s == lcol) va += Dh; if (s + 1 == lcol) vb += Dh;
                mv[q] = va; mv[q + 1] = vb;
            }
#pragma unroll
            for (int kk = 0; kk < 2; ++kk) {
                const float m8[8] = {mv[8 * kk], mv[8 * kk + 1], mv[8 * kk + 2], mv[8 * kk + 3], mv[8 * kk + 4], mv[8 * kk + 5], mv[8 * kk + 6], mv[8 * kk + 7]};
                const bf16x8 Bm = pack8f(m8);
#pragma unroll
                for (int pt = 0; pt < 2; ++pt) {
                    const int R = wid * 64 + 32 * pt + r, g = 4 * st + 2 * kk;
                    const bf16x4 lo = *(const PG8_LAS bf16x4*)(lds + L_XT + xt_off(R, g) + 8 * hh), hi = *(const PG8_LAS bf16x4*)(lds + L_XT + xt_off(R, g + 1) + 8 * hh);
                    yd[pt][lt] = MFMA32(join44(lo, hi), Bm, yd[pt][lt]);
                }
            }
        }
        __syncthreads();
#pragma unroll
        for (int i = 0; i < 8; ++i) { const int e = tid + 512 * i; *(PG8_LAS u32x4*)(lds + L_XT + (e >> 6) * ZP + (e & 63) * 16) = zraw[i]; }
        __syncthreads();
        float ssl[2];
#pragma unroll
        for (int lt = 0; lt < 2; ++lt) {
            const int lcol = 32 * lt + r;
            float ss = 0.f;
#pragma unroll
            for (int pt = 0; pt < 2; ++pt)
#pragma unroll
                for (int i = 0; i < 4; ++i) {
                    const u32x2 zw = *(const PG8_LAS u32x2*)(lds + L_XT + lcol * ZP + (wid * 64 + 32 * pt + 8 * i + 4 * hh) * 2);
                    const f32x2_t za = (f32x2_t){bflo(zw.x), bfhi(zw.x)}, zb2 = (f32x2_t){bflo(zw.y), bfhi(zw.y)};
                    const f32x2_t ga = (f32x2_t){yd[pt][lt][4 * i], yd[pt][lt][4 * i + 1]} * silu2(za), gb2 = (f32x2_t){yd[pt][lt][4 * i + 2], yd[pt][lt][4 * i + 3]} * silu2(zb2);
                    yd[pt][lt][4 * i] = ga.x; yd[pt][lt][4 * i + 1] = ga.y; yd[pt][lt][4 * i + 2] = gb2.x; yd[pt][lt][4 * i + 3] = gb2.y;
                    const f32x2_t sq = ga * ga + gb2 * gb2; ss += sq.x + sq.y;
                }
            ss += __shfl_xor(ss, 32);
            ssl[lt] = ss;
        }
        if (hh == 0) { red[wid * 64 + r] = ssl[0]; red[wid * 64 + 32 + r] = ssl[1]; }
        __syncthreads();
#pragma unroll
        for (int lt = 0; lt < 2; ++lt) {
            const int lcol = 32 * lt + r;
            float tot = 0.f;
#pragma unroll
            for (int w = 0; w < 8; ++w) tot += red[w * 64 + lcol];
            const float rstd = rsqrtf(tot * (1.0f / 512.f) + EPS);
#pragma unroll
            for (int pt = 0; pt < 2; ++pt)
#pragma unroll
                for (int i = 0; i < 4; ++i)
                { const f32x2_t a = (f32x2_t){yd[pt][lt][4 * i], yd[pt][lt][4 * i + 1]} * rstd, b = (f32x2_t){yd[pt][lt][4 * i + 2], yd[pt][lt][4 * i + 3]} * rstd;
                    *(PG8_LAS u32x2*)(lds + L_XT + lcol * ZP + (wid * 64 + 32 * pt + 8 * i + 4 * hh) * 2) = (u32x2){pk2(a.x, a.y), pk2(b.x, b.y)}; }
        }
        __syncthreads();
#pragma unroll
        for (int i = 0; i < 8; ++i) { const int e = tid + 512 * i, tok = e >> 6;
            if (tok < ci.nvalid) *(u32x4*)(p.yn + (size_t)(ci.row0 + tok) * 2048 + g * 512 + (e & 63) * 8) = *(const PG8_LAS u32x4*)(lds + L_XT + tok * ZP + (e & 63) * 16); }
        __syncthreads();
    }
}
#ifndef ATT_EXIT_P
#define ATT_EXIT_P 1e-20f
#endif
typedef short v4i16_t __attribute__((ext_vector_type(4)));
constexpr int AT_PITCH = 272;
constexpr int AT_TILE = 32 * AT_PITCH;
constexpr int ATT_LDS = 8 * 2 * AT_TILE;
__device__ __forceinline__ void ph_attn(CPR p, int l, LDSP lds) {
    const int tidx = tid_opaque(); const int lane = tidx & 63, r = lane & 31, hh = lane >> 5, wv = tidx >> 6, NGW = nblk_opaque() * 8, gw = (bid_opaque() * 8 + wv + (NGW >> 1)) % NGW;
    const bf16_t* kbb = p.kb; const bf16_t* vbb = p.vb;
    const float* ck = p.cache_k + (size_t)l * DEC_BATCH * PAST_LEN * 1024; const float* cv = p.cache_v + (size_t)l * DEC_BATCH * PAST_LEN * 1024;
    const float scale = 0.08838834764831845f;
    LDSP kl = lds + wv * (2 * AT_TILE); LDSP vl = kl + AT_TILE;
    const int st_g = (lane >> 5) * 1024 + (lane & 31) * 4;
    const int st_l = (lane >> 5) * AT_PITCH + (lane & 31) * 8;
    const int vs_g = (lane >> 4) * 1024 + (lane & 15) * 8;
    const int vs_l = (lane >> 4) * AT_PITCH + (lane & 15) * 16;
    const int ka_off = r * AT_PITCH + 16 * hh;
    const int vt_off = (4 * hh + ((lane & 15) >> 2)) * AT_PITCH + (16 * ((lane >> 4) & 1) + 4 * (lane & 3)) * 2;
    const int nwg = NGW >> 3, wgr = gw >> 3;
    for (int U = wgr; U < 512 + 32; U += nwg) {
        int hd, b, rowq0, P0;
        if (U < 512) { hd = U & 7; const int qt = 8 * (U >> 3) + wv; b = -1; rowq0 = 32 * qt; P0 = 32 * qt; }
        else { hd = wv; b = U - 512; rowq0 = M_P + 32 * b; P0 = PAST_LEN; }
        const bf16_t* qrow = p.qb + (size_t)(rowq0 + r) * 1024 + hd * 128 + 8 * hh;
        bf16x8 qf[8];
#pragma unroll
        for (int ks = 0; ks < 8; ++ks) qf[ks] = *(const bf16x8*)(qrow + 16 * ks);
        f32x16 O[4];
#pragma unroll
        for (int d = 0; d < 4; ++d) O[d] = zero16();
        float carry = 1.0f;
        const int ktd = P0 >> 5;
        u32x4 buf[16];
        { const bf16_t* kq = kbb + (size_t)(rowq0 + r) * 1024 + hd * 128 + 8 * hh;
#pragma unroll
          for (int ks = 0; ks < 8; ++ks) buf[8 + ks] = *(const u32x4*)(kq + 16 * ks); }
        for (int kt = ktd; kt >= 0; --kt) {
            const bool bfs = (b < 0) || (kt == ktd);
            f32x16 S = zero16();
            if (bfs) {
                const bf16_t* vq = vbb + (size_t)(b < 0 ? 32 * kt : rowq0) * 1024 + hd * 128 + vs_g;
#pragma unroll
                for (int i = 0; i < 8; ++i) buf[i] = *(const u32x4*)(vq + 4096 * i);
#pragma unroll
                for (int ks = 0; ks < 8; ++ks) S = MFMA32(__builtin_bit_cast(bf16x8, buf[8 + ks]), qf[ks], S);
            } else {
                const float* vb = cv + ((size_t)b * PAST_LEN + 32 * kt) * 1024 + hd * 128 + st_g;
#pragma unroll
                for (int i = 0; i < 16; ++i) buf[i] = *(const u32x4*)(vb + 2048 * i);
                asm volatile("s_waitcnt lgkmcnt(0)" ::: "memory");
#pragma unroll
                for (int ks = 0; ks < 8; ++ks) S = MFMA32(*(const PG8_LAS bf16x8*)(kl + ka_off + 32 * ks), qf[ks], S);
            }
            const bool diag = (kt == ktd);
            float kp[16], sg[16];
#pragma unroll
            for (int q = 0; q < 16; q += 2) {
                const int key = (q & 3) + 8 * (q >> 2) + 4 * hh;
                const f32x2_t z = (f32x2_t){S[q], S[q + 1]} * scale, e = exp2_2(__builtin_elementwise_abs(z) * (-1.4426950408889634f)), big = rcp_2(e + 1.0f), small = e * big;
                const bool v0 = !diag || key < r, v1 = !diag || key + 1 < r;
                sg[q] = v0 ? (z.x >= 0.f ? big.x : small.x) : 0.f; kp[q] = v0 ? (z.x >= 0.f ? small.x : big.x) : 1.0f;
                sg[q + 1] = v1 ? (z.y >= 0.f ? big.y : small.y) : 0.f; kp[q + 1] = v1 ? (z.y >= 0.f ? small.y : big.y) : 1.0f;
            }
            float T[4], Tp[4];
#pragma unroll
            for (int gi = 0; gi < 4; ++gi) { T[gi] = (kp[4 * gi] * kp[4 * gi + 1]) * (kp[4 * gi + 2] * kp[4 * gi + 3]); Tp[gi] = __shfl_xor(T[gi], 32); }
            float wg[16]; float aft = carry;
#pragma unroll
            for (int gi = 3; gi >= 0; --gi) {
                float suf = aft * (hh == 0 ? Tp[gi] : 1.0f);
#pragma unroll
                for (int j = 3; j >= 0; --j) { wg[4 * gi + j] = sg[4 * gi + j] * suf; suf *= kp[4 * gi + j]; }
                aft *= T[gi] * Tp[gi];
            }
            carry = aft;
            bf16x8 Pf[2];
#pragma unroll
            for (int kk = 0; kk < 2; ++kk) {
                const float w8[8] = {wg[8 * kk], wg[8 * kk + 1], wg[8 * kk + 2], wg[8 * kk + 3], wg[8 * kk + 4], wg[8 * kk + 5], wg[8 * kk + 6], wg[8 * kk + 7]};
                Pf[kk] = pack8f(w8);
            }
            if (bfs) {
#pragma unroll
                for (int i = 0; i < 8; ++i) *(PG8_LAS u32x4*)(vl + vs_l + 4 * AT_PITCH * i) = buf[i];
            } else {
#pragma unroll
                for (int i = 0; i < 16; ++i) { const float4 t = __builtin_bit_cast(float4, buf[i]); *(PG8_LAS u32x2*)(vl + st_l + 2 * AT_PITCH * i) = (u32x2){pk2(t.x, t.y), pk2(t.z, t.w)}; }
            }
            const bool more = (kt > 0) && !__all(carry < ATT_EXIT_P);
            if (more) {
                if (b < 0) { const bf16_t* kq = kbb + (size_t)(32 * (kt - 1) + r) * 1024 + hd * 128 + 8 * hh;
#pragma unroll
                    for (int ks = 0; ks < 8; ++ks) buf[8 + ks] = *(const u32x4*)(kq + 16 * ks); }
                else { const float* kb = ck + ((size_t)b * PAST_LEN + 32 * (kt - 1)) * 1024 + hd * 128 + st_g;
#pragma unroll
                    for (int i = 0; i < 16; ++i) buf[i] = *(const u32x4*)(kb + 2048 * i); }
            }
            asm volatile("s_waitcnt lgkmcnt(0)" ::: "memory");
#pragma unroll
            for (int kk = 0; kk < 2; ++kk)
#pragma unroll
                for (int d = 0; d < 4; ++d) {
                    const bf16x4 lo = __builtin_bit_cast(bf16x4, __builtin_amdgcn_ds_read_tr16_b64_v4i16((PG8_LAS v4i16_t*)(vl + vt_off + kk * 16 * AT_PITCH + d * 64)));
                    const bf16x4 hi = __builtin_bit_cast(bf16x4, __builtin_amdgcn_ds_read_tr16_b64_v4i16((PG8_LAS v4i16_t*)(vl + vt_off + kk * 16 * AT_PITCH + 8 * AT_PITCH + d * 64)));
                    O[d] = MFMA32(Pf[kk], join44(lo, hi), O[d]);
                }
            if (!more) break;
            if (b >= 0) {
#pragma unroll
                for (int i = 0; i < 16; ++i) { const float4 t = __builtin_bit_cast(float4, buf[i]); *(PG8_LAS u32x2*)(kl + st_l + 2 * AT_PITCH * i) = (u32x2){pk2(t.x, t.y), pk2(t.z, t.w)}; }
            }
        }
#pragma unroll
        for (int d = 0; d < 4; ++d)
#pragma unroll
            for (int q = 0; q < 16; ++q) *(PG8_LAS unsigned short*)(kl + ((q & 3) + 8 * (q >> 2) + 4 * hh) * AT_PITCH + (32 * d + r) * 2) = (unsigned short)pk2c(O[d][q], 0.0f);
        asm volatile("s_waitcnt lgkmcnt(0)" ::: "memory");
#pragma unroll
        for (int i = 0; i < 8; ++i) *(u32x4*)(p.att + (size_t)(rowq0 + (lane >> 4) + 4 * i) * 1024 + hd * 128 + (lane & 15) * 8) = *(const PG8_LAS u32x4*)(kl + vs_l + 4 * AT_PITCH * i);
    }
}

constexpr int MEGA_BODY = (ATT_LDS > pg8::STAGE_BYTES ? ATT_LDS : pg8::STAGE_BYTES);
constexpr int MEGA_LDS = MEGA_BODY + 64;
#ifndef WGM_IN
#define WGM_IN 4
#endif
#ifndef WGM_UP
#define WGM_UP 8
#endif
#ifndef PROBE_GBIG
#define PROBE_GBIG 1
#endif
#ifndef PROBE_GSMALL
#define PROBE_GSMALL 1
#endif
#ifndef PROBE_S
#define PROBE_S 1
#endif
#ifndef PROBE_A
#define PROBE_A 1
#endif
#ifndef PROBE_M
#define PROBE_M 1
#endif
#ifndef PROBE_P1
#define PROBE_P1 PROBE_S
#endif
#ifndef PROBE_P3
#define PROBE_P3 PROBE_S
#endif
#ifndef PROBE_P2
#define PROBE_P2 PROBE_M
#endif
#ifndef PROBE_FFN
#define PROBE_FFN PROBE_M
#endif
#ifndef PROBE_PRO
#define PROBE_PRO PROBE_M
#endif
#ifndef PROBE_NORM
#define PROBE_NORM 0
#endif
#ifndef PROBE_BAR
#define PROBE_BAR 1
#endif
#define GRID_BARRIER() do { for (int rb_ = 0; rb_ < PROBE_BAR; ++rb_) xcd_barrier(bar); } while (0)
template <class Epi> __device__ __forceinline__ void gemm_site(LDSP lds, const bf16_t* A, const bf16_t* Bt, int N, int K, const Epi& E) {
    for (int rep_ = 0; rep_ < (N > 1024 ? PROBE_GBIG : PROBE_GSMALL); ++rep_) {
    Gemm g; g.A = A; g.Bt = Bt; g.M = M_ALL; g.N = N; g.K = K;
    StaticOrder S; S.init(M_ALL, N, nblk_opaque(), bid_opaque(), N == 8192 ? WGM_UP : WGM_IN);
    pg8::gemm_phase<Epi, StaticOrder, false>(lds, g, S, E, nullptr);
    }
}
template <bool HALO, class Epi> __device__ __forceinline__ void gemm_small(LDSP lds, const bf16_t* A, const bf16_t* Bt, int K, const Epi& E, int c_ = -1, int G_ = 0) {
    const int tid = tid_opaque(), wid = tid >> 6, lane = tid & 63, r = lane & 31, hh = lane >> 5;
    const int nb = c_ < 0 ? nblk_opaque() : G_;
    for (int t = (c_ < 0 ? bid_opaque() : c_); t < (HALO ? 512 : 256); t += nb) {
        const int m0 = HALO ? (t >> 6) * 64 : M_P + (t >> 4) * 64, n0 = HALO ? (t & 63) * 64 : (t & 15) * 64, kbeg = wid * (K >> 3), nst = K >> 7;
        const int nrow = HALO ? (n0 >> 7) * 256 + (n0 & 127) : n0;
        const bf16_t* ap = A + (size_t)(m0 + r) * K + kbeg + 8 * hh; const bf16_t* bp = Bt + (size_t)(nrow + r) * K + kbeg + 8 * hh;
        const size_t hop = (size_t)32 * K;
        f32x16 acc[2][2];
#pragma unroll
        for (int a = 0; a < 2; ++a)
#pragma unroll
            for (int b = 0; b < 2; ++b) acc[a][b] = zero16();
        if (K >= 512) {
            LDSP wa = lds + wid * 16384; LDSP wb = wa + 8192;
            const int prow = lane >> 3, pp = lane & 7;
            const bf16_t* ag = A + (size_t)(m0 + prow) * K + kbeg + pp * 8; const bf16_t* bg = Bt + (size_t)(nrow + prow) * K + kbeg + pp * 8;
            const size_t r8 = (size_t)8 * K;
            const int nch = K >> 9;
            const int wofs = prow * 128 + ((pp ^ ((prow >> 1) & 7)) * 16);
            const int sw = (r >> 1) & 7, rofs = r * 128;
            u32x4 sa[8], sb[8];
#pragma unroll
            for (int i = 0; i < 8; ++i) { sa[i] = *(const u32x4*)(ag + i * r8); sb[i] = *(const u32x4*)(bg + i * r8); }
            for (int c = 0; c < nch; ++c) {
#pragma unroll
                for (int i = 0; i < 8; ++i) { const int row = prow + 8 * i; const int off = row * 128 + ((pp ^ ((row >> 1) & 7)) * 16); *(PG8_LAS u32x4*)(wa + off) = sa[i]; *(PG8_LAS u32x4*)(wb + off) = sb[i]; }
                const int cn = c + 1 < nch ? c + 1 : c;
#pragma unroll
                for (int i = 0; i < 8; ++i) { sa[i] = *(const u32x4*)(ag + i * r8 + 64 * cn); sb[i] = *(const u32x4*)(bg + i * r8 + 64 * cn); }
#pragma unroll
                for (int ks = 0; ks < 4; ++ks) {
                    const int so = ((2 * ks + hh) ^ sw) * 16;
                    const bf16x8 a0 = *(const PG8_LAS bf16x8*)(wa + rofs + so), a1 = *(const PG8_LAS bf16x8*)(wa + rofs + 4096 + so);
                    const bf16x8 b0 = *(const PG8_LAS bf16x8*)(wb + rofs + so), b1 = *(const PG8_LAS bf16x8*)(wb + rofs + 4096 + so);
                    acc[0][0] = MFMA32(a0, b0, acc[0][0]); acc[0][1] = MFMA32(a0, b1, acc[0][1]); acc[1][0] = MFMA32(a1, b0, acc[1][0]); acc[1][1] = MFMA32(a1, b1, acc[1][1]);
                }
            }
            (void)wofs;
        } else {
        bf16x8 fa[4][2], fb[4][2];
#pragma unroll
        for (int s = 0; s < 3; ++s) { const int ko = 16 * (s < nst ? s : 0);
            fa[s][0] = *(const bf16x8*)(ap + ko); fa[s][1] = *(const bf16x8*)(ap + hop + ko); fb[s][0] = *(const bf16x8*)(bp + ko); fb[s][1] = *(const bf16x8*)(bp + hop + ko); }
        for (int st = 0; st < nst; st += 2) {
#pragma unroll
            for (int s2 = 0; s2 < 2; ++s2) {
                const int cur = (st + s2) & 3, nxs = (st + s2 + 3) & 3, nx = st + s2 + 3, ko = 16 * (nx < nst ? nx : 0);
                if (((st >> 1) & 1) == 0) {
                    fa[(s2 + 3) & 3][0] = *(const bf16x8*)(ap + ko); fa[(s2 + 3) & 3][1] = *(const bf16x8*)(ap + hop + ko); fb[(s2 + 3) & 3][0] = *(const bf16x8*)(bp + ko); fb[(s2 + 3) & 3][1] = *(const bf16x8*)(bp + hop + ko);
#pragma unroll
                    for (int a = 0; a < 2; ++a)
#pragma unroll
                        for (int b = 0; b < 2; ++b) acc[a][b] = MFMA32(fa[s2][a], fb[s2][b], acc[a][b]);
                } else {
                    fa[(s2 + 1) & 3][0] = *(const bf16x8*)(ap + ko); fa[(s2 + 1) & 3][1] = *(const bf16x8*)(ap + hop + ko); fb[(s2 + 1) & 3][0] = *(const bf16x8*)(bp + ko); fb[(s2 + 1) & 3][1] = *(const bf16x8*)(bp + hop + ko);
#pragma unroll
                    for (int a = 0; a < 2; ++a)
#pragma unroll
                        for (int b = 0; b < 2; ++b) acc[a][b] = MFMA32(fa[s2 + 2][a], fb[s2 + 2][b], acc[a][b]);
                }
                (void)cur; (void)nxs;
            }
        }
        }
        PG8_LAS float* red = (PG8_LAS float*)lds;
#pragma unroll
        for (int a = 0; a < 2; ++a)
#pragma unroll
            for (int b = 0; b < 2; ++b)
#pragma unroll
                for (int q = 0; q < 16; ++q) red[((wid * 4 + a * 2 + b) * 16 + q) * 64 + lane] = acc[a][b][q];
        __syncthreads();
        { const int blk = wid & 3, q0 = (wid >> 2) * 8, a = blk >> 1, b = blk & 1;
#pragma unroll
          for (int q = 0; q < 8; ++q) { float v = 0.f;
#pragma unroll
              for (int w = 0; w < 8; ++w) v += red[((w * 4 + blk) * 16 + q0 + q) * 64 + lane];
              const int qq = q0 + q; E.elem(m0 + 32 * a + (qq & 3) + 8 * (qq >> 2) + 4 * hh, n0 + 32 * b + r, v); } }
        __syncthreads();
    }
}
template <class Epi> __device__ __forceinline__ void gemm_site_n1024_part(LDSP lds, const bf16_t* A, const bf16_t* Bt, int K, const Epi& E, int G, int c) {
    Gemm g; g.A = A; g.Bt = Bt; g.M = M_P; g.N = 1024; g.K = K;
    StaticOrder S; S.init(M_P, 1024, G, c);
    pg8::gemm_phase<Epi, StaticOrder, false>(lds, g, S, E, nullptr);
    gemm_small<false>(lds, A, Bt, K, E, c, G);
}
template <class Epi> __device__ __forceinline__ void gemm_site_n1024_prompt(LDSP lds, const bf16_t* A, const bf16_t* Bt, int K, const Epi& E) {
    Gemm g; g.A = A; g.Bt = Bt; g.M = M_P; g.N = 1024; g.K = K;
    StaticOrder S; S.init(M_P, 1024, nblk_opaque(), bid_opaque());
    pg8::gemm_phase<Epi, StaticOrder, false>(lds, g, S, E, nullptr);
}
template <class Epi> __device__ __forceinline__ void gemm_site_n1024(LDSP lds, const bf16_t* A, const bf16_t* Bt, int K, const Epi& E) {
    for (int rep_ = 0; rep_ < PROBE_GSMALL; ++rep_) {
    Gemm g; g.A = A; g.Bt = Bt; g.M = M_P; g.N = 1024; g.K = K;
    StaticOrder S; S.init(M_P, 1024, nblk_opaque(), bid_opaque());
    pg8::gemm_phase<Epi, StaticOrder, false>(lds, g, S, E, nullptr);
    gemm_small<false>(lds, A, Bt, K, E);
    }
}
__global__ void __launch_bounds__(512, 2) k_mega(Params p_) {
    extern __shared__ __attribute__((aligned(16))) unsigned char shm[];
    LDSP lds = (LDSP)shm;
    volatile LAS unsigned* xbw = (volatile LAS unsigned*)(lds + MEGA_BODY);
    if (threadIdx.x < 4) xbw[threadIdx.x] = 0u;
    __syncthreads();
    XcdBarrier bar = xcd_barrier_post(kargs()->bar, xbw);
    for (int rep_ = 0; rep_ < PROBE_PRO; ++rep_) { { CPR p = *kargs(); ph_wt(p, lds); }
    { CPR p = *kargs(); ph_xprep(p); } }
    GRID_BARRIER();
    for (int l = 0; l < DEPTH; ++l) {
        { CPR p = *kargs(); float* out = p.out; const bf16_t* wl = p.wt + (size_t)l * WT_LAYER; EpiIn E; E.rs = p.rs; E.zb = p.zb; E.xbcb = p.xbcb; E.qb = p.qb; E.kb = p.kb; E.vb = p.vb; E.gb = p.gb; E.dtb = p.dtb; E.dt_bias = p.ssd_dt_bias + l * 32;
          E.kP = out + O_P_K + (size_t)l * M_P * 1024; E.vP = out + O_P_V + (size_t)l * M_P * 1024; E.kS = out + O_S_K + (size_t)l * M_S * 1024; E.vS = out + O_S_V + (size_t)l * M_S * 1024;
          E.convP = out + O_P_CONV + (size_t)l * 3 * 3072; E.convS = out + O_S_CONV + (size_t)l * DEC_BATCH * 3 * 3072;
          gemm_site(lds, p.xb, wl + OW1, N1, 1024, E); }
        GRID_BARRIER();
        for (int rep_ = 0; rep_ < PROBE_P1; ++rep_) { CPR p = *kargs(); ph_ssd_p1(p, l, lds); }
        for (int rep_ = 0; rep_ < PROBE_A; ++rep_) { CPR p = *kargs(); ph_attn(p, l, lds); }
        GRID_BARRIER();
        for (int rep_ = 0; rep_ < PROBE_P2; ++rep_) { CPR p = *kargs(); ph_ssd_p2(p, l); }
        { CPR p = *kargs(); float* out = p.out; const bf16_t* wl = p.wt + (size_t)l * WT_LAYER; EpiBr E; E.gb = p.gb; E.t1in = nullptr; E.dst = p.t1; E.mode = 0; E.pad = 0; gemm_site_n1024_prompt(lds, p.att, wl + OW3, 1024, E); }
        GRID_BARRIER();
        for (int rep_ = 0; rep_ < PROBE_P3; ++rep_) { CPR p = *kargs(); ph_ssd_p3(p, l, lds); }
        if (bid_opaque() >= 128) { __syncthreads(); CPR p = *kargs(); const bf16_t* wl = p.wt + (size_t)l * WT_LAYER; EpiBr E; E.gb = p.gb; E.t1in = nullptr; E.dst = p.t1; E.mode = 0; E.pad = 0; gemm_small<false>(lds, p.att, wl + OW3, 1024, E, bid_opaque() - 128, 128); }
        GRID_BARRIER();
        { CPR p = *kargs(); float* out = p.out; const bf16_t* wl = p.wt + (size_t)l * WT_LAYER; EpiBr E; E.gb = p.gb; E.t1in = p.t1; E.dst = p.mixin; E.mode = 1; E.pad = 0; gemm_site_n1024(lds, p.yn, wl + OW2, 2048, E); }
        GRID_BARRIER();
        { CPR p = *kargs(); float* out = p.out; const bf16_t* wl = p.wt + (size_t)l * WT_LAYER; EpiF32Out E; E.dst = p.mixed; gemm_site_n1024(lds, p.mixin, wl + OW4, 1024, E); }
        GRID_BARRIER();
        { CPR p = *kargs(); float* out = p.out; (void)out; ph_norm(p.mixed, p.norm_post_mix + l * 1024, p.xr, p.xb, nullptr, nullptr, p.xh); }
        GRID_BARRIER();
        { CPR p = *kargs(); const bf16_t* wl = p.wt + (size_t)l * WT_LAYER; EpiHalo E; E.rs = nullptr; E.gh = p.gh; gemm_small<true>(lds, p.xh, wl + OW5, 1024, E); }
        GRID_BARRIER();
        { CPR p = *kargs(); float* out = p.out; const bf16_t* wl = p.wt + (size_t)l * WT_LAYER; EpiUpAct E; E.rs = p.rs2; E.gh = p.gh; E.ffb = p.ffb;
          E.ffnP = out + O_P_FFN + (size_t)l * 2 * D_FF; E.ffnS = out + O_S_FFN + (size_t)l * DEC_BATCH * 2 * D_FF;
          E.cw = p.ffn_conv_w + (size_t)l * 3 * D_FF; E.cb = p.ffn_conv_b + (size_t)l * D_FF; E.hist = p.state_ffn_conv + (size_t)l * DEC_BATCH * 2 * D_FF;
          gemm_site(lds, p.xb, wl + OW5, 8192, 1024, E); }
        if (bid_opaque() >= 128) { CPR p = *kargs(); const bf16_t* wl = p.wt + (size_t)l * WT_LAYER; EpiPlain E; E.dst = p.plea; gemm_site_n1024_part(lds, p.pb + (size_t)l * M_ALL * 256, wl + OW7, 256, E, 128, bid_opaque() - 128); }
        GRID_BARRIER();
        { CPR p = *kargs(); float* out = p.out; const bf16_t* wl = p.wt + (size_t)l * WT_LAYER; EpiF32Out E; E.dst = p.down; gemm_site_n1024(lds, p.ffb, wl + OW6, 4096, E); }
        GRID_BARRIER();
        { CPR p = *kargs(); float* out = p.out; (void)out; ph_norm(p.down, p.norm_post_ffn + l * 1024, p.xr, nullptr, nullptr, nullptr); }
        GRID_BARRIER();
        { CPR p = *kargs(); float* out = p.out; const bf16_t* wl = p.wt + (size_t)l * WT_LAYER; EpiPle E; E.plea = p.plea; E.dst = p.ple; gemm_site_n1024(lds, p.xr, wl + OW8, 1024, E); }
        GRID_BARRIER();
        { CPR p = *kargs(); float* out = p.out; (void)out; ph_norm(p.ple, p.norm_ple + l * 1024, p.xr, p.xb, l == DEPTH - 1 ? out + O_Y_P : nullptr, out + O_Y_S); }
        if (l + 1 < DEPTH) GRID_BARRIER();
    }
}

struct Bump { char* base; size_t off; template <class T> T* take(size_t n) { off = (off + 255) & ~(size_t)255; T* p = (T*)(base + off); off += n * sizeof(T); return p; } };
__global__ void k_fail_code(float* out, float code) { if (threadIdx.x == 0 && blockIdx.x == 0) out[0] = code; }

extern "C" void kernel_launch(void* const* d_in, const int* in_sizes, int n_in, void* d_out, int out_size, void* d_ws, size_t ws_size, hipStream_t stream) {
    Params p; memset(&p, 0, sizeof p);
    p.x_prompt = (const float*)d_in[0]; p.x_sample = (const float*)d_in[1]; p.state_ssd_conv = (const float*)d_in[2]; p.state_ssd = (const float*)d_in[3];
    p.cache_k = (const float*)d_in[4]; p.cache_v = (const float*)d_in[5]; p.state_ffn_conv = (const float*)d_in[6]; p.p_prompt = (const float*)d_in[7]; p.p_sample = (const float*)d_in[8];
    p.norm_pre_mix = (const float*)d_in[9]; p.w_in = (const float*)d_in[10]; p.ssd_conv_w = (const float*)d_in[11]; p.ssd_conv_b = (const float*)d_in[12]; p.ssd_dt_bias = (const float*)d_in[13];
    p.ssd_a_log = (const float*)d_in[14]; p.ssd_d = (const float*)d_in[15]; p.ssd_norm = (const float*)d_in[16]; p.w_br_ssd = (const float*)d_in[17]; p.w_br_sb = (const float*)d_in[18];
    p.w_out = (const float*)d_in[19]; p.norm_post_mix = (const float*)d_in[20]; p.norm_pre_ffn = (const float*)d_in[21]; p.w_up = (const float*)d_in[22]; p.ffn_conv_w = (const float*)d_in[23];
    p.ffn_conv_b = (const float*)d_in[24]; p.w_down = (const float*)d_in[25]; p.norm_post_ffn = (const float*)d_in[26]; p.w_ple = (const float*)d_in[27]; p.w_ple_gate = (const float*)d_in[28];
    p.norm_ple = (const float*)d_in[29];
    float* out = (float*)d_out; p.out = out;

    Bump B{(char*)d_ws, 0};
    const size_t R = M_ALL;
    p.bar = B.take<unsigned>(4096);
    p.wt = B.take<bf16_t>(DEPTH * WT_LAYER);
    p.xr = B.take<bf16_t>(R * 1024); p.xb = B.take<bf16_t>(R * 1024); p.rs = B.take<float>(R); p.rs2 = B.take<float>(R); p.pb = B.take<bf16_t>(DEPTH * R * 256);
    p.zb = B.take<bf16_t>(R * 2048); p.xbcb = B.take<bf16_t>(R * 3072); p.qb = B.take<bf16_t>(R * 1024); p.kb = B.take<bf16_t>(R * 1024); p.vb = B.take<bf16_t>(R * 1024); p.gb = B.take<bf16_t>(R * 2048); p.dtb = B.take<float>(R * 32);
    p.sst = B.take<float>((size_t)NCHUNK * STATE_SZ / 2); p.dec = B.take<float>(NCHUNK * 32); p.hpb = B.take<bf16_t>((size_t)NCHUNK * STATE_SZ);
    p.yn = B.take<bf16_t>(R * 2048); p.att = B.take<bf16_t>(R * 1024); p.t1 = B.take<bf16_t>(R * 1024); p.mixin = B.take<bf16_t>(R * 1024); p.mixed = B.take<bf16_t>(R * 1024);
    p.gh = B.take<bf16_t>((size_t)768 * 4096); p.xh = B.take<bf16_t>((size_t)768 * 1024); p.ffb = B.take<bf16_t>(R * 4096); p.down = B.take<bf16_t>(R * 1024); p.plea = B.take<bf16_t>(R * 1024); p.ple = B.take<bf16_t>(R * 1024);
    if (B.off > ws_size) { k_fail_code<<<1, 64, 0, stream>>>(out, 777000.f); return; }

    (void)hipMemsetAsync(p.bar, 0, 4096 * 4, stream);
    static bool minit = false;
    if (!minit) { (void)hipFuncSetAttribute((const void*)k_mega, hipFuncAttributeMaxDynamicSharedMemorySize, MEGA_LDS); minit = true; }
    hipLaunchKernelGGL(k_mega, dim3(256), dim3(512), MEGA_LDS, stream, p);
}
```

```cpp
#include <hip/hip_runtime.h>
#include <stdint.h>
#include <string.h>

constexpr int D_MODEL = 1024, SEQ = 16384, DEPTH = 2, DEC_BATCH = 32, DEC_SEQ = 32, PAST_LEN = 2048;
constexpr int D_SSM = 2048, SSD_HEAD_DIM = 64, SSD_HEADS = 32, SSD_GROUPS = 4, SSD_STATE = 128, SSD_CONV_DIM = 3072;
constexpr int SB_HEAD_DIM = 128, SB_HEADS = 8, SB_WIDTH = 1024, D_FF = 4096, PLE_DIM = 256;
constexpr int IN_DIM = 10272;
constexpr int M_P = SEQ, M_S = DEC_BATCH * DEC_SEQ, M_ALL = M_P + M_S;
constexpr float EPS = 1e-6f;
constexpr int C_Z = 0, C_XBC = 2048, C_DT = 5120, C_Q = 5152, C_K = 6176, C_V = 7200, C_G = 8224;
constexpr size_t O_Y_P = 0;
constexpr size_t O_Y_S = O_Y_P + (size_t)M_P * D_MODEL;
constexpr size_t O_P_CONV = O_Y_S + (size_t)M_S * D_MODEL;
constexpr size_t O_P_STATE = O_P_CONV + (size_t)DEPTH * 3 * SSD_CONV_DIM;
constexpr size_t O_P_K = O_P_STATE + (size_t)DEPTH * SSD_HEADS * SSD_HEAD_DIM * SSD_STATE;
constexpr size_t O_P_V = O_P_K + (size_t)DEPTH * M_P * SB_WIDTH;
constexpr size_t O_P_FFN = O_P_V + (size_t)DEPTH * M_P * SB_WIDTH;
constexpr size_t O_S_CONV = O_P_FFN + (size_t)DEPTH * 2 * D_FF;
constexpr size_t O_S_STATE = O_S_CONV + (size_t)DEPTH * DEC_BATCH * 3 * SSD_CONV_DIM;
constexpr size_t O_S_K = O_S_STATE + (size_t)DEPTH * DEC_BATCH * SSD_HEADS * SSD_HEAD_DIM * SSD_STATE;
constexpr size_t O_S_V = O_S_K + (size_t)DEPTH * M_S * SB_WIDTH;
constexpr size_t O_S_FFN = O_S_V + (size_t)DEPTH * M_S * SB_WIDTH;
constexpr size_t O_TOTAL = O_S_FFN + (size_t)DEPTH * DEC_BATCH * 2 * D_FF;
constexpr size_t STATE_SZ = (size_t)SSD_HEADS * SSD_HEAD_DIM * SSD_STATE;

typedef unsigned short bf16_t;

__device__ __forceinline__ float wave_sum(float v) {
#pragma unroll
    for (int o = 32; o >= 1; o >>= 1) v += __shfl_xor(v, o);
    return v;
}
__device__ __forceinline__ float sigmoidf_(float x) { return 1.0f / (1.0f + __expf(-x)); }
__device__ __forceinline__ float softplusf_(float x) { return fmaxf(x, 0.f) + log1pf(__expf(-fabsf(x))); }
__device__ __forceinline__ float siluf_(float x) { return x * sigmoidf_(x); }
__device__ __forceinline__ float gelu_tanhf_(float x) { const float u = 0.7978845608028654f * (x + 0.044715f * x * x * x); return 0.5f * x * (1.0f + tanhf(u)); }
__device__ __forceinline__ bf16_t f2bf(float f) { unsigned u = __float_as_uint(f); u += 0x7FFFu + ((u >> 16) & 1u); return (bf16_t)(u >> 16); }
__device__ __forceinline__ float bf2f(bf16_t b) { return __uint_as_float(((unsigned)b) << 16); }
typedef __bf16 bf16x2_t __attribute__((ext_vector_type(2)));
typedef float f32x2_t __attribute__((ext_vector_type(2)));
__device__ __forceinline__ unsigned pk2(float lo, float hi) { unsigned r; asm volatile("v_cvt_pk_bf16_f32 %0, %1, %2" : "=v"(r) : "v"(lo), "v"(hi)); return r; }
__device__ __forceinline__ unsigned pk2c(float lo, float hi) { const f32x2_t v = {lo, hi}; return __builtin_bit_cast(unsigned, __builtin_convertvector(v, bf16x2_t)); }
__device__ __forceinline__ f32x2_t exp2_2(f32x2_t x) { f32x2_t e; e.x = __builtin_amdgcn_exp2f(x.x); e.y = __builtin_amdgcn_exp2f(x.y); return e; }
__device__ __forceinline__ f32x2_t rcp_2(f32x2_t x) { f32x2_t r; r.x = __builtin_amdgcn_rcpf(x.x); r.y = __builtin_amdgcn_rcpf(x.y); return r; }
__device__ __forceinline__ f32x2_t sigmoid2(f32x2_t a) { return rcp_2(exp2_2(a * (-1.4426950408889634f)) + 1.0f); }
__device__ __forceinline__ f32x2_t silu2(f32x2_t a) { return a * sigmoid2(a); }
__device__ __forceinline__ f32x2_t gelu2(f32x2_t x) { const f32x2_t u2 = (x * x * 0.044715f + 1.0f) * x * 1.5957691216057308f; return x * sigmoid2(u2); }
__device__ __forceinline__ float bflo(unsigned w) { return __uint_as_float(w << 16); }
__device__ __forceinline__ float bfhi(unsigned w) { return __uint_as_float(w & 0xffff0000u); }

__device__ __forceinline__ int bid_opaque() { int b = blockIdx.x; asm volatile("" : "+s"(b)); return b; }
__device__ __forceinline__ int nblk_opaque() { int b = gridDim.x; asm volatile("" : "+s"(b)); return b; }
__device__ __forceinline__ int tid_opaque() { int t = threadIdx.x; asm volatile("" : "+v"(t)); return t; }

namespace pg8 {
#define PG8_LAS __attribute__((address_space(3)))
typedef unsigned short bf16_t;
typedef short bf16x8 __attribute__((ext_vector_type(8)));
typedef float f32x4 __attribute__((ext_vector_type(4)));
typedef unsigned u32x4 __attribute__((ext_vector_type(4)));
constexpr int BM = 256, BK = 64, HALF = 128, HTB = HALF * BK * 2  , STAGE_BYTES = 8 * HTB, NXCD = 8, WGM = 8;

__host__ __device__ __forceinline__ int lds_byte(int r, int c) { const int st = (r >> 4) * 2 + (c >> 5), rr = r & 15, cc = c & 31, ob = rr * 64 + cc * 2; return st * 1024 + (ob ^ (((ob >> 9) & 1) << 5)); }
__host__ __device__ __forceinline__ void stage_rc(int b, int& R, int& C) { const int st = b / 1024, sb = b % 1024, swz = sb ^ (((sb >> 9) & 1) << 5); R = (st >> 1) * 16 + swz / 64; C = (st & 1) * 32 + (swz % 64) / 2; }
__host__ __device__ __forceinline__ int perm32(int rho) { const int n = rho >> 4, i = rho & 15; return 8 * (i >> 2) + 4 * n + (i & 3); }

struct Unit { int pm, pn; };
struct Gemm { const bf16_t* A; const bf16_t* Bt; int M, N, K; };

struct StaticOrder {
    int nM, nN, nwg, G, c, wgm;
    __host__ __device__ void init(int M, int N, int G_, int c_, int wgm_ = WGM) { nM = M / BM; nN = N / BM; nwg = nM * nN; G = G_; c = c_; wgm = wgm_; }
    __host__ __device__ bool next(int i, Unit& u) const {
        const long L = (long)i * G + c; if (L >= nwg) return false;
        int wgid = (int)L; { const int q = nwg / NXCD, r = nwg % NXCD, xcd = wgid % NXCD, off = wgid / NXCD; wgid = (xcd < r ? xcd * (q + 1) : r * (q + 1) + (xcd - r) * q) + off; }
        const int nig = wgm * nN, gid = wgid / nig, fm = gid * wgm, gsz = (nM - fm) < wgm ? (nM - fm) : wgm;
        u.pm = fm + ((wgid % nig) % gsz); u.pn = (wgid % nig) / gsz; return true;
    }
    __device__ __forceinline__ void a_ready(const Unit&) const {}
    __device__ __forceinline__ void done(const Unit&) const {}
};
__device__ __forceinline__ unsigned cvt_pk_bf16(float lo, float hi) { unsigned r; asm volatile("v_cvt_pk_bf16_f32 %0, %1, %2" : "=v"(r) : "v"(lo), "v"(hi)); return r; }
typedef float f32x2 __attribute__((ext_vector_type(2)));
__device__ __forceinline__ f32x2 gelu_pk(f32x2 v) {
    const f32x2 av = __builtin_elementwise_abs(v), d = av * 0.2316418882f + 1.0f;
    f32x2 t; t.x = __builtin_amdgcn_rcpf(d.x); t.y = __builtin_amdgcn_rcpf(d.y);
    f32x2 q = t * 0.5307027145f + (-0.7265760135f); q = q * t + 0.7107068705f; q = q * t + (-0.142248368f); q = q * t + 0.127414796f; q = q * t;
    const f32x2 s = (v * v) * (-0.72134752044f);
    f32x2 e; e.x = __builtin_amdgcn_exp2f(s.x); e.y = __builtin_amdgcn_exp2f(s.y);
    const f32x2 m = v * (q * e), r = v - m;
    f32x2 o; o.x = v.x < 0.f ? m.x : r.x; o.y = v.y < 0.f ? m.y : r.y; return o;
}

struct EpiF32 {
    static constexpr bool PERM = false, AFTER_DRAIN = false;
    float* C; int ldc; const float* bias;
    __device__ __forceinline__ void operator()(const f32x4 (&acc)[2][2][4][2], const Unit& u, int wr, int wc, int fr, int fq) const {
        const int row0 = u.pm * BM + wr * 64 + fr, col0 = u.pn * BM + wc * 32 + 4 * fq;
        f32x4 bv[2][2];
#pragma unroll
        for (int bj = 0; bj < 2; ++bj)
#pragma unroll
            for (int n = 0; n < 2; ++n) bv[bj][n] = bias ? *(const f32x4*)(bias + col0 + bj * HALF + n * 16) : (f32x4){0.f, 0.f, 0.f, 0.f};
#pragma unroll
        for (int ai = 0; ai < 2; ++ai)
#pragma unroll
            for (int m = 0; m < 4; ++m) { float* rowp = C + (size_t)(row0 + ai * HALF + m * 16) * ldc + col0;
#pragma unroll
                for (int bj = 0; bj < 2; ++bj)
#pragma unroll
                    for (int n = 0; n < 2; ++n) *(f32x4*)(rowp + bj * HALF + n * 16) = acc[ai][bj][m][n] + bv[bj][n]; }
    }
};
template <int ACT  > struct EpiBf16 {
    static constexpr bool PERM = true, AFTER_DRAIN = false;
    bf16_t* O; int ldc; const float* bias; int split_cols; size_t split_stride;
    __device__ __forceinline__ void operator()(const f32x4 (&acc)[2][2][4][2], const Unit& u, int wr, int wc, int fr, int fq) const {
        const int row0 = u.pm * BM + wr * 64 + fr; int colt = u.pn * BM; bf16_t* base = O;
        if (split_cols) { const int t = colt / split_cols; base += (size_t)t * split_stride; colt -= t * split_cols; }
        const int col0 = colt + wc * 32 + 8 * fq, bcol0 = u.pn * BM + wc * 32 + 8 * fq;
        f32x4 bv[2][2];
#pragma unroll
        for (int bj = 0; bj < 2; ++bj)
#pragma unroll
            for (int n = 0; n < 2; ++n) bv[bj][n] = bias ? *(const f32x4*)(bias + bcol0 + bj * HALF + 4 * n) : (f32x4){0.f, 0.f, 0.f, 0.f};
#pragma unroll
        for (int ai = 0; ai < 2; ++ai)
#pragma unroll
            for (int m = 0; m < 4; ++m) { bf16_t* rowp = base + (size_t)(row0 + ai * HALF + m * 16) * ldc + col0;
#pragma unroll
                for (int bj = 0; bj < 2; ++bj) { f32x4 v0 = acc[ai][bj][m][0] + bv[bj][0], v1 = acc[ai][bj][m][1] + bv[bj][1];
                    if (ACT == 1) { f32x2 a = gelu_pk((f32x2){v0[0], v0[1]}), b = gelu_pk((f32x2){v0[2], v0[3]}), c = gelu_pk((f32x2){v1[0], v1[1]}), d = gelu_pk((f32x2){v1[2], v1[3]});
                        v0 = (f32x4){a.x, a.y, b.x, b.y}; v1 = (f32x4){c.x, c.y, d.x, d.y}; }
                    if (ACT == 2) {
#pragma unroll
                        for (int j = 0; j < 4; ++j) { v0[j] = 0.5f * v0[j] * (1.0f + erff(v0[j] * 0.70710678f)); v1[j] = 0.5f * v1[j] * (1.0f + erff(v1[j] * 0.70710678f)); } }
                    u32x4 w; w.x = cvt_pk_bf16(v0[0], v0[1]); w.y = cvt_pk_bf16(v0[2], v0[3]); w.z = cvt_pk_bf16(v1[0], v1[1]); w.w = cvt_pk_bf16(v1[2], v1[3]);
                    *(u32x4*)(rowp + bj * HALF) = w; } }
    }
};

template <class Epi, class Sched, bool STAMP = false>
__device__ __forceinline__ void gemm_phase(PG8_LAS unsigned char* lds, const Gemm g, const Sched& S, const Epi& E, unsigned long long* stamps) {
    const int tid = tid_opaque(), wid = __builtin_amdgcn_readfirstlane(tid >> 6), lane = tid & 63, wr = wid >> 2, wc = wid & 3, fr = lane & 15, fq = lane >> 4;
    const int K = g.K, nt = K / BK;
    int ts_lo = 0, ts_hi = 0, nts = 0; const unsigned long long rt_entry = STAMP ? (unsigned long long)wall_clock64() : 0ull;
#define PG8_STAMP() do { if (STAMP && wid == 0 && nts < 64) { const unsigned long long _c = (unsigned long long)clock64(); \
        ts_lo = (lane == nts) ? (int)(unsigned)_c : ts_lo; ts_hi = (lane == nts) ? (int)(unsigned)(_c >> 32) : ts_hi; ++nts; } } while (0)
    PG8_STAMP();
    unsigned voffA[2], voffB[2];
#pragma unroll
    for (int i = 0; i < 2; ++i) { int R, C; stage_rc(tid * 16 + i * 8192, R, C); const int Rb = Epi::PERM ? ((R & ~31) + perm32(R & 31)) : R;
        voffA[i] = (unsigned)(R * K + C) * 2u; voffB[i] = (unsigned)(Rb * K + C) * 2u; }
    const size_t kstep = (size_t)(BK * 2);
    const size_t hstep = (size_t)HALF * K * 2;
    const size_t tstep = 2 * hstep;
    const unsigned ldsw = (unsigned)wid * 1024u;
    const int aoff = lds_byte(wr * 64 + fr, fq * 8), boff = lds_byte(wc * 32 + fr, fq * 8);
#define PG8_SA(b, h) (((b) * 2 + (h)) * HTB)
#define PG8_SB(b, h) ((4 + (b) * 2 + (h)) * HTB)
#define PG8_STAGE(bufoff, gbase, voff) do { _Pragma("unroll") for (int _i = 0; _i < 2; ++_i) \
        __builtin_amdgcn_global_load_lds((const unsigned*)((const char*)(gbase) + (voff)[_i]), (PG8_LAS unsigned*)(lds + (bufoff) + ldsw + _i * 8192), 16, 0, 0); } while (0)
#define PG8_LDA(dst, b, h) do { _Pragma("unroll") for (int m = 0; m < 4; ++m) _Pragma("unroll") for (int k = 0; k < 2; ++k) dst[m][k] = *(const PG8_LAS bf16x8*)(lds + PG8_SA(b, h) + aoff + m * 2048 + k * 1024); } while (0)
#define PG8_LDB(dst, b, h) do { _Pragma("unroll") for (int n = 0; n < 2; ++n) _Pragma("unroll") for (int k = 0; k < 2; ++k) dst[n][k] = *(const PG8_LAS bf16x8*)(lds + PG8_SB(b, h) + boff + n * 2048 + k * 1024); } while (0)
#define PG8_MMA(ai, bj, At, Bt) do { __builtin_amdgcn_s_setprio(1); _Pragma("unroll") for (int m = 0; m < 4; ++m) _Pragma("unroll") for (int n = 0; n < 2; ++n) _Pragma("unroll") for (int k = 0; k < 2; ++k) \
        acc[ai][bj][m][n] = __builtin_amdgcn_mfma_f32_16x16x32_bf16(Bt[n][k], At[m][k], acc[ai][bj][m][n], 0, 0, 0); __builtin_amdgcn_s_setprio(0); } while (0)
#define PG8_WAIT_V(n) asm volatile("s_waitcnt vmcnt(" #n ")" ::: "memory")
#define PG8_WAIT_L(n) asm volatile("s_waitcnt lgkmcnt(" #n ")" ::: "memory")
#define PG8_BAR __builtin_amdgcn_s_barrier()
#define PG8_SCHED __builtin_amdgcn_sched_barrier(0)
    Unit cur, nxt; int ui = 0;
    if (!S.next(0, cur)) return;
    f32x4 acc[2][2][4][2];
#pragma unroll
    for (int a = 0; a < 2; ++a)
#pragma unroll
        for (int b = 0; b < 2; ++b)
#pragma unroll
            for (int m = 0; m < 4; ++m)
#pragma unroll
                for (int n = 0; n < 2; ++n) acc[a][b][m][n] = (f32x4){0.f, 0.f, 0.f, 0.f};
    bf16x8 At[4][2], B0[2][2], B1[2][2];
    const char* cA = (const char*)g.A + (size_t)cur.pm * tstep; const char* cB = (const char*)g.Bt + (size_t)cur.pn * tstep;
    S.a_ready(cur);
    PG8_STAGE(PG8_SB(0, 0), cB, voffB); PG8_STAGE(PG8_SA(0, 0), cA, voffA); PG8_STAGE(PG8_SB(0, 1), cB + hstep, voffB); PG8_STAGE(PG8_SA(0, 1), cA + hstep, voffA);
    if (wr == 1) PG8_BAR;
    PG8_WAIT_V(4); PG8_BAR;
    PG8_STAGE(PG8_SB(1, 0), cB + kstep, voffB); PG8_STAGE(PG8_SA(1, 0), cA + kstep, voffA); PG8_STAGE(PG8_SB(1, 1), cB + hstep + kstep, voffB);
    PG8_WAIT_V(6); PG8_BAR;
    PG8_STAMP();
    for (;;) {
        const bool has_next = S.next(ui + 1, nxt);
        const char* nA = has_next ? (const char*)g.A + (size_t)nxt.pm * tstep : cA; const char* nB = has_next ? (const char*)g.Bt + (size_t)nxt.pn * tstep : cB;
        for (int t = 0; t < nt; t += 2) {
            const bool last = (t == nt - 2);
            const char* a1 = cA + (size_t)(t + 1) * kstep;
            const char* a2 = last ? nA : cA + (size_t)(t + 2) * kstep; const char* b2 = last ? nB : cB + (size_t)(t + 2) * kstep;
            const char* a3 = a2 + kstep; const char* b3 = b2 + kstep;
            if (last && has_next) S.a_ready(nxt);
            PG8_LDB(B0, 0, 0); PG8_SCHED; PG8_LDA(At, 0, 0); PG8_STAGE(PG8_SA(1, 1), a1 + hstep, voffA);
            PG8_WAIT_L(8); PG8_BAR; PG8_WAIT_L(0); PG8_MMA(0, 0, At, B0); PG8_BAR; PG8_SCHED;
            PG8_LDB(B1, 0, 1); PG8_STAGE(PG8_SB(0, 0), b2, voffB);
            PG8_BAR; PG8_WAIT_L(0); PG8_MMA(0, 1, At, B1); PG8_BAR;
            PG8_LDA(At, 0, 1); PG8_STAGE(PG8_SA(0, 0), a2, voffA);
            PG8_BAR; PG8_WAIT_L(0); PG8_MMA(1, 0, At, B0); PG8_BAR; PG8_SCHED;
            PG8_STAGE(PG8_SB(0, 1), b2 + hstep, voffB);
            PG8_WAIT_V(6); PG8_BAR; PG8_MMA(1, 1, At, B1); PG8_BAR;
            PG8_LDB(B0, 1, 0); PG8_SCHED; PG8_LDA(At, 1, 0); PG8_STAGE(PG8_SA(0, 1), a2 + hstep, voffA);
            PG8_WAIT_L(8); PG8_BAR; PG8_WAIT_L(0); PG8_MMA(0, 0, At, B0); PG8_BAR; PG8_SCHED;
            PG8_LDB(B1, 1, 1); PG8_STAGE(PG8_SB(1, 0), b3, voffB);
            PG8_BAR; PG8_WAIT_L(0); PG8_MMA(0, 1, At, B1); PG8_BAR;
            PG8_LDA(At, 1, 1); PG8_STAGE(PG8_SA(1, 0), a3, voffA);
            PG8_BAR; PG8_WAIT_L(0); PG8_MMA(1, 0, At, B0); PG8_BAR; PG8_SCHED;
            PG8_STAGE(PG8_SB(1, 1), b3 + hstep, voffB);
            PG8_WAIT_V(6); PG8_BAR; PG8_MMA(1, 1, At, B1); PG8_BAR;
        }
        PG8_STAMP();
        if constexpr (!Epi::AFTER_DRAIN) { E(acc, cur, wr, wc, fr, fq); S.done(cur); }
        PG8_STAMP();
        if (!has_next) break;
#pragma unroll
        for (int a = 0; a < 2; ++a)
#pragma unroll
            for (int b = 0; b < 2; ++b)
#pragma unroll
                for (int m = 0; m < 4; ++m)
#pragma unroll
                    for (int n = 0; n < 2; ++n) acc[a][b][m][n] = (f32x4){0.f, 0.f, 0.f, 0.f};
        cur = nxt; cA = nA; cB = nB; ++ui;
    }
    PG8_WAIT_V(0);
    if (wr == 0) PG8_BAR;
    PG8_BAR;
    if constexpr (Epi::AFTER_DRAIN) { E.fused(acc, cur, wr, wc, fr, fq, lds, wid, lane); S.done(cur); }
    PG8_STAMP();
    if (STAMP && wid == 0) { stamps[lane] = lane < nts ? (((unsigned long long)(unsigned)ts_hi << 32) | (unsigned)ts_lo) : 0ull;
        if (lane == 62) stamps[62] = rt_entry; if (lane == 63) stamps[63] = (unsigned long long)wall_clock64(); }
#undef PG8_STAMP
#undef PG8_SA
#undef PG8_SB
#undef PG8_STAGE
#undef PG8_LDA
#undef PG8_LDB
#undef PG8_MMA
#undef PG8_WAIT_V
#undef PG8_WAIT_L
#undef PG8_BAR
#undef PG8_SCHED
}
}
#define XB_TMO      128
#define XB_XCNT(j)  (256  + 64 * (j))
#define XB_XSUB(j)  (1280 + 64 * (j))
#define XB_XGEN(j)  (2304 + 64 * (j))
#define XB_TOP      3328
#define XB_TOPGEN   3392
#define XCD_BAR_WORDS 3456
#define XB_SPIN_CAP (1u << 18)
#define LAS __attribute__((address_space(3)))

__device__ __forceinline__ unsigned xb_ld(unsigned* p)              { return __hip_atomic_load(p, __ATOMIC_RELAXED, __HIP_MEMORY_SCOPE_AGENT); }
__device__ __forceinline__ unsigned xb_add(unsigned* p, unsigned v) { return __hip_atomic_fetch_add(p, v, __ATOMIC_RELAXED, __HIP_MEMORY_SCOPE_AGENT); }
__device__ __forceinline__ unsigned xb_xcc_id() { return (unsigned)__builtin_amdgcn_s_getreg((3 << 11) | 20) & 0xFu; }
#define XB_SPIN(cond, bar) do { unsigned _sp = 0; while (cond) { __builtin_amdgcn_s_sleep(1); \
    if ((++_sp & 255u) == 0u) { if (xb_ld(&(bar)[XB_TMO])) break; if (_sp > XB_SPIN_CAP) { atomicAdd(&(bar)[XB_TMO], 1u); break; } } } } while (0)

struct XcdBarrier {
    unsigned* bar; unsigned x;
    volatile LAS unsigned* st;
};

__device__ __forceinline__ XcdBarrier xcd_barrier_post(unsigned* bar, volatile LAS unsigned* st) {
    XcdBarrier b; b.bar = bar; b.x = xb_xcc_id(); b.st = st;
    if (threadIdx.x == 0) (void)xb_add(&bar[XB_XCNT(b.x)], 1u);
    return b;
}
__device__ __forceinline__ void xcd_barrier_complete(unsigned* bar, unsigned x, unsigned& nloc, unsigned& nx) {
    const unsigned G = gridDim.x * gridDim.y * gridDim.z;
    unsigned sum, cnt, mine, sp = 0u;
    for (;;) {
        sum = 0u; cnt = 0u; mine = 0u;
#pragma unroll
        for (unsigned j = 0; j < 16; ++j) { const unsigned c = xb_ld(&bar[XB_XCNT(j)]); sum += c; cnt += (c > 0u) ? 1u : 0u; mine = (j == x) ? c : mine; }
        if (sum == G) break;
        __builtin_amdgcn_s_sleep(1);
        if ((++sp & 255u) == 0u) { if (xb_ld(&bar[XB_TMO])) break; if (sp > XB_SPIN_CAP) { atomicAdd(&bar[XB_TMO], 1u); break; } }
    }
    nloc = mine > 0u ? mine : 1u; nx = cnt > 0u ? cnt : 1u;
}

__device__ __forceinline__ void xcd_barrier(const XcdBarrier& b) {
    asm volatile("s_waitcnt vmcnt(0)" ::: "memory");
    __syncthreads();
    if (threadIdx.x == 0) {
        unsigned* bar = b.bar;
        __builtin_amdgcn_s_waitcnt(0);
        unsigned nloc = b.st[0], nx = b.st[1];
        if (nloc == 0u) { xcd_barrier_complete(bar, b.x, nloc, nx); b.st[0] = nloc; b.st[1] = nx; }
        const unsigned old = xb_add(&bar[XB_XSUB(b.x)], 1u);
        const unsigned gen = old / nloc;
        if (old + 1u == (gen + 1u) * nloc) {
            __builtin_amdgcn_fence(__ATOMIC_RELEASE, "agent");
            asm volatile("s_waitcnt vmcnt(0)" ::: "memory");
            const unsigned og = xb_add(&bar[XB_TOP], 1u);
            const unsigned tg = og / nx;
            if (og + 1u == (tg + 1u) * nx) xb_add(&bar[XB_TOPGEN], 1u);
            else XB_SPIN(xb_ld(&bar[XB_TOPGEN]) == tg, bar);
            __builtin_amdgcn_fence(__ATOMIC_ACQUIRE, "agent");
            xb_add(&bar[XB_XGEN(b.x)], 1u);
            asm volatile("s_waitcnt vmcnt(0)" ::: "memory");
        } else {
            XB_SPIN(xb_ld(&bar[XB_XGEN(b.x)]) == gen, bar);
            __builtin_amdgcn_fence(__ATOMIC_ACQUIRE, "agent");
            asm volatile("s_waitcnt vmcnt(0)" ::: "memory");
        }
    }
    __syncthreads();
}


using pg8::f32x4; using pg8::u32x4; using pg8::Unit; using pg8::Gemm; using pg8::StaticOrder;
typedef unsigned u32x2 __attribute__((ext_vector_type(2)));
#define LDSP PG8_LAS unsigned char*

constexpr int N1 = 10496;
constexpr size_t OW1 = 0, OW2 = OW1 + (size_t)N1 * 1024, OW3 = OW2 + (size_t)1024 * 2048, OW4 = OW3 + (size_t)1024 * 1024, OW5 = OW4 + (size_t)1024 * 1024,
                 OW6 = OW5 + (size_t)8192 * 1024, OW7 = OW6 + (size_t)1024 * 4096, OW8 = OW7 + (size_t)1024 * 256, WT_LAYER = OW8 + (size_t)1024 * 1024;
constexpr int NCHUNK = 256 + DEC_BATCH;

struct Params {
    const float *x_prompt, *x_sample, *state_ssd_conv, *state_ssd, *cache_k, *cache_v, *state_ffn_conv, *p_prompt, *p_sample;
    const float *norm_pre_mix, *w_in, *ssd_conv_w, *ssd_conv_b, *ssd_dt_bias, *ssd_a_log, *ssd_d, *ssd_norm, *w_br_ssd, *w_br_sb, *w_out, *norm_post_mix, *norm_pre_ffn,
                *w_up, *ffn_conv_w, *ffn_conv_b, *w_down, *norm_post_ffn, *w_ple, *w_ple_gate, *norm_ple;
    float* out;
    unsigned* bar;
    bf16_t* wt; bf16_t* xr; bf16_t* xb; float* rs; float* rs2; bf16_t* pb;
    bf16_t *zb, *xbcb, *qb, *gb, *kb, *vb; float* dtb;
    float* sst; float* dec; bf16_t* hpb;
    bf16_t *yn, *att, *t1, *mixin; bf16_t* mixed;
    bf16_t *gh, *xh, *ffb; bf16_t* down; bf16_t* plea; bf16_t* ple;
};

typedef const __attribute__((address_space(4))) Params CP;
#define CPR CP&
__device__ __forceinline__ CP* kargs() { CP* q = (CP*)__builtin_amdgcn_kernarg_segment_ptr(); asm volatile("" : "+s"(q)); return q; }

__device__ __forceinline__ void wt_item(const float* __restrict__ W, int K, int ldw, const float* __restrict__ gain, bf16_t* __restrict__ Wt, int nblk, int item, int w1map, PG8_LAS float* scr, int lane) {
    const int kb = item / nblk, nb = item % nblk, k0 = 64 * kb, n0 = 32 * nb;
    int sc0 = n0; if (w1map == 1) sc0 = (n0 < 5120) ? n0 : (n0 < 10240 ? n0 + 32 : (n0 < 10272 ? n0 - 5120 : -1));
    else if (w1map == 2) sc0 = ((n0 & 255) < 128 ? 0 : 4096) + (n0 >> 8) * 128 + (n0 & 127);
    const int kr = lane >> 3, c4 = (lane & 7) * 4;
    float4 v[8];
#pragma unroll
    for (int i = 0; i < 8; ++i) v[i] = (sc0 >= 0) ? *(const float4*)(W + (size_t)(k0 + kr + 8 * i) * ldw + sc0 + c4) : make_float4(0.f, 0.f, 0.f, 0.f);
#pragma unroll
    for (int i = 0; i < 8; ++i) { const int kk = kr + 8 * i; const float gm = gain ? gain[k0 + kk] : 1.0f; PG8_LAS float* d = scr + kk * 33 + c4;
        d[0] = v[i].x * gm; d[1] = v[i].y * gm; d[2] = v[i].z * gm; d[3] = v[i].w * gm; }
    asm volatile("s_waitcnt lgkmcnt(0)" ::: "memory");
    const int c = lane & 7;
#pragma unroll
    for (int j = 0; j < 4; ++j) { const int nn = (lane >> 3) + 8 * j; const PG8_LAS float* s = scr + (8 * c) * 33 + nn;
        *(u32x4*)(Wt + (size_t)(n0 + nn) * K + k0 + 8 * c) = (u32x4){pk2(s[0], s[33]), pk2(s[2 * 33], s[3 * 33]), pk2(s[4 * 33], s[5 * 33]), pk2(s[6 * 33], s[7 * 33])}; }
    asm volatile("s_waitcnt lgkmcnt(0)" ::: "memory");
}
__device__ __forceinline__ void ph_wt(CPR p, LDSP lds) {
    constexpr int U1 = 16 * 328, U2 = U1 + 32 * 32, U3 = U2 + 512, U4 = U3 + 512, U5 = U4 + 16 * 256, U6 = U5 + 64 * 32, U7 = U6 + 4 * 32, U8 = U7 + 512;
    const int tidx = tid_opaque(), lane = tidx & 63, wv = tidx >> 6, gw = bid_opaque() * 8 + wv, NGW = nblk_opaque() * 8;
    PG8_LAS float* scr = (PG8_LAS float*)(lds + wv * (64 * 33 * 4));
    for (int u = gw; u < DEPTH * U8; u += NGW) {
        const int l = u / U8; int v = u % U8; bf16_t* wl = p.wt + (size_t)l * WT_LAYER;
        if (v < U1)      { wt_item(p.w_in + (size_t)l * 1024 * IN_DIM, 1024, IN_DIM, p.norm_pre_mix + l * 1024, wl + OW1, 328, v, 1, scr, lane); }
        else if (v < U2) { v -= U1; wt_item(p.w_br_ssd + (size_t)l * 2048 * 1024, 2048, 1024, p.ssd_norm + l * 2048, wl + OW2, 32, v, 0, scr, lane); }
        else if (v < U3) { v -= U2; wt_item(p.w_br_sb + (size_t)l * 1024 * 1024, 1024, 1024, nullptr, wl + OW3, 32, v, 0, scr, lane); }
        else if (v < U4) { v -= U3; wt_item(p.w_out + (size_t)l * 1024 * 1024, 1024, 1024, nullptr, wl + OW4, 32, v, 0, scr, lane); }
        else if (v < U5) { v -= U4; wt_item(p.w_up + (size_t)l * 1024 * 8192, 1024, 8192, p.norm_pre_ffn + l * 1024, wl + OW5, 256, v, 2, scr, lane); }
        else if (v < U6) { v -= U5; wt_item(p.w_down + (size_t)l * 4096 * 1024, 4096, 1024, nullptr, wl + OW6, 32, v, 0, scr, lane); }
        else if (v < U7) { v -= U6; wt_item(p.w_ple + (size_t)l * 256 * 1024, 256, 1024, nullptr, wl + OW7, 32, v, 0, scr, lane); }
        else             { v -= U7; wt_item(p.w_ple_gate + (size_t)l * 1024 * 1024, 1024, 1024, nullptr, wl + OW8, 32, v, 0, scr, lane); }
    }
    __syncthreads();
}
__device__ __forceinline__ void ph_xprep(CPR p) {
    const int tidx = tid_opaque(); const int lane = tidx & 63, gw = bid_opaque() * 8 + (tidx >> 6), NGW = nblk_opaque() * 8;
    for (int row0 = 2 * gw; row0 < M_ALL; row0 += 2 * NGW) {
        float4 v[2][4]; float ss[2] = {0.f, 0.f};
#pragma unroll
        for (int q = 0; q < 2; ++q) { const int row = row0 + q; const float4* src = (const float4*)(row < M_P ? p.x_prompt + (size_t)row * 1024 : p.x_sample + (size_t)(row - M_P) * 1024);
#pragma unroll
            for (int j = 0; j < 4; ++j) v[q][j] = src[lane + 64 * j]; }
#pragma unroll
        for (int q = 0; q < 2; ++q) { const int row = row0 + q;
#pragma unroll
            for (int j = 0; j < 4; ++j) { ss[q] += v[q][j].x * v[q][j].x + v[q][j].y * v[q][j].y + v[q][j].z * v[q][j].z + v[q][j].w * v[q][j].w;
                ((u32x2*)(p.xr + (size_t)row * 1024))[lane + 64 * j] = (u32x2){pk2(v[q][j].x, v[q][j].y), pk2(v[q][j].z, v[q][j].w)}; }
            const float rn = rsqrtf(wave_sum(ss[q]) * (1.0f / 1024.f) + EPS);
#pragma unroll
            for (int j = 0; j < 4; ++j) ((u32x2*)(p.xb + (size_t)row * 1024))[lane + 64 * j] = (u32x2){pk2(v[q][j].x * rn, v[q][j].y * rn), pk2(v[q][j].z * rn, v[q][j].w * rn)}; }
    }
    for (int r0 = 4 * gw; r0 < DEPTH * M_ALL; r0 += 4 * NGW) {
        float4 v[4];
#pragma unroll
        for (int q = 0; q < 4; ++q) { const int r2 = r0 + q, l = r2 / M_ALL, row = r2 % M_ALL;
            v[q] = ((const float4*)(row < M_P ? p.p_prompt + ((size_t)l * M_P + row) * PLE_DIM : p.p_sample + ((size_t)l * M_S + row - M_P) * PLE_DIM))[lane]; }
#pragma unroll
        for (int q = 0; q < 4; ++q) ((u32x2*)(p.pb + (size_t)(r0 + q) * PLE_DIM))[lane] = (u32x2){pk2(v[q].x, v[q].y), pk2(v[q].z, v[q].w)};
    }
}
__device__ __forceinline__ void ph_norm(const bf16_t* __restrict__ src, const float* __restrict__ gain, bf16_t* xr, bf16_t* xb, float* yP, float* yS, bf16_t* xh = nullptr) {
    const int tidx = tid_opaque(); const int lane = tidx & 63, gw = bid_opaque() * 8 + (tidx >> 6), NGW = nblk_opaque() * 8;
    float4 g[4];
#pragma unroll
    for (int j = 0; j < 4; ++j) g[j] = ((const float4*)gain)[lane + 64 * j];
    for (int row0 = 2 * gw; row0 < M_ALL; row0 += 2 * NGW) {
        u32x2 sv[2][4], xv[2][4];
#pragma unroll
        for (int q = 0; q < 2; ++q)
#pragma unroll
            for (int j = 0; j < 4; ++j) { sv[q][j] = ((const u32x2*)(src + (size_t)(row0 + q) * 1024))[lane + 64 * j]; xv[q][j] = ((const u32x2*)(xr + (size_t)(row0 + q) * 1024))[lane + 64 * j]; }
#pragma unroll
        for (int q = 0; q < 2; ++q) {
            const int row = row0 + q;
            float4 v[4], x[4]; float ss = 0.f;
#pragma unroll
            for (int j = 0; j < 4; ++j) { v[j] = make_float4(bflo(sv[q][j].x), bfhi(sv[q][j].x), bflo(sv[q][j].y), bfhi(sv[q][j].y)); x[j] = make_float4(bflo(xv[q][j].x), bfhi(xv[q][j].x), bflo(xv[q][j].y), bfhi(xv[q][j].y));
                ss += v[j].x * v[j].x + v[j].y * v[j].y + v[j].z * v[j].z + v[j].w * v[j].w; }
            ss = wave_sum(ss);
            const float r = rsqrtf(ss * (1.0f / 1024.f) + EPS); float s2 = 0.f;
#pragma unroll
            for (int j = 0; j < 4; ++j) {
                x[j].x += v[j].x * r * g[j].x; x[j].y += v[j].y * r * g[j].y; x[j].z += v[j].z * r * g[j].z; x[j].w += v[j].w * r * g[j].w;
                s2 += x[j].x * x[j].x + x[j].y * x[j].y + x[j].z * x[j].z + x[j].w * x[j].w;
                ((u32x2*)(xr + (size_t)row * 1024))[lane + 64 * j] = (u32x2){pk2(x[j].x, x[j].y), pk2(x[j].z, x[j].w)};
            }
            if (xb) {
                const float rn = rsqrtf(wave_sum(s2) * (1.0f / 1024.f) + EPS);
#pragma unroll
                for (int j = 0; j < 4; ++j) {
                    const u32x2 wq = (u32x2){pk2(x[j].x * rn, x[j].y * rn), pk2(x[j].z * rn, x[j].w * rn)};
                    ((u32x2*)(xb + (size_t)row * 1024))[lane + 64 * j] = wq;
                    if (xh && (row & 63) >= 62) ((u32x2*)(xh + (size_t)(2 * ((row >> 6) + 1) + (row & 63) - 62) * 1024))[lane + 64 * j] = wq;
                }
            }
            if (yP) { float4* y4 = (float4*)(row < M_P ? yP + (size_t)row * 1024 : yS + (size_t)(row - M_P) * 1024);
#pragma unroll
                for (int j = 0; j < 4; ++j) y4[lane + 64 * j] = x[j]; }
        }
    }
}
__device__ __forceinline__ void unpack8(const u32x4 w, float (&v)[8]) {
    v[0] = bflo(w.x); v[1] = bfhi(w.x); v[2] = bflo(w.y); v[3] = bfhi(w.y); v[4] = bflo(w.z); v[5] = bfhi(w.z); v[6] = bflo(w.w); v[7] = bfhi(w.w);
}
__device__ __forceinline__ void load8f(const float* p, float (&v)[8]) { const float4 a = ((const float4*)p)[0], b = ((const float4*)p)[1]; v[0] = a.x; v[1] = a.y; v[2] = a.z; v[3] = a.w; v[4] = b.x; v[5] = b.y; v[6] = b.z; v[7] = b.w; }
__device__ __forceinline__ float gelu_fast(float x) { const float u2 = 1.5957691216057308f * (x + 0.044715f * x * x * x); return x * __builtin_amdgcn_rcpf(1.0f + __expf(-u2)); }
struct EpiIn {
    static constexpr bool PERM = true, AFTER_DRAIN = false;
    const float* rs; bf16_t *zb, *xbcb, *qb, *gb, *kb, *vb; float* dtb; const float* dt_bias; float *kP, *vP, *kS, *vS, *convP, *convS;
    __device__ __forceinline__ void operator()(const f32x4 (&acc)[2][2][4][2], const Unit& u, int wr, int wc, int fr, int fq) const {
        const int row0 = u.pm * 256 + wr * 64 + fr, seg = u.pn, cl = wc * 32 + 8 * fq;
#pragma unroll
        for (int ai = 0; ai < 2; ++ai)
#pragma unroll
            for (int m = 0; m < 4; ++m) {
                const int r = row0 + ai * 128 + m * 16;
#pragma unroll
                for (int bj = 0; bj < 2; ++bj) {
                    const int ct = cl + bj * 128; const f32x4 v0 = acc[ai][bj][m][0], v1 = acc[ai][bj][m][1];
                    const u32x4 w = (u32x4){pk2c(v0[0], v0[1]), pk2c(v0[2], v0[3]), pk2c(v1[0], v1[1]), pk2c(v1[2], v1[3])};
                    if (seg < 8) { *(u32x4*)(zb + (size_t)r * 2048 + seg * 256 + ct) = w; }
                    else if (seg < 20) {
                        const int c = (seg - 8) * 256 + ct; *(u32x4*)(xbcb + (size_t)r * 3072 + c) = w;
                        float* dst = nullptr;
                        if (r < M_P) { if (r >= M_P - 3) dst = convP + (size_t)(r - (M_P - 3)) * 3072; }
                        else { const int t = (r - M_P) & 31, b = (r - M_P) >> 5; if (t >= 29) dst = convS + ((size_t)b * 3 + (t - 29)) * 3072; }
                        if (dst) { *(f32x4*)(dst + c) = v0; *(f32x4*)(dst + c + 4) = v1; }
                    }
                    else if (seg < 24) { *(u32x4*)(qb + (size_t)r * 1024 + (seg - 20) * 256 + ct) = w; }
                    else if (seg < 32) {
                        const int c = ((seg - 24) & 3) * 256 + ct; const bool isk = seg < 28;
                        float* dst = (r < M_P) ? (isk ? kP : vP) + (size_t)r * 1024 : (isk ? kS : vS) + (size_t)(r - M_P) * 1024;
                        *(f32x4*)(dst + c) = v0; *(f32x4*)(dst + c + 4) = v1;
                        *(u32x4*)((isk ? kb : vb) + (size_t)r * 1024 + c) = w;
                    }
                    else if (seg < 40) {
                        const f32x2_t s0 = sigmoid2((f32x2_t){v0[0], v0[1]}), s1 = sigmoid2((f32x2_t){v0[2], v0[3]}), s2 = sigmoid2((f32x2_t){v1[0], v1[1]}), s3 = sigmoid2((f32x2_t){v1[2], v1[3]});
                        *(u32x4*)(gb + (size_t)r * 2048 + (seg - 32) * 256 + ct) = (u32x4){pk2(s0.x, s0.y), pk2(s1.x, s1.y), pk2(s2.x, s2.y), pk2(s3.x, s3.y)};
                    }
                    else if (wc == 0 && bj == 0) {
                        const f32x4 b0 = *(const f32x4*)(dt_bias + 8 * fq), b1 = *(const f32x4*)(dt_bias + 8 * fq + 4);
                        f32x4 o0, o1;
#pragma unroll
                        for (int j = 0; j < 4; ++j) { o0[j] = softplusf_(v0[j] + b0[j]); o1[j] = softplusf_(v1[j] + b1[j]); }
                        *(f32x4*)(dtb + (size_t)r * 32 + 8 * fq) = o0; *(f32x4*)(dtb + (size_t)r * 32 + 8 * fq + 4) = o1;
                    }
                }
            }
    }
};
struct EpiHalo {
    static constexpr bool PERM = true, AFTER_DRAIN = false;
    const float* rs; bf16_t* gh;
    __device__ __forceinline__ void elem(int hi, int ch, float v) const { gh[(size_t)hi * D_FF + ch] = f2bf(v); }
    __device__ __forceinline__ void operator()(const f32x4 (&acc)[2][2][4][2], const Unit& u, int wr, int wc, int fr, int fq) const {
        const int row0 = u.pm * 256 + wr * 64 + fr, c0 = u.pn * 128 + wc * 32 + 8 * fq;
#pragma unroll
        for (int ai = 0; ai < 2; ++ai)
#pragma unroll
            for (int m = 0; m < 4; ++m) {
                const int hi = row0 + ai * 128 + m * 16;
                const f32x4 v0 = acc[ai][0][m][0], v1 = acc[ai][0][m][1];
                *(u32x4*)(gh + (size_t)hi * D_FF + c0) = (u32x4){pk2c(v0[0], v0[1]), pk2c(v0[2], v0[3]), pk2c(v1[0], v1[1]), pk2c(v1[2], v1[3])};
            }
    }
};
struct EpiUpAct {
    static constexpr bool PERM = true, AFTER_DRAIN = false;
    const float* rs; const bf16_t* gh; bf16_t* ffb; float *ffnP, *ffnS; const float* cw; const float* cb; const float* hist;
    __device__ __forceinline__ void operator()(const f32x4 (&acc)[2][2][4][2], const Unit& u, int wr, int wc, int fr, int fq) const {
        const int c0 = u.pn * 128 + wc * 32 + 8 * fq;
        float w0[8], w1[8], w2[8], bb[8];
        load8f(cw + c0, w0); load8f(cw + D_FF + c0, w1); load8f(cw + 2 * D_FF + c0, w2); load8f(cb + c0, bb);
#pragma unroll
        for (int ai = 0; ai < 2; ++ai) {
            const int strip = 4 * u.pm + 2 * ai + wr;
            float gprev[8];
#pragma unroll
            for (int m = 0; m < 4; ++m) {
                const int r = strip * 64 + 16 * m + fr;
                float g[8], uv[8], p1[8], p2[8];
#pragma unroll
                for (int j = 0; j < 4; ++j) { g[j] = acc[ai][0][m][0][j]; g[4 + j] = acc[ai][0][m][1][j]; uv[j] = acc[ai][1][m][0][j]; uv[4 + j] = acc[ai][1][m][1][j]; }
                if (m == 0) { float e14[8], e15[8]; unpack8(*(const u32x4*)(gh + (size_t)(2 * strip) * D_FF + c0), e14); unpack8(*(const u32x4*)(gh + (size_t)(2 * strip + 1) * D_FF + c0), e15);
#pragma unroll
                    for (int j = 0; j < 8; ++j) gprev[j] = (fr == 15) ? e15[j] : e14[j]; }
#pragma unroll
                for (int j = 0; j < 8; ++j) {
                    const float c1 = (fr == 15) ? gprev[j] : g[j], c2 = (fr >= 14) ? gprev[j] : g[j];
                    p1[j] = __builtin_bit_cast(float, __builtin_amdgcn_update_dpp(0, __builtin_bit_cast(int, c1), 0x121, 0xf, 0xf, false));
                    p2[j] = __builtin_bit_cast(float, __builtin_amdgcn_update_dpp(0, __builtin_bit_cast(int, c2), 0x122, 0xf, 0xf, false));
                }
                const int t = (r < M_P) ? r : ((r - M_P) & 31);
                if (t < 2) {
                    float h0[8], h1[8];
                    if (r >= M_P) { const float* hp = hist + (size_t)((r - M_P) >> 5) * 2 * D_FF + c0; load8f(hp, h0); load8f(hp + D_FF, h1); }
                    else {
#pragma unroll
                        for (int j = 0; j < 8; ++j) { h0[j] = 0.f; h1[j] = 0.f; } }
#pragma unroll
                    for (int j = 0; j < 8; ++j) { if (t == 0) { p2[j] = h0[j]; p1[j] = h1[j]; } else { p2[j] = h1[j]; } }
                }
                float o[8];
#pragma unroll
                for (int j = 0; j < 8; j += 2) {
                    const f32x2_t a = (f32x2_t){bb[j], bb[j + 1]} + (f32x2_t){w0[j], w0[j + 1]} * (f32x2_t){p2[j], p2[j + 1]} + (f32x2_t){w1[j], w1[j + 1]} * (f32x2_t){p1[j], p1[j + 1]} + (f32x2_t){w2[j], w2[j + 1]} * (f32x2_t){g[j], g[j + 1]};
                    const f32x2_t ov = gelu2(a) * (f32x2_t){uv[j], uv[j + 1]}; o[j] = ov.x; o[j + 1] = ov.y; }
                *(u32x4*)(ffb + (size_t)r * D_FF + c0) = (u32x4){pk2(o[0], o[1]), pk2(o[2], o[3]), pk2(o[4], o[5]), pk2(o[6], o[7])};
                float* dst = nullptr;
                if (r < M_P) { if (r >= M_P - 2) dst = ffnP + (size_t)(r - (M_P - 2)) * D_FF; }
                else { const int b = (r - M_P) >> 5; if (t >= 30) dst = ffnS + ((size_t)b * 2 + (t - 30)) * D_FF; }
                if (dst) { *(f32x4*)(dst + c0) = (f32x4){g[0], g[1], g[2], g[3]}; *(f32x4*)(dst + c0 + 4) = (f32x4){g[4], g[5], g[6], g[7]}; }
#pragma unroll
                for (int j = 0; j < 8; ++j) gprev[j] = g[j];
            }
        }
    }
};
struct EpiBr {
    static constexpr bool PERM = true, AFTER_DRAIN = false;
    const bf16_t* gb; const bf16_t* t1in; bf16_t* dst; int mode; int pad;
    __device__ __forceinline__ void elem(int r, int c, float v) const {
        float o = bf2f(gb[(size_t)r * 2048 + (mode == 0 ? 1024 : 0) + c]) * v; if (mode == 1) o += bf2f(t1in[(size_t)r * 1024 + c]);
        dst[(size_t)r * 1024 + c] = f2bf(o); }
    __device__ __forceinline__ void operator()(const f32x4 (&acc)[2][2][4][2], const Unit& u, int wr, int wc, int fr, int fq) const {
        const int row0 = u.pm * 256 + wr * 64 + fr, cl = u.pn * 256 + wc * 32 + 8 * fq;
#pragma unroll
        for (int ai = 0; ai < 2; ++ai)
#pragma unroll
            for (int m = 0; m < 4; ++m) {
                const int r = row0 + ai * 128 + m * 16;
#pragma unroll
                for (int bj = 0; bj < 2; ++bj) {
                    const int c = cl + bj * 128; float g[8], o[8];
                    unpack8(*(const u32x4*)(gb + (size_t)r * 2048 + (mode == 0 ? 1024 : 0) + c), g);
                    const f32x4 v0 = acc[ai][bj][m][0], v1 = acc[ai][bj][m][1];
                    float tv[8];
                    if (mode == 1) unpack8(*(const u32x4*)(t1in + (size_t)r * 1024 + c), tv);
                    else {
#pragma unroll
                        for (int j = 0; j < 8; ++j) tv[j] = 0.f; }
#pragma unroll
                    for (int j = 0; j < 4; j += 2) {
                        const f32x2_t oa = (f32x2_t){g[j], g[j + 1]} * (f32x2_t){v0[j], v0[j + 1]} + (f32x2_t){tv[j], tv[j + 1]}, ob = (f32x2_t){g[4 + j], g[5 + j]} * (f32x2_t){v1[j], v1[j + 1]} + (f32x2_t){tv[4 + j], tv[5 + j]};
                        o[j] = oa.x; o[j + 1] = oa.y; o[4 + j] = ob.x; o[5 + j] = ob.y; }
                    *(u32x4*)(dst + (size_t)r * 1024 + c) = (u32x4){pk2(o[0], o[1]), pk2(o[2], o[3]), pk2(o[4], o[5]), pk2(o[6], o[7])};
                }
            }
    }
};
struct EpiPlain {
    static constexpr bool PERM = true, AFTER_DRAIN = false;
    bf16_t* dst;
    __device__ __forceinline__ void elem(int r, int c, float v) const { dst[(size_t)r * 1024 + c] = f2bf(v); }
    __device__ __forceinline__ void operator()(const f32x4 (&acc)[2][2][4][2], const Unit& u, int wr, int wc, int fr, int fq) const {
        const int row0 = u.pm * 256 + wr * 64 + fr, cl = u.pn * 256 + wc * 32 + 8 * fq;
#pragma unroll
        for (int ai = 0; ai < 2; ++ai)
#pragma unroll
            for (int m = 0; m < 4; ++m) {
                const int r = row0 + ai * 128 + m * 16;
#pragma unroll
                for (int bj = 0; bj < 2; ++bj) { const f32x4 v0 = acc[ai][bj][m][0], v1 = acc[ai][bj][m][1];
                    *(u32x4*)(dst + (size_t)r * 1024 + cl + bj * 128) = (u32x4){pk2c(v0[0], v0[1]), pk2c(v0[2], v0[3]), pk2c(v1[0], v1[1]), pk2c(v1[2], v1[3])}; }
            }
    }
};
struct EpiF32Out {
    static constexpr bool PERM = true, AFTER_DRAIN = false;
    bf16_t* dst;
    __device__ __forceinline__ void elem(int r, int c, float v) const { dst[(size_t)r * 1024 + c] = f2bf(v); }
    __device__ __forceinline__ void operator()(const f32x4 (&acc)[2][2][4][2], const Unit& u, int wr, int wc, int fr, int fq) const {
        const int row0 = u.pm * 256 + wr * 64 + fr, cl = u.pn * 256 + wc * 32 + 8 * fq;
#pragma unroll
        for (int ai = 0; ai < 2; ++ai)
#pragma unroll
            for (int m = 0; m < 4; ++m) {
                const int r = row0 + ai * 128 + m * 16;
#pragma unroll
                for (int bj = 0; bj < 2; ++bj) { const f32x4 v0 = acc[ai][bj][m][0], v1 = acc[ai][bj][m][1];
                    *(u32x4*)(dst + (size_t)r * 1024 + cl + bj * 128) = (u32x4){pk2c(v0[0], v0[1]), pk2c(v0[2], v0[3]), pk2c(v1[0], v1[1]), pk2c(v1[2], v1[3])}; }
            }
    }
};
struct EpiPle {
    static constexpr bool PERM = false, AFTER_DRAIN = false;
    const bf16_t* plea; bf16_t* dst;
    __device__ __forceinline__ void elem(int r, int c, float v) const { dst[(size_t)r * 1024 + c] = f2bf(bf2f(plea[(size_t)r * 1024 + c]) * sigmoidf_(v)); }
    __device__ __forceinline__ void operator()(const f32x4 (&acc)[2][2][4][2], const Unit& u, int wr, int wc, int fr, int fq) const {
        const int row0 = u.pm * 256 + wr * 64 + fr, col0 = u.pn * 256 + wc * 32 + 4 * fq;
#pragma unroll
        for (int ai = 0; ai < 2; ++ai)
#pragma unroll
            for (int m = 0; m < 4; ++m) { const size_t ro = (size_t)(row0 + ai * 128 + m * 16) * 1024 + col0;
#pragma unroll
                for (int bj = 0; bj < 2; ++bj)
#pragma unroll
                    for (int n = 0; n < 2; ++n) { const u32x2 a = *(const u32x2*)(plea + ro + bj * 128 + n * 16); const f32x4 v = acc[ai][bj][m][n];
                        const f32x2_t o0 = (f32x2_t){bflo(a.x), bfhi(a.x)} * sigmoid2((f32x2_t){v[0], v[1]}), o1 = (f32x2_t){bflo(a.y), bfhi(a.y)} * sigmoid2((f32x2_t){v[2], v[3]});
                        *(u32x2*)(dst + ro + bj * 128 + n * 16) = (u32x2){pk2(o0.x, o0.y), pk2(o1.x, o1.y)}; } }
    }
};

typedef short bf16x8 __attribute__((ext_vector_type(8)));
typedef float f32x16 __attribute__((ext_vector_type(16)));
typedef short bf16x4 __attribute__((ext_vector_type(4)));
#define MFMA32(a, b, c) __builtin_amdgcn_mfma_f32_32x32x16_bf16((a), (b), (c), 0, 0, 0)
__device__ __forceinline__ f32x16 zero16() { f32x16 z;
#pragma unroll
    for (int i = 0; i < 16; ++i) z[i] = 0.f; return z; }
__device__ __forceinline__ bf16x8 pack8f(const float (&v)[8]) { const u32x4 w = (u32x4){pk2(v[0], v[1]), pk2(v[2], v[3]), pk2(v[4], v[5]), pk2(v[6], v[7])}; return __builtin_bit_cast(bf16x8, w); }
__device__ __forceinline__ bf16x8 join44(bf16x4 lo, bf16x4 hi) { return __builtin_shufflevector(lo, hi, 0, 1, 2, 3, 4, 5, 6, 7); }

constexpr int PX = 72;
constexpr int PR = 136;
constexpr int L_XT = 0;
constexpr int L_B = L_XT + 8 * 64 * PX * 2;
constexpr int L_C = L_B + 128 * PX * 2;
constexpr int L_AC = L_C + 64 * PR * 2;
constexpr int L_DT = L_AC + 2048;
constexpr int L_WS = L_DT + 2048;
constexpr int ZP = 1040;
constexpr int SSD_LDS = L_WS + 2048;

struct ChunkInfo { int seqbase, row0, t0, nvalid; const float* hist; };
__device__ __forceinline__ ChunkInfo chunk_info(CPR p, int l, int ck) {
    ChunkInfo c;
    if (ck < 256) { c.seqbase = 0; c.row0 = 64 * ck; c.t0 = 64 * ck; c.nvalid = 64; c.hist = nullptr; }
    else { const int b = ck - 256; c.seqbase = M_P + 32 * b; c.row0 = c.seqbase; c.t0 = 0; c.nvalid = 32; c.hist = p.state_ssd_conv + ((size_t)l * DEC_BATCH + b) * 3 * 3072; }
    return c;
}
template <int NP> __device__ __forceinline__ void xbc_pad_raw(const bf16_t* __restrict__ xbcb, const float* __restrict__ hist, int rowbase, int hj, int c, unsigned (&d)[NP]) {
    if (hj >= 3) { const bf16_t* q = xbcb + (size_t)(rowbase + hj - 3) * 3072 + c;
        if (NP == 4) { const u32x4 t = *(const u32x4*)q; d[0] = t.x; d[1 % NP] = t.y; d[2 % NP] = t.z; d[3 % NP] = t.w; }
        else if (NP == 2) { const u32x2 t = *(const u32x2*)q; d[0] = t.x; d[1 % NP] = t.y; }
        else d[0] = *(const unsigned*)q; }
    else if (hist) {
#pragma unroll
        for (int k = 0; k < NP; ++k) { const float2 t = *(const float2*)(hist + (size_t)hj * 3072 + c + 2 * k); d[k] = pk2(t.x, t.y); } }
    else {
#pragma unroll
        for (int k = 0; k < NP; ++k) d[k] = 0u; }
}
__device__ __forceinline__ int xt_off(int R, int g) { return R * (PX * 2) + ((g ^ ((R >> 3) & 7)) << 4); }
template <int NP, class F> __device__ __forceinline__ void conv8(CPR p, int l, const ChunkInfo& ci, int s0, int c, F emit) {
    if (s0 >= ci.nvalid) {
        const float z[8] = {0.f, 0.f, 0.f, 0.f, 0.f, 0.f, 0.f, 0.f};
#pragma unroll
        for (int jp = 0; jp < NP; ++jp) emit(jp, z, z);
        return;
    }
    const float* cw = p.ssd_conv_w + (size_t)l * 4 * 3072 + c; const float* cb = p.ssd_conv_b + (size_t)l * 3072 + c;
    const int t = ci.t0 + s0;
    unsigned raw[11][NP];
#pragma unroll
    for (int k = 0; k < 11; ++k) xbc_pad_raw<NP>(p.xbcb, ci.hist, ci.seqbase, t + k, c, raw[k]);
#pragma unroll
    for (int jp = 0; jp < NP; ++jp) {
        const f32x2_t w0 = *(const f32x2_t*)(cw + 2 * jp), w1 = *(const f32x2_t*)(cw + 3072 + 2 * jp), w2 = *(const f32x2_t*)(cw + 2 * 3072 + 2 * jp), w3 = *(const f32x2_t*)(cw + 3 * 3072 + 2 * jp), bb = *(const f32x2_t*)(cb + 2 * jp);
        f32x2_t rv[11];
#pragma unroll
        for (int k = 0; k < 11; ++k) rv[k] = (f32x2_t){bflo(raw[k][jp]), bfhi(raw[k][jp])};
        float lo[8], hi[8];
#pragma unroll
        for (int i = 0; i < 8; ++i) {
            const f32x2_t a = bb + w0 * rv[i] + w1 * rv[i + 1] + w2 * rv[i + 2] + w3 * rv[i + 3];
            const f32x2_t sv = silu2(a);
            lo[i] = sv.x; hi[i] = sv.y;
        }
        emit(jp, lo, hi);
    }
}
__device__ __forceinline__ float unit_dt(CPR p, int l, int u, int wid, int lane) {
    const ChunkInfo ci = chunk_info(p, l, u >> 2);
    return (lane < ci.nvalid) ? p.dtb[(size_t)(ci.row0 + lane) * 32 + (u & 3) * 8 + wid] : 0.f;
}
__device__ __forceinline__ void head_scan(CPR p, int l, int h, int lane, float dtv, float& ac, float& aclast) {
    const float a = -__expf(p.ssd_a_log[l * 32 + h]);
    ac = dtv * a;
#pragma unroll
    for (int o = 1; o < 64; o <<= 1) { const float t = __shfl_up(ac, o); if (lane >= o) ac += t; }
    aclast = __shfl(ac, 63);
}
__device__ __forceinline__ void ph_ssd_p1(CPR p, int l, LDSP lds) {
    const int tid = tid_opaque(), wid = tid >> 6, lane = tid & 63, r = lane & 31, hh = lane >> 5;
    PG8_LAS float* acS = (PG8_LAS float*)(lds + L_AC); PG8_LAS float* wS = (PG8_LAS float*)(lds + L_WS);
    PG8_LAS bf16_t* xT = (PG8_LAS bf16_t*)(lds + L_XT); PG8_LAS bf16_t* BT = (PG8_LAS bf16_t*)(lds + L_B);
    const int u0 = bid_opaque(), nb = nblk_opaque();
    float dt_nx = (u0 < NCHUNK * 4) ? unit_dt(p, l, u0, wid, lane) : 0.f;
    for (int u = u0; u < NCHUNK * 4; u += nb) {
        const int ck = u >> 2, g = u & 3, h = g * 8 + wid;
        const ChunkInfo ci = chunk_info(p, l, ck);
        const float dtv = dt_nx; float ac, aclast; head_scan(p, l, h, lane, dtv, ac, aclast);
        dt_nx = (u + nb < NCHUNK * 4) ? unit_dt(p, l, u + nb, wid, lane) : 0.f;
        wS[wid * 64 + lane] = __expf(aclast - ac) * dtv;
        if (lane == 63) p.dec[ck * 32 + h] = __expf(aclast);
        __syncthreads();
        { const int cc = tid & 63, s0 = (tid >> 6) * 8, g8 = s0 >> 3, hl = cc >> 3, p0 = (cc & 7) * 8;
          float wv[8];
#pragma unroll
          for (int i = 0; i < 8; ++i) wv[i] = wS[hl * 64 + s0 + i];
          conv8<4>(p, l, ci, s0, g * 512 + cc * 8, [&](int jp, const float (&lo)[8], const float (&hi)[8]) {
              const int R = hl * 64 + p0 + 2 * jp;
              *(PG8_LAS u32x4*)(lds + L_XT + xt_off(R, g8)) = (u32x4){pk2(lo[0] * wv[0], lo[1] * wv[1]), pk2(lo[2] * wv[2], lo[3] * wv[3]), pk2(lo[4] * wv[4], lo[5] * wv[5]), pk2(lo[6] * wv[6], lo[7] * wv[7])};
              *(PG8_LAS u32x4*)(lds + L_XT + xt_off(R + 1, g8)) = (u32x4){pk2(hi[0] * wv[0], hi[1] * wv[1]), pk2(hi[2] * wv[2], hi[3] * wv[3]), pk2(hi[4] * wv[4], hi[5] * wv[5]), pk2(hi[6] * wv[6], hi[7] * wv[7])}; }); }
        { const int q = tid & 63, s0 = (tid >> 6) * 8, g8 = s0 >> 3, n0 = 2 * q;
          conv8<1>(p, l, ci, s0, 2048 + g * 128 + n0, [&](int jp, const float (&lo)[8], const float (&hi)[8]) {
              *(PG8_LAS u32x4*)(lds + L_B + xt_off(n0, g8)) = (u32x4){pk2(lo[0], lo[1]), pk2(lo[2], lo[3]), pk2(lo[4], lo[5]), pk2(lo[6], lo[7])};
              *(PG8_LAS u32x4*)(lds + L_B + xt_off(n0 + 1, g8)) = (u32x4){pk2(hi[0], hi[1]), pk2(hi[2], hi[3]), pk2(hi[4], hi[5]), pk2(hi[6], hi[7])}; }); }
        __syncthreads();
        f32x16 acc[4][2];
#pragma unroll
        for (int a = 0; a < 4; ++a)
#pragma unroll
            for (int b = 0; b < 2; ++b) acc[a][b] = zero16();
#pragma unroll
        for (int ks = 0; ks < 4; ++ks) {
            bf16x8 A[2], Bf[4];
#pragma unroll
            for (int pt = 0; pt < 2; ++pt) A[pt] = *(const PG8_LAS bf16x8*)(lds + L_XT + xt_off(wid * 64 + 32 * pt + r, 2 * ks + hh));
#pragma unroll
            for (int nt = 0; nt < 4; ++nt) Bf[nt] = *(const PG8_LAS bf16x8*)(lds + L_B + xt_off(32 * nt + r, 2 * ks + hh));
#pragma unroll
            for (int nt = 0; nt < 4; ++nt)
#pragma unroll
                for (int pt = 0; pt < 2; ++pt) acc[nt][pt] = MFMA32(Bf[nt], A[pt], acc[nt][pt]);
        }
        bf16_t* dst = (bf16_t*)p.sst + ((size_t)ck * 32 + h) * 8192 + lane * 16;
#pragma unroll
        for (int nt = 0; nt < 4; ++nt)
#pragma unroll
            for (int pt = 0; pt < 2; ++pt) {
                const f32x16& a = acc[nt][pt];
                *(u32x4*)(dst + (nt * 2 + pt) * 1024) = (u32x4){pk2c(a[0], a[1]), pk2c(a[2], a[3]), pk2c(a[4], a[5]), pk2c(a[6], a[7])};
                *(u32x4*)(dst + (nt * 2 + pt) * 1024 + 8) = (u32x4){pk2c(a[8], a[9]), pk2c(a[10], a[11]), pk2c(a[12], a[13]), pk2c(a[14], a[15])};
            }
        __syncthreads();
    }
}
__device__ __forceinline__ int frag_to_logical(int x) {
    const int h = x >> 13, y = x & 8191, T = y >> 10, L = (y >> 4) & 63, q = y & 15;
    const int p = 32 * (T & 1) + (L & 31), n = 32 * (T >> 1) + (q & 3) + 8 * (q >> 2) + 4 * (L >> 5);
    return h * 8192 + p * 128 + n;
}
__device__ __forceinline__ void ph_ssd_p2(CPR p, int l) {
    const int gtid = bid_opaque() * 512 + tid_opaque(), gsz = nblk_opaque() * 512;
    const unsigned* sst2 = (const unsigned*)p.sst; unsigned* hp2 = (unsigned*)p.hpb;
    for (int e = gtid; e < 131072; e += gsz) {
        const int h = e >> 12; float2 hc = make_float2(0.f, 0.f);
        for (int c0 = 0; c0 < 256; c0 += 32) {
            unsigned S[32]; float d[32];
#pragma unroll
            for (int i = 0; i < 32; ++i) { S[i] = sst2[(size_t)(c0 + i) * 131072 + e]; d[i] = p.dec[(c0 + i) * 32 + h]; }
#pragma unroll
            for (int i = 0; i < 32; ++i) { hp2[(size_t)(c0 + i) * 131072 + e] = pk2(hc.x, hc.y); const f32x2_t hn = (f32x2_t){hc.x, hc.y} * d[i] + (f32x2_t){bflo(S[i]), bfhi(S[i])}; hc.x = hn.x; hc.y = hn.y; }
        }
        ((float2*)(p.out + O_P_STATE + (size_t)l * STATE_SZ))[frag_to_logical(2 * e) >> 1] = hc;
    }
    for (int i = gtid; i < DEC_BATCH * 131072; i += gsz) {
        const int b = i >> 17, e = i & 131071, h = e >> 12, ck = 256 + b;
        const int el = frag_to_logical(2 * e) >> 1;
        const float2 h0 = ((const float2*)(p.state_ssd + ((size_t)l * DEC_BATCH + b) * STATE_SZ))[el]; const unsigned Sw = sst2[(size_t)ck * 131072 + e]; const float2 S = make_float2(bflo(Sw), bfhi(Sw)); const float d = p.dec[ck * 32 + h];
        hp2[(size_t)ck * 131072 + e] = pk2(h0.x, h0.y);
        ((float2*)(p.out + O_S_STATE + ((size_t)l * DEC_BATCH + b) * STATE_SZ))[el] = make_float2(fmaf(d, h0.x, S.x), fmaf(d, h0.y, S.y));
    }
}
__device__ __forceinline__ void ph_ssd_p3(CPR p, int l, LDSP lds) {
    const int tid = tid_opaque(), wid = tid >> 6, lane = tid & 63, r = lane & 31, hh = lane >> 5;
    PG8_LAS float* acS = (PG8_LAS float*)(lds + L_AC); PG8_LAS float* dtS = (PG8_LAS float*)(lds + L_DT); PG8_LAS float* red = (PG8_LAS float*)(lds + L_WS);
    PG8_LAS bf16_t* xT = (PG8_LAS bf16_t*)(lds + L_XT);
    const int u0 = bid_opaque(), nb = nblk_opaque();
    float dt_nx = (u0 < NCHUNK * 4) ? unit_dt(p, l, u0, wid, lane) : 0.f;
    for (int u = u0; u < NCHUNK * 4; u += nb) {
        const int ck = u >> 2, g = u & 3, h = g * 8 + wid;
        const ChunkInfo ci = chunk_info(p, l, ck);
        const float Dh = p.ssd_d[l * 32 + h];
        { const float dtv = dt_nx; float ac, aclast; head_scan(p, l, h, lane, dtv, ac, aclast); acS[wid * 64 + lane] = ac; dtS[wid * 64 + lane] = dtv; }
        dt_nx = (u + nb < NCHUNK * 4) ? unit_dt(p, l, u + nb, wid, lane) : 0.f;
        bf16x8 HA[8][2];
        const bf16_t* hp = p.hpb + ((size_t)ck * 32 + h) * 8192;
        { const int cc = tid & 63, s0 = (tid >> 6) * 8, g8 = s0 >> 3, hl = cc >> 3, p0 = (cc & 7) * 8;
          conv8<4>(p, l, ci, s0, g * 512 + cc * 8, [&](int jp, const float (&lo)[8], const float (&hi)[8]) {
              const int R = hl * 64 + p0 + 2 * jp;
              *(PG8_LAS u32x4*)(lds + L_XT + xt_off(R, g8)) = (u32x4){pk2(lo[0], lo[1]), pk2(lo[2], lo[3]), pk2(lo[4], lo[5]), pk2(lo[6], lo[7])};
              *(PG8_LAS u32x4*)(lds + L_XT + xt_off(R + 1, g8)) = (u32x4){pk2(hi[0], hi[1]), pk2(hi[2], hi[3]), pk2(hi[4], hi[5]), pk2(hi[6], hi[7])}; }); }
        { const int q = tid & 63, s0 = (tid >> 6) * 8, n4 = 4 * (q & 31), off = (q < 32 ? L_B : L_C) + n4 * 2;
          conv8<2>(p, l, ci, s0, (q < 32 ? 2048 : 2560) + g * 128 + n4, [&](int jp, const float (&lo)[8], const float (&hi)[8]) {
#pragma unroll
              for (int i = 0; i < 8; ++i) *(PG8_LAS unsigned*)(lds + off + jp * 4 + (s0 + i) * PR * 2) = pk2(lo[i], hi[i]); }); }
#pragma unroll
        for (int ks = 0; ks < 8; ++ks) { HA[ks][0] = *(const bf16x8*)(hp + ((ks >> 1) * 2 + 0) * 1024 + lane * 16 + 8 * (ks & 1)); HA[ks][1] = *(const bf16x8*)(hp + ((ks >> 1) * 2 + 1) * 1024 + lane * 16 + 8 * (ks & 1)); }
        __syncthreads();
        f32x16 yd[2][2];
#pragma unroll
        for (int a = 0; a < 2; ++a)
#pragma unroll
            for (int b = 0; b < 2; ++b) yd[a][b] = zero16();
#pragma unroll
        for (int ks = 0; ks < 8; ++ks) {
            bf16x8 Bf[2];
#pragma unroll
            for (int lt = 0; lt < 2; ++lt) { const int eo = ((32 * lt + r) * PR + 16 * ks + 4 * hh) * 2;
                Bf[lt] = join44(*(const PG8_LAS bf16x4*)(lds + L_C + eo), *(const PG8_LAS bf16x4*)(lds + L_C + eo + 16)); }
#pragma unroll
            for (int pt = 0; pt < 2; ++pt)
#pragma unroll
                for (int lt = 0; lt < 2; ++lt) yd[pt][lt] = MFMA32(HA[ks][pt], Bf[lt], yd[pt][lt]);
        }
#pragma unroll
        for (int lt = 0; lt < 2; ++lt) { const float eal = __expf(acS[wid * 64 + 32 * lt + r]);
#pragma unroll
            for (int pt = 0; pt < 2; ++pt)
#pragma unroll
                for (int q = 0; q < 16; q += 2) { const f32x2_t t = (f32x2_t){yd[pt][lt][q], yd[pt][lt][q + 1]} * eal; yd[pt][lt][q] = t.x; yd[pt][lt][q + 1] = t.y; } }
        u32x4 zraw[8];
#pragma unroll
        for (int i = 0; i < 8; ++i) { const int e = tid + 512 * i, tok = e >> 6; zraw[i] = *(const u32x4*)(p.zb + (size_t)(ci.row0 + (tok < ci.nvalid ? tok : 0)) * 2048 + g * 512 + (e & 63) * 8); }
#pragma unroll
        for (int tix = 0; tix < 3; ++tix) {
            const int st = (tix == 2) ? 1 : 0, lt = (tix == 0) ? 0 : 1;
            f32x16 G = zero16();
#pragma unroll
            for (int ks = 0; ks < 8; ++ks) {
                const bf16x8 A = *(const PG8_LAS bf16x8*)(lds + L_B + ((32 * st + r) * PR + 16 * ks + 8 * hh) * 2);
                const bf16x8 Bf = *(const PG8_LAS bf16x8*)(lds + L_C + ((32 * lt + r) * PR + 16 * ks + 8 * hh) * 2);
                G = MFMA32(A, Bf, G);
            }
            const int lcol = 32 * lt + r; const float acl = acS[wid * 64 + lcol];
            float mv[16];
#pragma unroll
            for (int q = 0; q < 16; q += 2) {
                const int s = 32 * st + (q & 3) + 8 * (q >> 2) + 4 * hh;
                const f32x2_t acs = *(const PG8_LAS f32x2_t*)(acS + wid * 64 + s), dts = *(const PG8_LAS f32x2_t*)(dtS + wid * 64 + s);
                const f32x2_t dd = __builtin_elementwise_min((f32x2_t){acl, acl} - acs, (f32x2_t){0.f, 0.f}) * 1.4426950408889634f;
                const f32x2_t v2 = (f32x2_t){G[q], G[q + 1]} * exp2_2(dd) * dts;
                float va = (s <= lcol) ? v2.x : 0.f, vb = (s + 1 <= lcol) ? v2.y : 0.f;
                if (s == lcol) va += Dh; if (s + 1 == lcol) vb += Dh;
                mv[q] = va; mv[q + 1] = vb;
            }
#pragma unroll
            for (int kk = 0; kk < 2; ++kk) {
                const float m8[8] = {mv[8 * kk], mv[8 * kk + 1], mv[8 * kk + 2], mv[8 * kk + 3], mv[8 * kk + 4], mv[8 * kk + 5], mv[8 * kk + 6], mv[8 * kk + 7]};
                const bf16x8 Bm = pack8f(m8);
#pragma unroll
                for (int pt = 0; pt < 2; ++pt) {
                    const int R = wid * 64 + 32 * pt + r, g = 4 * st + 2 * kk;
                    const bf16x4 lo = *(const PG8_LAS bf16x4*)(lds + L_XT + xt_off(R, g) + 8 * hh), hi = *(const PG8_LAS bf16x4*)(lds + L_XT + xt_off(R, g + 1) + 8 * hh);
                    yd[pt][lt] = MFMA32(join44(lo, hi), Bm, yd[pt][lt]);
                }
            }
        }
        __syncthreads();
#pragma unroll
        for (int i = 0; i < 8; ++i) { const int e = tid + 512 * i; *(PG8_LAS u32x4*)(lds + L_XT + (e >> 6) * ZP + (e & 63) * 16) = zraw[i]; }
        __syncthreads();
        float ssl[2];
#pragma unroll
        for (int lt = 0; lt < 2; ++lt) {
            const int lcol = 32 * lt + r;
            float ss = 0.f;
#pragma unroll
            for (int pt = 0; pt < 2; ++pt)
#pragma unroll
                for (int i = 0; i < 4; ++i) {
                    const u32x2 zw = *(const PG8_LAS u32x2*)(lds + L_XT + lcol * ZP + (wid * 64 + 32 * pt + 8 * i + 4 * hh) * 2);
                    const f32x2_t za = (f32x2_t){bflo(zw.x), bfhi(zw.x)}, zb2 = (f32x2_t){bflo(zw.y), bfhi(zw.y)};
                    const f32x2_t ga = (f32x2_t){yd[pt][lt][4 * i], yd[pt][lt][4 * i + 1]} * silu2(za), gb2 = (f32x2_t){yd[pt][lt][4 * i + 2], yd[pt][lt][4 * i + 3]} * silu2(zb2);
                    yd[pt][lt][4 * i] = ga.x; yd[pt][lt][4 * i + 1] = ga.y; yd[pt][lt][4 * i + 2] = gb2.x; yd[pt][lt][4 * i + 3] = gb2.y;
                    const f32x2_t sq = ga * ga + gb2 * gb2; ss += sq.x + sq.y;
                }
            ss += __shfl_xor(ss, 32);
            ssl[lt] = ss;
        }
        if (hh == 0) { red[wid * 64 + r] = ssl[0]; red[wid * 64 + 32 + r] = ssl[1]; }
        __syncthreads();
#pragma unroll
        for (int lt = 0; lt < 2; ++lt) {
            const int lcol = 32 * lt + r;
            float tot = 0.f;
#pragma unroll
            for (int w = 0; w < 8; ++w) tot += red[w * 64 + lcol];
            const float rstd = rsqrtf(tot * (1.0f / 512.f) + EPS);
#pragma unroll
            for (int pt = 0; pt < 2; ++pt)
#pragma unroll
                for (int i = 0; i < 4; ++i)
                { const f32x2_t a = (f32x2_t){yd[pt][lt][4 * i], yd[pt][lt][4 * i + 1]} * rstd, b = (f32x2_t){yd[pt][lt][4 * i + 2], yd[pt][lt][4 * i + 3]} * rstd;
                    *(PG8_LAS u32x2*)(lds + L_XT + lcol * ZP + (wid * 64 + 32 * pt + 8 * i + 4 * hh) * 2) = (u32x2){pk2(a.x, a.y), pk2(b.x, b.y)}; }
        }
        __syncthreads();
#pragma unroll
        for (int i = 0; i < 8; ++i) { const int e = tid + 512 * i, tok = e >> 6;
            if (tok < ci.nvalid) *(u32x4*)(p.yn + (size_t)(ci.row0 + tok) * 2048 + g * 512 + (e & 63) * 8) = *(const PG8_LAS u32x4*)(lds + L_XT + tok * ZP + (e & 63) * 16); }
        __syncthreads();
    }
}
#ifndef ATT_EXIT_P
#define ATT_EXIT_P 1e-20f
#endif
typedef short v4i16_t __attribute__((ext_vector_type(4)));
constexpr int AT_PITCH = 272;
constexpr int AT_TILE = 32 * AT_PITCH;
constexpr int ATT_LDS = 8 * 2 * AT_TILE;
__device__ __forceinline__ void ph_attn(CPR p, int l, LDSP lds) {
    const int tidx = tid_opaque(); const int lane = tidx & 63, r = lane & 31, hh = lane >> 5, wv = tidx >> 6, NGW = nblk_opaque() * 8, gw = (bid_opaque() * 8 + wv + (NGW >> 1)) % NGW;
    const bf16_t* kbb = p.kb; const bf16_t* vbb = p.vb;
    const float* ck = p.cache_k + (size_t)l * DEC_BATCH * PAST_LEN * 1024; const float* cv = p.cache_v + (size_t)l * DEC_BATCH * PAST_LEN * 1024;
    const float scale = 0.08838834764831845f;
    LDSP kl = lds + wv * (2 * AT_TILE); LDSP vl = kl + AT_TILE;
    const int st_g = (lane >> 5) * 1024 + (lane & 31) * 4;
    const int st_l = (lane >> 5) * AT_PITCH + (lane & 31) * 8;
    const int vs_g = (lane >> 4) * 1024 + (lane & 15) * 8;
    const int vs_l = (lane >> 4) * AT_PITCH + (lane & 15) * 16;
    const int ka_off = r * AT_PITCH + 16 * hh;
    const int vt_off = (4 * hh + ((lane & 15) >> 2)) * AT_PITCH + (16 * ((lane >> 4) & 1) + 4 * (lane & 3)) * 2;
    const int nwg = NGW >> 3, wgr = gw >> 3;
    for (int U = wgr; U < 512 + 32; U += nwg) {
        int hd, b, rowq0, P0;
        if (U < 512) { hd = U & 7; const int qt = 8 * (U >> 3) + wv; b = -1; rowq0 = 32 * qt; P0 = 32 * qt; }
        else { hd = wv; b = U - 512; rowq0 = M_P + 32 * b; P0 = PAST_LEN; }
        const bf16_t* qrow = p.qb + (size_t)(rowq0 + r) * 1024 + hd * 128 + 8 * hh;
        bf16x8 qf[8];
#pragma unroll
        for (int ks = 0; ks < 8; ++ks) qf[ks] = *(const bf16x8*)(qrow + 16 * ks);
        f32x16 O[4];
#pragma unroll
        for (int d = 0; d < 4; ++d) O[d] = zero16();
        float carry = 1.0f;
        const int ktd = P0 >> 5;
        u32x4 buf[16];
        { const bf16_t* kq = kbb + (size_t)rowq0 * 1024 + hd * 128 + vs_g;
#pragma unroll
          for (int i = 0; i < 8; ++i) buf[8 + i] = *(const u32x4*)(kq + 4096 * i);
#pragma unroll
          for (int i = 0; i < 8; ++i) *(PG8_LAS u32x4*)(kl + vs_l + 4 * AT_PITCH * i) = buf[8 + i]; }
        for (int kt = ktd; kt >= 0; --kt) {
            const bool bfs = (b < 0) || (kt == ktd);
            f32x16 S = zero16();
            if (bfs) {
                const bf16_t* vq = vbb + (size_t)(b < 0 ? 32 * kt : rowq0) * 1024 + hd * 128 + vs_g;
#pragma unroll
                for (int i = 0; i < 8; ++i) buf[i] = *(const u32x4*)(vq + 4096 * i);
            } else {
                const float* vb = cv + ((size_t)b * PAST_LEN + 32 * kt) * 1024 + hd * 128 + st_g;
#pragma unroll
                for (int i = 0; i < 16; ++i) buf[i] = *(const u32x4*)(vb + 2048 * i);
            }
            asm volatile("s_waitcnt lgkmcnt(0)" ::: "memory");
#pragma unroll
            for (int ks = 0; ks < 8; ++ks) S = MFMA32(*(const PG8_LAS bf16x8*)(kl + ka_off + 32 * ks), qf[ks], S);
            const bool diag = (kt == ktd);
            float kp[16], sg[16];
#pragma unroll
            for (int q = 0; q < 16; q += 2) {
                const int key = (q & 3) + 8 * (q >> 2) + 4 * hh;
                const f32x2_t z = (f32x2_t){S[q], S[q + 1]} * scale, e = exp2_2(__builtin_elementwise_abs(z) * (-1.4426950408889634f)), big = rcp_2(e + 1.0f), small = e * big;
                const bool v0 = !diag || key < r, v1 = !diag || key + 1 < r;
                sg[q] = v0 ? (z.x >= 0.f ? big.x : small.x) : 0.f; kp[q] = v0 ? (z.x >= 0.f ? small.x : big.x) : 1.0f;
                sg[q + 1] = v1 ? (z.y >= 0.f ? big.y : small.y) : 0.f; kp[q + 1] = v1 ? (z.y >= 0.f ? small.y : big.y) : 1.0f;
            }
            float T[4], Tp[4];
#pragma unroll
            for (int gi = 0; gi < 4; ++gi) { T[gi] = (kp[4 * gi] * kp[4 * gi + 1]) * (kp[4 * gi + 2] * kp[4 * gi + 3]); Tp[gi] = __shfl_xor(T[gi], 32); }
            float wg[16]; float aft = carry;
#pragma unroll
            for (int gi = 3; gi >= 0; --gi) {
                float suf = aft * (hh == 0 ? Tp[gi] : 1.0f);
#pragma unroll
                for (int j = 3; j >= 0; --j) { wg[4 * gi + j] = sg[4 * gi + j] * suf; suf *= kp[4 * gi + j]; }
                aft *= T[gi] * Tp[gi];
            }
            carry = aft;
            bf16x8 Pf[2];
#pragma unroll
            for (int kk = 0; kk < 2; ++kk) {
                const float w8[8] = {wg[8 * kk], wg[8 * kk + 1], wg[8 * kk + 2], wg[8 * kk + 3], wg[8 * kk + 4], wg[8 * kk + 5], wg[8 * kk + 6], wg[8 * kk + 7]};
                Pf[kk] = pack8f(w8);
            }
            if (bfs) {
#pragma unroll
                for (int i = 0; i < 8; ++i) *(PG8_LAS u32x4*)(vl + vs_l + 4 * AT_PITCH * i) = buf[i];
            } else {
#pragma unroll
                for (int i = 0; i < 16; ++i) { const float4 t = __builtin_bit_cast(float4, buf[i]); *(PG8_LAS u32x2*)(vl + st_l + 2 * AT_PITCH * i) = (u32x2){pk2(t.x, t.y), pk2(t.z, t.w)}; }
            }
            const bool more = (kt > 0) && !__all(carry < ATT_EXIT_P);
            if (more) {
                if (b < 0) { const bf16_t* kq = kbb + (size_t)(32 * (kt - 1)) * 1024 + hd * 128 + vs_g;
#pragma unroll
                    for (int i = 0; i < 8; ++i) buf[8 + i] = *(const u32x4*)(kq + 4096 * i); }
                else { const float* kb = ck + ((size_t)b * PAST_LEN + 32 * (kt - 1)) * 1024 + hd * 128 + st_g;
#pragma unroll
                    for (int i = 0; i < 16; ++i) buf[i] = *(const u32x4*)(kb + 2048 * i); }
            }
            asm volatile("s_waitcnt lgkmcnt(0)" ::: "memory");
#pragma unroll
            for (int kk = 0; kk < 2; ++kk)
#pragma unroll
                for (int d = 0; d < 4; ++d) {
                    const bf16x4 lo = __builtin_bit_cast(bf16x4, __builtin_amdgcn_ds_read_tr16_b64_v4i16((PG8_LAS v4i16_t*)(vl + vt_off + kk * 16 * AT_PITCH + d * 64)));
                    const bf16x4 hi = __builtin_bit_cast(bf16x4, __builtin_amdgcn_ds_read_tr16_b64_v4i16((PG8_LAS v4i16_t*)(vl + vt_off + kk * 16 * AT_PITCH + 8 * AT_PITCH + d * 64)));
                    O[d] = MFMA32(Pf[kk], join44(lo, hi), O[d]);
                }
            if (!more) break;
            if (b >= 0) {
#pragma unroll
                for (int i = 0; i < 16; ++i) { const float4 t = __builtin_bit_cast(float4, buf[i]); *(PG8_LAS u32x2*)(kl + st_l + 2 * AT_PITCH * i) = (u32x2){pk2(t.x, t.y), pk2(t.z, t.w)}; }
            } else {
#pragma unroll
                for (int i = 0; i < 8; ++i) *(PG8_LAS u32x4*)(kl + vs_l + 4 * AT_PITCH * i) = buf[8 + i];
            }
        }
#pragma unroll
        for (int d = 0; d < 4; ++d)
#pragma unroll
            for (int q = 0; q < 16; ++q) *(PG8_LAS unsigned short*)(kl + ((q & 3) + 8 * (q >> 2) + 4 * hh) * AT_PITCH + (32 * d + r) * 2) = (unsigned short)pk2c(O[d][q], 0.0f);
        asm volatile("s_waitcnt lgkmcnt(0)" ::: "memory");
#pragma unroll
        for (int i = 0; i < 8; ++i) *(u32x4*)(p.att + (size_t)(rowq0 + (lane >> 4) + 4 * i) * 1024 + hd * 128 + (lane & 15) * 8) = *(const PG8_LAS u32x4*)(kl + vs_l + 4 * AT_PITCH * i);
    }
}

constexpr int MEGA_BODY = (ATT_LDS > pg8::STAGE_BYTES ? ATT_LDS : pg8::STAGE_BYTES);
constexpr int MEGA_LDS = MEGA_BODY + 64;
#ifndef WGM_IN
#define WGM_IN 4
#endif
#ifndef WGM_UP
#define WGM_UP 8
#endif
#ifndef PROBE_GBIG
#define PROBE_GBIG 1
#endif
#ifndef PROBE_GSMALL
#define PROBE_GSMALL 1
#endif
#ifndef PROBE_S
#define PROBE_S 1
#endif
#ifndef PROBE_A
#define PROBE_A 1
#endif
#ifndef PROBE_M
#define PROBE_M 1
#endif
#ifndef PROBE_P1
#define PROBE_P1 PROBE_S
#endif
#ifndef PROBE_P3
#define PROBE_P3 PROBE_S
#endif
#ifndef PROBE_P2
#define PROBE_P2 PROBE_M
#endif
#ifndef PROBE_FFN
#define PROBE_FFN PROBE_M
#endif
#ifndef PROBE_PRO
#define PROBE_PRO PROBE_M
#endif
#ifndef PROBE_NORM
#define PROBE_NORM 0
#endif
#ifndef PROBE_BAR
#define PROBE_BAR 1
#endif
#define GRID_BARRIER() do { for (int rb_ = 0; rb_ < PROBE_BAR; ++rb_) xcd_barrier(bar); } while (0)
template <class Epi> __device__ __forceinline__ void gemm_site(LDSP lds, const bf16_t* A, const bf16_t* Bt, int N, int K, const Epi& E) {
    for (int rep_ = 0; rep_ < (N > 1024 ? PROBE_GBIG : PROBE_GSMALL); ++rep_) {
    Gemm g; g.A = A; g.Bt = Bt; g.M = M_ALL; g.N = N; g.K = K;
    StaticOrder S; S.init(M_ALL, N, nblk_opaque(), bid_opaque(), N == 8192 ? WGM_UP : WGM_IN);
    pg8::gemm_phase<Epi, StaticOrder, false>(lds, g, S, E, nullptr);
    }
}
template <bool HALO, class Epi> __device__ __forceinline__ void gemm_small(LDSP lds, const bf16_t* A, const bf16_t* Bt, int K, const Epi& E, int c_ = -1, int G_ = 0) {
    const int tid = tid_opaque(), wid = tid >> 6, lane = tid & 63, r = lane & 31, hh = lane >> 5;
    const int nb = c_ < 0 ? nblk_opaque() : G_;
    for (int t = (c_ < 0 ? bid_opaque() : c_); t < (HALO ? 512 : 256); t += nb) {
        const int m0 = HALO ? (t >> 6) * 64 : M_P + (t >> 4) * 64, n0 = HALO ? (t & 63) * 64 : (t & 15) * 64, kbeg = wid * (K >> 3), nst = K >> 7;
        const int nrow = HALO ? (n0 >> 7) * 256 + (n0 & 127) : n0;
        const bf16_t* ap = A + (size_t)(m0 + r) * K + kbeg + 8 * hh; const bf16_t* bp = Bt + (size_t)(nrow + r) * K + kbeg + 8 * hh;
        const size_t hop = (size_t)32 * K;
        f32x16 acc[2][2];
#pragma unroll
        for (int a = 0; a < 2; ++a)
#pragma unroll
            for (int b = 0; b < 2; ++b) acc[a][b] = zero16();
        if (K >= 512) {
            LDSP wa = lds + wid * 16384; LDSP wb = wa + 8192;
            const int prow = lane >> 3, pp = lane & 7;
            const bf16_t* ag = A + (size_t)(m0 + prow) * K + kbeg + pp * 8; const bf16_t* bg = Bt + (size_t)(nrow + prow) * K + kbeg + pp * 8;
            const size_t r8 = (size_t)8 * K;
            const int nch = K >> 9;
            const int wofs = prow * 128 + ((pp ^ ((prow >> 1) & 7)) * 16);
            const int sw = (r >> 1) & 7, rofs = r * 128;
            u32x4 sa[8], sb[8];
#pragma unroll
            for (int i = 0; i < 8; ++i) { sa[i] = *(const u32x4*)(ag + i * r8); sb[i] = *(const u32x4*)(bg + i * r8); }
            for (int c = 0; c < nch; ++c) {
#pragma unroll
                for (int i = 0; i < 8; ++i) { const int row = prow + 8 * i; const int off = row * 128 + ((pp ^ ((row >> 1) & 7)) * 16); *(PG8_LAS u32x4*)(wa + off) = sa[i]; *(PG8_LAS u32x4*)(wb + off) = sb[i]; }
                const int cn = c + 1 < nch ? c + 1 : c;
#pragma unroll
                for (int i = 0; i < 8; ++i) { sa[i] = *(const u32x4*)(ag + i * r8 + 64 * cn); sb[i] = *(const u32x4*)(bg + i * r8 + 64 * cn); }
#pragma unroll
                for (int ks = 0; ks < 4; ++ks) {
                    const int so = ((2 * ks + hh) ^ sw) * 16;
                    const bf16x8 a0 = *(const PG8_LAS bf16x8*)(wa + rofs + so), a1 = *(const PG8_LAS bf16x8*)(wa + rofs + 4096 + so);
                    const bf16x8 b0 = *(const PG8_LAS bf16x8*)(wb + rofs + so), b1 = *(const PG8_LAS bf16x8*)(wb + rofs + 4096 + so);
                    acc[0][0] = MFMA32(a0, b0, acc[0][0]); acc[0][1] = MFMA32(a0, b1, acc[0][1]); acc[1][0] = MFMA32(a1, b0, acc[1][0]); acc[1][1] = MFMA32(a1, b1, acc[1][1]);
                }
            }
            (void)wofs;
        } else {
        bf16x8 fa[4][2], fb[4][2];
#pragma unroll
        for (int s = 0; s < 3; ++s) { const int ko = 16 * (s < nst ? s : 0);
            fa[s][0] = *(const bf16x8*)(ap + ko); fa[s][1] = *(const bf16x8*)(ap + hop + ko); fb[s][0] = *(const bf16x8*)(bp + ko); fb[s][1] = *(const bf16x8*)(bp + hop + ko); }
        for (int st = 0; st < nst; st += 2) {
#pragma unroll
            for (int s2 = 0; s2 < 2; ++s2) {
                const int cur = (st + s2) & 3, nxs = (st + s2 + 3) & 3, nx = st + s2 + 3, ko = 16 * (nx < nst ? nx : 0);
                if (((st >> 1) & 1) == 0) {
                    fa[(s2 + 3) & 3][0] = *(const bf16x8*)(ap + ko); fa[(s2 + 3) & 3][1] = *(const bf16x8*)(ap + hop + ko); fb[(s2 + 3) & 3][0] = *(const bf16x8*)(bp + ko); fb[(s2 + 3) & 3][1] = *(const bf16x8*)(bp + hop + ko);
#pragma unroll
                    for (int a = 0; a < 2; ++a)
#pragma unroll
                        for (int b = 0; b < 2; ++b) acc[a][b] = MFMA32(fa[s2][a], fb[s2][b], acc[a][b]);
                } else {
                    fa[(s2 + 1) & 3][0] = *(const bf16x8*)(ap + ko); fa[(s2 + 1) & 3][1] = *(const bf16x8*)(ap + hop + ko); fb[(s2 + 1) & 3][0] = *(const bf16x8*)(bp + ko); fb[(s2 + 1) & 3][1] = *(const bf16x8*)(bp + hop + ko);
#pragma unroll
                    for (int a = 0; a < 2; ++a)
#pragma unroll
                        for (int b = 0; b < 2; ++b) acc[a][b] = MFMA32(fa[s2 + 2][a], fb[s2 + 2][b], acc[a][b]);
                }
                (void)cur; (void)nxs;
            }
        }
        }
        PG8_LAS float* red = (PG8_LAS float*)lds;
#pragma unroll
        for (int a = 0; a < 2; ++a)
#pragma unroll
            for (int b = 0; b < 2; ++b)
#pragma unroll
                for (int q = 0; q < 16; ++q) red[((wid * 4 + a * 2 + b) * 16 + q) * 64 + lane] = acc[a][b][q];
        __syncthreads();
        { const int blk = wid & 3, q0 = (wid >> 2) * 8, a = blk >> 1, b = blk & 1;
#pragma unroll
          for (int q = 0; q < 8; ++q) { float v = 0.f;
#pragma unroll
              for (int w = 0; w < 8; ++w) v += red[((w * 4 + blk) * 16 + q0 + q) * 64 + lane];
              const int qq = q0 + q; E.elem(m0 + 32 * a + (qq & 3) + 8 * (qq >> 2) + 4 * hh, n0 + 32 * b + r, v); } }
        __syncthreads();
    }
}
template <class Epi> __device__ __forceinline__ void gemm_site_n1024_part(LDSP lds, const bf16_t* A, const bf16_t* Bt, int K, const Epi& E, int G, int c) {
    Gemm g; g.A = A; g.Bt = Bt; g.M = M_P; g.N = 1024; g.K = K;
    StaticOrder S; S.init(M_P, 1024, G, c);
    pg8::gemm_phase<Epi, StaticOrder, false>(lds, g, S, E, nullptr);
    gemm_small<false>(lds, A, Bt, K, E, c, G);
}
template <class Epi> __device__ __forceinline__ void gemm_site_n1024_prompt(LDSP lds, const bf16_t* A, const bf16_t* Bt, int K, const Epi& E) {
    Gemm g; g.A = A; g.Bt = Bt; g.M = M_P; g.N = 1024; g.K = K;
    StaticOrder S; S.init(M_P, 1024, nblk_opaque(), bid_opaque());
    pg8::gemm_phase<Epi, StaticOrder, false>(lds, g, S, E, nullptr);
}
template <class Epi> __device__ __forceinline__ void gemm_site_n1024(LDSP lds, const bf16_t* A, const bf16_t* Bt, int K, const Epi& E) {
    for (int rep_ = 0; rep_ < PROBE_GSMALL; ++rep_) {
    Gemm g; g.A = A; g.Bt = Bt; g.M = M_P; g.N = 1024; g.K = K;
    StaticOrder S; S.init(M_P, 1024, nblk_opaque(), bid_opaque());
    pg8::gemm_phase<Epi, StaticOrder, false>(lds, g, S, E, nullptr);
    gemm_small<false>(lds, A, Bt, K, E);
    }
}
__global__ void __launch_bounds__(512, 2) k_mega(Params p_) {
    extern __shared__ __attribute__((aligned(16))) unsigned char shm[];
    LDSP lds = (LDSP)shm;
    volatile LAS unsigned* xbw = (volatile LAS unsigned*)(lds + MEGA_BODY);
    if (threadIdx.x < 4) xbw[threadIdx.x] = 0u;
    __syncthreads();
    XcdBarrier bar = xcd_barrier_post(kargs()->bar, xbw);
    for (int rep_ = 0; rep_ < PROBE_PRO; ++rep_) { { CPR p = *kargs(); ph_wt(p, lds); }
    { CPR p = *kargs(); ph_xprep(p); } }
    GRID_BARRIER();
    for (int l = 0; l < DEPTH; ++l) {
        { CPR p = *kargs(); float* out = p.out; const bf16_t* wl = p.wt + (size_t)l * WT_LAYER; EpiIn E; E.rs = p.rs; E.zb = p.zb; E.xbcb = p.xbcb; E.qb = p.qb; E.kb = p.kb; E.vb = p.vb; E.gb = p.gb; E.dtb = p.dtb; E.dt_bias = p.ssd_dt_bias + l * 32;
          E.kP = out + O_P_K + (size_t)l * M_P * 1024; E.vP = out + O_P_V + (size_t)l * M_P * 1024; E.kS = out + O_S_K + (size_t)l * M_S * 1024; E.vS = out + O_S_V + (size_t)l * M_S * 1024;
          E.convP = out + O_P_CONV + (size_t)l * 3 * 3072; E.convS = out + O_S_CONV + (size_t)l * DEC_BATCH * 3 * 3072;
          gemm_site(lds, p.xb, wl + OW1, N1, 1024, E); }
        GRID_BARRIER();
        for (int rep_ = 0; rep_ < PROBE_P1; ++rep_) { CPR p = *kargs(); ph_ssd_p1(p, l, lds); }
        for (int rep_ = 0; rep_ < PROBE_A; ++rep_) { CPR p = *kargs(); ph_attn(p, l, lds); }
        GRID_BARRIER();
        for (int rep_ = 0; rep_ < PROBE_P2; ++rep_) { CPR p = *kargs(); ph_ssd_p2(p, l); }
        { CPR p = *kargs(); float* out = p.out; const bf16_t* wl = p.wt + (size_t)l * WT_LAYER; EpiBr E; E.gb = p.gb; E.t1in = nullptr; E.dst = p.t1; E.mode = 0; E.pad = 0; gemm_site_n1024_prompt(lds, p.att, wl + OW3, 1024, E); }
        GRID_BARRIER();
        for (int rep_ = 0; rep_ < PROBE_P3; ++rep_) { CPR p = *kargs(); ph_ssd_p3(p, l, lds); }
        if (bid_opaque() >= 128) { __syncthreads(); CPR p = *kargs(); const bf16_t* wl = p.wt + (size_t)l * WT_LAYER; EpiBr E; E.gb = p.gb; E.t1in = nullptr; E.dst = p.t1; E.mode = 0; E.pad = 0; gemm_small<false>(lds, p.att, wl + OW3, 1024, E, bid_opaque() - 128, 128); }
        GRID_BARRIER();
        { CPR p = *kargs(); float* out = p.out; const bf16_t* wl = p.wt + (size_t)l * WT_LAYER; EpiBr E; E.gb = p.gb; E.t1in = p.t1; E.dst = p.mixin; E.mode = 1; E.pad = 0; gemm_site_n1024(lds, p.yn, wl + OW2, 2048, E); }
        GRID_BARRIER();
        { CPR p = *kargs(); float* out = p.out; const bf16_t* wl = p.wt + (size_t)l * WT_LAYER; EpiF32Out E; E.dst = p.mixed; gemm_site_n1024(lds, p.mixin, wl + OW4, 1024, E); }
        GRID_BARRIER();
        { CPR p = *kargs(); float* out = p.out; (void)out; ph_norm(p.mixed, p.norm_post_mix + l * 1024, p.xr, p.xb, nullptr, nullptr, p.xh); }
        GRID_BARRIER();
        { CPR p = *kargs(); const bf16_t* wl = p.wt + (size_t)l * WT_LAYER; EpiHalo E; E.rs = nullptr; E.gh = p.gh; gemm_small<true>(lds, p.xh, wl + OW5, 1024, E); }
        GRID_BARRIER();
        { CPR p = *kargs(); float* out = p.out; const bf16_t* wl = p.wt + (size_t)l * WT_LAYER; EpiUpAct E; E.rs = p.rs2; E.gh = p.gh; E.ffb = p.ffb;
          E.ffnP = out + O_P_FFN + (size_t)l * 2 * D_FF; E.ffnS = out + O_S_FFN + (size_t)l * DEC_BATCH * 2 * D_FF;
          E.cw = p.ffn_conv_w + (size_t)l * 3 * D_FF; E.cb = p.ffn_conv_b + (size_t)l * D_FF; E.hist = p.state_ffn_conv + (size_t)l * DEC_BATCH * 2 * D_FF;
          gemm_site(lds, p.xb, wl + OW5, 8192, 1024, E); }
        if (bid_opaque() >= 128) { CPR p = *kargs(); const bf16_t* wl = p.wt + (size_t)l * WT_LAYER; EpiPlain E; E.dst = p.plea; gemm_site_n1024_part(lds, p.pb + (size_t)l * M_ALL * 256, wl + OW7, 256, E, 128, bid_opaque() - 128); }
        GRID_BARRIER();
        { CPR p = *kargs(); float* out = p.out; const bf16_t* wl = p.wt + (size_t)l * WT_LAYER; EpiF32Out E; E.dst = p.down; gemm_site_n1024(lds, p.ffb, wl + OW6, 4096, E); }
        GRID_BARRIER();
        { CPR p = *kargs(); float* out = p.out; (void)out; ph_norm(p.down, p.norm_post_ffn + l * 1024, p.xr, nullptr, nullptr, nullptr); }
        GRID_BARRIER();
        { CPR p = *kargs(); float* out = p.out; const bf16_t* wl = p.wt + (size_t)l * WT_LAYER; EpiPle E; E.plea = p.plea; E.dst = p.ple; gemm_site_n1024(lds, p.xr, wl + OW8, 1024, E); }
        GRID_BARRIER();
        { CPR p = *kargs(); float* out = p.out; (void)out; ph_norm(p.ple, p.norm_ple + l * 1024, p.xr, p.xb, l == DEPTH - 1 ? out + O_Y_P : nullptr, out + O_Y_S); }
        if (l + 1 < DEPTH) GRID_BARRIER();
    }
}

struct Bump { char* base; size_t off; template <class T> T* take(size_t n) { off = (off + 255) & ~(size_t)255; T* p = (T*)(base + off); off += n * sizeof(T); return p; } };
__global__ void k_fail_code(float* out, float code) { if (threadIdx.x == 0 && blockIdx.x == 0) out[0] = code; }

extern "C" void kernel_launch(void* const* d_in, const int* in_sizes, int n_in, void* d_out, int out_size, void* d_ws, size_t ws_size, hipStream_t stream) {
    Params p; memset(&p, 0, sizeof p);
    p.x_prompt = (const float*)d_in[0]; p.x_sample = (const float*)d_in[1]; p.state_ssd_conv = (const float*)d_in[2]; p.state_ssd = (const float*)d_in[3];
    p.cache_k = (const float*)d_in[4]; p.cache_v = (const float*)d_in[5]; p.state_ffn_conv = (const float*)d_in[6]; p.p_prompt = (const float*)d_in[7]; p.p_sample = (const float*)d_in[8];
    p.norm_pre_mix = (const float*)d_in[9]; p.w_in = (const float*)d_in[10]; p.ssd_conv_w = (const float*)d_in[11]; p.ssd_conv_b = (const float*)d_in[12]; p.ssd_dt_bias = (const float*)d_in[13];
    p.ssd_a_log = (const float*)d_in[14]; p.ssd_d = (const float*)d_in[15]; p.ssd_norm = (const float*)d_in[16]; p.w_br_ssd = (const float*)d_in[17]; p.w_br_sb = (const float*)d_in[18];
    p.w_out = (const float*)d_in[19]; p.norm_post_mix = (const float*)d_in[20]; p.norm_pre_ffn = (const float*)d_in[21]; p.w_up = (const float*)d_in[22]; p.ffn_conv_w = (const float*)d_in[23];
    p.ffn_conv_b = (const float*)d_in[24]; p.w_down = (const float*)d_in[25]; p.norm_post_ffn = (const float*)d_in[26]; p.w_ple = (const float*)d_in[27]; p.w_ple_gate = (const float*)d_in[28];
    p.norm_ple = (const float*)d_in[29];
    float* out = (float*)d_out; p.out = out;

    Bump B{(char*)d_ws, 0};
    const size_t R = M_ALL;
    p.bar = B.take<unsigned>(4096);
    p.wt = B.take<bf16_t>(DEPTH * WT_LAYER);
    p.xr = B.take<bf16_t>(R * 1024); p.xb = B.take<bf16_t>(R * 1024); p.rs = B.take<float>(R); p.rs2 = B.take<float>(R); p.pb = B.take<bf16_t>(DEPTH * R * 256);
    p.zb = B.take<bf16_t>(R * 2048); p.xbcb = B.take<bf16_t>(R * 3072); p.qb = B.take<bf16_t>(R * 1024); p.kb = B.take<bf16_t>(R * 1024); p.vb = B.take<bf16_t>(R * 1024); p.gb = B.take<bf16_t>(R * 2048); p.dtb = B.take<float>(R * 32);
    p.sst = B.take<float>((size_t)NCHUNK * STATE_SZ / 2); p.dec = B.take<float>(NCHUNK * 32); p.hpb = B.take<bf16_t>((size_t)NCHUNK * STATE_SZ);
    p.yn = B.take<bf16_t>(R * 2048); p.att = B.take<bf16_t>(R * 1024); p.t1 = B.take<bf16_t>(R * 1024); p.mixin = B.take<bf16_t>(R * 1024); p.mixed = B.take<bf16_t>(R * 1024);
    p.gh = B.take<bf16_t>((size_t)768 * 4096); p.xh = B.take<bf16_t>((size_t)768 * 1024); p.ffb = B.take<bf16_t>(R * 4096); p.down = B.take<bf16_t>(R * 1024); p.plea = B.take<bf16_t>(R * 1024); p.ple = B.take<bf16_t>(R * 1024);
    if (B.off > ws_size) { k_fail_code<<<1, 64, 0, stream>>>(out, 777000.f); return; }

    (void)hipMemsetAsync(p.bar, 0, 4096 * 4, stream);
    static bool minit = false;
    if (!minit) { (void)hipFuncSetAttribute((const void*)k_mega, hipFuncAttributeMaxDynamicSharedMemorySize, MEGA_LDS); minit = true; }
    hipLaunchKernelGGL(k_mega, dim3(256), dim3(512), MEGA_LDS, stream, p);
}
```

```cpp
#include <hip/hip_runtime.h>
#include <stdint.h>
#include <string.h>

constexpr int D_MODEL = 1024, SEQ = 16384, DEPTH = 2, DEC_BATCH = 32, DEC_SEQ = 32, PAST_LEN = 2048;
constexpr int D_SSM = 2048, SSD_HEAD_DIM = 64, SSD_HEADS = 32, SSD_GROUPS = 4, SSD_STATE = 128, SSD_CONV_DIM = 3072;
constexpr int SB_HEAD_DIM = 128, SB_HEADS = 8, SB_WIDTH = 1024, D_FF = 4096, PLE_DIM = 256;
constexpr int IN_DIM = 10272;
constexpr int M_P = SEQ, M_S = DEC_BATCH * DEC_SEQ, M_ALL = M_P + M_S;
constexpr float EPS = 1e-6f;
constexpr int C_Z = 0, C_XBC = 2048, C_DT = 5120, C_Q = 5152, C_K = 6176, C_V = 7200, C_G = 8224;
constexpr size_t O_Y_P = 0;
constexpr size_t O_Y_S = O_Y_P + (size_t)M_P * D_MODEL;
constexpr size_t O_P_CONV = O_Y_S + (size_t)M_S * D_MODEL;
constexpr size_t O_P_STATE = O_P_CONV + (size_t)DEPTH * 3 * SSD_CONV_DIM;
constexpr size_t O_P_K = O_P_STATE + (size_t)DEPTH * SSD_HEADS * SSD_HEAD_DIM * SSD_STATE;
constexpr size_t O_P_V = O_P_K + (size_t)DEPTH * M_P * SB_WIDTH;
constexpr size_t O_P_FFN = O_P_V + (size_t)DEPTH * M_P * SB_WIDTH;
constexpr size_t O_S_CONV = O_P_FFN + (size_t)DEPTH * 2 * D_FF;
constexpr size_t O_S_STATE = O_S_CONV + (size_t)DEPTH * DEC_BATCH * 3 * SSD_CONV_DIM;
constexpr size_t O_S_K = O_S_STATE + (size_t)DEPTH * DEC_BATCH * SSD_HEADS * SSD_HEAD_DIM * SSD_STATE;
constexpr size_t O_S_V = O_S_K + (size_t)DEPTH * M_S * SB_WIDTH;
constexpr size_t O_S_FFN = O_S_V + (size_t)DEPTH * M_S * SB_WIDTH;
constexpr size_t O_TOTAL = O_S_FFN + (size_t)DEPTH * DEC_BATCH * 2 * D_FF;
constexpr size_t STATE_SZ = (size_t)SSD_HEADS * SSD_HEAD_DIM * SSD_STATE;

typedef unsigned short bf16_t;

__device__ __forceinline__ float wave_sum(float v) {
#pragma unroll
    for (int o = 32; o >= 1; o >>= 1) v += __shfl_xor(v, o);
    return v;
}
__device__ __forceinline__ float sigmoidf_(float x) { return 1.0f / (1.0f + __expf(-x)); }
__device__ __forceinline__ float softplusf_(float x) { return fmaxf(x, 0.f) + log1pf(__expf(-fabsf(x))); }
__device__ __forceinline__ float siluf_(float x) { return x * sigmoidf_(x); }
__device__ __forceinline__ float gelu_tanhf_(float x) { const float u = 0.7978845608028654f * (x + 0.044715f * x * x * x); return 0.5f * x * (1.0f + tanhf(u)); }
__device__ __forceinline__ bf16_t f2bf(float f) { unsigned u = __float_as_uint(f); u += 0x7FFFu + ((u >> 16) & 1u); return (bf16_t)(u >> 16); }
__device__ __forceinline__ float bf2f(bf16_t b) { return __uint_as_float(((unsigned)b) << 16); }
typedef __bf16 bf16x2_t __attribute__((ext_vector_type(2)));
typedef float f32x2_t __attribute__((ext_vector_type(2)));
__device__ __forceinline__ unsigned pk2(float lo, float hi) { unsigned r; asm volatile("v_cvt_pk_bf16_f32 %0, %1, %2" : "=v"(r) : "v"(lo), "v"(hi)); return r; }
__device__ __forceinline__ unsigned pk2c(float lo, float hi) { const f32x2_t v = {lo, hi}; return __builtin_bit_cast(unsigned, __builtin_convertvector(v, bf16x2_t)); }
__device__ __forceinline__ f32x2_t exp2_2(f32x2_t x) { f32x2_t e; e.x = __builtin_amdgcn_exp2f(x.x); e.y = __builtin_amdgcn_exp2f(x.y); return e; }
__device__ __forceinline__ f32x2_t rcp_2(f32x2_t x) { f32x2_t r; r.x = __builtin_amdgcn_rcpf(x.x); r.y = __builtin_amdgcn_rcpf(x.y); return r; }
__device__ __forceinline__ f32x2_t sigmoid2(f32x2_t a) { return rcp_2(exp2_2(a * (-1.4426950408889634f)) + 1.0f); }
__device__ __forceinline__ f32x2_t silu2(f32x2_t a) { return a * sigmoid2(a); }
__device__ __forceinline__ f32x2_t gelu2(f32x2_t x) { const f32x2_t u2 = (x * x * 0.044715f + 1.0f) * x * 1.5957691216057308f; return x * sigmoid2(u2); }
__device__ __forceinline__ float bflo(unsigned w) { return __uint_as_float(w << 16); }
__device__ __forceinline__ float bfhi(unsigned w) { return __uint_as_float(w & 0xffff0000u); }

__device__ __forceinline__ int bid_opaque() { int b = blockIdx.x; asm volatile("" : "+s"(b)); return b; }
__device__ __forceinline__ int nblk_opaque() { int b = gridDim.x; asm volatile("" : "+s"(b)); return b; }
__device__ __forceinline__ int tid_opaque() { int t = threadIdx.x; asm volatile("" : "+v"(t)); return t; }

namespace pg8 {
#define PG8_LAS __attribute__((address_space(3)))
typedef unsigned short bf16_t;
typedef short bf16x8 __attribute__((ext_vector_type(8)));
typedef float f32x4 __attribute__((ext_vector_type(4)));
typedef unsigned u32x4 __attribute__((ext_vector_type(4)));
constexpr int BM = 256, BK = 64, HALF = 128, HTB = HALF * BK * 2  , STAGE_BYTES = 8 * HTB, NXCD = 8, WGM = 8;

__host__ __device__ __forceinline__ int lds_byte(int r, int c) { const int st = (r >> 4) * 2 + (c >> 5), rr = r & 15, cc = c & 31, ob = rr * 64 + cc * 2; return st * 1024 + (ob ^ (((ob >> 9) & 1) << 5)); }
__host__ __device__ __forceinline__ void stage_rc(int b, int& R, int& C) { const int st = b / 1024, sb = b % 1024, swz = sb ^ (((sb >> 9) & 1) << 5); R = (st >> 1) * 16 + swz / 64; C = (st & 1) * 32 + (swz % 64) / 2; }
__host__ __device__ __forceinline__ int perm32(int rho) { const int n = rho >> 4, i = rho & 15; return 8 * (i >> 2) + 4 * n + (i & 3); }

struct Unit { int pm, pn; };
struct Gemm { const bf16_t* A; const bf16_t* Bt; int M, N, K; };

struct StaticOrder {
    int nM, nN, nwg, G, c, wgm;
    __host__ __device__ void init(int M, int N, int G_, int c_, int wgm_ = WGM) { nM = M / BM; nN = N / BM; nwg = nM * nN; G = G_; c = c_; wgm = wgm_; }
    __host__ __device__ bool next(int i, Unit& u) const {
        const long L = (long)i * G + c; if (L >= nwg) return false;
        int wgid = (int)L; { const int q = nwg / NXCD, r = nwg % NXCD, xcd = wgid % NXCD, off = wgid / NXCD; wgid = (xcd < r ? xcd * (q + 1) : r * (q + 1) + (xcd - r) * q) + off; }
        const int nig = wgm * nN, gid = wgid / nig, fm = gid * wgm, gsz = (nM - fm) < wgm ? (nM - fm) : wgm;
        u.pm = fm + ((wgid % nig) % gsz); u.pn = (wgid % nig) / gsz; return true;
    }
    __device__ __forceinline__ void a_ready(const Unit&) const {}
    __device__ __forceinline__ void done(const Unit&) const {}
};
__device__ __forceinline__ unsigned cvt_pk_bf16(float lo, float hi) { unsigned r; asm volatile("v_cvt_pk_bf16_f32 %0, %1, %2" : "=v"(r) : "v"(lo), "v"(hi)); return r; }
typedef float f32x2 __attribute__((ext_vector_type(2)));
__device__ __forceinline__ f32x2 gelu_pk(f32x2 v) {
    const f32x2 av = __builtin_elementwise_abs(v), d = av * 0.2316418882f + 1.0f;
    f32x2 t; t.x = __builtin_amdgcn_rcpf(d.x); t.y = __builtin_amdgcn_rcpf(d.y);
    f32x2 q = t * 0.5307027145f + (-0.7265760135f); q = q * t + 0.7107068705f; q = q * t + (-0.142248368f); q = q * t + 0.127414796f; q = q * t;
    const f32x2 s = (v * v) * (-0.72134752044f);
    f32x2 e; e.x = __builtin_amdgcn_exp2f(s.x); e.y = __builtin_amdgcn_exp2f(s.y);
    const f32x2 m = v * (q * e), r = v - m;
    f32x2 o; o.x = v.x < 0.f ? m.x : r.x; o.y = v.y < 0.f ? m.y : r.y; return o;
}

struct EpiF32 {
    static constexpr bool PERM = false, AFTER_DRAIN = false;
    float* C; int ldc; const float* bias;
    __device__ __forceinline__ void operator()(const f32x4 (&acc)[2][2][4][2], const Unit& u, int wr, int wc, int fr, int fq) const {
        const int row0 = u.pm * BM + wr * 64 + fr, col0 = u.pn * BM + wc * 32 + 4 * fq;
        f32x4 bv[2][2];
#pragma unroll
        for (int bj = 0; bj < 2; ++bj)
#pragma unroll
            for (int n = 0; n < 2; ++n) bv[bj][n] = bias ? *(const f32x4*)(bias + col0 + bj * HALF + n * 16) : (f32x4){0.f, 0.f, 0.f, 0.f};
#pragma unroll
        for (int ai = 0; ai < 2; ++ai)
#pragma unroll
            for (int m = 0; m < 4; ++m) { float* rowp = C + (size_t)(row0 + ai * HALF + m * 16) * ldc + col0;
#pragma unroll
                for (int bj = 0; bj < 2; ++bj)
#pragma unroll
                    for (int n = 0; n < 2; ++n) *(f32x4*)(rowp + bj * HALF + n * 16) = acc[ai][bj][m][n] + bv[bj][n]; }
    }
};
template <int ACT  > struct EpiBf16 {
    static constexpr bool PERM = true, AFTER_DRAIN = false;
    bf16_t* O; int ldc; const float* bias; int split_cols; size_t split_stride;
    __device__ __forceinline__ void operator()(const f32x4 (&acc)[2][2][4][2], const Unit& u, int wr, int wc, int fr, int fq) const {
        const int row0 = u.pm * BM + wr * 64 + fr; int colt = u.pn * BM; bf16_t* base = O;
        if (split_cols) { const int t = colt / split_cols; base += (size_t)t * split_stride; colt -= t * split_cols; }
        const int col0 = colt + wc * 32 + 8 * fq, bcol0 = u.pn * BM + wc * 32 + 8 * fq;
        f32x4 bv[2][2];
#pragma unroll
        for (int bj = 0; bj < 2; ++bj)
#pragma unroll
            for (int n = 0; n < 2; ++n) bv[bj][n] = bias ? *(const f32x4*)(bias + bcol0 + bj * HALF + 4 * n) : (f32x4){0.f, 0.f, 0.f, 0.f};
#pragma unroll
        for (int ai = 0; ai < 2; ++ai)
#pragma unroll
            for (int m = 0; m < 4; ++m) { bf16_t* rowp = base + (size_t)(row0 + ai * HALF + m * 16) * ldc + col0;
#pragma unroll
                for (int bj = 0; bj < 2; ++bj) { f32x4 v0 = acc[ai][bj][m][0] + bv[bj][0], v1 = acc[ai][bj][m][1] + bv[bj][1];
                    if (ACT == 1) { f32x2 a = gelu_pk((f32x2){v0[0], v0[1]}), b = gelu_pk((f32x2){v0[2], v0[3]}), c = gelu_pk((f32x2){v1[0], v1[1]}), d = gelu_pk((f32x2){v1[2], v1[3]});
                        v0 = (f32x4){a.x, a.y, b.x, b.y}; v1 = (f32x4){c.x, c.y, d.x, d.y}; }
                    if (ACT == 2) {
#pragma unroll
                        for (int j = 0; j < 4; ++j) { v0[j] = 0.5f * v0[j] * (1.0f + erff(v0[j] * 0.70710678f)); v1[j] = 0.5f * v1[j] * (1.0f + erff(v1[j] * 0.70710678f)); } }
                    u32x4 w; w.x = cvt_pk_bf16(v0[0], v0[1]); w.y = cvt_pk_bf16(v0[2], v0[3]); w.z = cvt_pk_bf16(v1[0], v1[1]); w.w = cvt_pk_bf16(v1[2], v1[3]);
                    *(u32x4*)(rowp + bj * HALF) = w; } }
    }
};

template <class Epi, class Sched, bool STAMP = false>
__device__ __forceinline__ void gemm_phase(PG8_LAS unsigned char* lds, const Gemm g, const Sched& S, const Epi& E, unsigned long long* stamps) {
    const int tid = tid_opaque(), wid = __builtin_amdgcn_readfirstlane(tid >> 6), lane = tid & 63, wr = wid >> 2, wc = wid & 3, fr = lane & 15, fq = lane >> 4;
    const int K = g.K, nt = K / BK;
    int ts_lo = 0, ts_hi = 0, nts = 0; const unsigned long long rt_entry = STAMP ? (unsigned long long)wall_clock64() : 0ull;
#define PG8_STAMP() do { if (STAMP && wid == 0 && nts < 64) { const unsigned long long _c = (unsigned long long)clock64(); \
        ts_lo = (lane == nts) ? (int)(unsigned)_c : ts_lo; ts_hi = (lane == nts) ? (int)(unsigned)(_c >> 32) : ts_hi; ++nts; } } while (0)
    PG8_STAMP();
    unsigned voffA[2], voffB[2];
#pragma unroll
    for (int i = 0; i < 2; ++i) { int R, C; stage_rc(tid * 16 + i * 8192, R, C); const int Rb = Epi::PERM ? ((R & ~31) + perm32(R & 31)) : R;
        voffA[i] = (unsigned)(R * K + C) * 2u; voffB[i] = (unsigned)(Rb * K + C) * 2u; }
    const size_t kstep = (size_t)(BK * 2);
    const size_t hstep = (size_t)HALF * K * 2;
    const size_t tstep = 2 * hstep;
    const unsigned ldsw = (unsigned)wid * 1024u;
    const int aoff = lds_byte(wr * 64 + fr, fq * 8), boff = lds_byte(wc * 32 + fr, fq * 8);
#define PG8_SA(b, h) (((b) * 2 + (h)) * HTB)
#define PG8_SB(b, h) ((4 + (b) * 2 + (h)) * HTB)
#define PG8_STAGE(bufoff, gbase, voff) do { _Pragma("unroll") for (int _i = 0; _i < 2; ++_i) \
        __builtin_amdgcn_global_load_lds((const unsigned*)((const char*)(gbase) + (voff)[_i]), (PG8_LAS unsigned*)(lds + (bufoff) + ldsw + _i * 8192), 16, 0, 0); } while (0)
#define PG8_LDA(dst, b, h) do { _Pragma("unroll") for (int m = 0; m < 4; ++m) _Pragma("unroll") for (int k = 0; k < 2; ++k) dst[m][k] = *(const PG8_LAS bf16x8*)(lds + PG8_SA(b, h) + aoff + m * 2048 + k * 1024); } while (0)
#define PG8_LDB(dst, b, h) do { _Pragma("unroll") for (int n = 0; n < 2; ++n) _Pragma("unroll") for (int k = 0; k < 2; ++k) dst[n][k] = *(const PG8_LAS bf16x8*)(lds + PG8_SB(b, h) + boff + n * 2048 + k * 1024); } while (0)
#define PG8_MMA(ai, bj, At, Bt) do { __builtin_amdgcn_s_setprio(1); _Pragma("unroll") for (int m = 0; m < 4; ++m) _Pragma("unroll") for (int n = 0; n < 2; ++n) _Pragma("unroll") for (int k = 0; k < 2; ++k) \
        acc[ai][bj][m][n] = __builtin_amdgcn_mfma_f32_16x16x32_bf16(Bt[n][k], At[m][k], acc[ai][bj][m][n], 0, 0, 0); __builtin_amdgcn_s_setprio(0); } while (0)
#define PG8_WAIT_V(n) asm volatile("s_waitcnt vmcnt(" #n ")" ::: "memory")
#define PG8_WAIT_L(n) asm volatile("s_waitcnt lgkmcnt(" #n ")" ::: "memory")
#define PG8_BAR __builtin_amdgcn_s_barrier()
#define PG8_SCHED __builtin_amdgcn_sched_barrier(0)
    Unit cur, nxt; int ui = 0;
    if (!S.next(0, cur)) return;
    f32x4 acc[2][2][4][2];
#pragma unroll
    for (int a = 0; a < 2; ++a)
#pragma unroll
        for (int b = 0; b < 2; ++b)
#pragma unroll
            for (int m = 0; m < 4; ++m)
#pragma unroll
                for (int n = 0; n < 2; ++n) acc[a][b][m][n] = (f32x4){0.f, 0.f, 0.f, 0.f};
    bf16x8 At[4][2], B0[2][2], B1[2][2];
    const char* cA = (const char*)g.A + (size_t)cur.pm * tstep; const char* cB = (const char*)g.Bt + (size_t)cur.pn * tstep;
    S.a_ready(cur);
    PG8_STAGE(PG8_SB(0, 0), cB, voffB); PG8_STAGE(PG8_SA(0, 0), cA, voffA); PG8_STAGE(PG8_SB(0, 1), cB + hstep, voffB); PG8_STAGE(PG8_SA(0, 1), cA + hstep, voffA);
    if (wr == 1) PG8_BAR;
    PG8_WAIT_V(4); PG8_BAR;
    PG8_STAGE(PG8_SB(1, 0), cB + kstep, voffB); PG8_STAGE(PG8_SA(1, 0), cA + kstep, voffA); PG8_STAGE(PG8_SB(1, 1), cB + hstep + kstep, voffB);
    PG8_WAIT_V(6); PG8_BAR;
    PG8_STAMP();
    for (;;) {
        const bool has_next = S.next(ui + 1, nxt);
        const char* nA = has_next ? (const char*)g.A + (size_t)nxt.pm * tstep : cA; const char* nB = has_next ? (const char*)g.Bt + (size_t)nxt.pn * tstep : cB;
        for (int t = 0; t < nt; t += 2) {
            const bool last = (t == nt - 2);
            const char* a1 = cA + (size_t)(t + 1) * kstep;
            const char* a2 = last ? nA : cA + (size_t)(t + 2) * kstep; const char* b2 = last ? nB : cB + (size_t)(t + 2) * kstep;
            const char* a3 = a2 + kstep; const char* b3 = b2 + kstep;
            if (last && has_next) S.a_ready(nxt);
            PG8_LDB(B0, 0, 0); PG8_SCHED; PG8_LDA(At, 0, 0); PG8_STAGE(PG8_SA(1, 1), a1 + hstep, voffA);
            PG8_WAIT_L(8); PG8_BAR; PG8_WAIT_L(0); PG8_MMA(0, 0, At, B0); PG8_BAR; PG8_SCHED;
            PG8_LDB(B1, 0, 1); PG8_STAGE(PG8_SB(0, 0), b2, voffB);
            PG8_BAR; PG8_WAIT_L(0); PG8_MMA(0, 1, At, B1); PG8_BAR;
            PG8_LDA(At, 0, 1); PG8_STAGE(PG8_SA(0, 0), a2, voffA);
            PG8_BAR; PG8_WAIT_L(0); PG8_MMA(1, 0, At, B0); PG8_BAR; PG8_SCHED;
            PG8_STAGE(PG8_SB(0, 1), b2 + hstep, voffB);
            PG8_WAIT_V(6); PG8_BAR; PG8_MMA(1, 1, At, B1); PG8_BAR;
            PG8_LDB(B0, 1, 0); PG8_SCHED; PG8_LDA(At, 1, 0); PG8_STAGE(PG8_SA(0, 1), a2 + hstep, voffA);
            PG8_WAIT_L(8); PG8_BAR; PG8_WAIT_L(0); PG8_MMA(0, 0, At, B0); PG8_BAR; PG8_SCHED;
            PG8_LDB(B1, 1, 1); PG8_STAGE(PG8_SB(1, 0), b3, voffB);
            PG8_BAR; PG8_WAIT_L(0); PG8_MMA(0, 1, At, B1); PG8_BAR;
            PG8_LDA(At, 1, 1); PG8_STAGE(PG8_SA(1, 0), a3, voffA);
            PG8_BAR; PG8_WAIT_L(0); PG8_MMA(1, 0, At, B0); PG8_BAR; PG8_SCHED;
            PG8_STAGE(PG8_SB(1, 1), b3 + hstep, voffB);
            PG8_WAIT_V(6); PG8_BAR; PG8_MMA(1, 1, At, B1); PG8_BAR;
        }
        PG8_STAMP();
        if constexpr (!Epi::AFTER_DRAIN) { E(acc, cur, wr, wc, fr, fq); S.done(cur); }
        PG8_STAMP();
        if (!has_next) break;
#pragma unroll
        for (int a = 0; a < 2; ++a)
#pragma unroll
            for (int b = 0; b < 2; ++b)
#pragma unroll
                for (int m = 0; m < 4; ++m)
#pragma unroll
                    for (int n = 0; n < 2; ++n) acc[a][b][m][n] = (f32x4){0.f, 0.f, 0.f, 0.f};
        cur = nxt; cA = nA; cB = nB; ++ui;
    }
    PG8_WAIT_V(0);
    if (wr == 0) PG8_BAR;
    PG8_BAR;
    if constexpr (Epi::AFTER_DRAIN) { E.fused(acc, cur, wr, wc, fr, fq, lds, wid, lane); S.done(cur); }
    PG8_STAMP();
    if (STAMP && wid == 0) { stamps[lane] = lane < nts ? (((unsigned long long)(unsigned)ts_hi << 32) | (unsigned)ts_lo) : 0ull;
        if (lane == 62) stamps[62] = rt_entry; if (lane == 63) stamps[63] = (unsigned long long)wall_clock64(); }
#undef PG8_STAMP
#undef PG8_SA
#undef PG8_SB
#undef PG8_STAGE
#undef PG8_LDA
#undef PG8_LDB
#undef PG8_MMA
#undef PG8_WAIT_V
#undef PG8_WAIT_L
#undef PG8_BAR
#undef PG8_SCHED
}
}
#define XB_TMO      128
#define XB_XCNT(j)  (256  + 64 * (j))
#define XB_XSUB(j)  (1280 + 64 * (j))
#define XB_XGEN(j)  (2304 + 64 * (j))
#define XB_TOP      3328
#define XB_TOPGEN   3392
#define XCD_BAR_WORDS 3456
#define XB_SPIN_CAP (1u << 18)
#define LAS __attribute__((address_space(3)))

__device__ __forceinline__ unsigned xb_ld(unsigned* p)              { return __hip_atomic_load(p, __ATOMIC_RELAXED, __HIP_MEMORY_SCOPE_AGENT); }
__device__ __forceinline__ unsigned xb_add(unsigned* p, unsigned v) { return __hip_atomic_fetch_add(p, v, __ATOMIC_RELAXED, __HIP_MEMORY_SCOPE_AGENT); }
__device__ __forceinline__ unsigned xb_xcc_id() { return (unsigned)__builtin_amdgcn_s_getreg((3 << 11) | 20) & 0xFu; }
#define XB_SPIN(cond, bar) do { unsigned _sp = 0; while (cond) { __builtin_amdgcn_s_sleep(1); \
    if ((++_sp & 255u) == 0u) { if (xb_ld(&(bar)[XB_TMO])) break; if (_sp > XB_SPIN_CAP) { atomicAdd(&(bar)[XB_TMO], 1u); break; } } } } while (0)

struct XcdBarrier {
    unsigned* bar; unsigned x;
    volatile LAS unsigned* st;
};

__device__ __forceinline__ XcdBarrier xcd_barrier_post(unsigned* bar, volatile LAS unsigned* st) {
    XcdBarrier b; b.bar = bar; b.x = xb_xcc_id(); b.st = st;
    if (threadIdx.x == 0) (void)xb_add(&bar[XB_XCNT(b.x)], 1u);
    return b;
}
__device__ __forceinline__ void xcd_barrier_complete(unsigned* bar, unsigned x, unsigned& nloc, unsigned& nx) {
    const unsigned G = gridDim.x * gridDim.y * gridDim.z;
    unsigned sum, cnt, mine, sp = 0u;
    for (;;) {
        sum = 0u; cnt = 0u; mine = 0u;
#pragma unroll
        for (unsigned j = 0; j < 16; ++j) { const unsigned c = xb_ld(&bar[XB_XCNT(j)]); sum += c; cnt += (c > 0u) ? 1u : 0u; mine = (j == x) ? c : mine; }
        if (sum == G) break;
        __builtin_amdgcn_s_sleep(1);
        if ((++sp & 255u) == 0u) { if (xb_ld(&bar[XB_TMO])) break; if (sp > XB_SPIN_CAP) { atomicAdd(&bar[XB_TMO], 1u); break; } }
    }
    nloc = mine > 0u ? mine : 1u; nx = cnt > 0u ? cnt : 1u;
}

__device__ __forceinline__ void xcd_barrier(const XcdBarrier& b) {
    asm volatile("s_waitcnt vmcnt(0)" ::: "memory");
    __syncthreads();
    if (threadIdx.x == 0) {
        unsigned* bar = b.bar;
        __builtin_amdgcn_s_waitcnt(0);
        unsigned nloc = b.st[0], nx = b.st[1];
        if (nloc == 0u) { xcd_barrier_complete(bar, b.x, nloc, nx); b.st[0] = nloc; b.st[1] = nx; }
        const unsigned old = xb_add(&bar[XB_XSUB(b.x)], 1u);
        const unsigned gen = old / nloc;
        if (old + 1u == (gen + 1u) * nloc) {
            __builtin_amdgcn_fence(__ATOMIC_RELEASE, "agent");
            asm volatile("s_waitcnt vmcnt(0)" ::: "memory");
            const unsigned og = xb_add(&bar[XB_TOP], 1u);
            const unsigned tg = og / nx;
            if (og + 1u == (tg + 1u) * nx) xb_add(&bar[XB_TOPGEN], 1u);
            else XB_SPIN(xb_ld(&bar[XB_TOPGEN]) == tg, bar);
            __builtin_amdgcn_fence(__ATOMIC_ACQUIRE, "agent");
            xb_add(&bar[XB_XGEN(b.x)], 1u);
            asm volatile("s_waitcnt vmcnt(0)" ::: "memory");
        } else {
            XB_SPIN(xb_ld(&bar[XB_XGEN(b.x)]) == gen, bar);
            __builtin_amdgcn_fence(__ATOMIC_ACQUIRE, "agent");
            asm volatile("s_waitcnt vmcnt(0)" ::: "memory");
        }
    }
    __syncthreads();
}


using pg8::f32x4; using pg8::u32x4; using pg8::Unit; using pg8::Gemm; using pg8::StaticOrder;
typedef unsigned u32x2 __attribute__((ext_vector_type(2)));
#define LDSP PG8_LAS unsigned char*

constexpr int N1 = 10496;
constexpr size_t OW1 = 0, OW2 = OW1 + (size_t)N1 * 1024, OW3 = OW2 + (size_t)1024 * 2048, OW4 = OW3 + (size_t)1024 * 1024, OW5 = OW4 + (size_t)1024 * 1024,
                 OW6 = OW5 + (size_t)8192 * 1024, OW7 = OW6 + (size_t)1024 * 4096, OW8 = OW7 + (size_t)1024 * 256, WT_LAYER = OW8 + (size_t)1024 * 1024;
constexpr int NCHUNK = 256 + DEC_BATCH;

struct Params {
    const float *x_prompt, *x_sample, *state_ssd_conv, *state_ssd, *cache_k, *cache_v, *state_ffn_conv, *p_prompt, *p_sample;
    const float *norm_pre_mix, *w_in, *ssd_conv_w, *ssd_conv_b, *ssd_dt_bias, *ssd_a_log, *ssd_d, *ssd_norm, *w_br_ssd, *w_br_sb, *w_out, *norm_post_mix, *norm_pre_ffn,
                *w_up, *ffn_conv_w, *ffn_conv_b, *w_down, *norm_post_ffn, *w_ple, *w_ple_gate, *norm_ple;
    float* out;
    unsigned* bar;
    bf16_t* wt; bf16_t* xr; bf16_t* xb; float* rs; float* rs2; bf16_t* pb;
    bf16_t *zb, *xbcb, *qb, *gb, *kb, *vb; float* dtb;
    float* sst; float* dec; bf16_t* hpb;
    bf16_t *yn, *att, *t1, *mixin; bf16_t* mixed;
    bf16_t *gh, *xh, *ffb; bf16_t* down; bf16_t* plea; bf16_t* ple;
};

typedef const __attribute__((address_space(4))) Params CP;
#define CPR CP&
__device__ __forceinline__ CP* kargs() { CP* q = (CP*)__builtin_amdgcn_kernarg_segment_ptr(); asm volatile("" : "+s"(q)); return q; }

__device__ __forceinline__ void wt_item(const float* __restrict__ W, int K, int ldw, const float* __restrict__ gain, bf16_t* __restrict__ Wt, int nblk, int item, int w1map, PG8_LAS float* scr, int lane) {
    const int kb = item / nblk, nb = item % nblk, k0 = 64 * kb, n0 = 32 * nb;
    int sc0 = n0; if (w1map == 1) sc0 = (n0 < 5120) ? n0 : (n0 < 10240 ? n0 + 32 : (n0 < 10272 ? n0 - 5120 : -1));
    else if (w1map == 2) sc0 = ((n0 & 255) < 128 ? 0 : 4096) + (n0 >> 8) * 128 + (n0 & 127);
    const int kr = lane >> 3, c4 = (lane & 7) * 4;
    float4 v[8];
#pragma unroll
    for (int i = 0; i < 8; ++i) v[i] = (sc0 >= 0) ? *(const float4*)(W + (size_t)(k0 + kr + 8 * i) * ldw + sc0 + c4) : make_float4(0.f, 0.f, 0.f, 0.f);
#pragma unroll
    for (int i = 0; i < 8; ++i) { const int kk = kr + 8 * i; const float gm = gain ? gain[k0 + kk] : 1.0f; PG8_LAS float* d = scr + kk * 33 + c4;
        d[0] = v[i].x * gm; d[1] = v[i].y * gm; d[2] = v[i].z * gm; d[3] = v[i].w * gm; }
    asm volatile("s_waitcnt lgkmcnt(0)" ::: "memory");
    const int c = lane & 7;
#pragma unroll
    for (int j = 0; j < 4; ++j) { const int nn = (lane >> 3) + 8 * j; const PG8_LAS float* s = scr + (8 * c) * 33 + nn;
        *(u32x4*)(Wt + (size_t)(n0 + nn) * K + k0 + 8 * c) = (u32x4){pk2(s[0], s[33]), pk2(s[2 * 33], s[3 * 33]), pk2(s[4 * 33], s[5 * 33]), pk2(s[6 * 33], s[7 * 33])}; }
    asm volatile("s_waitcnt lgkmcnt(0)" ::: "memory");
}
__device__ __forceinline__ void ph_wt(CPR p, LDSP lds) {
    constexpr int U1 = 16 * 328, U2 = U1 + 32 * 32, U3 = U2 + 512, U4 = U3 + 512, U5 = U4 + 16 * 256, U6 = U5 + 64 * 32, U7 = U6 + 4 * 32, U8 = U7 + 512;
    const int tidx = tid_opaque(), lane = tidx & 63, wv = tidx >> 6, gw = bid_opaque() * 8 + wv, NGW = nblk_opaque() * 8;
    PG8_LAS float* scr = (PG8_LAS float*)(lds + wv * (64 * 33 * 4));
    for (int u = gw; u < DEPTH * U8; u += NGW) {
        const int l = u / U8; int v = u % U8; bf16_t* wl = p.wt + (size_t)l * WT_LAYER;
        if (v < U1)      { wt_item(p.w_in + (size_t)l * 1024 * IN_DIM, 1024, IN_DIM, p.norm_pre_mix + l * 1024, wl + OW1, 328, v, 1, scr, lane); }
        else if (v < U2) { v -= U1; wt_item(p.w_br_ssd + (size_t)l * 2048 * 1024, 2048, 1024, p.ssd_norm + l * 2048, wl + OW2, 32, v, 0, scr, lane); }
        else if (v < U3) { v -= U2; wt_item(p.w_br_sb + (size_t)l * 1024 * 1024, 1024, 1024, nullptr, wl + OW3, 32, v, 0, scr, lane); }
        else if (v < U4) { v -= U3; wt_item(p.w_out + (size_t)l * 1024 * 1024, 1024, 1024, nullptr, wl + OW4, 32, v, 0, scr, lane); }
        else if (v < U5) { v -= U4; wt_item(p.w_up + (size_t)l * 1024 * 8192, 1024, 8192, p.norm_pre_ffn + l * 1024, wl + OW5, 256, v, 2, scr, lane); }
        else if (v < U6) { v -= U5; wt_item(p.w_down + (size_t)l * 4096 * 1024, 4096, 1024, nullptr, wl + OW6, 32, v, 0, scr, lane); }
        else if (v < U7) { v -= U6; wt_item(p.w_ple + (size_t)l * 256 * 1024, 256, 1024, nullptr, wl + OW7, 32, v, 0, scr, lane); }
        else             { v -= U7; wt_item(p.w_ple_gate + (size_t)l * 1024 * 1024, 1024, 1024, nullptr, wl + OW8, 32, v, 0, scr, lane); }
    }
    __syncthreads();
}
__device__ __forceinline__ void ph_xprep(CPR p) {
    const int tidx = tid_opaque(); const int lane = tidx & 63, gw = bid_opaque() * 8 + (tidx >> 6), NGW = nblk_opaque() * 8;
    for (int row0 = 2 * gw; row0 < M_ALL; row0 += 2 * NGW) {
        float4 v[2][4]; float ss[2] = {0.f, 0.f};
#pragma unroll
        for (int q = 0; q < 2; ++q) { const int row = row0 + q; const float4* src = (const float4*)(row < M_P ? p.x_prompt + (size_t)row * 1024 : p.x_sample + (size_t)(row - M_P) * 1024);
#pragma unroll
            for (int j = 0; j < 4; ++j) v[q][j] = src[lane + 64 * j]; }
#pragma unroll
        for (int q = 0; q < 2; ++q) { const int row = row0 + q;
#pragma unroll
            for (int j = 0; j < 4; ++j) { ss[q] += v[q][j].x * v[q][j].x + v[q][j].y * v[q][j].y + v[q][j].z * v[q][j].z + v[q][j].w * v[q][j].w;
                ((u32x2*)(p.xr + (size_t)row * 1024))[lane + 64 * j] = (u32x2){pk2(v[q][j].x, v[q][j].y), pk2(v[q][j].z, v[q][j].w)}; }
            const float rn = rsqrtf(wave_sum(ss[q]) * (1.0f / 1024.f) + EPS);
#pragma unroll
            for (int j = 0; j < 4; ++j) ((u32x2*)(p.xb + (size_t)row * 1024))[lane + 64 * j] = (u32x2){pk2(v[q][j].x * rn, v[q][j].y * rn), pk2(v[q][j].z * rn, v[q][j].w * rn)}; }
    }
    for (int r0 = 4 * gw; r0 < DEPTH * M_ALL; r0 += 4 * NGW) {
        float4 v[4];
#pragma unroll
        for (int q = 0; q < 4; ++q) { const int r2 = r0 + q, l = r2 / M_ALL, row = r2 % M_ALL;
            v[q] = ((const float4*)(row < M_P ? p.p_prompt + ((size_t)l * M_P + row) * PLE_DIM : p.p_sample + ((size_t)l * M_S + row - M_P) * PLE_DIM))[lane]; }
#pragma unroll
        for (int q = 0; q < 4; ++q) ((u32x2*)(p.pb + (size_t)(r0 + q) * PLE_DIM))[lane] = (u32x2){pk2(v[q].x, v[q].y), pk2(v[q].z, v[q].w)};
    }
}
__device__ __forceinline__ void ph_norm(const bf16_t* __restrict__ src, const float* __restrict__ gain, bf16_t* xr, bf16_t* xb, float* yP, float* yS, bf16_t* xh = nullptr) {
    const int tidx = tid_opaque(); const int lane = tidx & 63, gw = bid_opaque() * 8 + (tidx >> 6), NGW = nblk_opaque() * 8;
    float4 g[4];
#pragma unroll
    for (int j = 0; j < 4; ++j) g[j] = ((const float4*)gain)[lane + 64 * j];
    for (int row0 = 2 * gw; row0 < M_ALL; row0 += 2 * NGW) {
        u32x2 sv[2][4], xv[2][4];
#pragma unroll
        for (int q = 0; q < 2; ++q)
#pragma unroll
            for (int j = 0; j < 4; ++j) { sv[q][j] = ((const u32x2*)(src + (size_t)(row0 + q) * 1024))[lane + 64 * j]; xv[q][j] = ((const u32x2*)(xr + (size_t)(row0 + q) * 1024))[lane + 64 * j]; }
#pragma unroll
        for (int q = 0; q < 2; ++q) {
            const int row = row0 + q;
            float4 v[4], x[4]; float ss = 0.f;
#pragma unroll
            for (int j = 0; j < 4; ++j) { v[j] = make_float4(bflo(sv[q][j].x), bfhi(sv[q][j].x), bflo(sv[q][j].y), bfhi(sv[q][j].y)); x[j] = make_float4(bflo(xv[q][j].x), bfhi(xv[q][j].x), bflo(xv[q][j].y), bfhi(xv[q][j].y));
                ss += v[j].x * v[j].x + v[j].y * v[j].y + v[j].z * v[j].z + v[j].w * v[j].w; }
            ss = wave_sum(ss);
            const float r = rsqrtf(ss * (1.0f / 1024.f) + EPS); float s2 = 0.f;
#pragma unroll
            for (int j = 0; j < 4; ++j) {
                x[j].x += v[j].x * r * g[j].x; x[j].y += v[j].y * r * g[j].y; x[j].z += v[j].z * r * g[j].z; x[j].w += v[j].w * r * g[j].w;
                s2 += x[j].x * x[j].x + x[j].y * x[j].y + x[j].z * x[j].z + x[j].w * x[j].w;
                ((u32x2*)(xr + (size_t)row * 1024))[lane + 64 * j] = (u32x2){pk2(x[j].x, x[j].y), pk2(x[j].z, x[j].w)};
            }
            if (xb) {
                const float rn = rsqrtf(wave_sum(s2) * (1.0f / 1024.f) + EPS);
#pragma unroll
                for (int j = 0; j < 4; ++j) {
                    const u32x2 wq = (u32x2){pk2(x[j].x * rn, x[j].y * rn), pk2(x[j].z * rn, x[j].w * rn)};
                    ((u32x2*)(xb + (size_t)row * 1024))[lane + 64 * j] = wq;
                    if (xh && (row & 63) >= 62) ((u32x2*)(xh + (size_t)(2 * ((row >> 6) + 1) + (row & 63) - 62) * 1024))[lane + 64 * j] = wq;
                }
            }
            if (yP) { float4* y4 = (float4*)(row < M_P ? yP + (size_t)row * 1024 : yS + (size_t)(row - M_P) * 1024);
#pragma unroll
                for (int j = 0; j < 4; ++j) y4[lane + 64 * j] = x[j]; }
        }
    }
}
__device__ __forceinline__ void unpack8(const u32x4 w, float (&v)[8]) {
    v[0] = bflo(w.x); v[1] = bfhi(w.x); v[2] = bflo(w.y); v[3] = bfhi(w.y); v[4] = bflo(w.z); v[5] = bfhi(w.z); v[6] = bflo(w.w); v[7] = bfhi(w.w);
}
__device__ __forceinline__ void load8f(const float* p, float (&v)[8]) { const float4 a = ((const float4*)p)[0], b = ((const float4*)p)[1]; v[0] = a.x; v[1] = a.y; v[2] = a.z; v[3] = a.w; v[4] = b.x; v[5] = b.y; v[6] = b.z; v[7] = b.w; }
__device__ __forceinline__ float gelu_fast(float x) { const float u2 = 1.5957691216057308f * (x + 0.044715f * x * x * x); return x * __builtin_amdgcn_rcpf(1.0f + __expf(-u2)); }
struct EpiIn {
    static constexpr bool PERM = true, AFTER_DRAIN = false;
    const float* rs; bf16_t *zb, *xbcb, *qb, *gb, *kb, *vb; float* dtb; const float* dt_bias; float *kP, *vP, *kS, *vS, *convP, *convS;
    __device__ __forceinline__ void operator()(const f32x4 (&acc)[2][2][4][2], const Unit& u, int wr, int wc, int fr, int fq) const {
        const int row0 = u.pm * 256 + wr * 64 + fr, seg = u.pn, cl = wc * 32 + 8 * fq;
#pragma unroll
        for (int ai = 0; ai < 2; ++ai)
#pragma unroll
            for (int m = 0; m < 4; ++m) {
                const int r = row0 + ai * 128 + m * 16;
#pragma unroll
                for (int bj = 0; bj < 2; ++bj) {
                    const int ct = cl + bj * 128; const f32x4 v0 = acc[ai][bj][m][0], v1 = acc[ai][bj][m][1];
                    const u32x4 w = (u32x4){pk2c(v0[0], v0[1]), pk2c(v0[2], v0[3]), pk2c(v1[0], v1[1]), pk2c(v1[2], v1[3])};
                    if (seg < 8) { *(u32x4*)(zb + (size_t)r * 2048 + seg * 256 + ct) = w; }
                    else if (seg < 20) {
                        const int c = (seg - 8) * 256 + ct; *(u32x4*)(xbcb + (size_t)r * 3072 + c) = w;
                        float* dst = nullptr;
                        if (r < M_P) { if (r >= M_P - 3) dst = convP + (size_t)(r - (M_P - 3)) * 3072; }
                        else { const int t = (r - M_P) & 31, b = (r - M_P) >> 5; if (t >= 29) dst = convS + ((size_t)b * 3 + (t - 29)) * 3072; }
                        if (dst) { *(f32x4*)(dst + c) = v0; *(f32x4*)(dst + c + 4) = v1; }
                    }
                    else if (seg < 24) { *(u32x4*)(qb + (size_t)r * 1024 + (seg - 20) * 256 + ct) = w; }
                    else if (seg < 32) {
                        const int c = ((seg - 24) & 3) * 256 + ct; const bool isk = seg < 28;
                        float* dst = (r < M_P) ? (isk ? kP : vP) + (size_t)r * 1024 : (isk ? kS : vS) + (size_t)(r - M_P) * 1024;
                        *(f32x4*)(dst + c) = v0; *(f32x4*)(dst + c + 4) = v1;
                        *(u32x4*)((isk ? kb : vb) + (size_t)r * 1024 + c) = w;
                    }
                    else if (seg < 40) {
                        const f32x2_t s0 = sigmoid2((f32x2_t){v0[0], v0[1]}), s1 = sigmoid2((f32x2_t){v0[2], v0[3]}), s2 = sigmoid2((f32x2_t){v1[0], v1[1]}), s3 = sigmoid2((f32x2_t){v1[2], v1[3]});
                        *(u32x4*)(gb + (size_t)r * 2048 + (seg - 32) * 256 + ct) = (u32x4){pk2(s0.x, s0.y), pk2(s1.x, s1.y), pk2(s2.x, s2.y), pk2(s3.x, s3.y)};
                    }
                    else if (wc == 0 && bj == 0) {
                        const f32x4 b0 = *(const f32x4*)(dt_bias + 8 * fq), b1 = *(const f32x4*)(dt_bias + 8 * fq + 4);
                        f32x4 o0, o1;
#pragma unroll
                        for (int j = 0; j < 4; ++j) { o0[j] = softplusf_(v0[j] + b0[j]); o1[j] = softplusf_(v1[j] + b1[j]); }
                        *(f32x4*)(dtb + (size_t)r * 32 + 8 * fq) = o0; *(f32x4*)(dtb + (size_t)r * 32 + 8 * fq + 4) = o1;
                    }
                }
            }
    }
};
struct EpiHalo {
    static constexpr bool PERM = true, AFTER_DRAIN = false;
    const float* rs; bf16_t* gh;
    __device__ __forceinline__ void elem(int hi, int ch, float v) const { gh[(size_t)hi * D_FF + ch] = f2bf(v); }
    __device__ __forceinline__ void operator()(const f32x4 (&acc)[2][2][4][2], const Unit& u, int wr, int wc, int fr, int fq) const {
        const int row0 = u.pm * 256 + wr * 64 + fr, c0 = u.pn * 128 + wc * 32 + 8 * fq;
#pragma unroll
        for (int ai = 0; ai < 2; ++ai)
#pragma unroll
            for (int m = 0; m < 4; ++m) {
                const int hi = row0 + ai * 128 + m * 16;
                const f32x4 v0 = acc[ai][0][m][0], v1 = acc[ai][0][m][1];
                *(u32x4*)(gh + (size_t)hi * D_FF + c0) = (u32x4){pk2c(v0[0], v0[1]), pk2c(v0[2], v0[3]), pk2c(v1[0], v1[1]), pk2c(v1[2], v1[3])};
            }
    }
};
struct EpiUpAct {
    static constexpr bool PERM = true, AFTER_DRAIN = false;
    const float* rs; const bf16_t* gh; bf16_t* ffb; float *ffnP, *ffnS; const float* cw; const float* cb; const float* hist;
    __device__ __forceinline__ void operator()(const f32x4 (&acc)[2][2][4][2], const Unit& u, int wr, int wc, int fr, int fq) const {
        const int c0 = u.pn * 128 + wc * 32 + 8 * fq;
        float w0[8], w1[8], w2[8], bb[8];
        load8f(cw + c0, w0); load8f(cw + D_FF + c0, w1); load8f(cw + 2 * D_FF + c0, w2); load8f(cb + c0, bb);
#pragma unroll
        for (int ai = 0; ai < 2; ++ai) {
            const int strip = 4 * u.pm + 2 * ai + wr;
            float gprev[8];
#pragma unroll
            for (int m = 0; m < 4; ++m) {
                const int r = strip * 64 + 16 * m + fr;
                float g[8], uv[8], p1[8], p2[8];
#pragma unroll
                for (int j = 0; j < 4; ++j) { g[j] = acc[ai][0][m][0][j]; g[4 + j] = acc[ai][0][m][1][j]; uv[j] = acc[ai][1][m][0][j]; uv[4 + j] = acc[ai][1][m][1][j]; }
                if (m == 0) { float e14[8], e15[8]; unpack8(*(const u32x4*)(gh + (size_t)(2 * strip) * D_FF + c0), e14); unpack8(*(const u32x4*)(gh + (size_t)(2 * strip + 1) * D_FF + c0), e15);
#pragma unroll
                    for (int j = 0; j < 8; ++j) gprev[j] = (fr == 15) ? e15[j] : e14[j]; }
#pragma unroll
                for (int j = 0; j < 8; ++j) {
                    const float c1 = (fr == 15) ? gprev[j] : g[j], c2 = (fr >= 14) ? gprev[j] : g[j];
                    p1[j] = __builtin_bit_cast(float, __builtin_amdgcn_update_dpp(0, __builtin_bit_cast(int, c1), 0x121, 0xf, 0xf, false));
                    p2[j] = __builtin_bit_cast(float, __builtin_amdgcn_update_dpp(0, __builtin_bit_cast(int, c2), 0x122, 0xf, 0xf, false));
                }
                const int t = (r < M_P) ? r : ((r - M_P) & 31);
                if (t < 2) {
                    float h0[8], h1[8];
                    if (r >= M_P) { const float* hp = hist + (size_t)((r - M_P) >> 5) * 2 * D_FF + c0; load8f(hp, h0); load8f(hp + D_FF, h1); }
                    else {
#pragma unroll
                        for (int j = 0; j < 8; ++j) { h0[j] = 0.f; h1[j] = 0.f; } }
#pragma unroll
                    for (int j = 0; j < 8; ++j) { if (t == 0) { p2[j] = h0[j]; p1[j] = h1[j]; } else { p2[j] = h1[j]; } }
                }
                float o[8];
#pragma unroll
                for (int j = 0; j < 8; j += 2) {
                    const f32x2_t a = (f32x2_t){bb[j], bb[j + 1]} + (f32x2_t){w0[j], w0[j + 1]} * (f32x2_t){p2[j], p2[j + 1]} + (f32x2_t){w1[j], w1[j + 1]} * (f32x2_t){p1[j], p1[j + 1]} + (f32x2_t){w2[j], w2[j + 1]} * (f32x2_t){g[j], g[j + 1]};
                    const f32x2_t ov = gelu2(a) * (f32x2_t){uv[j], uv[j + 1]}; o[j] = ov.x; o[j + 1] = ov.y; }
                *(u32x4*)(ffb + (size_t)r * D_FF + c0) = (u32x4){pk2(o[0], o[1]), pk2(o[2], o[3]), pk2(o[4], o[5]), pk2(o[6], o[7])};
                float* dst = nullptr;
                if (r < M_P) { if (r >= M_P - 2) dst = ffnP + (size_t)(r - (M_P - 2)) * D_FF; }
                else { const int b = (r - M_P) >> 5; if (t >= 30) dst = ffnS + ((size_t)b * 2 + (t - 30)) * D_FF; }
                if (dst) { *(f32x4*)(dst + c0) = (f32x4){g[0], g[1], g[2], g[3]}; *(f32x4*)(dst + c0 + 4) = (f32x4){g[4], g[5], g[6], g[7]}; }
#pragma unroll
                for (int j = 0; j < 8; ++j) gprev[j] = g[j];
            }
        }
    }
};
struct EpiBr {
    static constexpr bool PERM = true, AFTER_DRAIN = false;
    const bf16_t* gb; const bf16_t* t1in; bf16_t* dst; int mode; int pad;
    __device__ __forceinline__ void elem(int r, int c, float v) const {
        float o = bf2f(gb[(size_t)r * 2048 + (mode == 0 ? 1024 : 0) + c]) * v; if (mode == 1) o += bf2f(t1in[(size_t)r * 1024 + c]);
        dst[(size_t)r * 1024 + c] = f2bf(o); }
    __device__ __forceinline__ void operator()(const f32x4 (&acc)[2][2][4][2], const Unit& u, int wr, int wc, int fr, int fq) const {
        const int row0 = u.pm * 256 + wr * 64 + fr, cl = u.pn * 256 + wc * 32 + 8 * fq;
#pragma unroll
        for (int ai = 0; ai < 2; ++ai)
#pragma unroll
            for (int m = 0; m < 4; ++m) {
                const int r = row0 + ai * 128 + m * 16;
#pragma unroll
                for (int bj = 0; bj < 2; ++bj) {
                    const int c = cl + bj * 128; float g[8], o[8];
                    unpack8(*(const u32x4*)(gb + (size_t)r * 2048 + (mode == 0 ? 1024 : 0) + c), g);
                    const f32x4 v0 = acc[ai][bj][m][0], v1 = acc[ai][bj][m][1];
                    float tv[8];
                    if (mode == 1) unpack8(*(const u32x4*)(t1in + (size_t)r * 1024 + c), tv);
                    else {
#pragma unroll
                        for (int j = 0; j < 8; ++j) tv[j] = 0.f; }
#pragma unroll
                    for (int j = 0; j < 4; j += 2) {
                        const f32x2_t oa = (f32x2_t){g[j], g[j + 1]} * (f32x2_t){v0[j], v0[j + 1]} + (f32x2_t){tv[j], tv[j + 1]}, ob = (f32x2_t){g[4 + j], g[5 + j]} * (f32x2_t){v1[j], v1[j + 1]} + (f32x2_t){tv[4 + j], tv[5 + j]};
                        o[j] = oa.x; o[j + 1] = oa.y; o[4 + j] = ob.x; o[5 + j] = ob.y; }
                    *(u32x4*)(dst + (size_t)r * 1024 + c) = (u32x4){pk2(o[0], o[1]), pk2(o[2], o[3]), pk2(o[4], o[5]), pk2(o[6], o[7])};
                }
            }
    }
};
struct EpiPlain {
    static constexpr bool PERM = true, AFTER_DRAIN = false;
    bf16_t* dst;
    __device__ __forceinline__ void elem(int r, int c, float v) const { dst[(size_t)r * 1024 + c] = f2bf(v); }
    __device__ __forceinline__ void operator()(const f32x4 (&acc)[2][2][4][2], const Unit& u, int wr, int wc, int fr, int fq) const {
        const int row0 = u.pm * 256 + wr * 64 + fr, cl = u.pn * 256 + wc * 32 + 8 * fq;
#pragma unroll
        for (int ai = 0; ai < 2; ++ai)
#pragma unroll
            for (int m = 0; m < 4; ++m) {
                const int r = row0 + ai * 128 + m * 16;
#pragma unroll
                for (int bj = 0; bj < 2; ++bj) { const f32x4 v0 = acc[ai][bj][m][0], v1 = acc[ai][bj][m][1];
                    *(u32x4*)(dst + (size_t)r * 1024 + cl + bj * 128) = (u32x4){pk2c(v0[0], v0[1]), pk2c(v0[2], v0[3]), pk2c(v1[0], v1[1]), pk2c(v1[2], v1[3])}; }
            }
    }
};
struct EpiF32Out {
    static constexpr bool PERM = true, AFTER_DRAIN = false;
    bf16_t* dst;
    __device__ __forceinline__ void elem(int r, int c, float v) const { dst[(size_t)r * 1024 + c] = f2bf(v); }
    __device__ __forceinline__ void operator()(const f32x4 (&acc)[2][2][4][2], const Unit& u, int wr, int wc, int fr, int fq) const {
        const int row0 = u.pm * 256 + wr * 64 + fr, cl = u.pn * 256 + wc * 32 + 8 * fq;
#pragma unroll
        for (int ai = 0; ai < 2; ++ai)
#pragma unroll
            for (int m = 0; m < 4; ++m) {
                const int r = row0 + ai * 128 + m * 16;
#pragma unroll
                for (int bj = 0; bj < 2; ++bj) { const f32x4 v0 = acc[ai][bj][m][0], v1 = acc[ai][bj][m][1];
                    *(u32x4*)(dst + (size_t)r * 1024 + cl + bj * 128) = (u32x4){pk2c(v0[0], v0[1]), pk2c(v0[2], v0[3]), pk2c(v1[0], v1[1]), pk2c(v1[2], v1[3])}; }
            }
    }
};
struct EpiPle {
    static constexpr bool PERM = false, AFTER_DRAIN = false;
    const bf16_t* plea; bf16_t* dst;
    __device__ __forceinline__ void elem(int r, int c, float v) const { dst[(size_t)r * 1024 + c] = f2bf(bf2f(plea[(size_t)r * 1024 + c]) * sigmoidf_(v)); }
    __device__ __forceinline__ void operator()(const f32x4 (&acc)[2][2][4][2], const Unit& u, int wr, int wc, int fr, int fq) const {
        const int row0 = u.pm * 256 + wr * 64 + fr, col0 = u.pn * 256 + wc * 32 + 4 * fq;
#pragma unroll
        for (int ai = 0; ai < 2; ++ai)
#pragma unroll
            for (int m = 0; m < 4; ++m) { const size_t ro = (size_t)(row0 + ai * 128 + m * 16) * 1024 + col0;
#pragma unroll
                for (int bj = 0; bj < 2; ++bj)
#pragma unroll
                    for (int n = 0; n < 2; ++n) { const u32x2 a = *(const u32x2*)(plea + ro + bj * 128 + n * 16); const f32x4 v = acc[ai][bj][m][n];
                        const f32x2_t o0 = (f32x2_t){bflo(a.x), bfhi(a.x)} * sigmoid2((f32x2_t){v[0], v[1]}), o1 = (f32x2_t){bflo(a.y), bfhi(a.y)} * sigmoid2((f32x2_t){v[2], v[3]});
                        *(u32x2*)(dst + ro + bj * 128 + n * 16) = (u32x2){pk2(o0.x, o0.y), pk2(o1.x, o1.y)}; } }
    }
};

typedef short bf16x8 __attribute__((ext_vector_type(8)));
typedef float f32x16 __attribute__((ext_vector_type(16)));
typedef short bf16x4 __attribute__((ext_vector_type(4)));
#define MFMA32(a, b, c) __builtin_amdgcn_mfma_f32_32x32x16_bf16((a), (b), (c), 0, 0, 0)
__device__ __forceinline__ f32x16 zero16() { f32x16 z;
#pragma unroll
    for (int i = 0; i < 16; ++i) z[i] = 0.f; return z; }
__device__ __forceinline__ bf16x8 pack8f(const float (&v)[8]) { const u32x4 w = (u32x4){pk2(v[0], v[1]), pk2(v[2], v[3]), pk2(v[4], v[5]), pk2(v[6], v[7])}; return __builtin_bit_cast(bf16x8, w); }
__device__ __forceinline__ bf16x8 join44(bf16x4 lo, bf16x4 hi) { return __builtin_shufflevector(lo, hi, 0, 1, 2, 3, 4, 5, 6, 7); }

constexpr int PX = 72;
constexpr int PR = 136;
constexpr int L_XT = 0;
constexpr int L_B = L_XT + 8 * 64 * PX * 2;
constexpr int L_C = L_B + 128 * PX * 2;
constexpr int L_AC = L_C + 64 * PR * 2;
constexpr int L_DT = L_AC + 2048;
constexpr int L_WS = L_DT + 2048;
constexpr int ZP = 1040;
constexpr int SSD_LDS = L_WS + 2048;

struct ChunkInfo { int seqbase, row0, t0, nvalid; const float* hist; };
__device__ __forceinline__ ChunkInfo chunk_info(CPR p, int l, int ck) {
    ChunkInfo c;
    if (ck < 256) { c.seqbase = 0; c.row0 = 64 * ck; c.t0 = 64 * ck; c.nvalid = 64; c.hist = nullptr; }
    else { const int b = ck - 256; c.seqbase = M_P + 32 * b; c.row0 = c.seqbase; c.t0 = 0; c.nvalid = 32; c.hist = p.state_ssd_conv + ((size_t)l * DEC_BATCH + b) * 3 * 3072; }
    return c;
}
template <int NP> __device__ __forceinline__ void xbc_pad_raw(const bf16_t* __restrict__ xbcb, const float* __restrict__ hist, int rowbase, int hj, int c, unsigned (&d)[NP]) {
    if (hj >= 3) { const bf16_t* q = xbcb + (size_t)(rowbase + hj - 3) * 3072 + c;
        if (NP == 4) { const u32x4 t = *(const u32x4*)q; d[0] = t.x; d[1 % NP] = t.y; d[2 % NP] = t.z; d[3 % NP] = t.w; }
        else if (NP == 2) { const u32x2 t = *(const u32x2*)q; d[0] = t.x; d[1 % NP] = t.y; }
        else d[0] = *(const unsigned*)q; }
    else if (hist) {
#pragma unroll
        for (int k = 0; k < NP; ++k) { const float2 t = *(const float2*)(hist + (size_t)hj * 3072 + c + 2 * k); d[k] = pk2(t.x, t.y); } }
    else {
#pragma unroll
        for (int k = 0; k < NP; ++k) d[k] = 0u; }
}
__device__ __forceinline__ int xt_off(int R, int g) { return R * (PX * 2) + ((g ^ ((R >> 3) & 7)) << 4); }
template <int NP, class F> __device__ __forceinline__ void conv8(CPR p, int l, const ChunkInfo& ci, int s0, int c, F emit) {
    if (s0 >= ci.nvalid) {
        const float z[8] = {0.f, 0.f, 0.f, 0.f, 0.f, 0.f, 0.f, 0.f};
#pragma unroll
        for (int jp = 0; jp < NP; ++jp) emit(jp, z, z);
        return;
    }
    const float* cw = p.ssd_conv_w + (size_t)l * 4 * 3072 + c; const float* cb = p.ssd_conv_b + (size_t)l * 3072 + c;
    const int t = ci.t0 + s0;
    unsigned raw[11][NP];
#pragma unroll
    for (int k = 0; k < 11; ++k) xbc_pad_raw<NP>(p.xbcb, ci.hist, ci.seqbase, t + k, c, raw[k]);
#pragma unroll
    for (int jp = 0; jp < NP; ++jp) {
        const f32x2_t w0 = *(const f32x2_t*)(cw + 2 * jp), w1 = *(const f32x2_t*)(cw + 3072 + 2 * jp), w2 = *(const f32x2_t*)(cw + 2 * 3072 + 2 * jp), w3 = *(const f32x2_t*)(cw + 3 * 3072 + 2 * jp), bb = *(const f32x2_t*)(cb + 2 * jp);
        f32x2_t rv[11];
#pragma unroll
        for (int k = 0; k < 11; ++k) rv[k] = (f32x2_t){bflo(raw[k][jp]), bfhi(raw[k][jp])};
        float lo[8], hi[8];
#pragma unroll
        for (int i = 0; i < 8; ++i) {
            const f32x2_t a = bb + w0 * rv[i] + w1 * rv[i + 1] + w2 * rv[i + 2] + w3 * rv[i + 3];
            const f32x2_t sv = silu2(a);
            lo[i] = sv.x; hi[i] = sv.y;
        }
        emit(jp, lo, hi);
    }
}
__device__ __forceinline__ float unit_dt(CPR p, int l, int u, int wid, int lane) {
    const ChunkInfo ci = chunk_info(p, l, u >> 2);
    return (lane < ci.nvalid) ? p.dtb[(size_t)(ci.row0 + lane) * 32 + (u & 3) * 8 + wid] : 0.f;
}
__device__ __forceinline__ void head_scan(CPR p, int l, int h, int lane, float dtv, float& ac, float& aclast) {
    const float a = -__expf(p.ssd_a_log[l * 32 + h]);
    ac = dtv * a;
#pragma unroll
    for (int o = 1; o < 64; o <<= 1) { const float t = __shfl_up(ac, o); if (lane >= o) ac += t; }
    aclast = __shfl(ac, 63);
}
__device__ __forceinline__ void ph_ssd_p1(CPR p, int l, LDSP lds) {
    const int tid = tid_opaque(), wid = tid >> 6, lane = tid & 63, r = lane & 31, hh = lane >> 5;
    PG8_LAS float* acS = (PG8_LAS float*)(lds + L_AC); PG8_LAS float* wS = (PG8_LAS float*)(lds + L_WS);
    PG8_LAS bf16_t* xT = (PG8_LAS bf16_t*)(lds + L_XT); PG8_LAS bf16_t* BT = (PG8_LAS bf16_t*)(lds + L_B);
    const int u0 = bid_opaque(), nb = nblk_opaque();
    float dt_nx = (u0 < NCHUNK * 4) ? unit_dt(p, l, u0, wid, lane) : 0.f;
    for (int u = u0; u < NCHUNK * 4; u += nb) {
        const int ck = u >> 2, g = u & 3, h = g * 8 + wid;
        const ChunkInfo ci = chunk_info(p, l, ck);
        const float dtv = dt_nx; float ac, aclast; head_scan(p, l, h, lane, dtv, ac, aclast);
        dt_nx = (u + nb < NCHUNK * 4) ? unit_dt(p, l, u + nb, wid, lane) : 0.f;
        wS[wid * 64 + lane] = __expf(aclast - ac) * dtv;
        if (lane == 63) p.dec[ck * 32 + h] = __expf(aclast);
        __syncthreads();
        { const int cc = tid & 63, s0 = (tid >> 6) * 8, g8 = s0 >> 3, hl = cc >> 3, p0 = (cc & 7) * 8;
          float wv[8];
#pragma unroll
          for (int i = 0; i < 8; ++i) wv[i] = wS[hl * 64 + s0 + i];
          conv8<4>(p, l, ci, s0, g * 512 + cc * 8, [&](int jp, const float (&lo)[8], const float (&hi)[8]) {
              const int R = hl * 64 + p0 + 2 * jp;
              *(PG8_LAS u32x4*)(lds + L_XT + xt_off(R, g8)) = (u32x4){pk2(lo[0] * wv[0], lo[1] * wv[1]), pk2(lo[2] * wv[2], lo[3] * wv[3]), pk2(lo[4] * wv[4], lo[5] * wv[5]), pk2(lo[6] * wv[6], lo[7] * wv[7])};
              *(PG8_LAS u32x4*)(lds + L_XT + xt_off(R + 1, g8)) = (u32x4){pk2(hi[0] * wv[0], hi[1] * wv[1]), pk2(hi[2] * wv[2], hi[3] * wv[3]), pk2(hi[4] * wv[4], hi[5] * wv[5]), pk2(hi[6] * wv[6], hi[7] * wv[7])}; }); }
        { const int q = tid & 63, s0 = (tid >> 6) * 8, g8 = s0 >> 3, n0 = 2 * q;
          conv8<1>(p, l, ci, s0, 2048 + g * 128 + n0, [&](int jp, const float (&lo)[8], const float (&hi)[8]) {
              *(PG8_LAS u32x4*)(lds + L_B + xt_off(n0, g8)) = (u32x4){pk2(lo[0], lo[1]), pk2(lo[2], lo[3]), pk2(lo[4], lo[5]), pk2(lo[6], lo[7])};
              *(PG8_LAS u32x4*)(lds + L_B + xt_off(n0 + 1, g8)) = (u32x4){pk2(hi[0], hi[1]), pk2(hi[2], hi[3]), pk2(hi[4], hi[5]), pk2(hi[6], hi[7])}; }); }
        __syncthreads();
        f32x16 acc[4][2];
#pragma unroll
        for (int a = 0; a < 4; ++a)
#pragma unroll
            for (int b = 0; b < 2; ++b) acc[a][b] = zero16();
#pragma unroll
        for (int ks = 0; ks < 4; ++ks) {
            bf16x8 A[2], Bf[4];
#pragma unroll
            for (int pt = 0; pt < 2; ++pt) A[pt] = *(const PG8_LAS bf16x8*)(lds + L_XT + xt_off(wid * 64 + 32 * pt + r, 2 * ks + hh));
#pragma unroll
            for (int nt = 0; nt < 4; ++nt) Bf[nt] = *(const PG8_LAS bf16x8*)(lds + L_B + xt_off(32 * nt + r, 2 * ks + hh));
#pragma unroll
            for (int nt = 0; nt < 4; ++nt)
#pragma unroll
                for (int pt = 0; pt < 2; ++pt) acc[nt][pt] = MFMA32(Bf[nt], A[pt], acc[nt][pt]);
        }
        bf16_t* dst = (bf16_t*)p.sst + ((size_t)ck * 32 + h) * 8192 + lane * 16;
#pragma unroll
        for (int nt = 0; nt < 4; ++nt)
#pragma unroll
            for (int pt = 0; pt < 2; ++pt) {
                const f32x16& a = acc[nt][pt];
                *(u32x4*)(dst + (nt * 2 + pt) * 1024) = (u32x4){pk2c(a[0], a[1]), pk2c(a[2], a[3]), pk2c(a[4], a[5]), pk2c(a[6], a[7])};
                *(u32x4*)(dst + (nt * 2 + pt) * 1024 + 8) = (u32x4){pk2c(a[8], a[9]), pk2c(a[10], a[11]), pk2c(a[12], a[13]), pk2c(a[14], a[15])};
            }
        __syncthreads();
    }
}
__device__ __forceinline__ int frag_to_logical(int x) {
    const int h = x >> 13, y = x & 8191, T = y >> 10, L = (y >> 4) & 63, q = y & 15;
    const int p = 32 * (T & 1) + (L & 31), n = 32 * (T >> 1) + (q & 3) + 8 * (q >> 2) + 4 * (L >> 5);
    return h * 8192 + p * 128 + n;
}
__device__ __forceinline__ void ph_ssd_p2(CPR p, int l) {
    const int gtid = bid_opaque() * 512 + tid_opaque(), gsz = nblk_opaque() * 512;
    const unsigned* sst2 = (const unsigned*)p.sst; unsigned* hp2 = (unsigned*)p.hpb;
    for (int e = gtid; e < 131072; e += gsz) {
        const int h = e >> 12; float2 hc = make_float2(0.f, 0.f);
        for (int c0 = 0; c0 < 256; c0 += 32) {
            unsigned S[32]; float d[32];
#pragma unroll
            for (int i = 0; i < 32; ++i) { S[i] = sst2[(size_t)(c0 + i) * 131072 + e]; d[i] = p.dec[(c0 + i) * 32 + h]; }
#pragma unroll
            for (int i = 0; i < 32; ++i) { hp2[(size_t)(c0 + i) * 131072 + e] = pk2(hc.x, hc.y); const f32x2_t hn = (f32x2_t){hc.x, hc.y} * d[i] + (f32x2_t){bflo(S[i]), bfhi(S[i])}; hc.x = hn.x; hc.y = hn.y; }
        }
        ((float2*)(p.out + O_P_STATE + (size_t)l * STATE_SZ))[frag_to_logical(2 * e) >> 1] = hc;
    }
    for (int i = gtid; i < DEC_BATCH * 131072; i += gsz) {
        const int b = i >> 17, e = i & 131071, h = e >> 12, ck = 256 + b;
        const int el = frag_to_logical(2 * e) >> 1;
        const float2 h0 = ((const float2*)(p.state_ssd + ((size_t)l * DEC_BATCH + b) * STATE_SZ))[el]; const unsigned Sw = sst2[(size_t)ck * 131072 + e]; const float2 S = make_float2(bflo(Sw), bfhi(Sw)); const float d = p.dec[ck * 32 + h];
        hp2[(size_t)ck * 131072 + e] = pk2(h0.x, h0.y);
        ((float2*)(p.out + O_S_STATE + ((size_t)l * DEC_BATCH + b) * STATE_SZ))[el] = make_float2(fmaf(d, h0.x, S.x), fmaf(d, h0.y, S.y));
    }
}
__device__ __forceinline__ void ph_ssd_p3(CPR p, int l, LDSP lds) {
    const int tid = tid_opaque(), wid = tid >> 6, lane = tid & 63, r = lane & 31, hh = lane >> 5;
    PG8_LAS float* acS = (PG8_LAS float*)(lds + L_AC); PG8_LAS float* dtS = (PG8_LAS float*)(lds + L_DT); PG8_LAS float* red = (PG8_LAS float*)(lds + L_WS);
    PG8_LAS bf16_t* xT = (PG8_LAS bf16_t*)(lds + L_XT);
    const int u0 = bid_opaque(), nb = nblk_opaque();
    float dt_nx = (u0 < NCHUNK * 4) ? unit_dt(p, l, u0, wid, lane) : 0.f;
    for (int u = u0; u < NCHUNK * 4; u += nb) {
        const int ck = u >> 2, g = u & 3, h = g * 8 + wid;
        const ChunkInfo ci = chunk_info(p, l, ck);
        const float Dh = p.ssd_d[l * 32 + h];
        { const float dtv = dt_nx; float ac, aclast; head_scan(p, l, h, lane, dtv, ac, aclast); acS[wid * 64 + lane] = ac; dtS[wid * 64 + lane] = dtv; }
        dt_nx = (u + nb < NCHUNK * 4) ? unit_dt(p, l, u + nb, wid, lane) : 0.f;
        bf16x8 HA[8][2];
        const bf16_t* hp = p.hpb + ((size_t)ck * 32 + h) * 8192;
        { const int cc = tid & 63, s0 = (tid >> 6) * 8, g8 = s0 >> 3, hl = cc >> 3, p0 = (cc & 7) * 8;
          conv8<4>(p, l, ci, s0, g * 512 + cc * 8, [&](int jp, const float (&lo)[8], const float (&hi)[8]) {
              const int R = hl * 64 + p0 + 2 * jp;
              *(PG8_LAS u32x4*)(lds + L_XT + xt_off(R, g8)) = (u32x4){pk2(lo[0], lo[1]), pk2(lo[2], lo[3]), pk2(lo[4], lo[5]), pk2(lo[6], lo[7])};
              *(PG8_LAS u32x4*)(lds + L_XT + xt_off(R + 1, g8)) = (u32x4){pk2(hi[0], hi[1]), pk2(hi[2], hi[3]), pk2(hi[4], hi[5]), pk2(hi[6], hi[7])}; }); }
        { const int q = tid & 63, s0 = (tid >> 6) * 8, n4 = 4 * (q & 31), off = (q < 32 ? L_B : L_C) + n4 * 2;
          conv8<2>(p, l, ci, s0, (q < 32 ? 2048 : 2560) + g * 128 + n4, [&](int jp, const float (&lo)[8], const float (&hi)[8]) {
#pragma unroll
              for (int i = 0; i < 8; ++i) *(PG8_LAS unsigned*)(lds + off + jp * 4 + (s0 + i) * PR * 2) = pk2(lo[i], hi[i]); }); }
#pragma unroll
        for (int ks = 0; ks < 8; ++ks) { HA[ks][0] = *(const bf16x8*)(hp + ((ks >> 1) * 2 + 0) * 1024 + lane * 16 + 8 * (ks & 1)); HA[ks][1] = *(const bf16x8*)(hp + ((ks >> 1) * 2 + 1) * 1024 + lane * 16 + 8 * (ks & 1)); }
        __syncthreads();
        f32x16 yd[2][2];
#pragma unroll
        for (int a = 0; a < 2; ++a)
#pragma unroll
            for (int b = 0; b < 2; ++b) yd[a][b] = zero16();
#pragma unroll
        for (int ks = 0; ks < 8; ++ks) {
            bf16x8 Bf[2];
#pragma unroll
            for (int lt = 0; lt < 2; ++lt) { const int eo = ((32 * lt + r) * PR + 16 * ks + 4 * hh) * 2;
                Bf[lt] = join44(*(const PG8_LAS bf16x4*)(lds + L_C + eo), *(const PG8_LAS bf16x4*)(lds + L_C + eo + 16)); }
#pragma unroll
            for (int pt = 0; pt < 2; ++pt)
#pragma unroll
                for (int lt = 0; lt < 2; ++lt) yd[pt][lt] = MFMA32(HA[ks][pt], Bf[lt], yd[pt][lt]);
        }
#pragma unroll
        for (int lt = 0; lt < 2; ++lt) { const float eal = __expf(acS[wid * 64 + 32 * lt + r]);
#pragma unroll
            for (int pt = 0; pt < 2; ++pt)
#pragma unroll
                for (int q = 0; q < 16; q += 2) { const f32x2_t t = (f32x2_t){yd[pt][lt][q], yd[pt][lt][q + 1]} * eal; yd[pt][lt][q] = t.x; yd[pt][lt][q + 1] = t.y; } }
        u32x4 zraw[8];
#pragma unroll
        for (int i = 0; i < 8; ++i) { const int e = tid + 512 * i, tok = e >> 6; zraw[i] = *(const u32x4*)(p.zb + (size_t)(ci.row0 + (tok < ci.nvalid ? tok : 0)) * 2048 + g * 512 + (e & 63) * 8); }
#pragma unroll
        for (int tix = 0; tix < 3; ++tix) {
            const int st = (tix == 2) ? 1 : 0, lt = (tix == 0) ? 0 : 1;
            f32x16 G = zero16();
#pragma unroll
            for (int ks = 0; ks < 8; ++ks) {
                const bf16x8 A = *(const PG8_LAS bf16x8*)(lds + L_B + ((32 * st + r) * PR + 16 * ks + 8 * hh) * 2);
                const bf16x8 Bf = *(const PG8_LAS bf16x8*)(lds + L_C + ((32 * lt + r) * PR + 16 * ks + 8 * hh) * 2);
                G = MFMA32(A, Bf, G);
            }
            const int lcol = 32 * lt + r; const float acl = acS[wid * 64 + lcol];
            float mv[16];
#pragma unroll
            for (int q = 0; q < 16; q += 2) {
                const int s = 32 * st + (q & 3) + 8 * (q >> 2) + 4 * hh;
                const f32x2_t acs = *(const PG8_LAS f32x2_t*)(acS + wid * 64 + s), dts = *(const PG8_LAS f32x2_t*)(dtS + wid * 64 + s);
                const f32x2_t dd = __builtin_elementwise_min((f32x2_t){acl, acl} - acs, (f32x2_t){0.f, 0.f}) * 1.4426950408889634f;
                const f32x2_t v2 = (f32x2_t){G[q], G[q + 1]} * exp2_2(dd) * dts;
                float va = (s <= lcol) ? v2.x : 0.f, vb = (s + 1 <= lcol) ? v2.y : 0.f;
                if (s == lcol) va += Dh; if (s + 1 == lcol) vb += Dh;
                mv[q] = va; mv[q + 1] = vb;
            }
#pragma unroll
            for (int kk = 0; kk < 2; ++kk) {
                const float m8[8] = {mv[8 * kk], mv[8 * kk + 1], mv[8 * kk + 2], mv[8 * kk + 3], mv[8 * kk + 4], mv[8 * kk + 5], mv[8 * kk + 6], mv[8 * kk + 7]};
                const bf16x8 Bm = pack8f(m8);
#pragma unroll
                for (int pt = 0; pt < 2; ++pt) {
                    const int R = wid * 64 + 32 * pt + r, g = 4 * st + 2 * kk;
                    const bf16x4 lo = *(const PG8_LAS bf16x4*)(lds + L_XT + xt_off(R, g) + 8 * hh), hi = *(const PG8_LAS bf16x4*)(lds + L_XT + xt_off(R, g + 1) + 8 * hh);
                    yd[pt][lt] = MFMA32(join44(lo, hi), Bm, yd[pt][lt]);
                }
            }
        }
        __syncthreads();
#pragma unroll
        for (int i = 0; i < 8; ++i) { const int e = tid + 512 * i; *(PG8_LAS u32x4*)(lds + L_XT + (e >> 6) * ZP + (e & 63) * 16) = zraw[i]; }
        __syncthreads();
        float ssl[2];
#pragma unroll
        for (int lt = 0; lt < 2; ++lt) {
            const int lcol = 32 * lt + r;
            float ss = 0.f;
#pragma unroll
            for (int pt = 0; pt < 2; ++pt)
#pragma unroll
                for (int i = 0; i < 4; ++i) {
                    const u32x2 zw = *(const PG8_LAS u32x2*)(lds + L_XT + lcol * ZP + (wid * 64 + 32 * pt + 8 * i + 4 * hh) * 2);
                    const f32x2_t za = (f32x2_t){bflo(zw.x), bfhi(zw.x)}, zb2 = (f32x2_t){bflo(zw.y), bfhi(zw.y)};
                    const f32x2_t ga = (f32x2_t){yd[pt][lt][4 * i], yd[pt][lt][4 * i + 1]} * silu2(za), gb2 = (f32x2_t){yd[pt][lt][4 * i + 2], yd[pt][lt][4 * i + 3]} * silu2(zb2);
                    yd[pt][lt][4 * i] = ga.x; yd[pt][lt][4 * i + 1] = ga.y; yd[pt][lt][4 * i + 2] = gb2.x; yd[pt][lt][4 * i + 3] = gb2.y;
                    const f32x2_t sq = ga * ga + gb2 * gb2; ss += sq.x + sq.y;
                }
            ss += __shfl_xor(ss, 32);
            ssl[lt] = ss;
        }
        if (hh == 0) { red[wid * 64 + r] = ssl[0]; red[wid * 64 + 32 + r] = ssl[1]; }
        __syncthreads();
#pragma unroll
        for (int lt = 0; lt < 2; ++lt) {
            const int lcol = 32 * lt + r;
            float tot = 0.f;
#pragma unroll
            for (int w = 0; w < 8; ++w) tot += red[w * 64 + lcol];
            const float rstd = rsqrtf(tot * (1.0f / 512.f) + EPS);
#pragma unroll
            for (int pt = 0; pt < 2; ++pt)
#pragma unroll
                for (int i = 0; i < 4; ++i)
                { const f32x2_t a = (f32x2_t){yd[pt][lt][4 * i], yd[pt][lt][4 * i + 1]} * rstd, b = (f32x2_t){yd[pt][lt][4 * i + 2], yd[pt][lt][4 * i + 3]} * rstd;
                    *(PG8_LAS u32x2*)(lds + L_XT + lcol * ZP + (wid * 64 + 32 * pt + 8 * i + 4 * hh) * 2) = (u32x2){pk2(a.x, a.y), pk2(b.x, b.y)}; }
        }
        __syncthreads();
#pragma unroll
        for (int i = 0; i < 8; ++i) { const int e = tid + 512 * i, tok = e >> 6;
            if (tok < ci.nvalid) *(u32x4*)(p.yn + (size_t)(ci.row0 + tok) * 2048 + g * 512 + (e & 63) * 8) = *(const PG8_LAS u32x4*)(lds + L_XT + tok * ZP + (e & 63) * 16); }
        __syncthreads();
    }
}
#ifndef ATT_EXIT_P
#define ATT_EXIT_P 1e-20f
#endif
typedef short v4i16_t __attribute__((ext_vector_type(4)));
constexpr int AT_PITCH = 272;
constexpr int AT_TILE = 32 * AT_PITCH;
constexpr int ATT_LDS = 8 * 2 * AT_TILE;
__device__ __forceinline__ void ph_attn(CPR p, int l, LDSP lds) {
    const int tidx = tid_opaque(); const int lane = tidx & 63, r = lane & 31, hh = lane >> 5, wv = tidx >> 6, NGW = nblk_opaque() * 8, gw = (bid_opaque() * 8 + wv + (NGW >> 1)) % NGW;
    const bf16_t* kbb = p.kb; const bf16_t* vbb = p.vb;
    const float* ck = p.cache_k + (size_t)l * DEC_BATCH * PAST_LEN * 1024; const float* cv = p.cache_v + (size_t)l * DEC_BATCH * PAST_LEN * 1024;
    const float scale = 0.08838834764831845f;
    LDSP kl = lds + wv * (2 * AT_TILE); LDSP vl = kl + AT_TILE;
    const int st_g = (lane >> 5) * 1024 + (lane & 31) * 4;
    const int st_l = (lane >> 5) * AT_PITCH + (lane & 31) * 8;
    const int vs_g = (lane >> 4) * 1024 + (lane & 15) * 8;
    const int vs_l = (lane >> 4) * AT_PITCH + (lane & 15) * 16;
    const int ka_off = r * AT_PITCH + 16 * hh;
    const int vt_off = (4 * hh + ((lane & 15) >> 2)) * AT_PITCH + (16 * ((lane >> 4) & 1) + 4 * (lane & 3)) * 2;
    const int nwg = NGW >> 3, wgr = gw >> 3;
    for (int U = wgr; U < 512 + 32; U += nwg) {
        int hd, b, rowq0, P0;
        if (U < 512) { hd = U & 7; const int qt = 8 * (U >> 3) + wv; b = -1; rowq0 = 32 * qt; P0 = 32 * qt; }
        else { hd = wv; b = U - 512; rowq0 = M_P + 32 * b; P0 = PAST_LEN; }
        bf16x8 qf[8];
        { const bf16_t* qg = p.qb + (size_t)rowq0 * 1024 + hd * 128 + vs_g; u32x4 qs[8];
#pragma unroll
          for (int i = 0; i < 8; ++i) qs[i] = *(const u32x4*)(qg + 4096 * i);
#pragma unroll
          for (int i = 0; i < 8; ++i) *(PG8_LAS u32x4*)(vl + vs_l + 4 * AT_PITCH * i) = qs[i];
          asm volatile("s_waitcnt lgkmcnt(0)" ::: "memory");
#pragma unroll
          for (int ks = 0; ks < 8; ++ks) qf[ks] = *(const PG8_LAS bf16x8*)(vl + ka_off + 32 * ks);
          asm volatile("s_waitcnt lgkmcnt(0)" ::: "memory"); }
        f32x16 O[4];
#pragma unroll
        for (int d = 0; d < 4; ++d) O[d] = zero16();
        float carry = 1.0f;
        const int ktd = P0 >> 5;
        u32x4 buf[16];
        { const bf16_t* kq = kbb + (size_t)rowq0 * 1024 + hd * 128 + vs_g;
#pragma unroll
          for (int i = 0; i < 8; ++i) buf[8 + i] = *(const u32x4*)(kq + 4096 * i);
#pragma unroll
          for (int i = 0; i < 8; ++i) *(PG8_LAS u32x4*)(kl + vs_l + 4 * AT_PITCH * i) = buf[8 + i]; }
        for (int kt = ktd; kt >= 0; --kt) {
            const bool bfs = (b < 0) || (kt == ktd);
            f32x16 S = zero16();
            if (bfs) {
                const bf16_t* vq = vbb + (size_t)(b < 0 ? 32 * kt : rowq0) * 1024 + hd * 128 + vs_g;
#pragma unroll
                for (int i = 0; i < 8; ++i) buf[i] = *(const u32x4*)(vq + 4096 * i);
            } else {
                const float* vb = cv + ((size_t)b * PAST_LEN + 32 * kt) * 1024 + hd * 128 + st_g;
#pragma unroll
                for (int i = 0; i < 16; ++i) buf[i] = *(const u32x4*)(vb + 2048 * i);
            }
            asm volatile("s_waitcnt lgkmcnt(0)" ::: "memory");
#pragma unroll
            for (int ks = 0; ks < 8; ++ks) S = MFMA32(*(const PG8_LAS bf16x8*)(kl + ka_off + 32 * ks), qf[ks], S);
            const bool diag = (kt == ktd);
            float kp[16], sg[16];
#pragma unroll
            for (int q = 0; q < 16; q += 2) {
                const int key = (q & 3) + 8 * (q >> 2) + 4 * hh;
                const f32x2_t z = (f32x2_t){S[q], S[q + 1]} * scale, e = exp2_2(__builtin_elementwise_abs(z) * (-1.4426950408889634f)), big = rcp_2(e + 1.0f), small = e * big;
                const bool v0 = !diag || key < r, v1 = !diag || key + 1 < r;
                sg[q] = v0 ? (z.x >= 0.f ? big.x : small.x) : 0.f; kp[q] = v0 ? (z.x >= 0.f ? small.x : big.x) : 1.0f;
                sg[q + 1] = v1 ? (z.y >= 0.f ? big.y : small.y) : 0.f; kp[q + 1] = v1 ? (z.y >= 0.f ? small.y : big.y) : 1.0f;
            }
            float T[4], Tp[4];
#pragma unroll
            for (int gi = 0; gi < 4; ++gi) { T[gi] = (kp[4 * gi] * kp[4 * gi + 1]) * (kp[4 * gi + 2] * kp[4 * gi + 3]); Tp[gi] = __shfl_xor(T[gi], 32); }
            float wg[16]; float aft = carry;
#pragma unroll
            for (int gi = 3; gi >= 0; --gi) {
                float suf = aft * (hh == 0 ? Tp[gi] : 1.0f);
#pragma unroll
                for (int j = 3; j >= 0; --j) { wg[4 * gi + j] = sg[4 * gi + j] * suf; suf *= kp[4 * gi + j]; }
                aft *= T[gi] * Tp[gi];
            }
            carry = aft;
            bf16x8 Pf[2];
#pragma unroll
            for (int kk = 0; kk < 2; ++kk) {
                const float w8[8] = {wg[8 * kk], wg[8 * kk + 1], wg[8 * kk + 2], wg[8 * kk + 3], wg[8 * kk + 4], wg[8 * kk + 5], wg[8 * kk + 6], wg[8 * kk + 7]};
                Pf[kk] = pack8f(w8);
            }
            if (bfs) {
#pragma unroll
                for (int i = 0; i < 8; ++i) *(PG8_LAS u32x4*)(vl + vs_l + 4 * AT_PITCH * i) = buf[i];
            } else {
#pragma unroll
                for (int i = 0; i < 16; ++i) { const float4 t = __builtin_bit_cast(float4, buf[i]); *(PG8_LAS u32x2*)(vl + st_l + 2 * AT_PITCH * i) = (u32x2){pk2(t.x, t.y), pk2(t.z, t.w)}; }
            }
            const bool more = (kt > 0) && !__all(carry < ATT_EXIT_P);
            if (more) {
                if (b < 0) { const bf16_t* kq = kbb + (size_t)(32 * (kt - 1)) * 1024 + hd * 128 + vs_g;
#pragma unroll
                    for (int i = 0; i < 8; ++i) buf[8 + i] = *(const u32x4*)(kq + 4096 * i); }
                else { const float* kb = ck + ((size_t)b * PAST_LEN + 32 * (kt - 1)) * 1024 + hd * 128 + st_g;
#pragma unroll
                    for (int i = 0; i < 16; ++i) buf[i] = *(const u32x4*)(kb + 2048 * i); }
            }
            asm volatile("s_waitcnt lgkmcnt(0)" ::: "memory");
#pragma unroll
            for (int kk = 0; kk < 2; ++kk)
#pragma unroll
                for (int d = 0; d < 4; ++d) {
                    const bf16x4 lo = __builtin_bit_cast(bf16x4, __builtin_amdgcn_ds_read_tr16_b64_v4i16((PG8_LAS v4i16_t*)(vl + vt_off + kk * 16 * AT_PITCH + d * 64)));
                    const bf16x4 hi = __builtin_bit_cast(bf16x4, __builtin_amdgcn_ds_read_tr16_b64_v4i16((PG8_LAS v4i16_t*)(vl + vt_off + kk * 16 * AT_PITCH + 8 * AT_PITCH + d * 64)));
                    O[d] = MFMA32(Pf[kk], join44(lo, hi), O[d]);
                }
            if (!more) break;
            if (b >= 0) {
#pragma unroll
                for (int i = 0; i < 16; ++i) { const float4 t = __builtin_bit_cast(float4, buf[i]); *(PG8_LAS u32x2*)(kl + st_l + 2 * AT_PITCH * i) = (u32x2){pk2(t.x, t.y), pk2(t.z, t.w)}; }
            } else {
#pragma unroll
                for (int i = 0; i < 8; ++i) *(PG8_LAS u32x4*)(kl + vs_l + 4 * AT_PITCH * i) = buf[8 + i];
            }
        }
#pragma unroll
        for (int d = 0; d < 4; ++d)
#pragma unroll
            for (int q = 0; q < 16; ++q) *(PG8_LAS unsigned short*)(kl + ((q & 3) + 8 * (q >> 2) + 4 * hh) * AT_PITCH + (32 * d + r) * 2) = (unsigned short)pk2c(O[d][q], 0.0f);
        asm volatile("s_waitcnt lgkmcnt(0)" ::: "memory");
#pragma unroll
        for (int i = 0; i < 8; ++i) *(u32x4*)(p.att + (size_t)(rowq0 + (lane >> 4) + 4 * i) * 1024 + hd * 128 + (lane & 15) * 8) = *(const PG8_LAS u32x4*)(kl + vs_l + 4 * AT_PITCH * i);
    }
}

constexpr int MEGA_BODY = (ATT_LDS > pg8::STAGE_BYTES ? ATT_LDS : pg8::STAGE_BYTES);
constexpr int MEGA_LDS = MEGA_BODY + 64;
#ifndef WGM_IN
#define WGM_IN 4
#endif
#ifndef WGM_UP
#define WGM_UP 8
#endif
#ifndef PROBE_GBIG
#define PROBE_GBIG 1
#endif
#ifndef PROBE_GSMALL
#define PROBE_GSMALL 1
#endif
#ifndef PROBE_S
#define PROBE_S 1
#endif
#ifndef PROBE_A
#define PROBE_A 1
#endif
#ifndef PROBE_M
#define PROBE_M 1
#endif
#ifndef PROBE_P1
#define PROBE_P1 PROBE_S
#endif
#ifndef PROBE_P3
#define PROBE_P3 PROBE_S
#endif
#ifndef PROBE_P2
#define PROBE_P2 PROBE_M
#endif
#ifndef PROBE_FFN
#define PROBE_FFN PROBE_M
#endif
#ifndef PROBE_PRO
#define PROBE_PRO PROBE_M
#endif
#ifndef PROBE_NORM
#define PROBE_NORM 0
#endif
#ifndef PROBE_BAR
#define PROBE_BAR 1
#endif
#define GRID_BARRIER() do { for (int rb_ = 0; rb_ < PROBE_BAR; ++rb_) xcd_barrier(bar); } while (0)
template <class Epi> __device__ __forceinline__ void gemm_site(LDSP lds, const bf16_t* A, const bf16_t* Bt, int N, int K, const Epi& E) {
    for (int rep_ = 0; rep_ < (N > 1024 ? PROBE_GBIG : PROBE_GSMALL); ++rep_) {
    Gemm g; g.A = A; g.Bt = Bt; g.M = M_ALL; g.N = N; g.K = K;
    StaticOrder S; S.init(M_ALL, N, nblk_opaque(), bid_opaque(), N == 8192 ? WGM_UP : WGM_IN);
    pg8::gemm_phase<Epi, StaticOrder, false>(lds, g, S, E, nullptr);
    }
}
template <bool HALO, class Epi> __device__ __forceinline__ void gemm_small(LDSP lds, const bf16_t* A, const bf16_t* Bt, int K, const Epi& E, int c_ = -1, int G_ = 0) {
    const int tid = tid_opaque(), wid = tid >> 6, lane = tid & 63, r = lane & 31, hh = lane >> 5;
    const int nb = c_ < 0 ? nblk_opaque() : G_;
    for (int t = (c_ < 0 ? bid_opaque() : c_); t < (HALO ? 512 : 256); t += nb) {
        const int m0 = HALO ? (t >> 6) * 64 : M_P + (t >> 4) * 64, n0 = HALO ? (t & 63) * 64 : (t & 15) * 64, kbeg = wid * (K >> 3), nst = K >> 7;
        const int nrow = HALO ? (n0 >> 7) * 256 + (n0 & 127) : n0;
        const bf16_t* ap = A + (size_t)(m0 + r) * K + kbeg + 8 * hh; const bf16_t* bp = Bt + (size_t)(nrow + r) * K + kbeg + 8 * hh;
        const size_t hop = (size_t)32 * K;
        f32x16 acc[2][2];
#pragma unroll
        for (int a = 0; a < 2; ++a)
#pragma unroll
            for (int b = 0; b < 2; ++b) acc[a][b] = zero16();
        if (K >= 512) {
            LDSP wa = lds + wid * 16384; LDSP wb = wa + 8192;
            const int prow = lane >> 3, pp = lane & 7;
            const bf16_t* ag = A + (size_t)(m0 + prow) * K + kbeg + pp * 8; const bf16_t* bg = Bt + (size_t)(nrow + prow) * K + kbeg + pp * 8;
            const size_t r8 = (size_t)8 * K;
            const int nch = K >> 9;
            const int wofs = prow * 128 + ((pp ^ ((prow >> 1) & 7)) * 16);
            const int sw = (r >> 1) & 7, rofs = r * 128;
            u32x4 sa[8], sb[8];
#pragma unroll
            for (int i = 0; i < 8; ++i) { sa[i] = *(const u32x4*)(ag + i * r8); sb[i] = *(const u32x4*)(bg + i * r8); }
            for (int c = 0; c < nch; ++c) {
#pragma unroll
                for (int i = 0; i < 8; ++i) { const int row = prow + 8 * i; const int off = row * 128 + ((pp ^ ((row >> 1) & 7)) * 16); *(PG8_LAS u32x4*)(wa + off) = sa[i]; *(PG8_LAS u32x4*)(wb + off) = sb[i]; }
                const int cn = c + 1 < nch ? c + 1 : c;
#pragma unroll
                for (int i = 0; i < 8; ++i) { sa[i] = *(const u32x4*)(ag + i * r8 + 64 * cn); sb[i] = *(const u32x4*)(bg + i * r8 + 64 * cn); }
#pragma unroll
                for (int ks = 0; ks < 4; ++ks) {
                    const int so = ((2 * ks + hh) ^ sw) * 16;
                    const bf16x8 a0 = *(const PG8_LAS bf16x8*)(wa + rofs + so), a1 = *(const PG8_LAS bf16x8*)(wa + rofs + 4096 + so);
                    const bf16x8 b0 = *(const PG8_LAS bf16x8*)(wb + rofs + so), b1 = *(const PG8_LAS bf16x8*)(wb + rofs + 4096 + so);
                    acc[0][0] = MFMA32(a0, b0, acc[0][0]); acc[0][1] = MFMA32(a0, b1, acc[0][1]); acc[1][0] = MFMA32(a1, b0, acc[1][0]); acc[1][1] = MFMA32(a1, b1, acc[1][1]);
                }
            }
            (void)wofs;
        } else {
        bf16x8 fa[4][2], fb[4][2];
#pragma unroll
        for (int s = 0; s < 3; ++s) { const int ko = 16 * (s < nst ? s : 0);
            fa[s][0] = *(const bf16x8*)(ap + ko); fa[s][1] = *(const bf16x8*)(ap + hop + ko); fb[s][0] = *(const bf16x8*)(bp + ko); fb[s][1] = *(const bf16x8*)(bp + hop + ko); }
        for (int st = 0; st < nst; st += 2) {
#pragma unroll
            for (int s2 = 0; s2 < 2; ++s2) {
                const int cur = (st + s2) & 3, nxs = (st + s2 + 3) & 3, nx = st + s2 + 3, ko = 16 * (nx < nst ? nx : 0);
                if (((st >> 1) & 1) == 0) {
                    fa[(s2 + 3) & 3][0] = *(const bf16x8*)(ap + ko); fa[(s2 + 3) & 3][1] = *(const bf16x8*)(ap + hop + ko); fb[(s2 + 3) & 3][0] = *(const bf16x8*)(bp + ko); fb[(s2 + 3) & 3][1] = *(const bf16x8*)(bp + hop + ko);
#pragma unroll
                    for (int a = 0; a < 2; ++a)
#pragma unroll
                        for (int b = 0; b < 2; ++b) acc[a][b] = MFMA32(fa[s2][a], fb[s2][b], acc[a][b]);
                } else {
                    fa[(s2 + 1) & 3][0] = *(const bf16x8*)(ap + ko); fa[(s2 + 1) & 3][1] = *(const bf16x8*)(ap + hop + ko); fb[(s2 + 1) & 3][0] = *(const bf16x8*)(bp + ko); fb[(s2 + 1) & 3][1] = *(const bf16x8*)(bp + hop + ko);
#pragma unroll
                    for (int a = 0; a < 2; ++a)
#pragma unroll
                        for (int b = 0; b < 2; ++b) acc[a][b] = MFMA32(fa[s2 + 2][a], fb[s2 + 2][b], acc[a][b]);
                }
                (void)cur; (void)nxs;
            }
        }
        }
        PG8_LAS float* red = (PG8_LAS float*)lds;
#pragma unroll
        for (int a = 0; a < 2; ++a)
#pragma unroll
            for (int b = 0; b < 2; ++b)
#pragma unroll
                for (int q = 0; q < 16; ++q) red[((wid * 4 + a * 2 + b) * 16 + q) * 64 + lane] = acc[a][b][q];
        __syncthreads();
        { const int blk = wid & 3, q0 = (wid >> 2) * 8, a = blk >> 1, b = blk & 1;
#pragma unroll
          for (int q = 0; q < 8; ++q) { float v = 0.f;
#pragma unroll
              for (int w = 0; w < 8; ++w) v += red[((w * 4 + blk) * 16 + q0 + q) * 64 + lane];
              const int qq = q0 + q; E.elem(m0 + 32 * a + (qq & 3) + 8 * (qq >> 2) + 4 * hh, n0 + 32 * b + r, v); } }
        __syncthreads();
    }
}
template <class Epi> __device__ __forceinline__ void gemm_site_n1024_part(LDSP lds, const bf16_t* A, const bf16_t* Bt, int K, const Epi& E, int G, int c) {
    Gemm g; g.A = A; g.Bt = Bt; g.M = M_P; g.N = 1024; g.K = K;
    StaticOrder S; S.init(M_P, 1024, G, c);
    pg8::gemm_phase<Epi, StaticOrder, false>(lds, g, S, E, nullptr);
    gemm_small<false>(lds, A, Bt, K, E, c, G);
}
template <class Epi> __device__ __forceinline__ void gemm_site_n1024_prompt(LDSP lds, const bf16_t* A, const bf16_t* Bt, int K, const Epi& E) {
    Gemm g; g.A = A; g.Bt = Bt; g.M = M_P; g.N = 1024; g.K = K;
    StaticOrder S; S.init(M_P, 1024, nblk_opaque(), bid_opaque());
    pg8::gemm_phase<Epi, StaticOrder, false>(lds, g, S, E, nullptr);
}
template <class Epi> __device__ __forceinline__ void gemm_site_n1024(LDSP lds, const bf16_t* A, const bf16_t* Bt, int K, const Epi& E) {
    for (int rep_ = 0; rep_ < PROBE_GSMALL; ++rep_) {
    Gemm g; g.A = A; g.Bt = Bt; g.M = M_P; g.N = 1024; g.K = K;
    StaticOrder S; S.init(M_P, 1024, nblk_opaque(), bid_opaque());
    pg8::gemm_phase<Epi, StaticOrder, false>(lds, g, S, E, nullptr);
    gemm_small<false>(lds, A, Bt, K, E);
    }
}
__global__ void __launch_bounds__(512, 2) k_mega(Params p_) {
    extern __shared__ __attribute__((aligned(16))) unsigned char shm[];
    LDSP lds = (LDSP)shm;
    volatile LAS unsigned* xbw = (volatile LAS unsigned*)(lds + MEGA_BODY);
    if (threadIdx.x < 4) xbw[threadIdx.x] = 0u;
    __syncthreads();
    XcdBarrier bar = xcd_barrier_post(kargs()->bar, xbw);
    for (int rep_ = 0; rep_ < PROBE_PRO; ++rep_) { { CPR p = *kargs(); ph_wt(p, lds); }
    { CPR p = *kargs(); ph_xprep(p); } }
    GRID_BARRIER();
    for (int l = 0; l < DEPTH; ++l) {
        { CPR p = *kargs(); float* out = p.out; const bf16_t* wl = p.wt + (size_t)l * WT_LAYER; EpiIn E; E.rs = p.rs; E.zb = p.zb; E.xbcb = p.xbcb; E.qb = p.qb; E.kb = p.kb; E.vb = p.vb; E.gb = p.gb; E.dtb = p.dtb; E.dt_bias = p.ssd_dt_bias + l * 32;
          E.kP = out + O_P_K + (size_t)l * M_P * 1024; E.vP = out + O_P_V + (size_t)l * M_P * 1024; E.kS = out + O_S_K + (size_t)l * M_S * 1024; E.vS = out + O_S_V + (size_t)l * M_S * 1024;
          E.convP = out + O_P_CONV + (size_t)l * 3 * 3072; E.convS = out + O_S_CONV + (size_t)l * DEC_BATCH * 3 * 3072;
          gemm_site(lds, p.xb, wl + OW1, N1, 1024, E); }
        GRID_BARRIER();
        for (int rep_ = 0; rep_ < PROBE_P1; ++rep_) { CPR p = *kargs(); ph_ssd_p1(p, l, lds); }
        for (int rep_ = 0; rep_ < PROBE_A; ++rep_) { CPR p = *kargs(); ph_attn(p, l, lds); }
        GRID_BARRIER();
        for (int rep_ = 0; rep_ < PROBE_P2; ++rep_) { CPR p = *kargs(); ph_ssd_p2(p, l); }
        { CPR p = *kargs(); float* out = p.out; const bf16_t* wl = p.wt + (size_t)l * WT_LAYER; EpiBr E; E.gb = p.gb; E.t1in = nullptr; E.dst = p.t1; E.mode = 0; E.pad = 0; gemm_site_n1024_prompt(lds, p.att, wl + OW3, 1024, E); }
        GRID_BARRIER();
        for (int rep_ = 0; rep_ < PROBE_P3; ++rep_) { CPR p = *kargs(); ph_ssd_p3(p, l, lds); }
        if (bid_opaque() >= 128) { __syncthreads(); CPR p = *kargs(); const bf16_t* wl = p.wt + (size_t)l * WT_LAYER; EpiBr E; E.gb = p.gb; E.t1in = nullptr; E.dst = p.t1; E.mode = 0; E.pad = 0; gemm_small<false>(lds, p.att, wl + OW3, 1024, E, bid_opaque() - 128, 128); }
        GRID_BARRIER();
        { CPR p = *kargs(); float* out = p.out; const bf16_t* wl = p.wt + (size_t)l * WT_LAYER; EpiBr E; E.gb = p.gb; E.t1in = p.t1; E.dst = p.mixin; E.mode = 1; E.pad = 0; gemm_site_n1024(lds, p.yn, wl + OW2, 2048, E); }
        GRID_BARRIER();
        { CPR p = *kargs(); float* out = p.out; const bf16_t* wl = p.wt + (size_t)l * WT_LAYER; EpiF32Out E; E.dst = p.mixed; gemm_site_n1024(lds, p.mixin, wl + OW4, 1024, E); }
        GRID_BARRIER();
        { CPR p = *kargs(); float* out = p.out; (void)out; ph_norm(p.mixed, p.norm_post_mix + l * 1024, p.xr, p.xb, nullptr, nullptr, p.xh); }
        GRID_BARRIER();
        { CPR p = *kargs(); const bf16_t* wl = p.wt + (size_t)l * WT_LAYER; EpiHalo E; E.rs = nullptr; E.gh = p.gh; gemm_small<true>(lds, p.xh, wl + OW5, 1024, E); }
        GRID_BARRIER();
        { CPR p = *kargs(); float* out = p.out; const bf16_t* wl = p.wt + (size_t)l * WT_LAYER; EpiUpAct E; E.rs = p.rs2; E.gh = p.gh; E.ffb = p.ffb;
          E.ffnP = out + O_P_FFN + (size_t)l * 2 * D_FF; E.ffnS = out + O_S_FFN + (size_t)l * DEC_BATCH * 2 * D_FF;
          E.cw = p.ffn_conv_w + (size_t)l * 3 * D_FF; E.cb = p.ffn_conv_b + (size_t)l * D_FF; E.hist = p.state_ffn_conv + (size_t)l * DEC_BATCH * 2 * D_FF;
          gemm_site(lds, p.xb, wl + OW5, 8192, 1024, E); }
        if (bid_opaque() >= 128) { CPR p = *kargs(); const bf16_t* wl = p.wt + (size_t)l * WT_LAYER; EpiPlain E; E.dst = p.plea; gemm_site_n1024_part(lds, p.pb + (size_t)l * M_ALL * 256, wl + OW7, 256, E, 128, bid_opaque() - 128); }
        GRID_BARRIER();
        { CPR p = *kargs(); float* out = p.out; const bf16_t* wl = p.wt + (size_t)l * WT_LAYER; EpiF32Out E; E.dst = p.down; gemm_site_n1024(lds, p.ffb, wl + OW6, 4096, E); }
        GRID_BARRIER();
        { CPR p = *kargs(); float* out = p.out; (void)out; ph_norm(p.down, p.norm_post_ffn + l * 1024, p.xr, nullptr, nullptr, nullptr); }
        GRID_BARRIER();
        { CPR p = *kargs(); float* out = p.out; const bf16_t* wl = p.wt + (size_t)l * WT_LAYER; EpiPle E; E.plea = p.plea; E.dst = p.ple; gemm_site_n1024(lds, p.xr, wl + OW8, 1024, E); }
        GRID_BARRIER();
        { CPR p = *kargs(); float* out = p.out; (void)out; ph_norm(p.ple, p.norm_ple + l * 1024, p.xr, p.xb, l == DEPTH - 1 ? out + O_Y_P : nullptr, out + O_Y_S); }
        if (l + 1 < DEPTH) GRID_BARRIER();
    }
}

struct Bump { char* base; size_t off; template <class T> T* take(size_t n) { off = (off + 255) & ~(size_t)255; T* p = (T*)(base + off); off += n * sizeof(T); return p; } };
__global__ void k_fail_code(float* out, float code) { if (threadIdx.x == 0 && blockIdx.x == 0) out[0] = code; }

extern "C" void kernel_launch(void* const* d_in, const int* in_sizes, int n_in, void* d_out, int out_size, void* d_ws, size_t ws_size, hipStream_t stream) {
    Params p; memset(&p, 0, sizeof p);
    p.x_prompt = (const float*)d_in[0]; p.x_sample = (const float*)d_in[1]; p.state_ssd_conv = (const float*)d_in[2]; p.state_ssd = (const float*)d_in[3];
    p.cache_k = (const float*)d_in[4]; p.cache_v = (const float*)d_in[5]; p.state_ffn_conv = (const float*)d_in[6]; p.p_prompt = (const float*)d_in[7]; p.p_sample = (const float*)d_in[8];
    p.norm_pre_mix = (const float*)d_in[9]; p.w_in = (const float*)d_in[10]; p.ssd_conv_w = (const float*)d_in[11]; p.ssd_conv_b = (const float*)d_in[12]; p.ssd_dt_bias = (const float*)d_in[13];
    p.ssd_a_log = (const float*)d_in[14]; p.ssd_d = (const float*)d_in[15]; p.ssd_norm = (const float*)d_in[16]; p.w_br_ssd = (const float*)d_in[17]; p.w_br_sb = (const float*)d_in[18];
    p.w_out = (const float*)d_in[19]; p.norm_post_mix = (const float*)d_in[20]; p.norm_pre_ffn = (const float*)d_in[21]; p.w_up = (const float*)d_in[22]; p.ffn_conv_w = (const float*)d_in[23];
    p.ffn_conv_b = (const float*)d_in[24]; p.w_down = (const float*)d_in[25]; p.norm_post_ffn = (const float*)d_in[26]; p.w_ple = (const float*)d_in[27]; p.w_ple_gate = (const float*)d_in[28];
    p.norm_ple = (const float*)d_in[29];
    float* out = (float*)d_out; p.out = out;

    Bump B{(char*)d_ws, 0};
    const size_t R = M_ALL;
    p.bar = B.take<unsigned>(4096);
    p.wt = B.take<bf16_t>(DEPTH * WT_LAYER);
    p.xr = B.take<bf16_t>(R * 1024); p.xb = B.take<bf16_t>(R * 1024); p.rs = B.take<float>(R); p.rs2 = B.take<float>(R); p.pb = B.take<bf16_t>(DEPTH * R * 256);
    p.zb = B.take<bf16_t>(R * 2048); p.xbcb = B.take<bf16_t>(R * 3072); p.qb = B.take<bf16_t>(R * 1024); p.kb = B.take<bf16_t>(R * 1024); p.vb = B.take<bf16_t>(R * 1024); p.gb = B.take<bf16_t>(R * 2048); p.dtb = B.take<float>(R * 32);
    p.sst = B.take<float>((size_t)NCHUNK * STATE_SZ / 2); p.dec = B.take<float>(NCHUNK * 32); p.hpb = B.take<bf16_t>((size_t)NCHUNK * STATE_SZ);
    p.yn = B.take<bf16_t>(R * 2048); p.att = B.take<bf16_t>(R * 1024); p.t1 = B.take<bf16_t>(R * 1024); p.mixin = B.take<bf16_t>(R * 1024); p.mixed = B.take<bf16_t>(R * 1024);
    p.gh = B.take<bf16_t>((size_t)768 * 4096); p.xh = B.take<bf16_t>((size_t)768 * 1024); p.ffb = B.take<bf16_t>(R * 4096); p.down = B.take<bf16_t>(R * 1024); p.plea = B.take<bf16_t>(R * 1024); p.ple = B.take<bf16_t>(R * 1024);
    if (B.off > ws_size) { k_fail_code<<<1, 64, 0, stream>>>(out, 777000.f); return; }

    (void)hipMemsetAsync(p.bar, 0, 4096 * 4, stream);
    static bool minit = false;
    if (!minit) { (void)hipFuncSetAttribute((const void*)k_mega, hipFuncAttributeMaxDynamicSharedMemorySize, MEGA_LDS); minit = true; }
    hipLaunchKernelGGL(k_mega, dim3(256), dim3(512), MEGA_LDS, stream, p);
}
```

```cpp
#include <hip/hip_runtime.h>
#include <stdint.h>
#include <string.h>

constexpr int D_MODEL = 1024, SEQ = 16384, DEPTH = 2, DEC_BATCH = 32, DEC_SEQ = 32, PAST_LEN = 2048;
constexpr int D_SSM = 2048, SSD_HEAD_DIM = 64, SSD_HEADS = 32, SSD_GROUPS = 4, SSD_STATE = 128, SSD_CONV_DIM = 3072;
constexpr int SB_HEAD_DIM = 128, SB_HEADS = 8, SB_WIDTH = 1024, D_FF = 4096, PLE_DIM = 256;
constexpr int IN_DIM = 10272;
constexpr int M_P = SEQ, M_S = DEC_BATCH * DEC_SEQ, M_ALL = M_P + M_S;
constexpr float EPS = 1e-6f;
constexpr int C_Z = 0, C_XBC = 2048, C_DT = 5120, C_Q = 5152, C_K = 6176, C_V = 7200, C_G = 8224;
constexpr size_t O_Y_P = 0;
constexpr size_t O_Y_S = O_Y_P + (size_t)M_P * D_MODEL;
constexpr size_t O_P_CONV = O_Y_S + (size_t)M_S * D_MODEL;
constexpr size_t O_P_STATE = O_P_CONV + (size_t)DEPTH * 3 * SSD_CONV_DIM;
constexpr size_t O_P_K = O_P_STATE + (size_t)DEPTH * SSD_HEADS * SSD_HEAD_DIM * SSD_STATE;
constexpr size_t O_P_V = O_P_K + (size_t)DEPTH * M_P * SB_WIDTH;
constexpr size_t O_P_FFN = O_P_V + (size_t)DEPTH * M_P * SB_WIDTH;
constexpr size_t O_S_CONV = O_P_FFN + (size_t)DEPTH * 2 * D_FF;
constexpr size_t O_S_STATE = O_S_CONV + (size_t)DEPTH * DEC_BATCH * 3 * SSD_CONV_DIM;
constexpr size_t O_S_K = O_S_STATE + (size_t)DEPTH * DEC_BATCH * SSD_HEADS * SSD_HEAD_DIM * SSD_STATE;
constexpr size_t O_S_V = O_S_K + (size_t)DEPTH * M_S * SB_WIDTH;
constexpr size_t O_S_FFN = O_S_V + (size_t)DEPTH * M_S * SB_WIDTH;
constexpr size_t O_TOTAL = O_S_FFN + (size_t)DEPTH * DEC_BATCH * 2 * D_FF;
constexpr size_t STATE_SZ = (size_t)SSD_HEADS * SSD_HEAD_DIM * SSD_STATE;

typedef unsigned short bf16_t;

__device__ __forceinline__ float wave_sum(float v) {
#pragma unroll
    for (int o = 32; o >= 1; o >>= 1) v += __shfl_xor(v, o);
    return v;
}
__device__ __forceinline__ float sigmoidf_(float x) { return 1.0f / (1.0f + __expf(-x)); }
__device__ __forceinline__ float softplusf_(float x) { return fmaxf(x, 0.f) + log1pf(__expf(-fabsf(x))); }
__device__ __forceinline__ float siluf_(float x) { return x * sigmoidf_(x); }
__device__ __forceinline__ float gelu_tanhf_(float x) { const float u = 0.7978845608028654f * (x + 0.044715f * x * x * x); return 0.5f * x * (1.0f + tanhf(u)); }
__device__ __forceinline__ bf16_t f2bf(float f) { unsigned u = __float_as_uint(f); u += 0x7FFFu + ((u >> 16) & 1u); return (bf16_t)(u >> 16); }
__device__ __forceinline__ float bf2f(bf16_t b) { return __uint_as_float(((unsigned)b) << 16); }
typedef __bf16 bf16x2_t __attribute__((ext_vector_type(2)));
typedef float f32x2_t __attribute__((ext_vector_type(2)));
__device__ __forceinline__ unsigned pk2(float lo, float hi) { unsigned r; asm volatile("v_cvt_pk_bf16_f32 %0, %1, %2" : "=v"(r) : "v"(lo), "v"(hi)); return r; }
__device__ __forceinline__ unsigned pk2c(float lo, float hi) { const f32x2_t v = {lo, hi}; return __builtin_bit_cast(unsigned, __builtin_convertvector(v, bf16x2_t)); }
__device__ __forceinline__ f32x2_t exp2_2(f32x2_t x) { f32x2_t e; e.x = __builtin_amdgcn_exp2f(x.x); e.y = __builtin_amdgcn_exp2f(x.y); return e; }
__device__ __forceinline__ f32x2_t rcp_2(f32x2_t x) { f32x2_t r; r.x = __builtin_amdgcn_rcpf(x.x); r.y = __builtin_amdgcn_rcpf(x.y); return r; }
__device__ __forceinline__ f32x2_t sigmoid2(f32x2_t a) { return rcp_2(exp2_2(a * (-1.4426950408889634f)) + 1.0f); }
__device__ __forceinline__ f32x2_t silu2(f32x2_t a) { return a * sigmoid2(a); }
__device__ __forceinline__ f32x2_t gelu2(f32x2_t x) { const f32x2_t u2 = (x * x * 0.044715f + 1.0f) * x * 1.5957691216057308f; return x * sigmoid2(u2); }
__device__ __forceinline__ float bflo(unsigned w) { return __uint_as_float(w << 16); }
__device__ __forceinline__ float bfhi(unsigned w) { return __uint_as_float(w & 0xffff0000u); }

__device__ __forceinline__ int bid_opaque() { int b = blockIdx.x; asm volatile("" : "+s"(b)); return b; }
__device__ __forceinline__ int nblk_opaque() { int b = gridDim.x; asm volatile("" : "+s"(b)); return b; }
__device__ __forceinline__ int tid_opaque() { int t = threadIdx.x; asm volatile("" : "+v"(t)); return t; }

namespace pg8 {
#define PG8_LAS __attribute__((address_space(3)))
typedef unsigned short bf16_t;
typedef short bf16x8 __attribute__((ext_vector_type(8)));
typedef float f32x4 __attribute__((ext_vector_type(4)));
typedef unsigned u32x4 __attribute__((ext_vector_type(4)));
constexpr int BM = 256, BK = 64, HALF = 128, HTB = HALF * BK * 2  , STAGE_BYTES = 8 * HTB, NXCD = 8, WGM = 8;

__host__ __device__ __forceinline__ int lds_byte(int r, int c) { const int st = (r >> 4) * 2 + (c >> 5), rr = r & 15, cc = c & 31, ob = rr * 64 + cc * 2; return st * 1024 + (ob ^ (((ob >> 9) & 1) << 5)); }
__host__ __device__ __forceinline__ void stage_rc(int b, int& R, int& C) { const int st = b / 1024, sb = b % 1024, swz = sb ^ (((sb >> 9) & 1) << 5); R = (st >> 1) * 16 + swz / 64; C = (st & 1) * 32 + (swz % 64) / 2; }
__host__ __device__ __forceinline__ int perm32(int rho) { const int n = rho >> 4, i = rho & 15; return 8 * (i >> 2) + 4 * n + (i & 3); }

struct Unit { int pm, pn; };
struct Gemm { const bf16_t* A; const bf16_t* Bt; int M, N, K; };

struct StaticOrder {
    int nM, nN, nwg, G, c, wgm;
    __host__ __device__ void init(int M, int N, int G_, int c_, int wgm_ = WGM) { nM = M / BM; nN = N / BM; nwg = nM * nN; G = G_; c = c_; wgm = wgm_; }
    __host__ __device__ bool next(int i, Unit& u) const {
        const long L = (long)i * G + c; if (L >= nwg) return false;
        int wgid = (int)L; { const int q = nwg / NXCD, r = nwg % NXCD, xcd = wgid % NXCD, off = wgid / NXCD; wgid = (xcd < r ? xcd * (q + 1) : r * (q + 1) + (xcd - r) * q) + off; }
        const int nig = wgm * nN, gid = wgid / nig, fm = gid * wgm, gsz = (nM - fm) < wgm ? (nM - fm) : wgm;
        u.pm = fm + ((wgid % nig) % gsz); u.pn = (wgid % nig) / gsz; return true;
    }
    __device__ __forceinline__ void a_ready(const Unit&) const {}
    __device__ __forceinline__ void done(const Unit&) const {}
};
__device__ __forceinline__ unsigned cvt_pk_bf16(float lo, float hi) { unsigned r; asm volatile("v_cvt_pk_bf16_f32 %0, %1, %2" : "=v"(r) : "v"(lo), "v"(hi)); return r; }
typedef float f32x2 __attribute__((ext_vector_type(2)));
__device__ __forceinline__ f32x2 gelu_pk(f32x2 v) {
    const f32x2 av = __builtin_elementwise_abs(v), d = av * 0.2316418882f + 1.0f;
    f32x2 t; t.x = __builtin_amdgcn_rcpf(d.x); t.y = __builtin_amdgcn_rcpf(d.y);
    f32x2 q = t * 0.5307027145f + (-0.7265760135f); q = q * t + 0.7107068705f; q = q * t + (-0.142248368f); q = q * t + 0.127414796f; q = q * t;
    const f32x2 s = (v * v) * (-0.72134752044f);
    f32x2 e; e.x = __builtin_amdgcn_exp2f(s.x); e.y = __builtin_amdgcn_exp2f(s.y);
    const f32x2 m = v * (q * e), r = v - m;
    f32x2 o; o.x = v.x < 0.f ? m.x : r.x; o.y = v.y < 0.f ? m.y : r.y; return o;
}

struct EpiF32 {
    static constexpr bool PERM = false, AFTER_DRAIN = false;
    float* C; int ldc; const float* bias;
    __device__ __forceinline__ void operator()(const f32x4 (&acc)[2][2][4][2], const Unit& u, int wr, int wc, int fr, int fq) const {
        const int row0 = u.pm * BM + wr * 64 + fr, col0 = u.pn * BM + wc * 32 + 4 * fq;
        f32x4 bv[2][2];
#pragma unroll
        for (int bj = 0; bj < 2; ++bj)
#pragma unroll
            for (int n = 0; n < 2; ++n) bv[bj][n] = bias ? *(const f32x4*)(bias + col0 + bj * HALF + n * 16) : (f32x4){0.f, 0.f, 0.f, 0.f};
#pragma unroll
        for (int ai = 0; ai < 2; ++ai)
#pragma unroll
            for (int m = 0; m < 4; ++m) { float* rowp = C + (size_t)(row0 + ai * HALF + m * 16) * ldc + col0;
#pragma unroll
                for (int bj = 0; bj < 2; ++bj)
#pragma unroll
                    for (int n = 0; n < 2; ++n) *(f32x4*)(rowp + bj * HALF + n * 16) = acc[ai][bj][m][n] + bv[bj][n]; }
    }
};
template <int ACT  > struct EpiBf16 {
    static constexpr bool PERM = true, AFTER_DRAIN = false;
    bf16_t* O; int ldc; const float* bias; int split_cols; size_t split_stride;
    __device__ __forceinline__ void operator()(const f32x4 (&acc)[2][2][4][2], const Unit& u, int wr, int wc, int fr, int fq) const {
        const int row0 = u.pm * BM + wr * 64 + fr; int colt = u.pn * BM; bf16_t* base = O;
        if (split_cols) { const int t = colt / split_cols; base += (size_t)t * split_stride; colt -= t * split_cols; }
        const int col0 = colt + wc * 32 + 8 * fq, bcol0 = u.pn * BM + wc * 32 + 8 * fq;
        f32x4 bv[2][2];
#pragma unroll
        for (int bj = 0; bj < 2; ++bj)
#pragma unroll
            for (int n = 0; n < 2; ++n) bv[bj][n] = bias ? *(const f32x4*)(bias + bcol0 + bj * HALF + 4 * n) : (f32x4){0.f, 0.f, 0.f, 0.f};
#pragma unroll
        for (int ai = 0; ai < 2; ++ai)
#pragma unroll
            for (int m = 0; m < 4; ++m) { bf16_t* rowp = base + (size_t)(row0 + ai * HALF + m * 16) * ldc + col0;
#pragma unroll
                for (int bj = 0; bj < 2; ++bj) { f32x4 v0 = acc[ai][bj][m][0] + bv[bj][0], v1 = acc[ai][bj][m][1] + bv[bj][1];
                    if (ACT == 1) { f32x2 a = gelu_pk((f32x2){v0[0], v0[1]}), b = gelu_pk((f32x2){v0[2], v0[3]}), c = gelu_pk((f32x2){v1[0], v1[1]}), d = gelu_pk((f32x2){v1[2], v1[3]});
                        v0 = (f32x4){a.x, a.y, b.x, b.y}; v1 = (f32x4){c.x, c.y, d.x, d.y}; }
                    if (ACT == 2) {
#pragma unroll
                        for (int j = 0; j < 4; ++j) { v0[j] = 0.5f * v0[j] * (1.0f + erff(v0[j] * 0.70710678f)); v1[j] = 0.5f * v1[j] * (1.0f + erff(v1[j] * 0.70710678f)); } }
                    u32x4 w; w.x = cvt_pk_bf16(v0[0], v0[1]); w.y = cvt_pk_bf16(v0[2], v0[3]); w.z = cvt_pk_bf16(v1[0], v1[1]); w.w = cvt_pk_bf16(v1[2], v1[3]);
                    *(u32x4*)(rowp + bj * HALF) = w; } }
    }
};

template <class Epi, class Sched, bool STAMP = false>
__device__ __forceinline__ void gemm_phase(PG8_LAS unsigned char* lds, const Gemm g, const Sched& S, const Epi& E, unsigned long long* stamps) {
    const int tid = tid_opaque(), wid = __builtin_amdgcn_readfirstlane(tid >> 6), lane = tid & 63, wr = wid >> 2, wc = wid & 3, fr = lane & 15, fq = lane >> 4;
    const int K = g.K, nt = K / BK;
    int ts_lo = 0, ts_hi = 0, nts = 0; const unsigned long long rt_entry = STAMP ? (unsigned long long)wall_clock64() : 0ull;
#define PG8_STAMP() do { if (STAMP && wid == 0 && nts < 64) { const unsigned long long _c = (unsigned long long)clock64(); \
        ts_lo = (lane == nts) ? (int)(unsigned)_c : ts_lo; ts_hi = (lane == nts) ? (int)(unsigned)(_c >> 32) : ts_hi; ++nts; } } while (0)
    PG8_STAMP();
    unsigned voffA[2], voffB[2];
#pragma unroll
    for (int i = 0; i < 2; ++i) { int R, C; stage_rc(tid * 16 + i * 8192, R, C); const int Rb = Epi::PERM ? ((R & ~31) + perm32(R & 31)) : R;
        voffA[i] = (unsigned)(R * K + C) * 2u; voffB[i] = (unsigned)(Rb * K + C) * 2u; }
    const size_t kstep = (size_t)(BK * 2);
    const size_t hstep = (size_t)HALF * K * 2;
    const size_t tstep = 2 * hstep;
    const unsigned ldsw = (unsigned)wid * 1024u;
    const int aoff = lds_byte(wr * 64 + fr, fq * 8), boff = lds_byte(wc * 32 + fr, fq * 8);
#define PG8_SA(b, h) (((b) * 2 + (h)) * HTB)
#define PG8_SB(b, h) ((4 + (b) * 2 + (h)) * HTB)
#define PG8_STAGE(bufoff, gbase, voff) do { _Pragma("unroll") for (int _i = 0; _i < 2; ++_i) \
        __builtin_amdgcn_global_load_lds((const unsigned*)((const char*)(gbase) + (voff)[_i]), (PG8_LAS unsigned*)(lds + (bufoff) + ldsw + _i * 8192), 16, 0, 0); } while (0)
#define PG8_LDA(dst, b, h) do { _Pragma("unroll") for (int m = 0; m < 4; ++m) _Pragma("unroll") for (int k = 0; k < 2; ++k) dst[m][k] = *(const PG8_LAS bf16x8*)(lds + PG8_SA(b, h) + aoff + m * 2048 + k * 1024); } while (0)
#define PG8_LDB(dst, b, h) do { _Pragma("unroll") for (int n = 0; n < 2; ++n) _Pragma("unroll") for (int k = 0; k < 2; ++k) dst[n][k] = *(const PG8_LAS bf16x8*)(lds + PG8_SB(b, h) + boff + n * 2048 + k * 1024); } while (0)
#define PG8_MMA(ai, bj, At, Bt) do { __builtin_amdgcn_s_setprio(1); _Pragma("unroll") for (int m = 0; m < 4; ++m) _Pragma("unroll") for (int n = 0; n < 2; ++n) _Pragma("unroll") for (int k = 0; k < 2; ++k) \
        acc[ai][bj][m][n] = __builtin_amdgcn_mfma_f32_16x16x32_bf16(Bt[n][k], At[m][k], acc[ai][bj][m][n], 0, 0, 0); __builtin_amdgcn_s_setprio(0); } while (0)
#define PG8_WAIT_V(n) asm volatile("s_waitcnt vmcnt(" #n ")" ::: "memory")
#define PG8_WAIT_L(n) asm volatile("s_waitcnt lgkmcnt(" #n ")" ::: "memory")
#define PG8_BAR __builtin_amdgcn_s_barrier()
#define PG8_SCHED __builtin_amdgcn_sched_barrier(0)
    Unit cur, nxt; int ui = 0;
    if (!S.next(0, cur)) return;
    f32x4 acc[2][2][4][2];
#pragma unroll
    for (int a = 0; a < 2; ++a)
#pragma unroll
        for (int b = 0; b < 2; ++b)
#pragma unroll
            for (int m = 0; m < 4; ++m)
#pragma unroll
                for (int n = 0; n < 2; ++n) acc[a][b][m][n] = (f32x4){0.f, 0.f, 0.f, 0.f};
    bf16x8 At[4][2], B0[2][2], B1[2][2];
    const char* cA = (const char*)g.A + (size_t)cur.pm * tstep; const char* cB = (const char*)g.Bt + (size_t)cur.pn * tstep;
    S.a_ready(cur);
    PG8_STAGE(PG8_SB(0, 0), cB, voffB); PG8_STAGE(PG8_SA(0, 0), cA, voffA); PG8_STAGE(PG8_SB(0, 1), cB + hstep, voffB); PG8_STAGE(PG8_SA(0, 1), cA + hstep, voffA);
    if (wr == 1) PG8_BAR;
    PG8_WAIT_V(4); PG8_BAR;
    PG8_STAGE(PG8_SB(1, 0), cB + kstep, voffB); PG8_STAGE(PG8_SA(1, 0), cA + kstep, voffA); PG8_STAGE(PG8_SB(1, 1), cB + hstep + kstep, voffB);
    PG8_WAIT_V(6); PG8_BAR;
    PG8_STAMP();
    for (;;) {
        const bool has_next = S.next(ui + 1, nxt);
        const char* nA = has_next ? (const char*)g.A + (size_t)nxt.pm * tstep : cA; const char* nB = has_next ? (const char*)g.Bt + (size_t)nxt.pn * tstep : cB;
        for (int t = 0; t < nt; t += 2) {
            const bool last = (t == nt - 2);
            const char* a1 = cA + (size_t)(t + 1) * kstep;
            const char* a2 = last ? nA : cA + (size_t)(t + 2) * kstep; const char* b2 = last ? nB : cB + (size_t)(t + 2) * kstep;
            const char* a3 = a2 + kstep; const char* b3 = b2 + kstep;
            if (last && has_next) S.a_ready(nxt);
            PG8_LDB(B0, 0, 0); PG8_SCHED; PG8_LDA(At, 0, 0); PG8_STAGE(PG8_SA(1, 1), a1 + hstep, voffA);
            PG8_WAIT_L(8); PG8_BAR; PG8_WAIT_L(0); PG8_MMA(0, 0, At, B0); PG8_BAR; PG8_SCHED;
            PG8_LDB(B1, 0, 1); PG8_STAGE(PG8_SB(0, 0), b2, voffB);
            PG8_BAR; PG8_WAIT_L(0); PG8_MMA(0, 1, At, B1); PG8_BAR;
            PG8_LDA(At, 0, 1); PG8_STAGE(PG8_SA(0, 0), a2, voffA);
            PG8_BAR; PG8_WAIT_L(0); PG8_MMA(1, 0, At, B0); PG8_BAR; PG8_SCHED;
            PG8_STAGE(PG8_SB(0, 1), b2 + hstep, voffB);
            PG8_WAIT_V(6); PG8_BAR; PG8_MMA(1, 1, At, B1); PG8_BAR;
            PG8_LDB(B0, 1, 0); PG8_SCHED; PG8_LDA(At, 1, 0); PG8_STAGE(PG8_SA(0, 1), a2 + hstep, voffA);
            PG8_WAIT_L(8); PG8_BAR; PG8_WAIT_L(0); PG8_MMA(0, 0, At, B0); PG8_BAR; PG8_SCHED;
            PG8_LDB(B1, 1, 1); PG8_STAGE(PG8_SB(1, 0), b3, voffB);
            PG8_BAR; PG8_WAIT_L(0); PG8_MMA(0, 1, At, B1); PG8_BAR;
            PG8_LDA(At, 1, 1); PG8_STAGE(PG8_SA(1, 0), a3, voffA);
            PG8_BAR; PG8_WAIT_L(0); PG8_MMA(1, 0, At, B0); PG8_BAR; PG8_SCHED;
            PG8_STAGE(PG8_SB(1, 1), b3 + hstep, voffB);
            PG8_WAIT_V(6); PG8_BAR; PG8_MMA(1, 1, At, B1); PG8_BAR;
        }
        PG8_STAMP();
        if constexpr (!Epi::AFTER_DRAIN) { E(acc, cur, wr, wc, fr, fq); S.done(cur); }
        PG8_STAMP();
        if (!has_next) break;
#pragma unroll
        for (int a = 0; a < 2; ++a)
#pragma unroll
            for (int b = 0; b < 2; ++b)
#pragma unroll
                for (int m = 0; m < 4; ++m)
#pragma unroll
                    for (int n = 0; n < 2; ++n) acc[a][b][m][n] = (f32x4){0.f, 0.f, 0.f, 0.f};
        cur = nxt; cA = nA; cB = nB; ++ui;
    }
    PG8_WAIT_V(0);
    if (wr == 0) PG8_BAR;
    PG8_BAR;
    if constexpr (Epi::AFTER_DRAIN) { E.fused(acc, cur, wr, wc, fr, fq, lds, wid, lane); S.done(cur); }
    PG8_STAMP();
    if (STAMP && wid == 0) { stamps[lane] = lane < nts ? (((unsigned long long)(unsigned)ts_hi << 32) | (unsigned)ts_lo) : 0ull;
        if (lane == 62) stamps[62] = rt_entry; if (lane == 63) stamps[63] = (unsigned long long)wall_clock64(); }
#undef PG8_STAMP
#undef PG8_SA
#undef PG8_SB
#undef PG8_STAGE
#undef PG8_LDA
#undef PG8_LDB
#undef PG8_MMA
#undef PG8_WAIT_V
#undef PG8_WAIT_L
#undef PG8_BAR
#undef PG8_SCHED
}
}
#define XB_TMO      128
#define XB_XCNT(j)  (256  + 64 * (j))
#define XB_XSUB(j)  (1280 + 64 * (j))
#define XB_XGEN(j)  (2304 + 64 * (j))
#define XB_TOP      3328
#define XB_TOPGEN   3392
#define XCD_BAR_WORDS 3456
#define XB_SPIN_CAP (1u << 18)
#define LAS __attribute__((address_space(3)))

__device__ __forceinline__ unsigned xb_ld(unsigned* p)              { return __hip_atomic_load(p, __ATOMIC_RELAXED, __HIP_MEMORY_SCOPE_AGENT); }
__device__ __forceinline__ unsigned xb_add(unsigned* p, unsigned v) { return __hip_atomic_fetch_add(p, v, __ATOMIC_RELAXED, __HIP_MEMORY_SCOPE_AGENT); }
__device__ __forceinline__ unsigned xb_xcc_id() { return (unsigned)__builtin_amdgcn_s_getreg((3 << 11) | 20) & 0xFu; }
#define XB_SPIN(cond, bar) do { unsigned _sp = 0; while (cond) { __builtin_amdgcn_s_sleep(1); \
    if ((++_sp & 255u) == 0u) { if (xb_ld(&(bar)[XB_TMO])) break; if (_sp > XB_SPIN_CAP) { atomicAdd(&(bar)[XB_TMO], 1u); break; } } } } while (0)

struct XcdBarrier {
    unsigned* bar; unsigned x;
    volatile LAS unsigned* st;
};

__device__ __forceinline__ XcdBarrier xcd_barrier_post(unsigned* bar, volatile LAS unsigned* st) {
    XcdBarrier b; b.bar = bar; b.x = xb_xcc_id(); b.st = st;
    if (threadIdx.x == 0) (void)xb_add(&bar[XB_XCNT(b.x)], 1u);
    return b;
}
__device__ __forceinline__ void xcd_barrier_complete(unsigned* bar, unsigned x, unsigned& nloc, unsigned& nx) {
    const unsigned G = gridDim.x * gridDim.y * gridDim.z;
    unsigned sum, cnt, mine, sp = 0u;
    for (;;) {
        sum = 0u; cnt = 0u; mine = 0u;
#pragma unroll
        for (unsigned j = 0; j < 16; ++j) { const unsigned c = xb_ld(&bar[XB_XCNT(j)]); sum += c; cnt += (c > 0u) ? 1u : 0u; mine = (j == x) ? c : mine; }
        if (sum == G) break;
        __builtin_amdgcn_s_sleep(1);
        if ((++sp & 255u) == 0u) { if (xb_ld(&bar[XB_TMO])) break; if (sp > XB_SPIN_CAP) { atomicAdd(&bar[XB_TMO], 1u); break; } }
    }
    nloc = mine > 0u ? mine : 1u; nx = cnt > 0u ? cnt : 1u;
}

__device__ __forceinline__ void xcd_barrier(const XcdBarrier& b) {
    asm volatile("s_waitcnt vmcnt(0)" ::: "memory");
    __syncthreads();
    if (threadIdx.x == 0) {
        unsigned* bar = b.bar;
        __builtin_amdgcn_s_waitcnt(0);
        unsigned nloc = b.st[0], nx = b.st[1];
        if (nloc == 0u) { xcd_barrier_complete(bar, b.x, nloc, nx); b.st[0] = nloc; b.st[1] = nx; }
        const unsigned old = xb_add(&bar[XB_XSUB(b.x)], 1u);
        const unsigned gen = old / nloc;
        if (old + 1u == (gen + 1u) * nloc) {
            __builtin_amdgcn_fence(__ATOMIC_RELEASE, "agent");
            asm volatile("s_waitcnt vmcnt(0)" ::: "memory");
            const unsigned og = xb_add(&bar[XB_TOP], 1u);
            const unsigned tg = og / nx;
            if (og + 1u == (tg + 1u) * nx) xb_add(&bar[XB_TOPGEN], 1u);
            else XB_SPIN(xb_ld(&bar[XB_TOPGEN]) == tg, bar);
            __builtin_amdgcn_fence(__ATOMIC_ACQUIRE, "agent");
            xb_add(&bar[XB_XGEN(b.x)], 1u);
            asm volatile("s_waitcnt vmcnt(0)" ::: "memory");
        } else {
            XB_SPIN(xb_ld(&bar[XB_XGEN(b.x)]) == gen, bar);
            __builtin_amdgcn_fence(__ATOMIC_ACQUIRE, "agent");
            asm volatile("s_waitcnt vmcnt(0)" ::: "memory");
        }
    }
    __syncthreads();
}


using pg8::f32x4; using pg8::u32x4; using pg8::Unit; using pg8::Gemm; using pg8::StaticOrder;
typedef unsigned u32x2 __attribute__((ext_vector_type(2)));
#define LDSP PG8_LAS unsigned char*

constexpr int N1 = 10496;
constexpr size_t OW1 = 0, OW2 = OW1 + (size_t)N1 * 1024, OW3 = OW2 + (size_t)1024 * 2048, OW4 = OW3 + (size_t)1024 * 1024, OW5 = OW4 + (size_t)1024 * 1024,
                 OW6 = OW5 + (size_t)8192 * 1024, OW7 = OW6 + (size_t)1024 * 4096, OW8 = OW7 + (size_t)1024 * 256, WT_LAYER = OW8 + (size_t)1024 * 1024;
constexpr int NCHUNK = 256 + DEC_BATCH;

struct Params {
    const float *x_prompt, *x_sample, *state_ssd_conv, *state_ssd, *cache_k, *cache_v, *state_ffn_conv, *p_prompt, *p_sample;
    const float *norm_pre_mix, *w_in, *ssd_conv_w, *ssd_conv_b, *ssd_dt_bias, *ssd_a_log, *ssd_d, *ssd_norm, *w_br_ssd, *w_br_sb, *w_out, *norm_post_mix, *norm_pre_ffn,
                *w_up, *ffn_conv_w, *ffn_conv_b, *w_down, *norm_post_ffn, *w_ple, *w_ple_gate, *norm_ple;
    float* out;
    unsigned* bar;
    bf16_t* wt; bf16_t* xr; bf16_t* xb; float* rs; float* rs2; bf16_t* pb;
    bf16_t *zb, *xbcb, *qb, *gb, *kb, *vb; float* dtb;
    float* sst; float* dec; bf16_t* hpb;
    bf16_t *yn, *att, *t1, *mixin; bf16_t* mixed;
    bf16_t *gh, *xh, *ffb; bf16_t* down; bf16_t* plea; bf16_t* ple;
};

typedef const __attribute__((address_space(4))) Params CP;
#define CPR CP&
__device__ __forceinline__ CP* kargs() { CP* q = (CP*)__builtin_amdgcn_kernarg_segment_ptr(); asm volatile("" : "+s"(q)); return q; }

__device__ __forceinline__ void wt_item(const float* __restrict__ W, int K, int ldw, const float* __restrict__ gain, bf16_t* __restrict__ Wt, int nblk, int item, int w1map, PG8_LAS float* scr, int lane) {
    const int kb = item / nblk, nb = item % nblk, k0 = 64 * kb, n0 = 32 * nb;
    int sc0 = n0; if (w1map == 1) sc0 = (n0 < 5120) ? n0 : (n0 < 10240 ? n0 + 32 : (n0 < 10272 ? n0 - 5120 : -1));
    else if (w1map == 2) sc0 = ((n0 & 255) < 128 ? 0 : 4096) + (n0 >> 8) * 128 + (n0 & 127);
    const int kr = lane >> 3, c4 = (lane & 7) * 4;
    float4 v[8];
#pragma unroll
    for (int i = 0; i < 8; ++i) v[i] = (sc0 >= 0) ? *(const float4*)(W + (size_t)(k0 + kr + 8 * i) * ldw + sc0 + c4) : make_float4(0.f, 0.f, 0.f, 0.f);
#pragma unroll
    for (int i = 0; i < 8; ++i) { const int kk = kr + 8 * i; const float gm = gain ? gain[k0 + kk] : 1.0f; PG8_LAS float* d = scr + kk * 33 + c4;
        d[0] = v[i].x * gm; d[1] = v[i].y * gm; d[2] = v[i].z * gm; d[3] = v[i].w * gm; }
    asm volatile("s_waitcnt lgkmcnt(0)" ::: "memory");
    const int c = lane & 7;
#pragma unroll
    for (int j = 0; j < 4; ++j) { const int nn = (lane >> 3) + 8 * j; const PG8_LAS float* s = scr + (8 * c) * 33 + nn;
        *(u32x4*)(Wt + (size_t)(n0 + nn) * K + k0 + 8 * c) = (u32x4){pk2(s[0], s[33]), pk2(s[2 * 33], s[3 * 33]), pk2(s[4 * 33], s[5 * 33]), pk2(s[6 * 33], s[7 * 33])}; }
    asm volatile("s_waitcnt lgkmcnt(0)" ::: "memory");
}
__device__ __forceinline__ void ph_wt(CPR p, LDSP lds) {
    constexpr int U1 = 16 * 328, U2 = U1 + 32 * 32, U3 = U2 + 512, U4 = U3 + 512, U5 = U4 + 16 * 256, U6 = U5 + 64 * 32, U7 = U6 + 4 * 32, U8 = U7 + 512;
    const int tidx = tid_opaque(), lane = tidx & 63, wv = tidx >> 6, gw = bid_opaque() * 8 + wv, NGW = nblk_opaque() * 8;
    PG8_LAS float* scr = (PG8_LAS float*)(lds + wv * (64 * 33 * 4));
    for (int u = gw; u < DEPTH * U8; u += NGW) {
        const int l = u / U8; int v = u % U8; bf16_t* wl = p.wt + (size_t)l * WT_LAYER;
        if (v < U1)      { wt_item(p.w_in + (size_t)l * 1024 * IN_DIM, 1024, IN_DIM, p.norm_pre_mix + l * 1024, wl + OW1, 328, v, 1, scr, lane); }
        else if (v < U2) { v -= U1; wt_item(p.w_br_ssd + (size_t)l * 2048 * 1024, 2048, 1024, p.ssd_norm + l * 2048, wl + OW2, 32, v, 0, scr, lane); }
        else if (v < U3) { v -= U2; wt_item(p.w_br_sb + (size_t)l * 1024 * 1024, 1024, 1024, nullptr, wl + OW3, 32, v, 0, scr, lane); }
        else if (v < U4) { v -= U3; wt_item(p.w_out + (size_t)l * 1024 * 1024, 1024, 1024, nullptr, wl + OW4, 32, v, 0, scr, lane); }
        else if (v < U5) { v -= U4; wt_item(p.w_up + (size_t)l * 1024 * 8192, 1024, 8192, p.norm_pre_ffn + l * 1024, wl + OW5, 256, v, 2, scr, lane); }
        else if (v < U6) { v -= U5; wt_item(p.w_down + (size_t)l * 4096 * 1024, 4096, 1024, nullptr, wl + OW6, 32, v, 0, scr, lane); }
        else if (v < U7) { v -= U6; wt_item(p.w_ple + (size_t)l * 256 * 1024, 256, 1024, nullptr, wl + OW7, 32, v, 0, scr, lane); }
        else             { v -= U7; wt_item(p.w_ple_gate + (size_t)l * 1024 * 1024, 1024, 1024, nullptr, wl + OW8, 32, v, 0, scr, lane); }
    }
    __syncthreads();
}
__device__ __forceinline__ void ph_xprep(CPR p) {
    const int tidx = tid_opaque(); const int lane = tidx & 63, gw = bid_opaque() * 8 + (tidx >> 6), NGW = nblk_opaque() * 8;
    for (int row0 = 2 * gw; row0 < M_ALL; row0 += 2 * NGW) {
        float4 v[2][4]; float ss[2] = {0.f, 0.f};
#pragma unroll
        for (int q = 0; q < 2; ++q) { const int row = row0 + q; const float4* src = (const float4*)(row < M_P ? p.x_prompt + (size_t)row * 1024 : p.x_sample + (size_t)(row - M_P) * 1024);
#pragma unroll
            for (int j = 0; j < 4; ++j) v[q][j] = src[lane + 64 * j]; }
#pragma unroll
        for (int q = 0; q < 2; ++q) { const int row = row0 + q;
#pragma unroll
            for (int j = 0; j < 4; ++j) { ss[q] += v[q][j].x * v[q][j].x + v[q][j].y * v[q][j].y + v[q][j].z * v[q][j].z + v[q][j].w * v[q][j].w;
                ((u32x2*)(p.xr + (size_t)row * 1024))[lane + 64 * j] = (u32x2){pk2(v[q][j].x, v[q][j].y), pk2(v[q][j].z, v[q][j].w)}; }
            const float rn = rsqrtf(wave_sum(ss[q]) * (1.0f / 1024.f) + EPS);
#pragma unroll
            for (int j = 0; j < 4; ++j) ((u32x2*)(p.xb + (size_t)row * 1024))[lane + 64 * j] = (u32x2){pk2(v[q][j].x * rn, v[q][j].y * rn), pk2(v[q][j].z * rn, v[q][j].w * rn)}; }
    }
    for (int r0 = 4 * gw; r0 < DEPTH * M_ALL; r0 += 4 * NGW) {
        float4 v[4];
#pragma unroll
        for (int q = 0; q < 4; ++q) { const int r2 = r0 + q, l = r2 / M_ALL, row = r2 % M_ALL;
            v[q] = ((const float4*)(row < M_P ? p.p_prompt + ((size_t)l * M_P + row) * PLE_DIM : p.p_sample + ((size_t)l * M_S + row - M_P) * PLE_DIM))[lane]; }
#pragma unroll
        for (int q = 0; q < 4; ++q) ((u32x2*)(p.pb + (size_t)(r0 + q) * PLE_DIM))[lane] = (u32x2){pk2(v[q].x, v[q].y), pk2(v[q].z, v[q].w)};
    }
}
__device__ __forceinline__ void ph_norm(const bf16_t* __restrict__ src, const float* __restrict__ gain, bf16_t* xr, bf16_t* xb, float* yP, float* yS, bf16_t* xh = nullptr) {
    const int tidx = tid_opaque(); const int lane = tidx & 63, gw = bid_opaque() * 8 + (tidx >> 6), NGW = nblk_opaque() * 8;
    float4 g[4];
#pragma unroll
    for (int j = 0; j < 4; ++j) g[j] = ((const float4*)gain)[lane + 64 * j];
    for (int row0 = 2 * gw; row0 < M_ALL; row0 += 2 * NGW) {
        u32x2 sv[2][4], xv[2][4];
#pragma unroll
        for (int q = 0; q < 2; ++q)
#pragma unroll
            for (int j = 0; j < 4; ++j) { sv[q][j] = ((const u32x2*)(src + (size_t)(row0 + q) * 1024))[lane + 64 * j]; xv[q][j] = ((const u32x2*)(xr + (size_t)(row0 + q) * 1024))[lane + 64 * j]; }
#pragma unroll
        for (int q = 0; q < 2; ++q) {
            const int row = row0 + q;
            float4 v[4], x[4]; float ss = 0.f;
#pragma unroll
            for (int j = 0; j < 4; ++j) { v[j] = make_float4(bflo(sv[q][j].x), bfhi(sv[q][j].x), bflo(sv[q][j].y), bfhi(sv[q][j].y)); x[j] = make_float4(bflo(xv[q][j].x), bfhi(xv[q][j].x), bflo(xv[q][j].y), bfhi(xv[q][j].y));
                ss += v[j].x * v[j].x + v[j].y * v[j].y + v[j].z * v[j].z + v[j].w * v[j].w; }
            ss = wave_sum(ss);
            const float r = rsqrtf(ss * (1.0f / 1024.f) + EPS); float s2 = 0.f;
#pragma unroll
            for (int j = 0; j < 4; ++j) {
                x[j].x += v[j].x * r * g[j].x; x[j].y += v[j].y * r * g[j].y; x[j].z += v[j].z * r * g[j].z; x[j].w += v[j].w * r * g[j].w;
                s2 += x[j].x * x[j].x + x[j].y * x[j].y + x[j].z * x[j].z + x[j].w * x[j].w;
                ((u32x2*)(xr + (size_t)row * 1024))[lane + 64 * j] = (u32x2){pk2(x[j].x, x[j].y), pk2(x[j].z, x[j].w)};
            }
            if (xb) {
                const float rn = rsqrtf(wave_sum(s2) * (1.0f / 1024.f) + EPS);
#pragma unroll
                for (int j = 0; j < 4; ++j) {
                    const u32x2 wq = (u32x2){pk2(x[j].x * rn, x[j].y * rn), pk2(x[j].z * rn, x[j].w * rn)};
                    ((u32x2*)(xb + (size_t)row * 1024))[lane + 64 * j] = wq;
                    if (xh && (row & 63) >= 62) ((u32x2*)(xh + (size_t)(2 * ((row >> 6) + 1) + (row & 63) - 62) * 1024))[lane + 64 * j] = wq;
                }
            }
            if (yP) { float4* y4 = (float4*)(row < M_P ? yP + (size_t)row * 1024 : yS + (size_t)(row - M_P) * 1024);
#pragma unroll
                for (int j = 0; j < 4; ++j) y4[lane + 64 * j] = x[j]; }
        }
    }
}
__device__ __forceinline__ void unpack8(const u32x4 w, float (&v)[8]) {
    v[0] = bflo(w.x); v[1] = bfhi(w.x); v[2] = bflo(w.y); v[3] = bfhi(w.y); v[4] = bflo(w.z); v[5] = bfhi(w.z); v[6] = bflo(w.w); v[7] = bfhi(w.w);
}
__device__ __forceinline__ void load8f(const float* p, float (&v)[8]) { const float4 a = ((const float4*)p)[0], b = ((const float4*)p)[1]; v[0] = a.x; v[1] = a.y; v[2] = a.z; v[3] = a.w; v[4] = b.x; v[5] = b.y; v[6] = b.z; v[7] = b.w; }
__device__ __forceinline__ float gelu_fast(float x) { const float u2 = 1.5957691216057308f * (x + 0.044715f * x * x * x); return x * __builtin_amdgcn_rcpf(1.0f + __expf(-u2)); }
struct EpiIn {
    static constexpr bool PERM = true, AFTER_DRAIN = false;
    const float* rs; bf16_t *zb, *xbcb, *qb, *gb, *kb, *vb; float* dtb; const float* dt_bias; float *kP, *vP, *kS, *vS, *convP, *convS;
    __device__ __forceinline__ void operator()(const f32x4 (&acc)[2][2][4][2], const Unit& u, int wr, int wc, int fr, int fq) const {
        const int row0 = u.pm * 256 + wr * 64 + fr, seg = u.pn, cl = wc * 32 + 8 * fq;
#pragma unroll
        for (int ai = 0; ai < 2; ++ai)
#pragma unroll
            for (int m = 0; m < 4; ++m) {
                const int r = row0 + ai * 128 + m * 16;
#pragma unroll
                for (int bj = 0; bj < 2; ++bj) {
                    const int ct = cl + bj * 128; const f32x4 v0 = acc[ai][bj][m][0], v1 = acc[ai][bj][m][1];
                    const u32x4 w = (u32x4){pk2c(v0[0], v0[1]), pk2c(v0[2], v0[3]), pk2c(v1[0], v1[1]), pk2c(v1[2], v1[3])};
                    if (seg < 8) { *(u32x4*)(zb + (size_t)r * 2048 + seg * 256 + ct) = w; }
                    else if (seg < 20) {
                        const int c = (seg - 8) * 256 + ct; *(u32x4*)(xbcb + (size_t)r * 3072 + c) = w;
                        float* dst = nullptr;
                        if (r < M_P) { if (r >= M_P - 3) dst = convP + (size_t)(r - (M_P - 3)) * 3072; }
                        else { const int t = (r - M_P) & 31, b = (r - M_P) >> 5; if (t >= 29) dst = convS + ((size_t)b * 3 + (t - 29)) * 3072; }
                        if (dst) { *(f32x4*)(dst + c) = v0; *(f32x4*)(dst + c + 4) = v1; }
                    }
                    else if (seg < 24) { *(u32x4*)(qb + (size_t)r * 1024 + (seg - 20) * 256 + ct) = w; }
                    else if (seg < 32) {
                        const int c = ((seg - 24) & 3) * 256 + ct; const bool isk = seg < 28;
                        float* dst = (r < M_P) ? (isk ? kP : vP) + (size_t)r * 1024 : (isk ? kS : vS) + (size_t)(r - M_P) * 1024;
                        *(f32x4*)(dst + c) = v0; *(f32x4*)(dst + c + 4) = v1;
                        *(u32x4*)((isk ? kb : vb) + (size_t)r * 1024 + c) = w;
                    }
                    else if (seg < 40) {
                        const f32x2_t s0 = sigmoid2((f32x2_t){v0[0], v0[1]}), s1 = sigmoid2((f32x2_t){v0[2], v0[3]}), s2 = sigmoid2((f32x2_t){v1[0], v1[1]}), s3 = sigmoid2((f32x2_t){v1[2], v1[3]});
                        *(u32x4*)(gb + (size_t)r * 2048 + (seg - 32) * 256 + ct) = (u32x4){pk2(s0.x, s0.y), pk2(s1.x, s1.y), pk2(s2.x, s2.y), pk2(s3.x, s3.y)};
                    }
                    else if (wc == 0 && bj == 0) {
                        const f32x4 b0 = *(const f32x4*)(dt_bias + 8 * fq), b1 = *(const f32x4*)(dt_bias + 8 * fq + 4);
                        f32x4 o0, o1;
#pragma unroll
                        for (int j = 0; j < 4; ++j) { o0[j] = softplusf_(v0[j] + b0[j]); o1[j] = softplusf_(v1[j] + b1[j]); }
                        *(f32x4*)(dtb + (size_t)r * 32 + 8 * fq) = o0; *(f32x4*)(dtb + (size_t)r * 32 + 8 * fq + 4) = o1;
                    }
                }
            }
    }
};
struct EpiHalo {
    static constexpr bool PERM = true, AFTER_DRAIN = false;
    const float* rs; bf16_t* gh;
    __device__ __forceinline__ void elem(int hi, int ch, float v) const { gh[(size_t)hi * D_FF + ch] = f2bf(v); }
    __device__ __forceinline__ void operator()(const f32x4 (&acc)[2][2][4][2], const Unit& u, int wr, int wc, int fr, int fq) const {
        const int row0 = u.pm * 256 + wr * 64 + fr, c0 = u.pn * 128 + wc * 32 + 8 * fq;
#pragma unroll
        for (int ai = 0; ai < 2; ++ai)
#pragma unroll
            for (int m = 0; m < 4; ++m) {
                const int hi = row0 + ai * 128 + m * 16;
                const f32x4 v0 = acc[ai][0][m][0], v1 = acc[ai][0][m][1];
                *(u32x4*)(gh + (size_t)hi * D_FF + c0) = (u32x4){pk2c(v0[0], v0[1]), pk2c(v0[2], v0[3]), pk2c(v1[0], v1[1]), pk2c(v1[2], v1[3])};
            }
    }
};
struct EpiUpAct {
    static constexpr bool PERM = true, AFTER_DRAIN = false;
    const float* rs; const bf16_t* gh; bf16_t* ffb; float *ffnP, *ffnS; const float* cw; const float* cb; const float* hist;
    __device__ __forceinline__ void operator()(const f32x4 (&acc)[2][2][4][2], const Unit& u, int wr, int wc, int fr, int fq) const {
        const int c0 = u.pn * 128 + wc * 32 + 8 * fq;
        float w0[8], w1[8], w2[8], bb[8];
        load8f(cw + c0, w0); load8f(cw + D_FF + c0, w1); load8f(cw + 2 * D_FF + c0, w2); load8f(cb + c0, bb);
#pragma unroll
        for (int ai = 0; ai < 2; ++ai) {
            const int strip = 4 * u.pm + 2 * ai + wr;
            float gprev[8];
#pragma unroll
            for (int m = 0; m < 4; ++m) {
                const int r = strip * 64 + 16 * m + fr;
                float g[8], uv[8], p1[8], p2[8];
#pragma unroll
                for (int j = 0; j < 4; ++j) { g[j] = acc[ai][0][m][0][j]; g[4 + j] = acc[ai][0][m][1][j]; uv[j] = acc[ai][1][m][0][j]; uv[4 + j] = acc[ai][1][m][1][j]; }
                if (m == 0) { float e14[8], e15[8]; unpack8(*(const u32x4*)(gh + (size_t)(2 * strip) * D_FF + c0), e14); unpack8(*(const u32x4*)(gh + (size_t)(2 * strip + 1) * D_FF + c0), e15);
#pragma unroll
                    for (int j = 0; j < 8; ++j) gprev[j] = (fr == 15) ? e15[j] : e14[j]; }
#pragma unroll
                for (int j = 0; j < 8; ++j) {
                    const float c1 = (fr == 15) ? gprev[j] : g[j], c2 = (fr >= 14) ? gprev[j] : g[j];
                    p1[j] = __builtin_bit_cast(float, __builtin_amdgcn_update_dpp(0, __builtin_bit_cast(int, c1), 0x121, 0xf, 0xf, false));
                    p2[j] = __builtin_bit_cast(float, __builtin_amdgcn_update_dpp(0, __builtin_bit_cast(int, c2), 0x122, 0xf, 0xf, false));
                }
                const int t = (r < M_P) ? r : ((r - M_P) & 31);
                if (t < 2) {
                    float h0[8], h1[8];
                    if (r >= M_P) { const float* hp = hist + (size_t)((r - M_P) >> 5) * 2 * D_FF + c0; load8f(hp, h0); load8f(hp + D_FF, h1); }
                    else {
#pragma unroll
                        for (int j = 0; j < 8; ++j) { h0[j] = 0.f; h1[j] = 0.f; } }
#pragma unroll
                    for (int j = 0; j < 8; ++j) { if (t == 0) { p2[j] = h0[j]; p1[j] = h1[j]; } else { p2[j] = h1[j]; } }
                }
                float o[8];
#pragma unroll
                for (int j = 0; j < 8; j += 2) {
                    const f32x2_t a = (f32x2_t){bb[j], bb[j + 1]} + (f32x2_t){w0[j], w0[j + 1]} * (f32x2_t){p2[j], p2[j + 1]} + (f32x2_t){w1[j], w1[j + 1]} * (f32x2_t){p1[j], p1[j + 1]} + (f32x2_t){w2[j], w2[j + 1]} * (f32x2_t){g[j], g[j + 1]};
                    const f32x2_t ov = gelu2(a) * (f32x2_t){uv[j], uv[j + 1]}; o[j] = ov.x; o[j + 1] = ov.y; }
                *(u32x4*)(ffb + (size_t)r * D_FF + c0) = (u32x4){pk2(o[0], o[1]), pk2(o[2], o[3]), pk2(o[4], o[5]), pk2(o[6], o[7])};
                float* dst = nullptr;
                if (r < M_P) { if (r >= M_P - 2) dst = ffnP + (size_t)(r - (M_P - 2)) * D_FF; }
                else { const int b = (r - M_P) >> 5; if (t >= 30) dst = ffnS + ((size_t)b * 2 + (t - 30)) * D_FF; }
                if (dst) { *(f32x4*)(dst + c0) = (f32x4){g[0], g[1], g[2], g[3]}; *(f32x4*)(dst + c0 + 4) = (f32x4){g[4], g[5], g[6], g[7]}; }
#pragma unroll
                for (int j = 0; j < 8; ++j) gprev[j] = g[j];
            }
        }
    }
};
struct EpiBr {
    static constexpr bool PERM = true, AFTER_DRAIN = false;
    const bf16_t* gb; const bf16_t* t1in; bf16_t* dst; int mode; int pad;
    __device__ __forceinline__ void elem(int r, int c, float v) const {
        float o = bf2f(gb[(size_t)r * 2048 + (mode == 0 ? 1024 : 0) + c]) * v; if (mode == 1) o += bf2f(t1in[(size_t)r * 1024 + c]);
        dst[(size_t)r * 1024 + c] = f2bf(o); }
    __device__ __forceinline__ void operator()(const f32x4 (&acc)[2][2][4][2], const Unit& u, int wr, int wc, int fr, int fq) const {
        const int row0 = u.pm * 256 + wr * 64 + fr, cl = u.pn * 256 + wc * 32 + 8 * fq;
#pragma unroll
        for (int ai = 0; ai < 2; ++ai)
#pragma unroll
            for (int m = 0; m < 4; ++m) {
                const int r = row0 + ai * 128 + m * 16;
#pragma unroll
                for (int bj = 0; bj < 2; ++bj) {
                    const int c = cl + bj * 128; float g[8], o[8];
                    unpack8(*(const u32x4*)(gb + (size_t)r * 2048 + (mode == 0 ? 1024 : 0) + c), g);
                    const f32x4 v0 = acc[ai][bj][m][0], v1 = acc[ai][bj][m][1];
                    float tv[8];
                    if (mode == 1) unpack8(*(const u32x4*)(t1in + (size_t)r * 1024 + c), tv);
                    else {
#pragma unroll
                        for (int j = 0; j < 8; ++j) tv[j] = 0.f; }
#pragma unroll
                    for (int j = 0; j < 4; j += 2) {
                        const f32x2_t oa = (f32x2_t){g[j], g[j + 1]} * (f32x2_t){v0[j], v0[j + 1]} + (f32x2_t){tv[j], tv[j + 1]}, ob = (f32x2_t){g[4 + j], g[5 + j]} * (f32x2_t){v1[j], v1[j + 1]} + (f32x2_t){tv[4 + j], tv[5 + j]};
                        o[j] = oa.x; o[j + 1] = oa.y; o[4 + j] = ob.x; o[5 + j] = ob.y; }
                    *(u32x4*)(dst + (size_t)r * 1024 + c) = (u32x4){pk2(o[0], o[1]), pk2(o[2], o[3]), pk2(o[4], o[5]), pk2(o[6], o[7])};
                }
            }
    }
};
struct EpiPlain {
    static constexpr bool PERM = true, AFTER_DRAIN = false;
    bf16_t* dst;
    __device__ __forceinline__ void elem(int r, int c, float v) const { dst[(size_t)r * 1024 + c] = f2bf(v); }
    __device__ __forceinline__ void operator()(const f32x4 (&acc)[2][2][4][2], const Unit& u, int wr, int wc, int fr, int fq) const {
        const int row0 = u.pm * 256 + wr * 64 + fr, cl = u.pn * 256 + wc * 32 + 8 * fq;
#pragma unroll
        for (int ai = 0; ai < 2; ++ai)
#pragma unroll
            for (int m = 0; m < 4; ++m) {
                const int r = row0 + ai * 128 + m * 16;
#pragma unroll
                for (int bj = 0; bj < 2; ++bj) { const f32x4 v0 = acc[ai][bj][m][0], v1 = acc[ai][bj][m][1];
                    *(u32x4*)(dst + (size_t)r * 1024 + cl + bj * 128) = (u32x4){pk2c(v0[0], v0[1]), pk2c(v0[2], v0[3]), pk2c(v1[0], v1[1]), pk2c(v1[2], v1[3])}; }
            }
    }
};
struct EpiF32Out {
    static constexpr bool PERM = true, AFTER_DRAIN = false;
    bf16_t* dst;
    __device__ __forceinline__ void elem(int r, int c, float v) const { dst[(size_t)r * 1024 + c] = f2bf(v); }
    __device__ __forceinline__ void operator()(const f32x4 (&acc)[2][2][4][2], const Unit& u, int wr, int wc, int fr, int fq) const {
        const int row0 = u.pm * 256 + wr * 64 + fr, cl = u.pn * 256 + wc * 32 + 8 * fq;
#pragma unroll
        for (int ai = 0; ai < 2; ++ai)
#pragma unroll
            for (int m = 0; m < 4; ++m) {
                const int r = row0 + ai * 128 + m * 16;
#pragma unroll
                for (int bj = 0; bj < 2; ++bj) { const f32x4 v0 = acc[ai][bj][m][0], v1 = acc[ai][bj][m][1];
                    *(u32x4*)(dst + (size_t)r * 1024 + cl + bj * 128) = (u32x4){pk2c(v0[0], v0[1]), pk2c(v0[2], v0[3]), pk2c(v1[0], v1[1]), pk2c(v1[2], v1[3])}; }
            }
    }
};
struct EpiPle {
    static constexpr bool PERM = false, AFTER_DRAIN = false;
    const bf16_t* plea; bf16_t* dst;
    __device__ __forceinline__ void elem(int r, int c, float v) const { dst[(size_t)r * 1024 + c] = f2bf(bf2f(plea[(size_t)r * 1024 + c]) * sigmoidf_(v)); }
    __device__ __forceinline__ void operator()(const f32x4 (&acc)[2][2][4][2], const Unit& u, int wr, int wc, int fr, int fq) const {
        const int row0 = u.pm * 256 + wr * 64 + fr, col0 = u.pn * 256 + wc * 32 + 4 * fq;
#pragma unroll
        for (int ai = 0; ai < 2; ++ai)
#pragma unroll
            for (int m = 0; m < 4; ++m) { const size_t ro = (size_t)(row0 + ai * 128 + m * 16) * 1024 + col0;
#pragma unroll
                for (int bj = 0; bj < 2; ++bj)
#pragma unroll
                    for (int n = 0; n < 2; ++n) { const u32x2 a = *(const u32x2*)(plea + ro + bj * 128 + n * 16); const f32x4 v = acc[ai][bj][m][n];
                        const f32x2_t o0 = (f32x2_t){bflo(a.x), bfhi(a.x)} * sigmoid2((f32x2_t){v[0], v[1]}), o1 = (f32x2_t){bflo(a.y), bfhi(a.y)} * sigmoid2((f32x2_t){v[2], v[3]});
                        *(u32x2*)(dst + ro + bj * 128 + n * 16) = (u32x2){pk2(o0.x, o0.y), pk2(o1.x, o1.y)}; } }
    }
};

typedef short bf16x8 __attribute__((ext_vector_type(8)));
typedef float f32x16 __attribute__((ext_vector_type(16)));
typedef short bf16x4 __attribute__((ext_vector_type(4)));
#define MFMA32(a, b, c) __builtin_amdgcn_mfma_f32_32x32x16_bf16((a), (b), (c), 0, 0, 0)
__device__ __forceinline__ f32x16 zero16() { f32x16 z;
#pragma unroll
    for (int i = 0; i < 16; ++i) z[i] = 0.f; return z; }
__device__ __forceinline__ bf16x8 pack8f(const float (&v)[8]) { const u32x4 w = (u32x4){pk2(v[0], v[1]), pk2(v[2], v[3]), pk2(v[4], v[5]), pk2(v[6], v[7])}; return __builtin_bit_cast(bf16x8, w); }
__device__ __forceinline__ bf16x8 join44(bf16x4 lo, bf16x4 hi) { return __builtin_shufflevector(lo, hi, 0, 1, 2, 3, 4, 5, 6, 7); }

constexpr int PX = 72;
constexpr int PR = 136;
constexpr int L_XT = 0;
constexpr int L_B = L_XT + 8 * 64 * PX * 2;
constexpr int L_C = L_B + 128 * PX * 2;
constexpr int L_AC = L_C + 64 * PR * 2;
constexpr int L_DT = L_AC + 2048;
constexpr int L_WS = L_DT + 2048;
constexpr int ZP = 1040;
constexpr int SSD_LDS = L_WS + 2048;

struct ChunkInfo { int seqbase, row0, t0, nvalid; const float* hist; };
__device__ __forceinline__ ChunkInfo chunk_info(CPR p, int l, int ck) {
    ChunkInfo c;
    if (ck < 256) { c.seqbase = 0; c.row0 = 64 * ck; c.t0 = 64 * ck; c.nvalid = 64; c.hist = nullptr; }
    else { const int b = ck - 256; c.seqbase = M_P + 32 * b; c.row0 = c.seqbase; c.t0 = 0; c.nvalid = 32; c.hist = p.state_ssd_conv + ((size_t)l * DEC_BATCH + b) * 3 * 3072; }
    return c;
}
template <int NP> __device__ __forceinline__ void xbc_pad_raw(const bf16_t* __restrict__ xbcb, const float* __restrict__ hist, int rowbase, int hj, int c, unsigned (&d)[NP]) {
    if (hj >= 3) { const bf16_t* q = xbcb + (size_t)(rowbase + hj - 3) * 3072 + c;
        if (NP == 4) { const u32x4 t = *(const u32x4*)q; d[0] = t.x; d[1 % NP] = t.y; d[2 % NP] = t.z; d[3 % NP] = t.w; }
        else if (NP == 2) { const u32x2 t = *(const u32x2*)q; d[0] = t.x; d[1 % NP] = t.y; }
        else d[0] = *(const unsigned*)q; }
    else if (hist) {
#pragma unroll
        for (int k = 0; k < NP; ++k) { const float2 t = *(const float2*)(hist + (size_t)hj * 3072 + c + 2 * k); d[k] = pk2(t.x, t.y); } }
    else {
#pragma unroll
        for (int k = 0; k < NP; ++k) d[k] = 0u; }
}
__device__ __forceinline__ int xt_off(int R, int g) { return R * (PX * 2) + ((g ^ ((R >> 3) & 7)) << 4); }
template <int NP, class F> __device__ __forceinline__ void conv8(CPR p, int l, const ChunkInfo& ci, int s0, int c, F emit) {
    if (s0 >= ci.nvalid) {
        const float z[8] = {0.f, 0.f, 0.f, 0.f, 0.f, 0.f, 0.f, 0.f};
#pragma unroll
        for (int jp = 0; jp < NP; ++jp) emit(jp, z, z);
        return;
    }
    const float* cw = p.ssd_conv_w + (size_t)l * 4 * 3072 + c; const float* cb = p.ssd_conv_b + (size_t)l * 3072 + c;
    const int t = ci.t0 + s0;
    unsigned raw[11][NP];
#pragma unroll
    for (int k = 0; k < 11; ++k) xbc_pad_raw<NP>(p.xbcb, ci.hist, ci.seqbase, t + k, c, raw[k]);
#pragma unroll
    for (int jp = 0; jp < NP; ++jp) {
        const f32x2_t w0 = *(const f32x2_t*)(cw + 2 * jp), w1 = *(const f32x2_t*)(cw + 3072 + 2 * jp), w2 = *(const f32x2_t*)(cw + 2 * 3072 + 2 * jp), w3 = *(const f32x2_t*)(cw + 3 * 3072 + 2 * jp), bb = *(const f32x2_t*)(cb + 2 * jp);
        f32x2_t rv[11];
#pragma unroll
        for (int k = 0; k < 11; ++k) rv[k] = (f32x2_t){bflo(raw[k][jp]), bfhi(raw[k][jp])};
        float lo[8], hi[8];
#pragma unroll
        for (int i = 0; i < 8; ++i) {
            const f32x2_t a = bb + w0 * rv[i] + w1 * rv[i + 1] + w2 * rv[i + 2] + w3 * rv[i + 3];
            const f32x2_t sv = silu2(a);
            lo[i] = sv.x; hi[i] = sv.y;
        }
        emit(jp, lo, hi);
    }
}
__device__ __forceinline__ float unit_dt(CPR p, int l, int u, int wid, int lane) {
    const ChunkInfo ci = chunk_info(p, l, u >> 2);
    return (lane < ci.nvalid) ? p.dtb[(size_t)(ci.row0 + lane) * 32 + (u & 3) * 8 + wid] : 0.f;
}
__device__ __forceinline__ void head_scan(CPR p, int l, int h, int lane, float dtv, float& ac, float& aclast) {
    const float a = -__expf(p.ssd_a_log[l * 32 + h]);
    ac = dtv * a;
#pragma unroll
    for (int o = 1; o < 64; o <<= 1) { const float t = __shfl_up(ac, o); if (lane >= o) ac += t; }
    aclast = __shfl(ac, 63);
}
__device__ __forceinline__ void ph_ssd_p1(CPR p, int l, LDSP lds) {
    const int tid = tid_opaque(), wid = tid >> 6, lane = tid & 63, r = lane & 31, hh = lane >> 5;
    PG8_LAS float* acS = (PG8_LAS float*)(lds + L_AC); PG8_LAS float* wS = (PG8_LAS float*)(lds + L_WS);
    PG8_LAS bf16_t* xT = (PG8_LAS bf16_t*)(lds + L_XT); PG8_LAS bf16_t* BT = (PG8_LAS bf16_t*)(lds + L_B);
    const int u0 = bid_opaque(), nb = nblk_opaque();
    float dt_nx = (u0 < NCHUNK * 4) ? unit_dt(p, l, u0, wid, lane) : 0.f;
    for (int u = u0; u < NCHUNK * 4; u += nb) {
        const int ck = u >> 2, g = u & 3, h = g * 8 + wid;
        const ChunkInfo ci = chunk_info(p, l, ck);
        const float dtv = dt_nx; float ac, aclast; head_scan(p, l, h, lane, dtv, ac, aclast);
        dt_nx = (u + nb < NCHUNK * 4) ? unit_dt(p, l, u + nb, wid, lane) : 0.f;
        wS[wid * 64 + lane] = __expf(aclast - ac) * dtv;
        if (lane == 63) p.dec[ck * 32 + h] = __expf(aclast);
        __syncthreads();
        { const int cc = tid & 63, s0 = (tid >> 6) * 8, g8 = s0 >> 3, hl = cc >> 3, p0 = (cc & 7) * 8;
          float wv[8];
#pragma unroll
          for (int i = 0; i < 8; ++i) wv[i] = wS[hl * 64 + s0 + i];
          conv8<4>(p, l, ci, s0, g * 512 + cc * 8, [&](int jp, const float (&lo)[8], const float (&hi)[8]) {
              const int R = hl * 64 + p0 + 2 * jp;
              *(PG8_LAS u32x4*)(lds + L_XT + xt_off(R, g8)) = (u32x4){pk2(lo[0] * wv[0], lo[1] * wv[1]), pk2(lo[2] * wv[2], lo[3] * wv[3]), pk2(lo[4] * wv[4], lo[5] * wv[5]), pk2(lo[6] * wv[6], lo[7] * wv[7])};
              *(PG8_LAS u32x4*)(lds + L_XT + xt_off(R + 1, g8)) = (u32x4){pk2(hi[0] * wv[0], hi[1] * wv[1]), pk2(hi[2] * wv[2], hi[3] * wv[3]), pk2(hi[4] * wv[4], hi[5] * wv[5]), pk2(hi[6] * wv[6], hi[7] * wv[7])}; }); }
        { const int q = tid & 63, s0 = (tid >> 6) * 8, g8 = s0 >> 3, n0 = 2 * q;
          conv8<1>(p, l, ci, s0, 2048 + g * 128 + n0, [&](int jp, const float (&lo)[8], const float (&hi)[8]) {
              *(PG8_LAS u32x4*)(lds + L_B + xt_off(n0, g8)) = (u32x4){pk2(lo[0], lo[1]), pk2(lo[2], lo[3]), pk2(lo[4], lo[5]), pk2(lo[6], lo[7])};
              *(PG8_LAS u32x4*)(lds + L_B + xt_off(n0 + 1, g8)) = (u32x4){pk2(hi[0], hi[1]), pk2(hi[2], hi[3]), pk2(hi[4], hi[5]), pk2(hi[6], hi[7])}; }); }
        __syncthreads();
        f32x16 acc[4][2];
#pragma unroll
        for (int a = 0; a < 4; ++a)
#pragma unroll
            for (int b = 0; b < 2; ++b) acc[a][b] = zero16();
#pragma unroll
        for (int ks = 0; ks < 4; ++ks) {
            bf16x8 A[2], Bf[4];
#pragma unroll
            for (int pt = 0; pt < 2; ++pt) A[pt] = *(const PG8_LAS bf16x8*)(lds + L_XT + xt_off(wid * 64 + 32 * pt + r, 2 * ks + hh));
#pragma unroll
            for (int nt = 0; nt < 4; ++nt) Bf[nt] = *(const PG8_LAS bf16x8*)(lds + L_B + xt_off(32 * nt + r, 2 * ks + hh));
#pragma unroll
            for (int nt = 0; nt < 4; ++nt)
#pragma unroll
                for (int pt = 0; pt < 2; ++pt) acc[nt][pt] = MFMA32(Bf[nt], A[pt], acc[nt][pt]);
        }
        bf16_t* dst = (bf16_t*)p.sst + ((size_t)ck * 32 + h) * 8192 + lane * 16;
#pragma unroll
        for (int nt = 0; nt < 4; ++nt)
#pragma unroll
            for (int pt = 0; pt < 2; ++pt) {
                const f32x16& a = acc[nt][pt];
                *(u32x4*)(dst + (nt * 2 + pt) * 1024) = (u32x4){pk2c(a[0], a[1]), pk2c(a[2], a[3]), pk2c(a[4], a[5]), pk2c(a[6], a[7])};
                *(u32x4*)(dst + (nt * 2 + pt) * 1024 + 8) = (u32x4){pk2c(a[8], a[9]), pk2c(a[10], a[11]), pk2c(a[12], a[13]), pk2c(a[14], a[15])};
            }
        __syncthreads();
    }
}
__device__ __forceinline__ int frag_to_logical(int x) {
    const int h = x >> 13, y = x & 8191, T = y >> 10, L = (y >> 4) & 63, q = y & 15;
    const int p = 32 * (T & 1) + (L & 31), n = 32 * (T >> 1) + (q & 3) + 8 * (q >> 2) + 4 * (L >> 5);
    return h * 8192 + p * 128 + n;
}
__device__ __forceinline__ void ph_ssd_p2(CPR p, int l) {
    const int gtid = bid_opaque() * 512 + tid_opaque(), gsz = nblk_opaque() * 512;
    const unsigned* sst2 = (const unsigned*)p.sst; unsigned* hp2 = (unsigned*)p.hpb;
    for (int e = gtid; e < 131072; e += gsz) {
        const int h = e >> 12; float2 hc = make_float2(0.f, 0.f);
        for (int c0 = 0; c0 < 256; c0 += 32) {
            unsigned S[32]; float d[32];
#pragma unroll
            for (int i = 0; i < 32; ++i) { S[i] = __builtin_nontemporal_load(sst2 + (size_t)(c0 + i) * 131072 + e); d[i] = p.dec[(c0 + i) * 32 + h]; }
#pragma unroll
            for (int i = 0; i < 32; ++i) { __builtin_nontemporal_store(pk2(hc.x, hc.y), hp2 + (size_t)(c0 + i) * 131072 + e); const f32x2_t hn = (f32x2_t){hc.x, hc.y} * d[i] + (f32x2_t){bflo(S[i]), bfhi(S[i])}; hc.x = hn.x; hc.y = hn.y; }
        }
        ((float2*)(p.out + O_P_STATE + (size_t)l * STATE_SZ))[frag_to_logical(2 * e) >> 1] = hc;
    }
    for (int i = gtid; i < DEC_BATCH * 131072; i += gsz) {
        const int b = i >> 17, e = i & 131071, h = e >> 12, ck = 256 + b;
        const int el = frag_to_logical(2 * e) >> 1;
        const float2 h0 = ((const float2*)(p.state_ssd + ((size_t)l * DEC_BATCH + b) * STATE_SZ))[el]; const unsigned Sw = sst2[(size_t)ck * 131072 + e]; const float2 S = make_float2(bflo(Sw), bfhi(Sw)); const float d = p.dec[ck * 32 + h];
        hp2[(size_t)ck * 131072 + e] = pk2(h0.x, h0.y);
        ((float2*)(p.out + O_S_STATE + ((size_t)l * DEC_BATCH + b) * STATE_SZ))[el] = make_float2(fmaf(d, h0.x, S.x), fmaf(d, h0.y, S.y));
    }
}
__device__ __forceinline__ void ph_ssd_p3(CPR p, int l, LDSP lds) {
    const int tid = tid_opaque(), wid = tid >> 6, lane = tid & 63, r = lane & 31, hh = lane >> 5;
    PG8_LAS float* acS = (PG8_LAS float*)(lds + L_AC); PG8_LAS float* dtS = (PG8_LAS float*)(lds + L_DT); PG8_LAS float* red = (PG8_LAS float*)(lds + L_WS);
    PG8_LAS bf16_t* xT = (PG8_LAS bf16_t*)(lds + L_XT);
    const int u0 = bid_opaque(), nb = nblk_opaque();
    float dt_nx = (u0 < NCHUNK * 4) ? unit_dt(p, l, u0, wid, lane) : 0.f;
    for (int u = u0; u < NCHUNK * 4; u += nb) {
        const int ck = u >> 2, g = u & 3, h = g * 8 + wid;
        const ChunkInfo ci = chunk_info(p, l, ck);
        const float Dh = p.ssd_d[l * 32 + h];
        { const float dtv = dt_nx; float ac, aclast; head_scan(p, l, h, lane, dtv, ac, aclast); acS[wid * 64 + lane] = ac; dtS[wid * 64 + lane] = dtv; }
        dt_nx = (u + nb < NCHUNK * 4) ? unit_dt(p, l, u + nb, wid, lane) : 0.f;
        bf16x8 HA[8][2];
        const bf16_t* hp = p.hpb + ((size_t)ck * 32 + h) * 8192;
        { const int cc = tid & 63, s0 = (tid >> 6) * 8, g8 = s0 >> 3, hl = cc >> 3, p0 = (cc & 7) * 8;
          conv8<4>(p, l, ci, s0, g * 512 + cc * 8, [&](int jp, const float (&lo)[8], const float (&hi)[8]) {
              const int R = hl * 64 + p0 + 2 * jp;
              *(PG8_LAS u32x4*)(lds + L_XT + xt_off(R, g8)) = (u32x4){pk2(lo[0], lo[1]), pk2(lo[2], lo[3]), pk2(lo[4], lo[5]), pk2(lo[6], lo[7])};
              *(PG8_LAS u32x4*)(lds + L_XT + xt_off(R + 1, g8)) = (u32x4){pk2(hi[0], hi[1]), pk2(hi[2], hi[3]), pk2(hi[4], hi[5]), pk2(hi[6], hi[7])}; }); }
        { const int q = tid & 63, s0 = (tid >> 6) * 8, n4 = 4 * (q & 31), off = (q < 32 ? L_B : L_C) + n4 * 2;
          conv8<2>(p, l, ci, s0, (q < 32 ? 2048 : 2560) + g * 128 + n4, [&](int jp, const float (&lo)[8], const float (&hi)[8]) {
#pragma unroll
              for (int i = 0; i < 8; ++i) *(PG8_LAS unsigned*)(lds + off + jp * 4 + (s0 + i) * PR * 2) = pk2(lo[i], hi[i]); }); }
#pragma unroll
        for (int ks = 0; ks < 8; ++ks) { HA[ks][0] = *(const bf16x8*)(hp + ((ks >> 1) * 2 + 0) * 1024 + lane * 16 + 8 * (ks & 1)); HA[ks][1] = *(const bf16x8*)(hp + ((ks >> 1) * 2 + 1) * 1024 + lane * 16 + 8 * (ks & 1)); }
        __syncthreads();
        f32x16 yd[2][2];
#pragma unroll
        for (int a = 0; a < 2; ++a)
#pragma unroll
            for (int b = 0; b < 2; ++b) yd[a][b] = zero16();
#pragma unroll
        for (int ks = 0; ks < 8; ++ks) {
            bf16x8 Bf[2];
#pragma unroll
            for (int lt = 0; lt < 2; ++lt) { const int eo = ((32 * lt + r) * PR + 16 * ks + 4 * hh) * 2;
                Bf[lt] = join44(*(const PG8_LAS bf16x4*)(lds + L_C + eo), *(const PG8_LAS bf16x4*)(lds + L_C + eo + 16)); }
#pragma unroll
            for (int pt = 0; pt < 2; ++pt)
#pragma unroll
                for (int lt = 0; lt < 2; ++lt) yd[pt][lt] = MFMA32(HA[ks][pt], Bf[lt], yd[pt][lt]);
        }
#pragma unroll
        for (int lt = 0; lt < 2; ++lt) { const float eal = __expf(acS[wid * 64 + 32 * lt + r]);
#pragma unroll
            for (int pt = 0; pt < 2; ++pt)
#pragma unroll
                for (int q = 0; q < 16; q += 2) { const f32x2_t t = (f32x2_t){yd[pt][lt][q], yd[pt][lt][q + 1]} * eal; yd[pt][lt][q] = t.x; yd[pt][lt][q + 1] = t.y; } }
        u32x4 zraw[8];
#pragma unroll
        for (int i = 0; i < 8; ++i) { const int e = tid + 512 * i, tok = e >> 6; zraw[i] = *(const u32x4*)(p.zb + (size_t)(ci.row0 + (tok < ci.nvalid ? tok : 0)) * 2048 + g * 512 + (e & 63) * 8); }
#pragma unroll
        for (int tix = 0; tix < 3; ++tix) {
            const int st = (tix == 2) ? 1 : 0, lt = (tix == 0) ? 0 : 1;
            f32x16 G = zero16();
#pragma unroll
            for (int ks = 0; ks < 8; ++ks) {
                const bf16x8 A = *(const PG8_LAS bf16x8*)(lds + L_B + ((32 * st + r) * PR + 16 * ks + 8 * hh) * 2);
                const bf16x8 Bf = *(const PG8_LAS bf16x8*)(lds + L_C + ((32 * lt + r) * PR + 16 * ks + 8 * hh) * 2);
                G = MFMA32(A, Bf, G);
            }
            const int lcol = 32 * lt + r; const float acl = acS[wid * 64 + lcol];
            float mv[16];
#pragma unroll
            for (int q = 0; q < 16; q += 2) {
                const int s = 32 * st + (q & 3) + 8 * (q >> 2) + 4 * hh;
                const f32x2_t acs = *(const PG8_LAS f32x2_t*)(acS + wid * 64 + s), dts = *(const PG8_LAS f32x2_t*)(dtS + wid * 64 + s);
                const f32x2_t dd = __builtin_elementwise_min((f32x2_t){acl, acl} - acs, (f32x2_t){0.f, 0.f}) * 1.4426950408889634f;
                const f32x2_t v2 = (f32x2_t){G[q], G[q + 1]} * exp2_2(dd) * dts;
                float va = (s <= lcol) ? v2.x : 0.f, vb = (s + 1 <= lcol) ? v2.y : 0.f;
                if (s == lcol) va += Dh; if (s + 1 == lcol) vb += Dh;
                mv[q] = va; mv[q + 1] = vb;
            }
#pragma unroll
            for (int kk = 0; kk < 2; ++kk) {
                const float m8[8] = {mv[8 * kk], mv[8 * kk + 1], mv[8 * kk + 2], mv[8 * kk + 3], mv[8 * kk + 4], mv[8 * kk + 5], mv[8 * kk + 6], mv[8 * kk + 7]};
                const bf16x8 Bm = pack8f(m8);
#pragma unroll
                for (int pt = 0; pt < 2; ++pt) {
                    const int R = wid * 64 + 32 * pt + r, g = 4 * st + 2 * kk;
                    const bf16x4 lo = *(const PG8_LAS bf16x4*)(lds + L_XT + xt_off(R, g) + 8 * hh), hi = *(const PG8_LAS bf16x4*)(lds + L_XT + xt_off(R, g + 1) + 8 * hh);
                    yd[pt][lt] = MFMA32(join44(lo, hi), Bm, yd[pt][lt]);
                }
            }
        }
        __syncthreads();
#pragma unroll
        for (int i = 0; i < 8; ++i) { const int e = tid + 512 * i; *(PG8_LAS u32x4*)(lds + L_XT + (e >> 6) * ZP + (e & 63) * 16) = zraw[i]; }
        __syncthreads();
        float ssl[2];
#pragma unroll
        for (int lt = 0; lt < 2; ++lt) {
            const int lcol = 32 * lt + r;
            float ss = 0.f;
#pragma unroll
            for (int pt = 0; pt < 2; ++pt)
#pragma unroll
                for (int i = 0; i < 4; ++i) {
                    const u32x2 zw = *(const PG8_LAS u32x2*)(lds + L_XT + lcol * ZP + (wid * 64 + 32 * pt + 8 * i + 4 * hh) * 2);
                    const f32x2_t za = (f32x2_t){bflo(zw.x), bfhi(zw.x)}, zb2 = (f32x2_t){bflo(zw.y), bfhi(zw.y)};
                    const f32x2_t ga = (f32x2_t){yd[pt][lt][4 * i], yd[pt][lt][4 * i + 1]} * silu2(za), gb2 = (f32x2_t){yd[pt][lt][4 * i + 2], yd[pt][lt][4 * i + 3]} * silu2(zb2);
                    yd[pt][lt][4 * i] = ga.x; yd[pt][lt][4 * i + 1] = ga.y; yd[pt][lt][4 * i + 2] = gb2.x; yd[pt][lt][4 * i + 3] = gb2.y;
                    const f32x2_t sq = ga * ga + gb2 * gb2; ss += sq.x + sq.y;
                }
            ss += __shfl_xor(ss, 32);
            ssl[lt] = ss;
        }
        if (hh == 0) { red[wid * 64 + r] = ssl[0]; red[wid * 64 + 32 + r] = ssl[1]; }
        __syncthreads();
#pragma unroll
        for (int lt = 0; lt < 2; ++lt) {
            const int lcol = 32 * lt + r;
            float tot = 0.f;
#pragma unroll
            for (int w = 0; w < 8; ++w) tot += red[w * 64 + lcol];
            const float rstd = rsqrtf(tot * (1.0f / 512.f) + EPS);
#pragma unroll
            for (int pt = 0; pt < 2; ++pt)
#pragma unroll
                for (int i = 0; i < 4; ++i)
                { const f32x2_t a = (f32x2_t){yd[pt][lt][4 * i], yd[pt][lt][4 * i + 1]} * rstd, b = (f32x2_t){yd[pt][lt][4 * i + 2], yd[pt][lt][4 * i + 3]} * rstd;
                    *(PG8_LAS u32x2*)(lds + L_XT + lcol * ZP + (wid * 64 + 32 * pt + 8 * i + 4 * hh) * 2) = (u32x2){pk2(a.x, a.y), pk2(b.x, b.y)}; }
        }
        __syncthreads();
#pragma unroll
        for (int i = 0; i < 8; ++i) { const int e = tid + 512 * i, tok = e >> 6;
            if (tok < ci.nvalid) *(u32x4*)(p.yn + (size_t)(ci.row0 + tok) * 2048 + g * 512 + (e & 63) * 8) = *(const PG8_LAS u32x4*)(lds + L_XT + tok * ZP + (e & 63) * 16); }
        __syncthreads();
    }
}
#ifndef ATT_EXIT_P
#define ATT_EXIT_P 1e-20f
#endif
typedef short v4i16_t __attribute__((ext_vector_type(4)));
constexpr int AT_PITCH = 272;
constexpr int AT_TILE = 32 * AT_PITCH;
constexpr int ATT_LDS = 8 * 2 * AT_TILE;
__device__ __forceinline__ void ph_attn(CPR p, int l, LDSP lds) {
    const int tidx = tid_opaque(); const int lane = tidx & 63, r = lane & 31, hh = lane >> 5, wv = tidx >> 6, NGW = nblk_opaque() * 8, gw = (bid_opaque() * 8 + wv + (NGW >> 1)) % NGW;
    const bf16_t* kbb = p.kb; const bf16_t* vbb = p.vb;
    const float* ck = p.cache_k + (size_t)l * DEC_BATCH * PAST_LEN * 1024; const float* cv = p.cache_v + (size_t)l * DEC_BATCH * PAST_LEN * 1024;
    const float scale = 0.08838834764831845f;
    LDSP kl = lds + wv * (2 * AT_TILE); LDSP vl = kl + AT_TILE;
    const int st_g = (lane >> 5) * 1024 + (lane & 31) * 4;
    const int st_l = (lane >> 5) * AT_PITCH + (lane & 31) * 8;
    const int vs_g = (lane >> 4) * 1024 + (lane & 15) * 8;
    const int vs_l = (lane >> 4) * AT_PITCH + (lane & 15) * 16;
    const int ka_off = r * AT_PITCH + 16 * hh;
    const int vt_off = (4 * hh + ((lane & 15) >> 2)) * AT_PITCH + (16 * ((lane >> 4) & 1) + 4 * (lane & 3)) * 2;
    const int nwg = NGW >> 3, wgr = gw >> 3;
    for (int U = wgr; U < 512 + 32; U += nwg) {
        int hd, b, rowq0, P0;
        if (U < 512) { hd = U & 7; const int qt = 8 * (U >> 3) + wv; b = -1; rowq0 = 32 * qt; P0 = 32 * qt; }
        else { hd = wv; b = U - 512; rowq0 = M_P + 32 * b; P0 = PAST_LEN; }
        bf16x8 qf[8];
        { const bf16_t* qg = p.qb + (size_t)rowq0 * 1024 + hd * 128 + vs_g; u32x4 qs[8];
#pragma unroll
          for (int i = 0; i < 8; ++i) qs[i] = *(const u32x4*)(qg + 4096 * i);
#pragma unroll
          for (int i = 0; i < 8; ++i) *(PG8_LAS u32x4*)(vl + vs_l + 4 * AT_PITCH * i) = qs[i];
          asm volatile("s_waitcnt lgkmcnt(0)" ::: "memory");
#pragma unroll
          for (int ks = 0; ks < 8; ++ks) qf[ks] = *(const PG8_LAS bf16x8*)(vl + ka_off + 32 * ks);
          asm volatile("s_waitcnt lgkmcnt(0)" ::: "memory"); }
        f32x16 O[4];
#pragma unroll
        for (int d = 0; d < 4; ++d) O[d] = zero16();
        float carry = 1.0f;
        const int ktd = P0 >> 5;
        u32x4 buf[16];
        { const bf16_t* kq = kbb + (size_t)rowq0 * 1024 + hd * 128 + vs_g;
#pragma unroll
          for (int i = 0; i < 8; ++i) buf[8 + i] = *(const u32x4*)(kq + 4096 * i);
#pragma unroll
          for (int i = 0; i < 8; ++i) *(PG8_LAS u32x4*)(kl + vs_l + 4 * AT_PITCH * i) = buf[8 + i]; }
        for (int kt = ktd; kt >= 0; --kt) {
            const bool bfs = (b < 0) || (kt == ktd);
            f32x16 S = zero16();
            if (bfs) {
                const bf16_t* vq = vbb + (size_t)(b < 0 ? 32 * kt : rowq0) * 1024 + hd * 128 + vs_g;
#pragma unroll
                for (int i = 0; i < 8; ++i) buf[i] = *(const u32x4*)(vq + 4096 * i);
            } else {
                const float* vb = cv + ((size_t)b * PAST_LEN + 32 * kt) * 1024 + hd * 128 + st_g;
#pragma unroll
                for (int i = 0; i < 16; ++i) buf[i] = *(const u32x4*)(vb + 2048 * i);
            }
            asm volatile("s_waitcnt lgkmcnt(0)" ::: "memory");
#pragma unroll
            for (int ks = 0; ks < 8; ++ks) S = MFMA32(*(const PG8_LAS bf16x8*)(kl + ka_off + 32 * ks), qf[ks], S);
            const bool diag = (kt == ktd);
            float kp[16], sg[16];
#pragma unroll
            for (int q = 0; q < 16; q += 2) {
                const int key = (q & 3) + 8 * (q >> 2) + 4 * hh;
                const f32x2_t z = (f32x2_t){S[q], S[q + 1]} * scale, e = exp2_2(__builtin_elementwise_abs(z) * (-1.4426950408889634f)), big = rcp_2(e + 1.0f), small = e * big;
                const bool v0 = !diag || key < r, v1 = !diag || key + 1 < r;
                sg[q] = v0 ? (z.x >= 0.f ? big.x : small.x) : 0.f; kp[q] = v0 ? (z.x >= 0.f ? small.x : big.x) : 1.0f;
                sg[q + 1] = v1 ? (z.y >= 0.f ? big.y : small.y) : 0.f; kp[q + 1] = v1 ? (z.y >= 0.f ? small.y : big.y) : 1.0f;
            }
            float T[4], Tp[4];
#pragma unroll
            for (int gi = 0; gi < 4; ++gi) { T[gi] = (kp[4 * gi] * kp[4 * gi + 1]) * (kp[4 * gi + 2] * kp[4 * gi + 3]); Tp[gi] = __shfl_xor(T[gi], 32); }
            float wg[16]; float aft = carry;
#pragma unroll
            for (int gi = 3; gi >= 0; --gi) {
                float suf = aft * (hh == 0 ? Tp[gi] : 1.0f);
#pragma unroll
                for (int j = 3; j >= 0; --j) { wg[4 * gi + j] = sg[4 * gi + j] * suf; suf *= kp[4 * gi + j]; }
                aft *= T[gi] * Tp[gi];
            }
            carry = aft;
            bf16x8 Pf[2];
#pragma unroll
            for (int kk = 0; kk < 2; ++kk) {
                const float w8[8] = {wg[8 * kk], wg[8 * kk + 1], wg[8 * kk + 2], wg[8 * kk + 3], wg[8 * kk + 4], wg[8 * kk + 5], wg[8 * kk + 6], wg[8 * kk + 7]};
                Pf[kk] = pack8f(w8);
            }
            if (bfs) {
#pragma unroll
                for (int i = 0; i < 8; ++i) *(PG8_LAS u32x4*)(vl + vs_l + 4 * AT_PITCH * i) = buf[i];
            } else {
#pragma unroll
                for (int i = 0; i < 16; ++i) { const float4 t = __builtin_bit_cast(float4, buf[i]); *(PG8_LAS u32x2*)(vl + st_l + 2 * AT_PITCH * i) = (u32x2){pk2(t.x, t.y), pk2(t.z, t.w)}; }
            }
            const bool more = (kt > 0) && !__all(carry < ATT_EXIT_P);
            if (more) {
                if (b < 0) { const bf16_t* kq = kbb + (size_t)(32 * (kt - 1)) * 1024 + hd * 128 + vs_g;
#pragma unroll
                    for (int i = 0; i < 8; ++i) buf[8 + i] = *(const u32x4*)(kq + 4096 * i); }
                else { const float* kb = ck + ((size_t)b * PAST_LEN + 32 * (kt - 1)) * 1024 + hd * 128 + st_g;
#pragma unroll
                    for (int i = 0; i < 16; ++i) buf[i] = *(const u32x4*)(kb + 2048 * i); }
            }
            asm volatile("s_waitcnt lgkmcnt(0)" ::: "memory");
#pragma unroll
            for (int kk = 0; kk < 2; ++kk)
#pragma unroll
                for (int d = 0; d < 4; ++d) {
                    const bf16x4 lo = __builtin_bit_cast(bf16x4, __builtin_amdgcn_ds_read_tr16_b64_v4i16((PG8_LAS v4i16_t*)(vl + vt_off + kk * 16 * AT_PITCH + d * 64)));
                    const bf16x4 hi = __builtin_bit_cast(bf16x4, __builtin_amdgcn_ds_read_tr16_b64_v4i16((PG8_LAS v4i16_t*)(vl + vt_off + kk * 16 * AT_PITCH + 8 * AT_PITCH + d * 64)));
                    O[d] = MFMA32(Pf[kk], join44(lo, hi), O[d]);
                }
            if (!more) break;
            if (b >= 0) {
#pragma unroll
                for (int i = 0; i < 16; ++i) { const float4 t = __builtin_bit_cast(float4, buf[i]); *(PG8_LAS u32x2*)(kl + st_l + 2 * AT_PITCH * i) = (u32x2){pk2(t.x, t.y), pk2(t.z, t.w)}; }
            } else {
#pragma unroll
                for (int i = 0; i < 8; ++i) *(PG8_LAS u32x4*)(kl + vs_l + 4 * AT_PITCH * i) = buf[8 + i];
            }
        }
#pragma unroll
        for (int d = 0; d < 4; ++d)
#pragma unroll
            for (int q = 0; q < 16; ++q) *(PG8_LAS unsigned short*)(kl + ((q & 3) + 8 * (q >> 2) + 4 * hh) * AT_PITCH + (32 * d + r) * 2) = (unsigned short)pk2c(O[d][q], 0.0f);
        asm volatile("s_waitcnt lgkmcnt(0)" ::: "memory");
#pragma unroll
        for (int i = 0; i < 8; ++i) *(u32x4*)(p.att + (size_t)(rowq0 + (lane >> 4) + 4 * i) * 1024 + hd * 128 + (lane & 15) * 8) = *(const PG8_LAS u32x4*)(kl + vs_l + 4 * AT_PITCH * i);
    }
}

constexpr int MEGA_BODY = (ATT_LDS > pg8::STAGE_BYTES ? ATT_LDS : pg8::STAGE_BYTES);
constexpr int MEGA_LDS = MEGA_BODY + 64;
#ifndef WGM_IN
#define WGM_IN 4
#endif
#ifndef WGM_UP
#define WGM_UP 8
#endif
#ifndef PROBE_GBIG
#define PROBE_GBIG 1
#endif
#ifndef PROBE_GSMALL
#define PROBE_GSMALL 1
#endif
#ifndef PROBE_S
#define PROBE_S 1
#endif
#ifndef PROBE_A
#define PROBE_A 1
#endif
#ifndef PROBE_M
#define PROBE_M 1
#endif
#ifndef PROBE_P1
#define PROBE_P1 PROBE_S
#endif
#ifndef PROBE_P3
#define PROBE_P3 PROBE_S
#endif
#ifndef PROBE_P2
#define PROBE_P2 PROBE_M
#endif
#ifndef PROBE_FFN
#define PROBE_FFN PROBE_M
#endif
#ifndef PROBE_PRO
#define PROBE_PRO PROBE_M
#endif
#ifndef PROBE_NORM
#define PROBE_NORM 0
#endif
#ifndef PROBE_BAR
#define PROBE_BAR 1
#endif
#define GRID_BARRIER() do { for (int rb_ = 0; rb_ < PROBE_BAR; ++rb_) xcd_barrier(bar); } while (0)
template <class Epi> __device__ __forceinline__ void gemm_site(LDSP lds, const bf16_t* A, const bf16_t* Bt, int N, int K, const Epi& E) {
    for (int rep_ = 0; rep_ < (N > 1024 ? PROBE_GBIG : PROBE_GSMALL); ++rep_) {
    Gemm g; g.A = A; g.Bt = Bt; g.M = M_ALL; g.N = N; g.K = K;
    StaticOrder S; S.init(M_ALL, N, nblk_opaque(), bid_opaque(), N == 8192 ? WGM_UP : WGM_IN);
    pg8::gemm_phase<Epi, StaticOrder, false>(lds, g, S, E, nullptr);
    }
}
template <bool HALO, class Epi> __device__ __forceinline__ void gemm_small(LDSP lds, const bf16_t* A, const bf16_t* Bt, int K, const Epi& E, int c_ = -1, int G_ = 0) {
    const int tid = tid_opaque(), wid = tid >> 6, lane = tid & 63, r = lane & 31, hh = lane >> 5;
    const int nb = c_ < 0 ? nblk_opaque() : G_;
    for (int t = (c_ < 0 ? bid_opaque() : c_); t < (HALO ? 512 : 256); t += nb) {
        const int m0 = HALO ? (t >> 6) * 64 : M_P + (t >> 4) * 64, n0 = HALO ? (t & 63) * 64 : (t & 15) * 64, kbeg = wid * (K >> 3), nst = K >> 7;
        const int nrow = HALO ? (n0 >> 7) * 256 + (n0 & 127) : n0;
        const bf16_t* ap = A + (size_t)(m0 + r) * K + kbeg + 8 * hh; const bf16_t* bp = Bt + (size_t)(nrow + r) * K + kbeg + 8 * hh;
        const size_t hop = (size_t)32 * K;
        f32x16 acc[2][2];
#pragma unroll
        for (int a = 0; a < 2; ++a)
#pragma unroll
            for (int b = 0; b < 2; ++b) acc[a][b] = zero16();
        if (K >= 512) {
            LDSP wa = lds + wid * 16384; LDSP wb = wa + 8192;
            const int prow = lane >> 3, pp = lane & 7;
            const bf16_t* ag = A + (size_t)(m0 + prow) * K + kbeg + pp * 8; const bf16_t* bg = Bt + (size_t)(nrow + prow) * K + kbeg + pp * 8;
            const size_t r8 = (size_t)8 * K;
            const int nch = K >> 9;
            const int wofs = prow * 128 + ((pp ^ ((prow >> 1) & 7)) * 16);
            const int sw = (r >> 1) & 7, rofs = r * 128;
            u32x4 sa[8], sb[8];
#pragma unroll
            for (int i = 0; i < 8; ++i) { sa[i] = *(const u32x4*)(ag + i * r8); sb[i] = *(const u32x4*)(bg + i * r8); }
            for (int c = 0; c < nch; ++c) {
#pragma unroll
                for (int i = 0; i < 8; ++i) { const int row = prow + 8 * i; const int off = row * 128 + ((pp ^ ((row >> 1) & 7)) * 16); *(PG8_LAS u32x4*)(wa + off) = sa[i]; *(PG8_LAS u32x4*)(wb + off) = sb[i]; }
                const int cn = c + 1 < nch ? c + 1 : c;
#pragma unroll
                for (int i = 0; i < 8; ++i) { sa[i] = *(const u32x4*)(ag + i * r8 + 64 * cn); sb[i] = *(const u32x4*)(bg + i * r8 + 64 * cn); }
#pragma unroll
                for (int ks = 0; ks < 4; ++ks) {
                    const int so = ((2 * ks + hh) ^ sw) * 16;
                    const bf16x8 a0 = *(const PG8_LAS bf16x8*)(wa + rofs + so), a1 = *(const PG8_LAS bf16x8*)(wa + rofs + 4096 + so);
                    const bf16x8 b0 = *(const PG8_LAS bf16x8*)(wb + rofs + so), b1 = *(const PG8_LAS bf16x8*)(wb + rofs + 4096 + so);
                    acc[0][0] = MFMA32(a0, b0, acc[0][0]); acc[0][1] = MFMA32(a0, b1, acc[0][1]); acc[1][0] = MFMA32(a1, b0, acc[1][0]); acc[1][1] = MFMA32(a1, b1, acc[1][1]);
                }
            }
            (void)wofs;
        } else {
        bf16x8 fa[4][2], fb[4][2];
#pragma unroll
        for (int s = 0; s < 3; ++s) { const int ko = 16 * (s < nst ? s : 0);
            fa[s][0] = *(const bf16x8*)(ap + ko); fa[s][1] = *(const bf16x8*)(ap + hop + ko); fb[s][0] = *(const bf16x8*)(bp + ko); fb[s][1] = *(const bf16x8*)(bp + hop + ko); }
        for (int st = 0; st < nst; st += 2) {
#pragma unroll
            for (int s2 = 0; s2 < 2; ++s2) {
                const int cur = (st + s2) & 3, nxs = (st + s2 + 3) & 3, nx = st + s2 + 3, ko = 16 * (nx < nst ? nx : 0);
                if (((st >> 1) & 1) == 0) {
                    fa[(s2 + 3) & 3][0] = *(const bf16x8*)(ap + ko); fa[(s2 + 3) & 3][1] = *(const bf16x8*)(ap + hop + ko); fb[(s2 + 3) & 3][0] = *(const bf16x8*)(bp + ko); fb[(s2 + 3) & 3][1] = *(const bf16x8*)(bp + hop + ko);
#pragma unroll
                    for (int a = 0; a < 2; ++a)
#pragma unroll
                        for (int b = 0; b < 2; ++b) acc[a][b] = MFMA32(fa[s2][a], fb[s2][b], acc[a][b]);
                } else {
                    fa[(s2 + 1) & 3][0] = *(const bf16x8*)(ap + ko); fa[(s2 + 1) & 3][1] = *(const bf16x8*)(ap + hop + ko); fb[(s2 + 1) & 3][0] = *(const bf16x8*)(bp + ko); fb[(s2 + 1) & 3][1] = *(const bf16x8*)(bp + hop + ko);
#pragma unroll
                    for (int a = 0; a < 2; ++a)
#pragma unroll
                        for (int b = 0; b < 2; ++b) acc[a][b] = MFMA32(fa[s2 + 2][a], fb[s2 + 2][b], acc[a][b]);
                }
                (void)cur; (void)nxs;
            }
        }
        }
        PG8_LAS float* red = (PG8_LAS float*)lds;
#pragma unroll
        for (int a = 0; a < 2; ++a)
#pragma unroll
            for (int b = 0; b < 2; ++b)
#pragma unroll
                for (int q = 0; q < 16; ++q) red[((wid * 4 + a * 2 + b) * 16 + q) * 64 + lane] = acc[a][b][q];
        __syncthreads();
        { const int blk = wid & 3, q0 = (wid >> 2) * 8, a = blk >> 1, b = blk & 1;
#pragma unroll
          for (int q = 0; q < 8; ++q) { float v = 0.f;
#pragma unroll
              for (int w = 0; w < 8; ++w) v += red[((w * 4 + blk) * 16 + q0 + q) * 64 + lane];
              const int qq = q0 + q; E.elem(m0 + 32 * a + (qq & 3) + 8 * (qq >> 2) + 4 * hh, n0 + 32 * b + r, v); } }
        __syncthreads();
    }
}
template <class Epi> __device__ __forceinline__ void gemm_site_n1024_part(LDSP lds, const bf16_t* A, const bf16_t* Bt, int K, const Epi& E, int G, int c) {
    Gemm g; g.A = A; g.Bt = Bt; g.M = M_P; g.N = 1024; g.K = K;
    StaticOrder S; S.init(M_P, 1024, G, c);
    pg8::gemm_phase<Epi, StaticOrder, false>(lds, g, S, E, nullptr);
    gemm_small<false>(lds, A, Bt, K, E, c, G);
}
template <class Epi> __device__ __forceinline__ void gemm_site_n1024_prompt(LDSP lds, const bf16_t* A, const bf16_t* Bt, int K, const Epi& E) {
    Gemm g; g.A = A; g.Bt = Bt; g.M = M_P; g.N = 1024; g.K = K;
    StaticOrder S; S.init(M_P, 1024, nblk_opaque(), bid_opaque());
    pg8::gemm_phase<Epi, StaticOrder, false>(lds, g, S, E, nullptr);
}
template <class Epi> __device__ __forceinline__ void gemm_site_n1024(LDSP lds, const bf16_t* A, const bf16_t* Bt, int K, const Epi& E) {
    for (int rep_ = 0; rep_ < PROBE_GSMALL; ++rep_) {
    Gemm g; g.A = A; g.Bt = Bt; g.M = M_P; g.N = 1024; g.K = K;
    StaticOrder S; S.init(M_P, 1024, nblk_opaque(), bid_opaque());
    pg8::gemm_phase<Epi, StaticOrder, false>(lds, g, S, E, nullptr);
    gemm_small<false>(lds, A, Bt, K, E);
    }
}
__global__ void __launch_bounds__(512, 2) k_mega(Params p_) {
    extern __shared__ __attribute__((aligned(16))) unsigned char shm[];
    LDSP lds = (LDSP)shm;
    volatile LAS unsigned* xbw = (volatile LAS unsigned*)(lds + MEGA_BODY);
    if (threadIdx.x < 4) xbw[threadIdx.x] = 0u;
    __syncthreads();
    XcdBarrier bar = xcd_barrier_post(kargs()->bar, xbw);
    for (int rep_ = 0; rep_ < PROBE_PRO; ++rep_) { { CPR p = *kargs(); ph_wt(p, lds); }
    { CPR p = *kargs(); ph_xprep(p); } }
    GRID_BARRIER();
    for (int l = 0; l < DEPTH; ++l) {
        { CPR p = *kargs(); float* out = p.out; const bf16_t* wl = p.wt + (size_t)l * WT_LAYER; EpiIn E; E.rs = p.rs; E.zb = p.zb; E.xbcb = p.xbcb; E.qb = p.qb; E.kb = p.kb; E.vb = p.vb; E.gb = p.gb; E.dtb = p.dtb; E.dt_bias = p.ssd_dt_bias + l * 32;
          E.kP = out + O_P_K + (size_t)l * M_P * 1024; E.vP = out + O_P_V + (size_t)l * M_P * 1024; E.kS = out + O_S_K + (size_t)l * M_S * 1024; E.vS = out + O_S_V + (size_t)l * M_S * 1024;
          E.convP = out + O_P_CONV + (size_t)l * 3 * 3072; E.convS = out + O_S_CONV + (size_t)l * DEC_BATCH * 3 * 3072;
          gemm_site(lds, p.xb, wl + OW1, N1, 1024, E); }
        GRID_BARRIER();
        for (int rep_ = 0; rep_ < PROBE_P1; ++rep_) { CPR p = *kargs(); ph_ssd_p1(p, l, lds); }
        for (int rep_ = 0; rep_ < PROBE_A; ++rep_) { CPR p = *kargs(); ph_attn(p, l, lds); }
        GRID_BARRIER();
        for (int rep_ = 0; rep_ < PROBE_P2; ++rep_) { CPR p = *kargs(); ph_ssd_p2(p, l); }
        { CPR p = *kargs(); float* out = p.out; const bf16_t* wl = p.wt + (size_t)l * WT_LAYER; EpiBr E; E.gb = p.gb; E.t1in = nullptr; E.dst = p.t1; E.mode = 0; E.pad = 0; gemm_site_n1024_prompt(lds, p.att, wl + OW3, 1024, E); }
        GRID_BARRIER();
        for (int rep_ = 0; rep_ < PROBE_P3; ++rep_) { CPR p = *kargs(); ph_ssd_p3(p, l, lds); }
        if (bid_opaque() >= 128) { __syncthreads(); CPR p = *kargs(); const bf16_t* wl = p.wt + (size_t)l * WT_LAYER; EpiBr E; E.gb = p.gb; E.t1in = nullptr; E.dst = p.t1; E.mode = 0; E.pad = 0; gemm_small<false>(lds, p.att, wl + OW3, 1024, E, bid_opaque() - 128, 128); }
        GRID_BARRIER();
        { CPR p = *kargs(); float* out = p.out; const bf16_t* wl = p.wt + (size_t)l * WT_LAYER; EpiBr E; E.gb = p.gb; E.t1in = p.t1; E.dst = p.mixin; E.mode = 1; E.pad = 0; gemm_site_n1024(lds, p.yn, wl + OW2, 2048, E); }
        GRID_BARRIER();
        { CPR p = *kargs(); float* out = p.out; const bf16_t* wl = p.wt + (size_t)l * WT_LAYER; EpiF32Out E; E.dst = p.mixed; gemm_site_n1024(lds, p.mixin, wl + OW4, 1024, E); }
        GRID_BARRIER();
        { CPR p = *kargs(); float* out = p.out; (void)out; ph_norm(p.mixed, p.norm_post_mix + l * 1024, p.xr, p.xb, nullptr, nullptr, p.xh); }
        GRID_BARRIER();
        { CPR p = *kargs(); const bf16_t* wl = p.wt + (size_t)l * WT_LAYER; EpiHalo E; E.rs = nullptr; E.gh = p.gh; gemm_small<true>(lds, p.xh, wl + OW5, 1024, E); }
        GRID_BARRIER();
        { CPR p = *kargs(); float* out = p.out; const bf16_t* wl = p.wt + (size_t)l * WT_LAYER; EpiUpAct E; E.rs = p.rs2; E.gh = p.gh; E.ffb = p.ffb;
          E.ffnP = out + O_P_FFN + (size_t)l * 2 * D_FF; E.ffnS = out + O_S_FFN + (size_t)l * DEC_BATCH * 2 * D_FF;
          E.cw = p.ffn_conv_w + (size_t)l * 3 * D_FF; E.cb = p.ffn_conv_b + (size_t)l * D_FF; E.hist = p.state_ffn_conv + (size_t)l * DEC_BATCH * 2 * D_FF;
          gemm_site(lds, p.xb, wl + OW5, 8192, 1024, E); }
        if (bid_opaque() >= 128) { CPR p = *kargs(); const bf16_t* wl = p.wt + (size_t)l * WT_LAYER; EpiPlain E; E.dst = p.plea; gemm_site_n1024_part(lds, p.pb + (size_t)l * M_ALL * 256, wl + OW7, 256, E, 128, bid_opaque() - 128); }
        GRID_BARRIER();
        { CPR p = *kargs(); float* out = p.out; const bf16_t* wl = p.wt + (size_t)l * WT_LAYER; EpiF32Out E; E.dst = p.down; gemm_site_n1024(lds, p.ffb, wl + OW6, 4096, E); }
        GRID_BARRIER();
        { CPR p = *kargs(); float* out = p.out; (void)out; ph_norm(p.down, p.norm_post_ffn + l * 1024, p.xr, nullptr, nullptr, nullptr); }
        GRID_BARRIER();
        { CPR p = *kargs(); float* out = p.out; const bf16_t* wl = p.wt + (size_t)l * WT_LAYER; EpiPle E; E.plea = p.plea; E.dst = p.ple; gemm_site_n1024(lds, p.xr, wl + OW8, 1024, E); }
        GRID_BARRIER();
        { CPR p = *kargs(); float* out = p.out; (void)out; ph_norm(p.ple, p.norm_ple + l * 1024, p.xr, p.xb, l == DEPTH - 1 ? out + O_Y_P : nullptr, out + O_Y_S); }
        if (l + 1 < DEPTH) GRID_BARRIER();
    }
}

struct Bump { char* base; size_t off; template <class T> T* take(size_t n) { off = (off + 255) & ~(size_t)255; T* p = (T*)(base + off); off += n * sizeof(T); return p; } };
__global__ void k_fail_code(float* out, float code) { if (threadIdx.x == 0 && blockIdx.x == 0) out[0] = code; }

extern "C" void kernel_launch(void* const* d_in, const int* in_sizes, int n_in, void* d_out, int out_size, void* d_ws, size_t ws_size, hipStream_t stream) {
    Params p; memset(&p, 0, sizeof p);
    p.x_prompt = (const float*)d_in[0]; p.x_sample = (const float*)d_in[1]; p.state_ssd_conv = (const float*)d_in[2]; p.state_ssd = (const float*)d_in[3];
    p.cache_k = (const float*)d_in[4]; p.cache_v = (const float*)d_in[5]; p.state_ffn_conv = (const float*)d_in[6]; p.p_prompt = (const float*)d_in[7]; p.p_sample = (const float*)d_in[8];
    p.norm_pre_mix = (const float*)d_in[9]; p.w_in = (const float*)d_in[10]; p.ssd_conv_w = (const float*)d_in[11]; p.ssd_conv_b = (const float*)d_in[12]; p.ssd_dt_bias = (const float*)d_in[13];
    p.ssd_a_log = (const float*)d_in[14]; p.ssd_d = (const float*)d_in[15]; p.ssd_norm = (const float*)d_in[16]; p.w_br_ssd = (const float*)d_in[17]; p.w_br_sb = (const float*)d_in[18];
    p.w_out = (const float*)d_in[19]; p.norm_post_mix = (const float*)d_in[20]; p.norm_pre_ffn = (const float*)d_in[21]; p.w_up = (const float*)d_in[22]; p.ffn_conv_w = (const float*)d_in[23];
    p.ffn_conv_b = (const float*)d_in[24]; p.w_down = (const float*)d_in[25]; p.norm_post_ffn = (const float*)d_in[26]; p.w_ple = (const float*)d_in[27]; p.w_ple_gate = (const float*)d_in[28];
    p.norm_ple = (const float*)d_in[29];
    float* out = (float*)d_out; p.out = out;

    Bump B{(char*)d_ws, 0};
    const size_t R = M_ALL;
    p.bar = B.take<unsigned>(4096);
    p.wt = B.take<bf16_t>(DEPTH * WT_LAYER);
    p.xr = B.take<bf16_t>(R * 1024); p.xb = B.take<bf16_t>(R * 1024); p.rs = B.take<float>(R); p.rs2 = B.take<float>(R); p.pb = B.take<bf16_t>(DEPTH * R * 256);
    p.zb = B.take<bf16_t>(R * 2048); p.xbcb = B.take<bf16_t>(R * 3072); p.qb = B.take<bf16_t>(R * 1024); p.kb = B.take<bf16_t>(R * 1024); p.vb = B.take<bf16_t>(R * 1024); p.gb = B.take<bf16_t>(R * 2048); p.dtb = B.take<float>(R * 32);
    p.sst = B.take<float>((size_t)NCHUNK * STATE_SZ / 2); p.dec = B.take<float>(NCHUNK * 32); p.hpb = B.take<bf16_t>((size_t)NCHUNK * STATE_SZ);
    p.yn = B.take<bf16_t>(R * 2048); p.att = B.take<bf16_t>(R * 1024); p.t1 = B.take<bf16_t>(R * 1024); p.mixin = B.take<bf16_t>(R * 1024); p.mixed = B.take<bf16_t>(R * 1024);
    p.gh = B.take<bf16_t>((size_t)768 * 4096); p.xh = B.take<bf16_t>((size_t)768 * 1024); p.ffb = B.take<bf16_t>(R * 4096); p.down = B.take<bf16_t>(R * 1024); p.plea = B.take<bf16_t>(R * 1024); p.ple = B.take<bf16_t>(R * 1024);
    if (B.off > ws_size) { k_fail_code<<<1, 64, 0, stream>>>(out, 777000.f); return; }

    (void)hipMemsetAsync(p.bar, 0, 4096 * 4, stream);
    static bool minit = false;
    if (!minit) { (void)hipFuncSetAttribute((const void*)k_mega, hipFuncAttributeMaxDynamicSharedMemorySize, MEGA_LDS); minit = true; }
    hipLaunchKernelGGL(k_mega, dim3(256), dim3(512), MEGA_LDS, stream, p);
}
```

```cpp
#include <hip/hip_runtime.h>
#include <stdint.h>
#include <string.h>

constexpr int D_MODEL = 1024, SEQ = 16384, DEPTH = 2, DEC_BATCH = 32, DEC_SEQ = 32, PAST_LEN = 2048;
constexpr int D_SSM = 2048, SSD_HEAD_DIM = 64, SSD_HEADS = 32, SSD_GROUPS = 4, SSD_STATE = 128, SSD_CONV_DIM = 3072;
constexpr int SB_HEAD_DIM = 128, SB_HEADS = 8, SB_WIDTH = 1024, D_FF = 4096, PLE_DIM = 256;
constexpr int IN_DIM = 10272;
constexpr int M_P = SEQ, M_S = DEC_BATCH * DEC_SEQ, M_ALL = M_P + M_S;
constexpr float EPS = 1e-6f;
constexpr int C_Z = 0, C_XBC = 2048, C_DT = 5120, C_Q = 5152, C_K = 6176, C_V = 7200, C_G = 8224;
constexpr size_t O_Y_P = 0;
constexpr size_t O_Y_S = O_Y_P + (size_t)M_P * D_MODEL;
constexpr size_t O_P_CONV = O_Y_S + (size_t)M_S * D_MODEL;
constexpr size_t O_P_STATE = O_P_CONV + (size_t)DEPTH * 3 * SSD_CONV_DIM;
constexpr size_t O_P_K = O_P_STATE + (size_t)DEPTH * SSD_HEADS * SSD_HEAD_DIM * SSD_STATE;
constexpr size_t O_P_V = O_P_K + (size_t)DEPTH * M_P * SB_WIDTH;
constexpr size_t O_P_FFN = O_P_V + (size_t)DEPTH * M_P * SB_WIDTH;
constexpr size_t O_S_CONV = O_P_FFN + (size_t)DEPTH * 2 * D_FF;
constexpr size_t O_S_STATE = O_S_CONV + (size_t)DEPTH * DEC_BATCH * 3 * SSD_CONV_DIM;
constexpr size_t O_S_K = O_S_STATE + (size_t)DEPTH * DEC_BATCH * SSD_HEADS * SSD_HEAD_DIM * SSD_STATE;
constexpr size_t O_S_V = O_S_K + (size_t)DEPTH * M_S * SB_WIDTH;
constexpr size_t O_S_FFN = O_S_V + (size_t)DEPTH * M_S * SB_WIDTH;
constexpr size_t O_TOTAL = O_S_FFN + (size_t)DEPTH * DEC_BATCH * 2 * D_FF;
constexpr size_t STATE_SZ = (size_t)SSD_HEADS * SSD_HEAD_DIM * SSD_STATE;

typedef unsigned short bf16_t;

__device__ __forceinline__ float wave_sum(float v) {
#pragma unroll
    for (int o = 32; o >= 1; o >>= 1) v += __shfl_xor(v, o);
    return v;
}
__device__ __forceinline__ float sigmoidf_(float x) { return 1.0f / (1.0f + __expf(-x)); }
__device__ __forceinline__ float softplusf_(float x) { return fmaxf(x, 0.f) + log1pf(__expf(-fabsf(x))); }
__device__ __forceinline__ float siluf_(float x) { return x * sigmoidf_(x); }
__device__ __forceinline__ float gelu_tanhf_(float x) { const float u = 0.7978845608028654f * (x + 0.044715f * x * x * x); return 0.5f * x * (1.0f + tanhf(u)); }
__device__ __forceinline__ bf16_t f2bf(float f) { unsigned u = __float_as_uint(f); u += 0x7FFFu + ((u >> 16) & 1u); return (bf16_t)(u >> 16); }
__device__ __forceinline__ float bf2f(bf16_t b) { return __uint_as_float(((unsigned)b) << 16); }
typedef __bf16 bf16x2_t __attribute__((ext_vector_type(2)));
typedef float f32x2_t __attribute__((ext_vector_type(2)));
__device__ __forceinline__ unsigned pk2(float lo, float hi) { unsigned r; asm volatile("v_cvt_pk_bf16_f32 %0, %1, %2" : "=v"(r) : "v"(lo), "v"(hi)); return r; }
__device__ __forceinline__ unsigned pk2c(float lo, float hi) { const f32x2_t v = {lo, hi}; return __builtin_bit_cast(unsigned, __builtin_convertvector(v, bf16x2_t)); }
__device__ __forceinline__ f32x2_t exp2_2(f32x2_t x) { f32x2_t e; e.x = __builtin_amdgcn_exp2f(x.x); e.y = __builtin_amdgcn_exp2f(x.y); return e; }
__device__ __forceinline__ f32x2_t rcp_2(f32x2_t x) { f32x2_t r; r.x = __builtin_amdgcn_rcpf(x.x); r.y = __builtin_amdgcn_rcpf(x.y); return r; }
__device__ __forceinline__ f32x2_t sigmoid2(f32x2_t a) { return rcp_2(exp2_2(a * (-1.4426950408889634f)) + 1.0f); }
__device__ __forceinline__ f32x2_t silu2(f32x2_t a) { return a * sigmoid2(a); }
__device__ __forceinline__ f32x2_t gelu2(f32x2_t x) { const f32x2_t u2 = (x * x * 0.044715f + 1.0f) * x * 1.5957691216057308f; return x * sigmoid2(u2); }
__device__ __forceinline__ float bflo(unsigned w) { return __uint_as_float(w << 16); }
__device__ __forceinline__ float bfhi(unsigned w) { return __uint_as_float(w & 0xffff0000u); }

__device__ __forceinline__ int bid_opaque() { int b = blockIdx.x; asm volatile("" : "+s"(b)); return b; }
__device__ __forceinline__ int nblk_opaque() { int b = gridDim.x; asm volatile("" : "+s"(b)); return b; }
__device__ __forceinline__ int tid_opaque() { int t = threadIdx.x; asm volatile("" : "+v"(t)); return t; }

namespace pg8 {
#define PG8_LAS __attribute__((address_space(3)))
typedef unsigned short bf16_t;
typedef short bf16x8 __attribute__((ext_vector_type(8)));
typedef float f32x4 __attribute__((ext_vector_type(4)));
typedef unsigned u32x4 __attribute__((ext_vector_type(4)));
constexpr int BM = 256, BK = 64, HALF = 128, HTB = HALF * BK * 2  , STAGE_BYTES = 8 * HTB, NXCD = 8, WGM = 8;

__host__ __device__ __forceinline__ int lds_byte(int r, int c) { const int st = (r >> 4) * 2 + (c >> 5), rr = r & 15, cc = c & 31, ob = rr * 64 + cc * 2; return st * 1024 + (ob ^ (((ob >> 9) & 1) << 5)); }
__host__ __device__ __forceinline__ void stage_rc(int b, int& R, int& C) { const int st = b / 1024, sb = b % 1024, swz = sb ^ (((sb >> 9) & 1) << 5); R = (st >> 1) * 16 + swz / 64; C = (st & 1) * 32 + (swz % 64) / 2; }
__host__ __device__ __forceinline__ int perm32(int rho) { const int n = rho >> 4, i = rho & 15; return 8 * (i >> 2) + 4 * n + (i & 3); }

struct Unit { int pm, pn; };
struct Gemm { const bf16_t* A; const bf16_t* Bt; int M, N, K; };

struct StaticOrder {
    int nM, nN, nwg, G, c, wgm;
    __host__ __device__ void init(int M, int N, int G_, int c_, int wgm_ = WGM) { nM = M / BM; nN = N / BM; nwg = nM * nN; G = G_; c = c_; wgm = wgm_; }
    __host__ __device__ bool next(int i, Unit& u) const {
        const long L = (long)i * G + c; if (L >= nwg) return false;
        int wgid = (int)L; { const int q = nwg / NXCD, r = nwg % NXCD, xcd = wgid % NXCD, off = wgid / NXCD; wgid = (xcd < r ? xcd * (q + 1) : r * (q + 1) + (xcd - r) * q) + off; }
        const int nig = wgm * nN, gid = wgid / nig, fm = gid * wgm, gsz = (nM - fm) < wgm ? (nM - fm) : wgm;
        u.pm = fm + ((wgid % nig) % gsz); u.pn = (wgid % nig) / gsz; return true;
    }
    __device__ __forceinline__ void a_ready(const Unit&) const {}
    __device__ __forceinline__ void done(const Unit&) const {}
};
__device__ __forceinline__ unsigned cvt_pk_bf16(float lo, float hi) { unsigned r; asm volatile("v_cvt_pk_bf16_f32 %0, %1, %2" : "=v"(r) : "v"(lo), "v"(hi)); return r; }
typedef float f32x2 __attribute__((ext_vector_type(2)));
__device__ __forceinline__ f32x2 gelu_pk(f32x2 v) {
    const f32x2 av = __builtin_elementwise_abs(v), d = av * 0.2316418882f + 1.0f;
    f32x2 t; t.x = __builtin_amdgcn_rcpf(d.x); t.y = __builtin_amdgcn_rcpf(d.y);
    f32x2 q = t * 0.5307027145f + (-0.7265760135f); q = q * t + 0.7107068705f; q = q * t + (-0.142248368f); q = q * t + 0.127414796f; q = q * t;
    const f32x2 s = (v * v) * (-0.72134752044f);
    f32x2 e; e.x = __builtin_amdgcn_exp2f(s.x); e.y = __builtin_amdgcn_exp2f(s.y);
    const f32x2 m = v * (q * e), r = v - m;
    f32x2 o; o.x = v.x < 0.f ? m.x : r.x; o.y = v.y < 0.f ? m.y : r.y; return o;
}

struct EpiF32 {
    static constexpr bool PERM = false, AFTER_DRAIN = false;
    float* C; int ldc; const float* bias;
    __device__ __forceinline__ void operator()(const f32x4 (&acc)[2][2][4][2], const Unit& u, int wr, int wc, int fr, int fq) const {
        const int row0 = u.pm * BM + wr * 64 + fr, col0 = u.pn * BM + wc * 32 + 4 * fq;
        f32x4 bv[2][2];
#pragma unroll
        for (int bj = 0; bj < 2; ++bj)
#pragma unroll
            for (int n = 0; n < 2; ++n) bv[bj][n] = bias ? *(const f32x4*)(bias + col0 + bj * HALF + n * 16) : (f32x4){0.f, 0.f, 0.f, 0.f};
#pragma unroll
        for (int ai = 0; ai < 2; ++ai)
#pragma unroll
            for (int m = 0; m < 4; ++m) { float* rowp = C + (size_t)(row0 + ai * HALF + m * 16) * ldc + col0;
#pragma unroll
                for (int bj = 0; bj < 2; ++bj)
#pragma unroll
                    for (int n = 0; n < 2; ++n) *(f32x4*)(rowp + bj * HALF + n * 16) = acc[ai][bj][m][n] + bv[bj][n]; }
    }
};
template <int ACT  > struct EpiBf16 {
    static constexpr bool PERM = true, AFTER_DRAIN = false;
    bf16_t* O; int ldc; const float* bias; int split_cols; size_t split_stride;
    __device__ __forceinline__ void operator()(const f32x4 (&acc)[2][2][4][2], const Unit& u, int wr, int wc, int fr, int fq) const {
        const int row0 = u.pm * BM + wr * 64 + fr; int colt = u.pn * BM; bf16_t* base = O;
        if (split_cols) { const int t = colt / split_cols; base += (size_t)t * split_stride; colt -= t * split_cols; }
        const int col0 = colt + wc * 32 + 8 * fq, bcol0 = u.pn * BM + wc * 32 + 8 * fq;
        f32x4 bv[2][2];
#pragma unroll
        for (int bj = 0; bj < 2; ++bj)
#pragma unroll
            for (int n = 0; n < 2; ++n) bv[bj][n] = bias ? *(const f32x4*)(bias + bcol0 + bj * HALF + 4 * n) : (f32x4){0.f, 0.f, 0.f, 0.f};
#pragma unroll
        for (int ai = 0; ai < 2; ++ai)
#pragma unroll
            for (int m = 0; m < 4; ++m) { bf16_t* rowp = base + (size_t)(row0 + ai * HALF + m * 16) * ldc + col0;
#pragma unroll
                for (int bj = 0; bj < 2; ++bj) { f32x4 v0 = acc[ai][bj][m][0] + bv[bj][0], v1 = acc[ai][bj][m][1] + bv[bj][1];
                    if (ACT == 1) { f32x2 a = gelu_pk((f32x2){v0[0], v0[1]}), b = gelu_pk((f32x2){v0[2], v0[3]}), c = gelu_pk((f32x2){v1[0], v1[1]}), d = gelu_pk((f32x2){v1[2], v1[3]});
                        v0 = (f32x4){a.x, a.y, b.x, b.y}; v1 = (f32x4){c.x, c.y, d.x, d.y}; }
                    if (ACT == 2) {
#pragma unroll
                        for (int j = 0; j < 4; ++j) { v0[j] = 0.5f * v0[j] * (1.0f + erff(v0[j] * 0.70710678f)); v1[j] = 0.5f * v1[j] * (1.0f + erff(v1[j] * 0.70710678f)); } }
                    u32x4 w; w.x = cvt_pk_bf16(v0[0], v0[1]); w.y = cvt_pk_bf16(v0[2], v0[3]); w.z = cvt_pk_bf16(v1[0], v1[1]); w.w = cvt_pk_bf16(v1[2], v1[3]);
                    *(u32x4*)(rowp + bj * HALF) = w; } }
    }
};

template <class Epi, class Sched, bool STAMP = false>
__device__ __forceinline__ void gemm_phase(PG8_LAS unsigned char* lds, const Gemm g, const Sched& S, const Epi& E, unsigned long long* stamps) {
    const int tid = tid_opaque(), wid = __builtin_amdgcn_readfirstlane(tid >> 6), lane = tid & 63, wr = wid >> 2, wc = wid & 3, fr = lane & 15, fq = lane >> 4;
    const int K = g.K, nt = K / BK;
    int ts_lo = 0, ts_hi = 0, nts = 0; const unsigned long long rt_entry = STAMP ? (unsigned long long)wall_clock64() : 0ull;
#define PG8_STAMP() do { if (STAMP && wid == 0 && nts < 64) { const unsigned long long _c = (unsigned long long)clock64(); \
        ts_lo = (lane == nts) ? (int)(unsigned)_c : ts_lo; ts_hi = (lane == nts) ? (int)(unsigned)(_c >> 32) : ts_hi; ++nts; } } while (0)
    PG8_STAMP();
    unsigned voffA[2], voffB[2];
#pragma unroll
    for (int i = 0; i < 2; ++i) { int R, C; stage_rc(tid * 16 + i * 8192, R, C); const int Rb = Epi::PERM ? ((R & ~31) + perm32(R & 31)) : R;
        voffA[i] = (unsigned)(R * K + C) * 2u; voffB[i] = (unsigned)(Rb * K + C) * 2u; }
    const size_t kstep = (size_t)(BK * 2);
    const size_t hstep = (size_t)HALF * K * 2;
    const size_t tstep = 2 * hstep;
    const unsigned ldsw = (unsigned)wid * 1024u;
    const int aoff = lds_byte(wr * 64 + fr, fq * 8), boff = lds_byte(wc * 32 + fr, fq * 8);
#define PG8_SA(b, h) (((b) * 2 + (h)) * HTB)
#define PG8_SB(b, h) ((4 + (b) * 2 + (h)) * HTB)
#define PG8_STAGE(bufoff, gbase, voff) do { _Pragma("unroll") for (int _i = 0; _i < 2; ++_i) \
        __builtin_amdgcn_global_load_lds((const unsigned*)((const char*)(gbase) + (voff)[_i]), (PG8_LAS unsigned*)(lds + (bufoff) + ldsw + _i * 8192), 16, 0, 0); } while (0)
#define PG8_LDA(dst, b, h) do { _Pragma("unroll") for (int m = 0; m < 4; ++m) _Pragma("unroll") for (int k = 0; k < 2; ++k) dst[m][k] = *(const PG8_LAS bf16x8*)(lds + PG8_SA(b, h) + aoff + m * 2048 + k * 1024); } while (0)
#define PG8_LDB(dst, b, h) do { _Pragma("unroll") for (int n = 0; n < 2; ++n) _Pragma("unroll") for (int k = 0; k < 2; ++k) dst[n][k] = *(const PG8_LAS bf16x8*)(lds + PG8_SB(b, h) + boff + n * 2048 + k * 1024); } while (0)
#define PG8_MMA(ai, bj, At, Bt) do { __builtin_amdgcn_s_setprio(1); _Pragma("unroll") for (int m = 0; m < 4; ++m) _Pragma("unroll") for (int n = 0; n < 2; ++n) _Pragma("unroll") for (int k = 0; k < 2; ++k) \
        acc[ai][bj][m][n] = __builtin_amdgcn_mfma_f32_16x16x32_bf16(Bt[n][k], At[m][k], acc[ai][bj][m][n], 0, 0, 0); __builtin_amdgcn_s_setprio(0); } while (0)
#define PG8_WAIT_V(n) asm volatile("s_waitcnt vmcnt(" #n ")" ::: "memory")
#define PG8_WAIT_L(n) asm volatile("s_waitcnt lgkmcnt(" #n ")" ::: "memory")
#define PG8_BAR __builtin_amdgcn_s_barrier()
#define PG8_SCHED __builtin_amdgcn_sched_barrier(0)
    Unit cur, nxt; int ui = 0;
    if (!S.next(0, cur)) return;
    f32x4 acc[2][2][4][2];
#pragma unroll
    for (int a = 0; a < 2; ++a)
#pragma unroll
        for (int b = 0; b < 2; ++b)
#pragma unroll
            for (int m = 0; m < 4; ++m)
#pragma unroll
                for (int n = 0; n < 2; ++n) acc[a][b][m][n] = (f32x4){0.f, 0.f, 0.f, 0.f};
    bf16x8 At[4][2], B0[2][2], B1[2][2];
    const char* cA = (const char*)g.A + (size_t)cur.pm * tstep; const char* cB = (const char*)g.Bt + (size_t)cur.pn * tstep;
    S.a_ready(cur);
    PG8_STAGE(PG8_SB(0, 0), cB, voffB); PG8_STAGE(PG8_SA(0, 0), cA, voffA); PG8_STAGE(PG8_SB(0, 1), cB + hstep, voffB); PG8_STAGE(PG8_SA(0, 1), cA + hstep, voffA);
    if (wr == 1) PG8_BAR;
    PG8_WAIT_V(4); PG8_BAR;
    PG8_STAGE(PG8_SB(1, 0), cB + kstep, voffB); PG8_STAGE(PG8_SA(1, 0), cA + kstep, voffA); PG8_STAGE(PG8_SB(1, 1), cB + hstep + kstep, voffB);
    PG8_WAIT_V(6); PG8_BAR;
    PG8_STAMP();
    for (;;) {
        const bool has_next = S.next(ui + 1, nxt);
        const char* nA = has_next ? (const char*)g.A + (size_t)nxt.pm * tstep : cA; const char* nB = has_next ? (const char*)g.Bt + (size_t)nxt.pn * tstep : cB;
        for (int t = 0; t < nt; t += 2) {
            const bool last = (t == nt - 2);
            const char* a1 = cA + (size_t)(t + 1) * kstep;
            const char* a2 = last ? nA : cA + (size_t)(t + 2) * kstep; const char* b2 = last ? nB : cB + (size_t)(t + 2) * kstep;
            const char* a3 = a2 + kstep; const char* b3 = b2 + kstep;
            if (last && has_next) S.a_ready(nxt);
            PG8_LDB(B0, 0, 0); PG8_SCHED; PG8_LDA(At, 0, 0); PG8_STAGE(PG8_SA(1, 1), a1 + hstep, voffA);
            PG8_WAIT_L(8); PG8_BAR; PG8_WAIT_L(0); PG8_MMA(0, 0, At, B0); PG8_BAR; PG8_SCHED;
            PG8_LDB(B1, 0, 1); PG8_STAGE(PG8_SB(0, 0), b2, voffB);
            PG8_BAR; PG8_WAIT_L(0); PG8_MMA(0, 1, At, B1); PG8_BAR;
            PG8_LDA(At, 0, 1); PG8_STAGE(PG8_SA(0, 0), a2, voffA);
            PG8_BAR; PG8_WAIT_L(0); PG8_MMA(1, 0, At, B0); PG8_BAR; PG8_SCHED;
            PG8_STAGE(PG8_SB(0, 1), b2 + hstep, voffB);
            PG8_WAIT_V(6); PG8_BAR; PG8_MMA(1, 1, At, B1); PG8_BAR;
            PG8_LDB(B0, 1, 0); PG8_SCHED; PG8_LDA(At, 1, 0); PG8_STAGE(PG8_SA(0, 1), a2 + hstep, voffA);
            PG8_WAIT_L(8); PG8_BAR; PG8_WAIT_L(0); PG8_MMA(0, 0, At, B0); PG8_BAR; PG8_SCHED;
            PG8_LDB(B1, 1, 1); PG8_STAGE(PG8_SB(1, 0), b3, voffB);
            PG8_BAR; PG8_WAIT_L(0); PG8_MMA(0, 1, At, B1); PG8_BAR;
            PG8_LDA(At, 1, 1); PG8_STAGE(PG8_SA(1, 0), a3, voffA);
            PG8_BAR; PG8_WAIT_L(0); PG8_MMA(1, 0, At, B0); PG8_BAR; PG8_SCHED;
            PG8_STAGE(PG8_SB(1, 1), b3 + hstep, voffB);
            PG8_WAIT_V(6); PG8_BAR; PG8_MMA(1, 1, At, B1); PG8_BAR;
        }
        PG8_STAMP();
        if constexpr (!Epi::AFTER_DRAIN) { E(acc, cur, wr, wc, fr, fq); S.done(cur); }
        PG8_STAMP();
        if (!has_next) break;
#pragma unroll
        for (int a = 0; a < 2; ++a)
#pragma unroll
            for (int b = 0; b < 2; ++b)
#pragma unroll
                for (int m = 0; m < 4; ++m)
#pragma unroll
                    for (int n = 0; n < 2; ++n) acc[a][b][m][n] = (f32x4){0.f, 0.f, 0.f, 0.f};
        cur = nxt; cA = nA; cB = nB; ++ui;
    }
    PG8_WAIT_V(0);
    if (wr == 0) PG8_BAR;
    PG8_BAR;
    if constexpr (Epi::AFTER_DRAIN) { E.fused(acc, cur, wr, wc, fr, fq, lds, wid, lane); S.done(cur); }
    PG8_STAMP();
    if (STAMP && wid == 0) { stamps[lane] = lane < nts ? (((unsigned long long)(unsigned)ts_hi << 32) | (unsigned)ts_lo) : 0ull;
        if (lane == 62) stamps[62] = rt_entry; if (lane == 63) stamps[63] = (unsigned long long)wall_clock64(); }
#undef PG8_STAMP
#undef PG8_SA
#undef PG8_SB
#undef PG8_STAGE
#undef PG8_LDA
#undef PG8_LDB
#undef PG8_MMA
#undef PG8_WAIT_V
#undef PG8_WAIT_L
#undef PG8_BAR
#undef PG8_SCHED
}
}
#define XB_TMO      128
#define XB_XCNT(j)  (256  + 64 * (j))
#define XB_XSUB(j)  (1280 + 64 * (j))
#define XB_XGEN(j)  (2304 + 64 * (j))
#define XB_TOP      3328
#define XB_TOPGEN   3392
#define XCD_BAR_WORDS 3456
#define XB_SPIN_CAP (1u << 18)
#define LAS __attribute__((address_space(3)))

__device__ __forceinline__ unsigned xb_ld(unsigned* p)              { return __hip_atomic_load(p, __ATOMIC_RELAXED, __HIP_MEMORY_SCOPE_AGENT); }
__device__ __forceinline__ unsigned xb_add(unsigned* p, unsigned v) { return __hip_atomic_fetch_add(p, v, __ATOMIC_RELAXED, __HIP_MEMORY_SCOPE_AGENT); }
__device__ __forceinline__ unsigned xb_xcc_id() { return (unsigned)__builtin_amdgcn_s_getreg((3 << 11) | 20) & 0xFu; }
#define XB_SPIN(cond, bar) do { unsigned _sp = 0; while (cond) { __builtin_amdgcn_s_sleep(1); \
    if ((++_sp & 255u) == 0u) { if (xb_ld(&(bar)[XB_TMO])) break; if (_sp > XB_SPIN_CAP) { atomicAdd(&(bar)[XB_TMO], 1u); break; } } } } while (0)

struct XcdBarrier {
    unsigned* bar; unsigned x;
    volatile LAS unsigned* st;
};

__device__ __forceinline__ XcdBarrier xcd_barrier_post(unsigned* bar, volatile LAS unsigned* st) {
    XcdBarrier b; b.bar = bar; b.x = xb_xcc_id(); b.st = st;
    if (threadIdx.x == 0) (void)xb_add(&bar[XB_XCNT(b.x)], 1u);
    return b;
}
__device__ __forceinline__ void xcd_barrier_complete(unsigned* bar, unsigned x, unsigned& nloc, unsigned& nx) {
    const unsigned G = gridDim.x * gridDim.y * gridDim.z;
    unsigned sum, cnt, mine, sp = 0u;
    for (;;) {
        sum = 0u; cnt = 0u; mine = 0u;
#pragma unroll
        for (unsigned j = 0; j < 16; ++j) { const unsigned c = xb_ld(&bar[XB_XCNT(j)]); sum += c; cnt += (c > 0u) ? 1u : 0u; mine = (j == x) ? c : mine; }
        if (sum == G) break;
        __builtin_amdgcn_s_sleep(1);
        if ((++sp & 255u) == 0u) { if (xb_ld(&bar[XB_TMO])) break; if (sp > XB_SPIN_CAP) { atomicAdd(&bar[XB_TMO], 1u); break; } }
    }
    nloc = mine > 0u ? mine : 1u; nx = cnt > 0u ? cnt : 1u;
}

__device__ __forceinline__ void xcd_barrier(const XcdBarrier& b) {
    asm volatile("s_waitcnt vmcnt(0)" ::: "memory");
    __syncthreads();
    if (threadIdx.x == 0) {
        unsigned* bar = b.bar;
        __builtin_amdgcn_s_waitcnt(0);
        unsigned nloc = b.st[0], nx = b.st[1];
        if (nloc == 0u) { xcd_barrier_complete(bar, b.x, nloc, nx); b.st[0] = nloc; b.st[1] = nx; }
        const unsigned old = xb_add(&bar[XB_XSUB(b.x)], 1u);
        const unsigned gen = old / nloc;
        if (old + 1u == (gen + 1u) * nloc) {
            __builtin_amdgcn_fence(__ATOMIC_RELEASE, "agent");
            asm volatile("s_waitcnt vmcnt(0)" ::: "memory");
            const unsigned og = xb_add(&bar[XB_TOP], 1u);
            const unsigned tg = og / nx;
            if (og + 1u == (tg + 1u) * nx) xb_add(&bar[XB_TOPGEN], 1u);
            else XB_SPIN(xb_ld(&bar[XB_TOPGEN]) == tg, bar);
            __builtin_amdgcn_fence(__ATOMIC_ACQUIRE, "agent");
            xb_add(&bar[XB_XGEN(b.x)], 1u);
            asm volatile("s_waitcnt vmcnt(0)" ::: "memory");
        } else {
            XB_SPIN(xb_ld(&bar[XB_XGEN(b.x)]) == gen, bar);
            __builtin_amdgcn_fence(__ATOMIC_ACQUIRE, "agent");
            asm volatile("s_waitcnt vmcnt(0)" ::: "memory");
        }
    }
    __syncthreads();
}


using pg8::f32x4; using pg8::u32x4; using pg8::Unit; using pg8::Gemm; using pg8::StaticOrder;
typedef unsigned u32x2 __attribute__((ext_vector_type(2)));
#define LDSP PG8_LAS unsigned char*

constexpr int N1 = 10496;
constexpr size_t OW1 = 0, OW2 = OW1 + (size_t)N1 * 1024, OW3 = OW2 + (size_t)1024 * 2048, OW4 = OW3 + (size_t)1024 * 1024, OW5 = OW4 + (size_t)1024 * 1024,
                 OW6 = OW5 + (size_t)8192 * 1024, OW7 = OW6 + (size_t)1024 * 4096, OW8 = OW7 + (size_t)1024 * 256, WT_LAYER = OW8 + (size_t)1024 * 1024;
constexpr int NCHUNK = 256 + DEC_BATCH;

struct Params {
    const float *x_prompt, *x_sample, *state_ssd_conv, *state_ssd, *cache_k, *cache_v, *state_ffn_conv, *p_prompt, *p_sample;
    const float *norm_pre_mix, *w_in, *ssd_conv_w, *ssd_conv_b, *ssd_dt_bias, *ssd_a_log, *ssd_d, *ssd_norm, *w_br_ssd, *w_br_sb, *w_out, *norm_post_mix, *norm_pre_ffn,
                *w_up, *ffn_conv_w, *ffn_conv_b, *w_down, *norm_post_ffn, *w_ple, *w_ple_gate, *norm_ple;
    float* out;
    unsigned* bar;
    bf16_t* wt; bf16_t* xr; bf16_t* xb; float* rs; float* rs2; bf16_t* pb;
    bf16_t *zb, *xbcb, *qb, *gb, *kb, *vb; float* dtb;
    float* sst; float* dec; bf16_t* hpb;
    bf16_t *yn, *att, *t1, *mixin; bf16_t* mixed;
    bf16_t *gh, *xh, *ffb; bf16_t* down; bf16_t* plea; bf16_t* ple;
};

typedef const __attribute__((address_space(4))) Params CP;
#define CPR CP&
__device__ __forceinline__ CP* kargs() { CP* q = (CP*)__builtin_amdgcn_kernarg_segment_ptr(); asm volatile("" : "+s"(q)); return q; }

__device__ __forceinline__ void wt_item(const float* __restrict__ W, int K, int ldw, const float* __restrict__ gain, bf16_t* __restrict__ Wt, int nblk, int item, int w1map, PG8_LAS float* scr, int lane) {
    const int kb = item / nblk, nb = item % nblk, k0 = 64 * kb, n0 = 32 * nb;
    int sc0 = n0; if (w1map == 1) sc0 = (n0 < 5120) ? n0 : (n0 < 10240 ? n0 + 32 : (n0 < 10272 ? n0 - 5120 : -1));
    else if (w1map == 2) sc0 = ((n0 & 255) < 128 ? 0 : 4096) + (n0 >> 8) * 128 + (n0 & 127);
    const int kr = lane >> 3, c4 = (lane & 7) * 4;
    float4 v[8];
#pragma unroll
    for (int i = 0; i < 8; ++i) { f32x4 t = (f32x4){0.f, 0.f, 0.f, 0.f}; if (sc0 >= 0) t = __builtin_nontemporal_load((const f32x4*)(W + (size_t)(k0 + kr + 8 * i) * ldw + sc0 + c4)); v[i] = make_float4(t[0], t[1], t[2], t[3]); }
#pragma unroll
    for (int i = 0; i < 8; ++i) { const int kk = kr + 8 * i; const float gm = gain ? gain[k0 + kk] : 1.0f; PG8_LAS float* d = scr + kk * 33 + c4;
        d[0] = v[i].x * gm; d[1] = v[i].y * gm; d[2] = v[i].z * gm; d[3] = v[i].w * gm; }
    asm volatile("s_waitcnt lgkmcnt(0)" ::: "memory");
    const int c = lane & 7;
#pragma unroll
    for (int j = 0; j < 4; ++j) { const int nn = (lane >> 3) + 8 * j; const PG8_LAS float* s = scr + (8 * c) * 33 + nn;
        *(u32x4*)(Wt + (size_t)(n0 + nn) * K + k0 + 8 * c) = (u32x4){pk2(s[0], s[33]), pk2(s[2 * 33], s[3 * 33]), pk2(s[4 * 33], s[5 * 33]), pk2(s[6 * 33], s[7 * 33])}; }
    asm volatile("s_waitcnt lgkmcnt(0)" ::: "memory");
}
__device__ __forceinline__ void ph_wt(CPR p, LDSP lds) {
    constexpr int U1 = 16 * 328, U2 = U1 + 32 * 32, U3 = U2 + 512, U4 = U3 + 512, U5 = U4 + 16 * 256, U6 = U5 + 64 * 32, U7 = U6 + 4 * 32, U8 = U7 + 512;
    const int tidx = tid_opaque(), lane = tidx & 63, wv = tidx >> 6, gw = bid_opaque() * 8 + wv, NGW = nblk_opaque() * 8;
    PG8_LAS float* scr = (PG8_LAS float*)(lds + wv * (64 * 33 * 4));
    for (int u = gw; u < DEPTH * U8; u += NGW) {
        const int l = u / U8; int v = u % U8; bf16_t* wl = p.wt + (size_t)l * WT_LAYER;
        if (v < U1)      { wt_item(p.w_in + (size_t)l * 1024 * IN_DIM, 1024, IN_DIM, p.norm_pre_mix + l * 1024, wl + OW1, 328, v, 1, scr, lane); }
        else if (v < U2) { v -= U1; wt_item(p.w_br_ssd + (size_t)l * 2048 * 1024, 2048, 1024, p.ssd_norm + l * 2048, wl + OW2, 32, v, 0, scr, lane); }
        else if (v < U3) { v -= U2; wt_item(p.w_br_sb + (size_t)l * 1024 * 1024, 1024, 1024, nullptr, wl + OW3, 32, v, 0, scr, lane); }
        else if (v < U4) { v -= U3; wt_item(p.w_out + (size_t)l * 1024 * 1024, 1024, 1024, nullptr, wl + OW4, 32, v, 0, scr, lane); }
        else if (v < U5) { v -= U4; wt_item(p.w_up + (size_t)l * 1024 * 8192, 1024, 8192, p.norm_pre_ffn + l * 1024, wl + OW5, 256, v, 2, scr, lane); }
        else if (v < U6) { v -= U5; wt_item(p.w_down + (size_t)l * 4096 * 1024, 4096, 1024, nullptr, wl + OW6, 32, v, 0, scr, lane); }
        else if (v < U7) { v -= U6; wt_item(p.w_ple + (size_t)l * 256 * 1024, 256, 1024, nullptr, wl + OW7, 32, v, 0, scr, lane); }
        else             { v -= U7; wt_item(p.w_ple_gate + (size_t)l * 1024 * 1024, 1024, 1024, nullptr, wl + OW8, 32, v, 0, scr, lane); }
    }
    __syncthreads();
}
__device__ __forceinline__ void ph_xprep(CPR p) {
    const int tidx = tid_opaque(); const int lane = tidx & 63, gw = bid_opaque() * 8 + (tidx >> 6), NGW = nblk_opaque() * 8;
    for (int row0 = 2 * gw; row0 < M_ALL; row0 += 2 * NGW) {
        float4 v[2][4]; float ss[2] = {0.f, 0.f};
#pragma unroll
        for (int q = 0; q < 2; ++q) { const int row = row0 + q; const float4* src = (const float4*)(row < M_P ? p.x_prompt + (size_t)row * 1024 : p.x_sample + (size_t)(row - M_P) * 1024);
#pragma unroll
            for (int j = 0; j < 4; ++j) { const f32x4 t = __builtin_nontemporal_load((const f32x4*)src + lane + 64 * j); v[q][j] = make_float4(t[0], t[1], t[2], t[3]); } }
#pragma unroll
        for (int q = 0; q < 2; ++q) { const int row = row0 + q;
#pragma unroll
            for (int j = 0; j < 4; ++j) { ss[q] += v[q][j].x * v[q][j].x + v[q][j].y * v[q][j].y + v[q][j].z * v[q][j].z + v[q][j].w * v[q][j].w;
                ((u32x2*)(p.xr + (size_t)row * 1024))[lane + 64 * j] = (u32x2){pk2(v[q][j].x, v[q][j].y), pk2(v[q][j].z, v[q][j].w)}; }
            const float rn = rsqrtf(wave_sum(ss[q]) * (1.0f / 1024.f) + EPS);
#pragma unroll
            for (int j = 0; j < 4; ++j) ((u32x2*)(p.xb + (size_t)row * 1024))[lane + 64 * j] = (u32x2){pk2(v[q][j].x * rn, v[q][j].y * rn), pk2(v[q][j].z * rn, v[q][j].w * rn)}; }
    }
    for (int r0 = 4 * gw; r0 < DEPTH * M_ALL; r0 += 4 * NGW) {
        float4 v[4];
#pragma unroll
        for (int q = 0; q < 4; ++q) { const int r2 = r0 + q, l = r2 / M_ALL, row = r2 % M_ALL;
            v[q] = ((const float4*)(row < M_P ? p.p_prompt + ((size_t)l * M_P + row) * PLE_DIM : p.p_sample + ((size_t)l * M_S + row - M_P) * PLE_DIM))[lane]; }
#pragma unroll
        for (int q = 0; q < 4; ++q) ((u32x2*)(p.pb + (size_t)(r0 + q) * PLE_DIM))[lane] = (u32x2){pk2(v[q].x, v[q].y), pk2(v[q].z, v[q].w)};
    }
}
__device__ __forceinline__ void ph_norm(const bf16_t* __restrict__ src, const float* __restrict__ gain, bf16_t* xr, bf16_t* xb, float* yP, float* yS, bf16_t* xh = nullptr) {
    const int tidx = tid_opaque(); const int lane = tidx & 63, gw = bid_opaque() * 8 + (tidx >> 6), NGW = nblk_opaque() * 8;
    float4 g[4];
#pragma unroll
    for (int j = 0; j < 4; ++j) g[j] = ((const float4*)gain)[lane + 64 * j];
    for (int row0 = 2 * gw; row0 < M_ALL; row0 += 2 * NGW) {
        u32x2 sv[2][4], xv[2][4];
#pragma unroll
        for (int q = 0; q < 2; ++q)
#pragma unroll
            for (int j = 0; j < 4; ++j) { sv[q][j] = ((const u32x2*)(src + (size_t)(row0 + q) * 1024))[lane + 64 * j]; xv[q][j] = ((const u32x2*)(xr + (size_t)(row0 + q) * 1024))[lane + 64 * j]; }
#pragma unroll
        for (int q = 0; q < 2; ++q) {
            const int row = row0 + q;
            float4 v[4], x[4]; float ss = 0.f;
#pragma unroll
            for (int j = 0; j < 4; ++j) { v[j] = make_float4(bflo(sv[q][j].x), bfhi(sv[q][j].x), bflo(sv[q][j].y), bfhi(sv[q][j].y)); x[j] = make_float4(bflo(xv[q][j].x), bfhi(xv[q][j].x), bflo(xv[q][j].y), bfhi(xv[q][j].y));
                ss += v[j].x * v[j].x + v[j].y * v[j].y + v[j].z * v[j].z + v[j].w * v[j].w; }
            ss = wave_sum(ss);
            const float r = rsqrtf(ss * (1.0f / 1024.f) + EPS); float s2 = 0.f;
#pragma unroll
            for (int j = 0; j < 4; ++j) {
                x[j].x += v[j].x * r * g[j].x; x[j].y += v[j].y * r * g[j].y; x[j].z += v[j].z * r * g[j].z; x[j].w += v[j].w * r * g[j].w;
                s2 += x[j].x * x[j].x + x[j].y * x[j].y + x[j].z * x[j].z + x[j].w * x[j].w;
                ((u32x2*)(xr + (size_t)row * 1024))[lane + 64 * j] = (u32x2){pk2(x[j].x, x[j].y), pk2(x[j].z, x[j].w)};
            }
            if (xb) {
                const float rn = rsqrtf(wave_sum(s2) * (1.0f / 1024.f) + EPS);
#pragma unroll
                for (int j = 0; j < 4; ++j) {
                    const u32x2 wq = (u32x2){pk2(x[j].x * rn, x[j].y * rn), pk2(x[j].z * rn, x[j].w * rn)};
                    ((u32x2*)(xb + (size_t)row * 1024))[lane + 64 * j] = wq;
                    if (xh && (row & 63) >= 62) ((u32x2*)(xh + (size_t)(2 * ((row >> 6) + 1) + (row & 63) - 62) * 1024))[lane + 64 * j] = wq;
                }
            }
            if (yP) { float4* y4 = (float4*)(row < M_P ? yP + (size_t)row * 1024 : yS + (size_t)(row - M_P) * 1024);
#pragma unroll
                for (int j = 0; j < 4; ++j) y4[lane + 64 * j] = x[j]; }
        }
    }
}
__device__ __forceinline__ void unpack8(const u32x4 w, float (&v)[8]) {
    v[0] = bflo(w.x); v[1] = bfhi(w.x); v[2] = bflo(w.y); v[3] = bfhi(w.y); v[4] = bflo(w.z); v[5] = bfhi(w.z); v[6] = bflo(w.w); v[7] = bfhi(w.w);
}
__device__ __forceinline__ void load8f(const float* p, float (&v)[8]) { const float4 a = ((const float4*)p)[0], b = ((const float4*)p)[1]; v[0] = a.x; v[1] = a.y; v[2] = a.z; v[3] = a.w; v[4] = b.x; v[5] = b.y; v[6] = b.z; v[7] = b.w; }
__device__ __forceinline__ float gelu_fast(float x) { const float u2 = 1.5957691216057308f * (x + 0.044715f * x * x * x); return x * __builtin_amdgcn_rcpf(1.0f + __expf(-u2)); }
struct EpiIn {
    static constexpr bool PERM = true, AFTER_DRAIN = false;
    const float* rs; bf16_t *zb, *xbcb, *qb, *gb, *kb, *vb; float* dtb; const float* dt_bias; float *kP, *vP, *kS, *vS, *convP, *convS;
    __device__ __forceinline__ void operator()(const f32x4 (&acc)[2][2][4][2], const Unit& u, int wr, int wc, int fr, int fq) const {
        const int row0 = u.pm * 256 + wr * 64 + fr, seg = u.pn, cl = wc * 32 + 8 * fq;
#pragma unroll
        for (int ai = 0; ai < 2; ++ai)
#pragma unroll
            for (int m = 0; m < 4; ++m) {
                const int r = row0 + ai * 128 + m * 16;
#pragma unroll
                for (int bj = 0; bj < 2; ++bj) {
                    const int ct = cl + bj * 128; const f32x4 v0 = acc[ai][bj][m][0], v1 = acc[ai][bj][m][1];
                    const u32x4 w = (u32x4){pk2c(v0[0], v0[1]), pk2c(v0[2], v0[3]), pk2c(v1[0], v1[1]), pk2c(v1[2], v1[3])};
                    if (seg < 8) { *(u32x4*)(zb + (size_t)r * 2048 + seg * 256 + ct) = w; }
                    else if (seg < 20) {
                        const int c = (seg - 8) * 256 + ct; *(u32x4*)(xbcb + (size_t)r * 3072 + c) = w;
                        float* dst = nullptr;
                        if (r < M_P) { if (r >= M_P - 3) dst = convP + (size_t)(r - (M_P - 3)) * 3072; }
                        else { const int t = (r - M_P) & 31, b = (r - M_P) >> 5; if (t >= 29) dst = convS + ((size_t)b * 3 + (t - 29)) * 3072; }
                        if (dst) { *(f32x4*)(dst + c) = v0; *(f32x4*)(dst + c + 4) = v1; }
                    }
                    else if (seg < 24) { *(u32x4*)(qb + (size_t)r * 1024 + (seg - 20) * 256 + ct) = w; }
                    else if (seg < 32) {
                        const int c = ((seg - 24) & 3) * 256 + ct; const bool isk = seg < 28;
                        float* dst = (r < M_P) ? (isk ? kP : vP) + (size_t)r * 1024 : (isk ? kS : vS) + (size_t)(r - M_P) * 1024;
                        *(f32x4*)(dst + c) = v0; *(f32x4*)(dst + c + 4) = v1;
                        *(u32x4*)((isk ? kb : vb) + (size_t)r * 1024 + c) = w;
                    }
                    else if (seg < 40) {
                        const f32x2_t s0 = sigmoid2((f32x2_t){v0[0], v0[1]}), s1 = sigmoid2((f32x2_t){v0[2], v0[3]}), s2 = sigmoid2((f32x2_t){v1[0], v1[1]}), s3 = sigmoid2((f32x2_t){v1[2], v1[3]});
                        *(u32x4*)(gb + (size_t)r * 2048 + (seg - 32) * 256 + ct) = (u32x4){pk2(s0.x, s0.y), pk2(s1.x, s1.y), pk2(s2.x, s2.y), pk2(s3.x, s3.y)};
                    }
                    else if (wc == 0 && bj == 0) {
                        const f32x4 b0 = *(const f32x4*)(dt_bias + 8 * fq), b1 = *(const f32x4*)(dt_bias + 8 * fq + 4);
                        f32x4 o0, o1;
#pragma unroll
                        for (int j = 0; j < 4; ++j) { o0[j] = softplusf_(v0[j] + b0[j]); o1[j] = softplusf_(v1[j] + b1[j]); }
                        *(f32x4*)(dtb + (size_t)r * 32 + 8 * fq) = o0; *(f32x4*)(dtb + (size_t)r * 32 + 8 * fq + 4) = o1;
                    }
                }
            }
    }
};
struct EpiHalo {
    static constexpr bool PERM = true, AFTER_DRAIN = false;
    const float* rs; bf16_t* gh;
    __device__ __forceinline__ void elem(int hi, int ch, float v) const { gh[(size_t)hi * D_FF + ch] = f2bf(v); }
    __device__ __forceinline__ void operator()(const f32x4 (&acc)[2][2][4][2], const Unit& u, int wr, int wc, int fr, int fq) const {
        const int row0 = u.pm * 256 + wr * 64 + fr, c0 = u.pn * 128 + wc * 32 + 8 * fq;
#pragma unroll
        for (int ai = 0; ai < 2; ++ai)
#pragma unroll
            for (int m = 0; m < 4; ++m) {
                const int hi = row0 + ai * 128 + m * 16;
                const f32x4 v0 = acc[ai][0][m][0], v1 = acc[ai][0][m][1];
                *(u32x4*)(gh + (size_t)hi * D_FF + c0) = (u32x4){pk2c(v0[0], v0[1]), pk2c(v0[2], v0[3]), pk2c(v1[0], v1[1]), pk2c(v1[2], v1[3])};
            }
    }
};
struct EpiUpAct {
    static constexpr bool PERM = true, AFTER_DRAIN = false;
    const float* rs; const bf16_t* gh; bf16_t* ffb; float *ffnP, *ffnS; const float* cw; const float* cb; const float* hist;
    __device__ __forceinline__ void operator()(const f32x4 (&acc)[2][2][4][2], const Unit& u, int wr, int wc, int fr, int fq) const {
        const int c0 = u.pn * 128 + wc * 32 + 8 * fq;
        float w0[8], w1[8], w2[8], bb[8];
        load8f(cw + c0, w0); load8f(cw + D_FF + c0, w1); load8f(cw + 2 * D_FF + c0, w2); load8f(cb + c0, bb);
#pragma unroll
        for (int ai = 0; ai < 2; ++ai) {
            const int strip = 4 * u.pm + 2 * ai + wr;
            float gprev[8];
#pragma unroll
            for (int m = 0; m < 4; ++m) {
                const int r = strip * 64 + 16 * m + fr;
                float g[8], uv[8], p1[8], p2[8];
#pragma unroll
                for (int j = 0; j < 4; ++j) { g[j] = acc[ai][0][m][0][j]; g[4 + j] = acc[ai][0][m][1][j]; uv[j] = acc[ai][1][m][0][j]; uv[4 + j] = acc[ai][1][m][1][j]; }
                if (m == 0) { float e14[8], e15[8]; unpack8(*(const u32x4*)(gh + (size_t)(2 * strip) * D_FF + c0), e14); unpack8(*(const u32x4*)(gh + (size_t)(2 * strip + 1) * D_FF + c0), e15);
#pragma unroll
                    for (int j = 0; j < 8; ++j) gprev[j] = (fr == 15) ? e15[j] : e14[j]; }
#pragma unroll
                for (int j = 0; j < 8; ++j) {
                    const float c1 = (fr == 15) ? gprev[j] : g[j], c2 = (fr >= 14) ? gprev[j] : g[j];
                    p1[j] = __builtin_bit_cast(float, __builtin_amdgcn_update_dpp(0, __builtin_bit_cast(int, c1), 0x121, 0xf, 0xf, false));
                    p2[j] = __builtin_bit_cast(float, __builtin_amdgcn_update_dpp(0, __builtin_bit_cast(int, c2), 0x122, 0xf, 0xf, false));
                }
                const int t = (r < M_P) ? r : ((r - M_P) & 31);
                if (t < 2) {
                    float h0[8], h1[8];
                    if (r >= M_P) { const float* hp = hist + (size_t)((r - M_P) >> 5) * 2 * D_FF + c0; load8f(hp, h0); load8f(hp + D_FF, h1); }
                    else {
#pragma unroll
                        for (int j = 0; j < 8; ++j) { h0[j] = 0.f; h1[j] = 0.f; } }
#pragma unroll
                    for (int j = 0; j < 8; ++j) { if (t == 0) { p2[j] = h0[j]; p1[j] = h1[j]; } else { p2[j] = h1[j]; } }
                }
                float o[8];
#pragma unroll
                for (int j = 0; j < 8; j += 2) {
                    const f32x2_t a = (f32x2_t){bb[j], bb[j + 1]} + (f32x2_t){w0[j], w0[j + 1]} * (f32x2_t){p2[j], p2[j + 1]} + (f32x2_t){w1[j], w1[j + 1]} * (f32x2_t){p1[j], p1[j + 1]} + (f32x2_t){w2[j], w2[j + 1]} * (f32x2_t){g[j], g[j + 1]};
                    const f32x2_t ov = gelu2(a) * (f32x2_t){uv[j], uv[j + 1]}; o[j] = ov.x; o[j + 1] = ov.y; }
                *(u32x4*)(ffb + (size_t)r * D_FF + c0) = (u32x4){pk2(o[0], o[1]), pk2(o[2], o[3]), pk2(o[4], o[5]), pk2(o[6], o[7])};
                float* dst = nullptr;
                if (r < M_P) { if (r >= M_P - 2) dst = ffnP + (size_t)(r - (M_P - 2)) * D_FF; }
                else { const int b = (r - M_P) >> 5; if (t >= 30) dst = ffnS + ((size_t)b * 2 + (t - 30)) * D_FF; }
                if (dst) { *(f32x4*)(dst + c0) = (f32x4){g[0], g[1], g[2], g[3]}; *(f32x4*)(dst + c0 + 4) = (f32x4){g[4], g[5], g[6], g[7]}; }
#pragma unroll
                for (int j = 0; j < 8; ++j) gprev[j] = g[j];
            }
        }
    }
};
struct EpiBr {
    static constexpr bool PERM = true, AFTER_DRAIN = false;
    const bf16_t* gb; const bf16_t* t1in; bf16_t* dst; int mode; int pad;
    __device__ __forceinline__ void elem(int r, int c, float v) const {
        float o = bf2f(gb[(size_t)r * 2048 + (mode == 0 ? 1024 : 0) + c]) * v; if (mode == 1) o += bf2f(t1in[(size_t)r * 1024 + c]);
        dst[(size_t)r * 1024 + c] = f2bf(o); }
    __device__ __forceinline__ void operator()(const f32x4 (&acc)[2][2][4][2], const Unit& u, int wr, int wc, int fr, int fq) const {
        const int row0 = u.pm * 256 + wr * 64 + fr, cl = u.pn * 256 + wc * 32 + 8 * fq;
#pragma unroll
        for (int ai = 0; ai < 2; ++ai)
#pragma unroll
            for (int m = 0; m < 4; ++m) {
                const int r = row0 + ai * 128 + m * 16;
#pragma unroll
                for (int bj = 0; bj < 2; ++bj) {
                    const int c = cl + bj * 128; float g[8], o[8];
                    unpack8(*(const u32x4*)(gb + (size_t)r * 2048 + (mode == 0 ? 1024 : 0) + c), g);
                    const f32x4 v0 = acc[ai][bj][m][0], v1 = acc[ai][bj][m][1];
                    float tv[8];
                    if (mode == 1) unpack8(*(const u32x4*)(t1in + (size_t)r * 1024 + c), tv);
                    else {
#pragma unroll
                        for (int j = 0; j < 8; ++j) tv[j] = 0.f; }
#pragma unroll
                    for (int j = 0; j < 4; j += 2) {
                        const f32x2_t oa = (f32x2_t){g[j], g[j + 1]} * (f32x2_t){v0[j], v0[j + 1]} + (f32x2_t){tv[j], tv[j + 1]}, ob = (f32x2_t){g[4 + j], g[5 + j]} * (f32x2_t){v1[j], v1[j + 1]} + (f32x2_t){tv[4 + j], tv[5 + j]};
                        o[j] = oa.x; o[j + 1] = oa.y; o[4 + j] = ob.x; o[5 + j] = ob.y; }
                    *(u32x4*)(dst + (size_t)r * 1024 + c) = (u32x4){pk2(o[0], o[1]), pk2(o[2], o[3]), pk2(o[4], o[5]), pk2(o[6], o[7])};
                }
            }
    }
};
struct EpiPlain {
    static constexpr bool PERM = true, AFTER_DRAIN = false;
    bf16_t* dst;
    __device__ __forceinline__ void elem(int r, int c, float v) const { dst[(size_t)r * 1024 + c] = f2bf(v); }
    __device__ __forceinline__ void operator()(const f32x4 (&acc)[2][2][4][2], const Unit& u, int wr, int wc, int fr, int fq) const {
        const int row0 = u.pm * 256 + wr * 64 + fr, cl = u.pn * 256 + wc * 32 + 8 * fq;
#pragma unroll
        for (int ai = 0; ai < 2; ++ai)
#pragma unroll
            for (int m = 0; m < 4; ++m) {
                const int r = row0 + ai * 128 + m * 16;
#pragma unroll
                for (int bj = 0; bj < 2; ++bj) { const f32x4 v0 = acc[ai][bj][m][0], v1 = acc[ai][bj][m][1];
                    *(u32x4*)(dst + (size_t)r * 1024 + cl + bj * 128) = (u32x4){pk2c(v0[0], v0[1]), pk2c(v0[2], v0[3]), pk2c(v1[0], v1[1]), pk2c(v1[2], v1[3])}; }
            }
    }
};
struct EpiF32Out {
    static constexpr bool PERM = true, AFTER_DRAIN = false;
    bf16_t* dst;
    __device__ __forceinline__ void elem(int r, int c, float v) const { dst[(size_t)r * 1024 + c] = f2bf(v); }
    __device__ __forceinline__ void operator()(const f32x4 (&acc)[2][2][4][2], const Unit& u, int wr, int wc, int fr, int fq) const {
        const int row0 = u.pm * 256 + wr * 64 + fr, cl = u.pn * 256 + wc * 32 + 8 * fq;
#pragma unroll
        for (int ai = 0; ai < 2; ++ai)
#pragma unroll
            for (int m = 0; m < 4; ++m) {
                const int r = row0 + ai * 128 + m * 16;
#pragma unroll
                for (int bj = 0; bj < 2; ++bj) { const f32x4 v0 = acc[ai][bj][m][0], v1 = acc[ai][bj][m][1];
                    *(u32x4*)(dst + (size_t)r * 1024 + cl + bj * 128) = (u32x4){pk2c(v0[0], v0[1]), pk2c(v0[2], v0[3]), pk2c(v1[0], v1[1]), pk2c(v1[2], v1[3])}; }
            }
    }
};
struct EpiPle {
    static constexpr bool PERM = false, AFTER_DRAIN = false;
    const bf16_t* plea; bf16_t* dst;
    __device__ __forceinline__ void elem(int r, int c, float v) const { dst[(size_t)r * 1024 + c] = f2bf(bf2f(plea[(size_t)r * 1024 + c]) * sigmoidf_(v)); }
    __device__ __forceinline__ void operator()(const f32x4 (&acc)[2][2][4][2], const Unit& u, int wr, int wc, int fr, int fq) const {
        const int row0 = u.pm * 256 + wr * 64 + fr, col0 = u.pn * 256 + wc * 32 + 4 * fq;
#pragma unroll
        for (int ai = 0; ai < 2; ++ai)
#pragma unroll
            for (int m = 0; m < 4; ++m) { const size_t ro = (size_t)(row0 + ai * 128 + m * 16) * 1024 + col0;
#pragma unroll
                for (int bj = 0; bj < 2; ++bj)
#pragma unroll
                    for (int n = 0; n < 2; ++n) { const u32x2 a = *(const u32x2*)(plea + ro + bj * 128 + n * 16); const f32x4 v = acc[ai][bj][m][n];
                        const f32x2_t o0 = (f32x2_t){bflo(a.x), bfhi(a.x)} * sigmoid2((f32x2_t){v[0], v[1]}), o1 = (f32x2_t){bflo(a.y), bfhi(a.y)} * sigmoid2((f32x2_t){v[2], v[3]});
                        *(u32x2*)(dst + ro + bj * 128 + n * 16) = (u32x2){pk2(o0.x, o0.y), pk2(o1.x, o1.y)}; } }
    }
};

typedef short bf16x8 __attribute__((ext_vector_type(8)));
typedef float f32x16 __attribute__((ext_vector_type(16)));
typedef short bf16x4 __attribute__((ext_vector_type(4)));
#define MFMA32(a, b, c) __builtin_amdgcn_mfma_f32_32x32x16_bf16((a), (b), (c), 0, 0, 0)
__device__ __forceinline__ f32x16 zero16() { f32x16 z;
#pragma unroll
    for (int i = 0; i < 16; ++i) z[i] = 0.f; return z; }
__device__ __forceinline__ bf16x8 pack8f(const float (&v)[8]) { const u32x4 w = (u32x4){pk2(v[0], v[1]), pk2(v[2], v[3]), pk2(v[4], v[5]), pk2(v[6], v[7])}; return __builtin_bit_cast(bf16x8, w); }
__device__ __forceinline__ bf16x8 join44(bf16x4 lo, bf16x4 hi) { return __builtin_shufflevector(lo, hi, 0, 1, 2, 3, 4, 5, 6, 7); }

constexpr int PX = 72;
constexpr int PR = 136;
constexpr int L_XT = 0;
constexpr int L_B = L_XT + 8 * 64 * PX * 2;
constexpr int L_C = L_B + 128 * PX * 2;
constexpr int L_AC = L_C + 64 * PR * 2;
constexpr int L_DT = L_AC + 2048;
constexpr int L_WS = L_DT + 2048;
constexpr int ZP = 1040;
constexpr int SSD_LDS = L_WS + 2048;

struct ChunkInfo { int seqbase, row0, t0, nvalid; const float* hist; };
__device__ __forceinline__ ChunkInfo chunk_info(CPR p, int l, int ck) {
    ChunkInfo c;
    if (ck < 256) { c.seqbase = 0; c.row0 = 64 * ck; c.t0 = 64 * ck; c.nvalid = 64; c.hist = nullptr; }
    else { const int b = ck - 256; c.seqbase = M_P + 32 * b; c.row0 = c.seqbase; c.t0 = 0; c.nvalid = 32; c.hist = p.state_ssd_conv + ((size_t)l * DEC_BATCH + b) * 3 * 3072; }
    return c;
}
template <int NP> __device__ __forceinline__ void xbc_pad_raw(const bf16_t* __restrict__ xbcb, const float* __restrict__ hist, int rowbase, int hj, int c, unsigned (&d)[NP]) {
    if (hj >= 3) { const bf16_t* q = xbcb + (size_t)(rowbase + hj - 3) * 3072 + c;
        if (NP == 4) { const u32x4 t = *(const u32x4*)q; d[0] = t.x; d[1 % NP] = t.y; d[2 % NP] = t.z; d[3 % NP] = t.w; }
        else if (NP == 2) { const u32x2 t = *(const u32x2*)q; d[0] = t.x; d[1 % NP] = t.y; }
        else d[0] = *(const unsigned*)q; }
    else if (hist) {
#pragma unroll
        for (int k = 0; k < NP; ++k) { const float2 t = *(const float2*)(hist + (size_t)hj * 3072 + c + 2 * k); d[k] = pk2(t.x, t.y); } }
    else {
#pragma unroll
        for (int k = 0; k < NP; ++k) d[k] = 0u; }
}
__device__ __forceinline__ int xt_off(int R, int g) { return R * (PX * 2) + ((g ^ ((R >> 3) & 7)) << 4); }
template <int NP, class F> __device__ __forceinline__ void conv8(CPR p, int l, const ChunkInfo& ci, int s0, int c, F emit) {
    if (s0 >= ci.nvalid) {
        const float z[8] = {0.f, 0.f, 0.f, 0.f, 0.f, 0.f, 0.f, 0.f};
#pragma unroll
        for (int jp = 0; jp < NP; ++jp) emit(jp, z, z);
        return;
    }
    const float* cw = p.ssd_conv_w + (size_t)l * 4 * 3072 + c; const float* cb = p.ssd_conv_b + (size_t)l * 3072 + c;
    const int t = ci.t0 + s0;
    unsigned raw[11][NP];
#pragma unroll
    for (int k = 0; k < 11; ++k) xbc_pad_raw<NP>(p.xbcb, ci.hist, ci.seqbase, t + k, c, raw[k]);
#pragma unroll
    for (int jp = 0; jp < NP; ++jp) {
        const f32x2_t w0 = *(const f32x2_t*)(cw + 2 * jp), w1 = *(const f32x2_t*)(cw + 3072 + 2 * jp), w2 = *(const f32x2_t*)(cw + 2 * 3072 + 2 * jp), w3 = *(const f32x2_t*)(cw + 3 * 3072 + 2 * jp), bb = *(const f32x2_t*)(cb + 2 * jp);
        f32x2_t rv[11];
#pragma unroll
        for (int k = 0; k < 11; ++k) rv[k] = (f32x2_t){bflo(raw[k][jp]), bfhi(raw[k][jp])};
        float lo[8], hi[8];
#pragma unroll
        for (int i = 0; i < 8; ++i) {
            const f32x2_t a = bb + w0 * rv[i] + w1 * rv[i + 1] + w2 * rv[i + 2] + w3 * rv[i + 3];
            const f32x2_t sv = silu2(a);
            lo[i] = sv.x; hi[i] = sv.y;
        }
        emit(jp, lo, hi);
    }
}
__device__ __forceinline__ float unit_dt(CPR p, int l, int u, int wid, int lane) {
    const ChunkInfo ci = chunk_info(p, l, u >> 2);
    return (lane < ci.nvalid) ? p.dtb[(size_t)(ci.row0 + lane) * 32 + (u & 3) * 8 + wid] : 0.f;
}
__device__ __forceinline__ void head_scan(CPR p, int l, int h, int lane, float dtv, float& ac, float& aclast) {
    const float a = -__expf(p.ssd_a_log[l * 32 + h]);
    ac = dtv * a;
#pragma unroll
    for (int o = 1; o < 64; o <<= 1) { const float t = __shfl_up(ac, o); if (lane >= o) ac += t; }
    aclast = __shfl(ac, 63);
}
__device__ __forceinline__ void ph_ssd_p1(CPR p, int l, LDSP lds) {
    const int tid = tid_opaque(), wid = tid >> 6, lane = tid & 63, r = lane & 31, hh = lane >> 5;
    PG8_LAS float* acS = (PG8_LAS float*)(lds + L_AC); PG8_LAS float* wS = (PG8_LAS float*)(lds + L_WS);
    PG8_LAS bf16_t* xT = (PG8_LAS bf16_t*)(lds + L_XT); PG8_LAS bf16_t* BT = (PG8_LAS bf16_t*)(lds + L_B);
    const int u0 = bid_opaque(), nb = nblk_opaque();
    float dt_nx = (u0 < NCHUNK * 4) ? unit_dt(p, l, u0, wid, lane) : 0.f;
    for (int u = u0; u < NCHUNK * 4; u += nb) {
        const int ck = u >> 2, g = u & 3, h = g * 8 + wid;
        const ChunkInfo ci = chunk_info(p, l, ck);
        const float dtv = dt_nx; float ac, aclast; head_scan(p, l, h, lane, dtv, ac, aclast);
        dt_nx = (u + nb < NCHUNK * 4) ? unit_dt(p, l, u + nb, wid, lane) : 0.f;
        wS[wid * 64 + lane] = __expf(aclast - ac) * dtv;
        if (lane == 63) p.dec[ck * 32 + h] = __expf(aclast);
        __syncthreads();
        { const int cc = tid & 63, s0 = (tid >> 6) * 8, g8 = s0 >> 3, hl = cc >> 3, p0 = (cc & 7) * 8;
          float wv[8];
#pragma unroll
          for (int i = 0; i < 8; ++i) wv[i] = wS[hl * 64 + s0 + i];
          conv8<4>(p, l, ci, s0, g * 512 + cc * 8, [&](int jp, const float (&lo)[8], const float (&hi)[8]) {
              const int R = hl * 64 + p0 + 2 * jp;
              *(PG8_LAS u32x4*)(lds + L_XT + xt_off(R, g8)) = (u32x4){pk2(lo[0] * wv[0], lo[1] * wv[1]), pk2(lo[2] * wv[2], lo[3] * wv[3]), pk2(lo[4] * wv[4], lo[5] * wv[5]), pk2(lo[6] * wv[6], lo[7] * wv[7])};
              *(PG8_LAS u32x4*)(lds + L_XT + xt_off(R + 1, g8)) = (u32x4){pk2(hi[0] * wv[0], hi[1] * wv[1]), pk2(hi[2] * wv[2], hi[3] * wv[3]), pk2(hi[4] * wv[4], hi[5] * wv[5]), pk2(hi[6] * wv[6], hi[7] * wv[7])}; }); }
        { const int q = tid & 63, s0 = (tid >> 6) * 8, g8 = s0 >> 3, n0 = 2 * q;
          conv8<1>(p, l, ci, s0, 2048 + g * 128 + n0, [&](int jp, const float (&lo)[8], const float (&hi)[8]) {
              *(PG8_LAS u32x4*)(lds + L_B + xt_off(n0, g8)) = (u32x4){pk2(lo[0], lo[1]), pk2(lo[2], lo[3]), pk2(lo[4], lo[5]), pk2(lo[6], lo[7])};
              *(PG8_LAS u32x4*)(lds + L_B + xt_off(n0 + 1, g8)) = (u32x4){pk2(hi[0], hi[1]), pk2(hi[2], hi[3]), pk2(hi[4], hi[5]), pk2(hi[6], hi[7])}; }); }
        __syncthreads();
        f32x16 acc[4][2];
#pragma unroll
        for (int a = 0; a < 4; ++a)
#pragma unroll
            for (int b = 0; b < 2; ++b) acc[a][b] = zero16();
#pragma unroll
        for (int ks = 0; ks < 4; ++ks) {
            bf16x8 A[2], Bf[4];
#pragma unroll
            for (int pt = 0; pt < 2; ++pt) A[pt] = *(const PG8_LAS bf16x8*)(lds + L_XT + xt_off(wid * 64 + 32 * pt + r, 2 * ks + hh));
#pragma unroll
            for (int nt = 0; nt < 4; ++nt) Bf[nt] = *(const PG8_LAS bf16x8*)(lds + L_B + xt_off(32 * nt + r, 2 * ks + hh));
#pragma unroll
            for (int nt = 0; nt < 4; ++nt)
#pragma unroll
                for (int pt = 0; pt < 2; ++pt) acc[nt][pt] = MFMA32(Bf[nt], A[pt], acc[nt][pt]);
        }
        bf16_t* dst = (bf16_t*)p.sst + ((size_t)ck * 32 + h) * 8192 + lane * 16;
#pragma unroll
        for (int nt = 0; nt < 4; ++nt)
#pragma unroll
            for (int pt = 0; pt < 2; ++pt) {
                const f32x16& a = acc[nt][pt];
                *(u32x4*)(dst + (nt * 2 + pt) * 1024) = (u32x4){pk2c(a[0], a[1]), pk2c(a[2], a[3]), pk2c(a[4], a[5]), pk2c(a[6], a[7])};
                *(u32x4*)(dst + (nt * 2 + pt) * 1024 + 8) = (u32x4){pk2c(a[8], a[9]), pk2c(a[10], a[11]), pk2c(a[12], a[13]), pk2c(a[14], a[15])};
            }
        __syncthreads();
    }
}
__device__ __forceinline__ int frag_to_logical(int x) {
    const int h = x >> 13, y = x & 8191, T = y >> 10, L = (y >> 4) & 63, q = y & 15;
    const int p = 32 * (T & 1) + (L & 31), n = 32 * (T >> 1) + (q & 3) + 8 * (q >> 2) + 4 * (L >> 5);
    return h * 8192 + p * 128 + n;
}
__device__ __forceinline__ void ph_ssd_p2(CPR p, int l) {
    const int gtid = bid_opaque() * 512 + tid_opaque(), gsz = nblk_opaque() * 512;
    const unsigned* sst2 = (const unsigned*)p.sst; unsigned* hp2 = (unsigned*)p.hpb;
    for (int e = gtid; e < 131072; e += gsz) {
        const int h = e >> 12; float2 hc = make_float2(0.f, 0.f);
        for (int c0 = 0; c0 < 256; c0 += 32) {
            unsigned S[32]; float d[32];
#pragma unroll
            for (int i = 0; i < 32; ++i) { S[i] = __builtin_nontemporal_load(sst2 + (size_t)(c0 + i) * 131072 + e); d[i] = p.dec[(c0 + i) * 32 + h]; }
#pragma unroll
            for (int i = 0; i < 32; ++i) { __builtin_nontemporal_store(pk2(hc.x, hc.y), hp2 + (size_t)(c0 + i) * 131072 + e); const f32x2_t hn = (f32x2_t){hc.x, hc.y} * d[i] + (f32x2_t){bflo(S[i]), bfhi(S[i])}; hc.x = hn.x; hc.y = hn.y; }
        }
        ((float2*)(p.out + O_P_STATE + (size_t)l * STATE_SZ))[frag_to_logical(2 * e) >> 1] = hc;
    }
    for (int i = gtid; i < DEC_BATCH * 131072; i += gsz) {
        const int b = i >> 17, e = i & 131071, h = e >> 12, ck = 256 + b;
        const int el = frag_to_logical(2 * e) >> 1;
        const float2 h0 = ((const float2*)(p.state_ssd + ((size_t)l * DEC_BATCH + b) * STATE_SZ))[el]; const unsigned Sw = sst2[(size_t)ck * 131072 + e]; const float2 S = make_float2(bflo(Sw), bfhi(Sw)); const float d = p.dec[ck * 32 + h];
        hp2[(size_t)ck * 131072 + e] = pk2(h0.x, h0.y);
        ((float2*)(p.out + O_S_STATE + ((size_t)l * DEC_BATCH + b) * STATE_SZ))[el] = make_float2(fmaf(d, h0.x, S.x), fmaf(d, h0.y, S.y));
    }
}
__device__ __forceinline__ void ph_ssd_p3(CPR p, int l, LDSP lds) {
    const int tid = tid_opaque(), wid = tid >> 6, lane = tid & 63, r = lane & 31, hh = lane >> 5;
    PG8_LAS float* acS = (PG8_LAS float*)(lds + L_AC); PG8_LAS float* dtS = (PG8_LAS float*)(lds + L_DT); PG8_LAS float* red = (PG8_LAS float*)(lds + L_WS);
    PG8_LAS bf16_t* xT = (PG8_LAS bf16_t*)(lds + L_XT);
    const int u0 = bid_opaque(), nb = nblk_opaque();
    float dt_nx = (u0 < NCHUNK * 4) ? unit_dt(p, l, u0, wid, lane) : 0.f;
    for (int u = u0; u < NCHUNK * 4; u += nb) {
        const int ck = u >> 2, g = u & 3, h = g * 8 + wid;
        const ChunkInfo ci = chunk_info(p, l, ck);
        const float Dh = p.ssd_d[l * 32 + h];
        { const float dtv = dt_nx; float ac, aclast; head_scan(p, l, h, lane, dtv, ac, aclast); acS[wid * 64 + lane] = ac; dtS[wid * 64 + lane] = dtv; }
        dt_nx = (u + nb < NCHUNK * 4) ? unit_dt(p, l, u + nb, wid, lane) : 0.f;
        bf16x8 HA[8][2];
        const bf16_t* hp = p.hpb + ((size_t)ck * 32 + h) * 8192;
        { const int cc = tid & 63, s0 = (tid >> 6) * 8, g8 = s0 >> 3, hl = cc >> 3, p0 = (cc & 7) * 8;
          conv8<4>(p, l, ci, s0, g * 512 + cc * 8, [&](int jp, const float (&lo)[8], const float (&hi)[8]) {
              const int R = hl * 64 + p0 + 2 * jp;
              *(PG8_LAS u32x4*)(lds + L_XT + xt_off(R, g8)) = (u32x4){pk2(lo[0], lo[1]), pk2(lo[2], lo[3]), pk2(lo[4], lo[5]), pk2(lo[6], lo[7])};
              *(PG8_LAS u32x4*)(lds + L_XT + xt_off(R + 1, g8)) = (u32x4){pk2(hi[0], hi[1]), pk2(hi[2], hi[3]), pk2(hi[4], hi[5]), pk2(hi[6], hi[7])}; }); }
        { const int q = tid & 63, s0 = (tid >> 6) * 8, n4 = 4 * (q & 31), off = (q < 32 ? L_B : L_C) + n4 * 2;
          conv8<2>(p, l, ci, s0, (q < 32 ? 2048 : 2560) + g * 128 + n4, [&](int jp, const float (&lo)[8], const float (&hi)[8]) {
#pragma unroll
              for (int i = 0; i < 8; ++i) *(PG8_LAS unsigned*)(lds + off + jp * 4 + (s0 + i) * PR * 2) = pk2(lo[i], hi[i]); }); }
#pragma unroll
        for (int ks = 0; ks < 8; ++ks) { HA[ks][0] = *(const bf16x8*)(hp + ((ks >> 1) * 2 + 0) * 1024 + lane * 16 + 8 * (ks & 1)); HA[ks][1] = *(const bf16x8*)(hp + ((ks >> 1) * 2 + 1) * 1024 + lane * 16 + 8 * (ks & 1)); }
        __syncthreads();
        f32x16 yd[2][2];
#pragma unroll
        for (int a = 0; a < 2; ++a)
#pragma unroll
            for (int b = 0; b < 2; ++b) yd[a][b] = zero16();
#pragma unroll
        for (int ks = 0; ks < 8; ++ks) {
            bf16x8 Bf[2];
#pragma unroll
            for (int lt = 0; lt < 2; ++lt) { const int eo = ((32 * lt + r) * PR + 16 * ks + 4 * hh) * 2;
                Bf[lt] = join44(*(const PG8_LAS bf16x4*)(lds + L_C + eo), *(const PG8_LAS bf16x4*)(lds + L_C + eo + 16)); }
#pragma unroll
            for (int pt = 0; pt < 2; ++pt)
#pragma unroll
                for (int lt = 0; lt < 2; ++lt) yd[pt][lt] = MFMA32(HA[ks][pt], Bf[lt], yd[pt][lt]);
        }
#pragma unroll
        for (int lt = 0; lt < 2; ++lt) { const float eal = __expf(acS[wid * 64 + 32 * lt + r]);
#pragma unroll
            for (int pt = 0; pt < 2; ++pt)
#pragma unroll
                for (int q = 0; q < 16; q += 2) { const f32x2_t t = (f32x2_t){yd[pt][lt][q], yd[pt][lt][q + 1]} * eal; yd[pt][lt][q] = t.x; yd[pt][lt][q + 1] = t.y; } }
        u32x4 zraw[8];
#pragma unroll
        for (int i = 0; i < 8; ++i) { const int e = tid + 512 * i, tok = e >> 6; zraw[i] = *(const u32x4*)(p.zb + (size_t)(ci.row0 + (tok < ci.nvalid ? tok : 0)) * 2048 + g * 512 + (e & 63) * 8); }
#pragma unroll
        for (int tix = 0; tix < 3; ++tix) {
            const int st = (tix == 2) ? 1 : 0, lt = (tix == 0) ? 0 : 1;
            f32x16 G = zero16();
#pragma unroll
            for (int ks = 0; ks < 8; ++ks) {
                const bf16x8 A = *(const PG8_LAS bf16x8*)(lds + L_B + ((32 * st + r) * PR + 16 * ks + 8 * hh) * 2);
                const bf16x8 Bf = *(const PG8_LAS bf16x8*)(lds + L_C + ((32 * lt + r) * PR + 16 * ks + 8 * hh) * 2);
                G = MFMA32(A, Bf, G);
            }
            const int lcol = 32 * lt + r; const float acl = acS[wid * 64 + lcol];
            float mv[16];
#pragma unroll
            for (int q = 0; q < 16; q += 2) {
                const int s = 32 * st + (q & 3) + 8 * (q >> 2) + 4 * hh;
                const f32x2_t acs = *(const PG8_LAS f32x2_t*)(acS + wid * 64 + s), dts = *(const PG8_LAS f32x2_t*)(dtS + wid * 64 + s);
                const f32x2_t dd = __builtin_elementwise_min((f32x2_t){acl, acl} - acs, (f32x2_t){0.f, 0.f}) * 1.4426950408889634f;
                const f32x2_t v2 = (f32x2_t){G[q], G[q + 1]} * exp2_2(dd) * dts;
                float va = (s <= lcol) ? v2.x : 0.f, vb = (s + 1 <= lcol) ? v2.y : 0.f;
                if (s == lcol) va += Dh; if (s + 1 == lcol) vb += Dh;
                mv[q] = va; mv[q + 1] = vb;
            }
#pragma unroll
            for (int kk = 0; kk < 2; ++kk) {
                const float m8[8] = {mv[8 * kk], mv[8 * kk + 1], mv[8 * kk + 2], mv[8 * kk + 3], mv[8 * kk + 4], mv[8 * kk + 5], mv[8 * kk + 6], mv[8 * kk + 7]};
                const bf16x8 Bm = pack8f(m8);
#pragma unroll
                for (int pt = 0; pt < 2; ++pt) {
                    const int R = wid * 64 + 32 * pt + r, g = 4 * st + 2 * kk;
                    const bf16x4 lo = *(const PG8_LAS bf16x4*)(lds + L_XT + xt_off(R, g) + 8 * hh), hi = *(const PG8_LAS bf16x4*)(lds + L_XT + xt_off(R, g + 1) + 8 * hh);
                    yd[pt][lt] = MFMA32(join44(lo, hi), Bm, yd[pt][lt]);
                }
            }
        }
        __syncthreads();
#pragma unroll
        for (int i = 0; i < 8; ++i) { const int e = tid + 512 * i; *(PG8_LAS u32x4*)(lds + L_XT + (e >> 6) * ZP + (e & 63) * 16) = zraw[i]; }
        __syncthreads();
        float ssl[2];
#pragma unroll
        for (int lt = 0; lt < 2; ++lt) {
            const int lcol = 32 * lt + r;
            float ss = 0.f;
#pragma unroll
            for (int pt = 0; pt < 2; ++pt)
#pragma unroll
                for (int i = 0; i < 4; ++i) {
                    const u32x2 zw = *(const PG8_LAS u32x2*)(lds + L_XT + lcol * ZP + (wid * 64 + 32 * pt + 8 * i + 4 * hh) * 2);
                    const f32x2_t za = (f32x2_t){bflo(zw.x), bfhi(zw.x)}, zb2 = (f32x2_t){bflo(zw.y), bfhi(zw.y)};
                    const f32x2_t ga = (f32x2_t){yd[pt][lt][4 * i], yd[pt][lt][4 * i + 1]} * silu2(za), gb2 = (f32x2_t){yd[pt][lt][4 * i + 2], yd[pt][lt][4 * i + 3]} * silu2(zb2);
                    yd[pt][lt][4 * i] = ga.x; yd[pt][lt][4 * i + 1] = ga.y; yd[pt][lt][4 * i + 2] = gb2.x; yd[pt][lt][4 * i + 3] = gb2.y;
                    const f32x2_t sq = ga * ga + gb2 * gb2; ss += sq.x + sq.y;
                }
            ss += __shfl_xor(ss, 32);
            ssl[lt] = ss;
        }
        if (hh == 0) { red[wid * 64 + r] = ssl[0]; red[wid * 64 + 32 + r] = ssl[1]; }
        __syncthreads();
#pragma unroll
        for (int lt = 0; lt < 2; ++lt) {
            const int lcol = 32 * lt + r;
            float tot = 0.f;
#pragma unroll
            for (int w = 0; w < 8; ++w) tot += red[w * 64 + lcol];
            const float rstd = rsqrtf(tot * (1.0f / 512.f) + EPS);
#pragma unroll
            for (int pt = 0; pt < 2; ++pt)
#pragma unroll
                for (int i = 0; i < 4; ++i)
                { const f32x2_t a = (f32x2_t){yd[pt][lt][4 * i], yd[pt][lt][4 * i + 1]} * rstd, b = (f32x2_t){yd[pt][lt][4 * i + 2], yd[pt][lt][4 * i + 3]} * rstd;
                    *(PG8_LAS u32x2*)(lds + L_XT + lcol * ZP + (wid * 64 + 32 * pt + 8 * i + 4 * hh) * 2) = (u32x2){pk2(a.x, a.y), pk2(b.x, b.y)}; }
        }
        __syncthreads();
#pragma unroll
        for (int i = 0; i < 8; ++i) { const int e = tid + 512 * i, tok = e >> 6;
            if (tok < ci.nvalid) *(u32x4*)(p.yn + (size_t)(ci.row0 + tok) * 2048 + g * 512 + (e & 63) * 8) = *(const PG8_LAS u32x4*)(lds + L_XT + tok * ZP + (e & 63) * 16); }
        __syncthreads();
    }
}
#ifndef ATT_EXIT_P
#define ATT_EXIT_P 1e-20f
#endif
typedef short v4i16_t __attribute__((ext_vector_type(4)));
constexpr int AT_PITCH = 272;
constexpr int AT_TILE = 32 * AT_PITCH;
constexpr int ATT_LDS = 8 * 2 * AT_TILE;
__device__ __forceinline__ void ph_attn(CPR p, int l, LDSP lds) {
    const int tidx = tid_opaque(); const int lane = tidx & 63, r = lane & 31, hh = lane >> 5, wv = tidx >> 6, NGW = nblk_opaque() * 8, gw = (bid_opaque() * 8 + wv + (NGW >> 1)) % NGW;
    const bf16_t* kbb = p.kb; const bf16_t* vbb = p.vb;
    const float* ck = p.cache_k + (size_t)l * DEC_BATCH * PAST_LEN * 1024; const float* cv = p.cache_v + (size_t)l * DEC_BATCH * PAST_LEN * 1024;
    const float scale = 0.08838834764831845f;
    LDSP kl = lds + wv * (2 * AT_TILE); LDSP vl = kl + AT_TILE;
    const int st_g = (lane >> 5) * 1024 + (lane & 31) * 4;
    const int st_l = (lane >> 5) * AT_PITCH + (lane & 31) * 8;
    const int vs_g = (lane >> 4) * 1024 + (lane & 15) * 8;
    const int vs_l = (lane >> 4) * AT_PITCH + (lane & 15) * 16;
    const int ka_off = r * AT_PITCH + 16 * hh;
    const int vt_off = (4 * hh + ((lane & 15) >> 2)) * AT_PITCH + (16 * ((lane >> 4) & 1) + 4 * (lane & 3)) * 2;
    const int nwg = NGW >> 3, wgr = gw >> 3;
    for (int U = wgr; U < 512 + 32; U += nwg) {
        int hd, b, rowq0, P0;
        if (U < 512) { hd = U & 7; const int qt = 8 * (U >> 3) + wv; b = -1; rowq0 = 32 * qt; P0 = 32 * qt; }
        else { hd = wv; b = U - 512; rowq0 = M_P + 32 * b; P0 = PAST_LEN; }
        bf16x8 qf[8];
        { const bf16_t* qg = p.qb + (size_t)rowq0 * 1024 + hd * 128 + vs_g; u32x4 qs[8];
#pragma unroll
          for (int i = 0; i < 8; ++i) qs[i] = *(const u32x4*)(qg + 4096 * i);
#pragma unroll
          for (int i = 0; i < 8; ++i) *(PG8_LAS u32x4*)(vl + vs_l + 4 * AT_PITCH * i) = qs[i];
          asm volatile("s_waitcnt lgkmcnt(0)" ::: "memory");
#pragma unroll
          for (int ks = 0; ks < 8; ++ks) qf[ks] = *(const PG8_LAS bf16x8*)(vl + ka_off + 32 * ks);
          asm volatile("s_waitcnt lgkmcnt(0)" ::: "memory"); }
        f32x16 O[4];
#pragma unroll
        for (int d = 0; d < 4; ++d) O[d] = zero16();
        float carry = 1.0f;
        const int ktd = P0 >> 5;
        u32x4 buf[16];
        { const bf16_t* kq = kbb + (size_t)rowq0 * 1024 + hd * 128 + vs_g;
#pragma unroll
          for (int i = 0; i < 8; ++i) buf[8 + i] = *(const u32x4*)(kq + 4096 * i);
#pragma unroll
          for (int i = 0; i < 8; ++i) *(PG8_LAS u32x4*)(kl + vs_l + 4 * AT_PITCH * i) = buf[8 + i]; }
        for (int kt = ktd; kt >= 0; --kt) {
            const bool bfs = (b < 0) || (kt == ktd);
            f32x16 S = zero16();
            if (bfs) {
                const bf16_t* vq = vbb + (size_t)(b < 0 ? 32 * kt : rowq0) * 1024 + hd * 128 + vs_g;
#pragma unroll
                for (int i = 0; i < 8; ++i) buf[i] = *(const u32x4*)(vq + 4096 * i);
            } else {
                const float* vb = cv + ((size_t)b * PAST_LEN + 32 * kt) * 1024 + hd * 128 + st_g;
#pragma unroll
                for (int i = 0; i < 16; ++i) buf[i] = *(const u32x4*)(vb + 2048 * i);
            }
            asm volatile("s_waitcnt lgkmcnt(0)" ::: "memory");
#pragma unroll
            for (int ks = 0; ks < 8; ++ks) S = MFMA32(*(const PG8_LAS bf16x8*)(kl + ka_off + 32 * ks), qf[ks], S);
            const bool diag = (kt == ktd);
            float kp[16], sg[16];
#pragma unroll
            for (int q = 0; q < 16; q += 2) {
                const int key = (q & 3) + 8 * (q >> 2) + 4 * hh;
                const f32x2_t z = (f32x2_t){S[q], S[q + 1]} * scale, e = exp2_2(__builtin_elementwise_abs(z) * (-1.4426950408889634f)), big = rcp_2(e + 1.0f), small = e * big;
                const bool v0 = !diag || key < r, v1 = !diag || key + 1 < r;
                sg[q] = v0 ? (z.x >= 0.f ? big.x : small.x) : 0.f; kp[q] = v0 ? (z.x >= 0.f ? small.x : big.x) : 1.0f;
                sg[q + 1] = v1 ? (z.y >= 0.f ? big.y : small.y) : 0.f; kp[q + 1] = v1 ? (z.y >= 0.f ? small.y : big.y) : 1.0f;
            }
            float T[4], Tp[4];
#pragma unroll
            for (int gi = 0; gi < 4; ++gi) { T[gi] = (kp[4 * gi] * kp[4 * gi + 1]) * (kp[4 * gi + 2] * kp[4 * gi + 3]); Tp[gi] = __shfl_xor(T[gi], 32); }
            float wg[16]; float aft = carry;
#pragma unroll
            for (int gi = 3; gi >= 0; --gi) {
                float suf = aft * (hh == 0 ? Tp[gi] : 1.0f);
#pragma unroll
                for (int j = 3; j >= 0; --j) { wg[4 * gi + j] = sg[4 * gi + j] * suf; suf *= kp[4 * gi + j]; }
                aft *= T[gi] * Tp[gi];
            }
            carry = aft;
            bf16x8 Pf[2];
#pragma unroll
            for (int kk = 0; kk < 2; ++kk) {
                const float w8[8] = {wg[8 * kk], wg[8 * kk + 1], wg[8 * kk + 2], wg[8 * kk + 3], wg[8 * kk + 4], wg[8 * kk + 5], wg[8 * kk + 6], wg[8 * kk + 7]};
                Pf[kk] = pack8f(w8);
            }
            if (bfs) {
#pragma unroll
                for (int i = 0; i < 8; ++i) *(PG8_LAS u32x4*)(vl + vs_l + 4 * AT_PITCH * i) = buf[i];
            } else {
#pragma unroll
                for (int i = 0; i < 16; ++i) { const float4 t = __builtin_bit_cast(float4, buf[i]); *(PG8_LAS u32x2*)(vl + st_l + 2 * AT_PITCH * i) = (u32x2){pk2(t.x, t.y), pk2(t.z, t.w)}; }
            }
            const bool more = (kt > 0) && !__all(carry < ATT_EXIT_P);
            if (more) {
                if (b < 0) { const bf16_t* kq = kbb + (size_t)(32 * (kt - 1)) * 1024 + hd * 128 + vs_g;
#pragma unroll
                    for (int i = 0; i < 8; ++i) buf[8 + i] = *(const u32x4*)(kq + 4096 * i); }
                else { const float* kb = ck + ((size_t)b * PAST_LEN + 32 * (kt - 1)) * 1024 + hd * 128 + st_g;
#pragma unroll
                    for (int i = 0; i < 16; ++i) buf[i] = *(const u32x4*)(kb + 2048 * i); }
            }
            asm volatile("s_waitcnt lgkmcnt(0)" ::: "memory");
#pragma unroll
            for (int kk = 0; kk < 2; ++kk)
#pragma unroll
                for (int d = 0; d < 4; ++d) {
                    const bf16x4 lo = __builtin_bit_cast(bf16x4, __builtin_amdgcn_ds_read_tr16_b64_v4i16((PG8_LAS v4i16_t*)(vl + vt_off + kk * 16 * AT_PITCH + d * 64)));
                    const bf16x4 hi = __builtin_bit_cast(bf16x4, __builtin_amdgcn_ds_read_tr16_b64_v4i16((PG8_LAS v4i16_t*)(vl + vt_off + kk * 16 * AT_PITCH + 8 * AT_PITCH + d * 64)));
                    O[d] = MFMA32(Pf[kk], join44(lo, hi), O[d]);
                }
            if (!more) break;
            if (b >= 0) {
#pragma unroll
                for (int i = 0; i < 16; ++i) { const float4 t = __builtin_bit_cast(float4, buf[i]); *(PG8_LAS u32x2*)(kl + st_l + 2 * AT_PITCH * i) = (u32x2){pk2(t.x, t.y), pk2(t.z, t.w)}; }
            } else {
#pragma unroll
                for (int i = 0; i < 8; ++i) *(PG8_LAS u32x4*)(kl + vs_l + 4 * AT_PITCH * i) = buf[8 + i];
            }
        }
#pragma unroll
        for (int d = 0; d < 4; ++d)
#pragma unroll
            for (int q = 0; q < 16; ++q) *(PG8_LAS unsigned short*)(kl + ((q & 3) + 8 * (q >> 2) + 4 * hh) * AT_PITCH + (32 * d + r) * 2) = (unsigned short)pk2c(O[d][q], 0.0f);
        asm volatile("s_waitcnt lgkmcnt(0)" ::: "memory");
#pragma unroll
        for (int i = 0; i < 8; ++i) *(u32x4*)(p.att + (size_t)(rowq0 + (lane >> 4) + 4 * i) * 1024 + hd * 128 + (lane & 15) * 8) = *(const PG8_LAS u32x4*)(kl + vs_l + 4 * AT_PITCH * i);
    }
}

constexpr int MEGA_BODY = (ATT_LDS > pg8::STAGE_BYTES ? ATT_LDS : pg8::STAGE_BYTES);
constexpr int MEGA_LDS = MEGA_BODY + 64;
#ifndef WGM_IN
#define WGM_IN 4
#endif
#ifndef WGM_UP
#define WGM_UP 8
#endif
#ifndef PROBE_GBIG
#define PROBE_GBIG 1
#endif
#ifndef PROBE_GSMALL
#define PROBE_GSMALL 1
#endif
#ifndef PROBE_S
#define PROBE_S 1
#endif
#ifndef PROBE_A
#define PROBE_A 1
#endif
#ifndef PROBE_M
#define PROBE_M 1
#endif
#ifndef PROBE_P1
#define PROBE_P1 PROBE_S
#endif
#ifndef PROBE_P3
#define PROBE_P3 PROBE_S
#endif
#ifndef PROBE_P2
#define PROBE_P2 PROBE_M
#endif
#ifndef PROBE_FFN
#define PROBE_FFN PROBE_M
#endif
#ifndef PROBE_PRO
#define PROBE_PRO PROBE_M
#endif
#ifndef PROBE_NORM
#define PROBE_NORM 0
#endif
#ifndef PROBE_BAR
#define PROBE_BAR 1
#endif
#define GRID_BARRIER() do { for (int rb_ = 0; rb_ < PROBE_BAR; ++rb_) xcd_barrier(bar); } while (0)
template <class Epi> __device__ __forceinline__ void gemm_site(LDSP lds, const bf16_t* A, const bf16_t* Bt, int N, int K, const Epi& E) {
    for (int rep_ = 0; rep_ < (N > 1024 ? PROBE_GBIG : PROBE_GSMALL); ++rep_) {
    Gemm g; g.A = A; g.Bt = Bt; g.M = M_ALL; g.N = N; g.K = K;
    StaticOrder S; S.init(M_ALL, N, nblk_opaque(), bid_opaque(), N == 8192 ? WGM_UP : WGM_IN);
    pg8::gemm_phase<Epi, StaticOrder, false>(lds, g, S, E, nullptr);
    }
}
template <bool HALO, class Epi> __device__ __forceinline__ void gemm_small(LDSP lds, const bf16_t* A, const bf16_t* Bt, int K, const Epi& E, int c_ = -1, int G_ = 0) {
    const int tid = tid_opaque(), wid = tid >> 6, lane = tid & 63, r = lane & 31, hh = lane >> 5;
    const int nb = c_ < 0 ? nblk_opaque() : G_;
    for (int t = (c_ < 0 ? bid_opaque() : c_); t < (HALO ? 512 : 256); t += nb) {
        const int m0 = HALO ? (t >> 6) * 64 : M_P + (t >> 4) * 64, n0 = HALO ? (t & 63) * 64 : (t & 15) * 64, kbeg = wid * (K >> 3), nst = K >> 7;
        const int nrow = HALO ? (n0 >> 7) * 256 + (n0 & 127) : n0;
        const bf16_t* ap = A + (size_t)(m0 + r) * K + kbeg + 8 * hh; const bf16_t* bp = Bt + (size_t)(nrow + r) * K + kbeg + 8 * hh;
        const size_t hop = (size_t)32 * K;
        f32x16 acc[2][2];
#pragma unroll
        for (int a = 0; a < 2; ++a)
#pragma unroll
            for (int b = 0; b < 2; ++b) acc[a][b] = zero16();
        if (K >= 512) {
            LDSP wa = lds + wid * 16384; LDSP wb = wa + 8192;
            const int prow = lane >> 3, pp = lane & 7;
            const bf16_t* ag = A + (size_t)(m0 + prow) * K + kbeg + pp * 8; const bf16_t* bg = Bt + (size_t)(nrow + prow) * K + kbeg + pp * 8;
            const size_t r8 = (size_t)8 * K;
            const int nch = K >> 9;
            const int wofs = prow * 128 + ((pp ^ ((prow >> 1) & 7)) * 16);
            const int sw = (r >> 1) & 7, rofs = r * 128;
            u32x4 sa[8], sb[8];
#pragma unroll
            for (int i = 0; i < 8; ++i) { sa[i] = *(const u32x4*)(ag + i * r8); sb[i] = *(const u32x4*)(bg + i * r8); }
            for (int c = 0; c < nch; ++c) {
#pragma unroll
                for (int i = 0; i < 8; ++i) { const int row = prow + 8 * i; const int off = row * 128 + ((pp ^ ((row >> 1) & 7)) * 16); *(PG8_LAS u32x4*)(wa + off) = sa[i]; *(PG8_LAS u32x4*)(wb + off) = sb[i]; }
                const int cn = c + 1 < nch ? c + 1 : c;
#pragma unroll
                for (int i = 0; i < 8; ++i) { sa[i] = *(const u32x4*)(ag + i * r8 + 64 * cn); sb[i] = *(const u32x4*)(bg + i * r8 + 64 * cn); }
#pragma unroll
                for (int ks = 0; ks < 4; ++ks) {
                    const int so = ((2 * ks + hh) ^ sw) * 16;
                    const bf16x8 a0 = *(const PG8_LAS bf16x8*)(wa + rofs + so), a1 = *(const PG8_LAS bf16x8*)(wa + rofs + 4096 + so);
                    const bf16x8 b0 = *(const PG8_LAS bf16x8*)(wb + rofs + so), b1 = *(const PG8_LAS bf16x8*)(wb + rofs + 4096 + so);
                    acc[0][0] = MFMA32(a0, b0, acc[0][0]); acc[0][1] = MFMA32(a0, b1, acc[0][1]); acc[1][0] = MFMA32(a1, b0, acc[1][0]); acc[1][1] = MFMA32(a1, b1, acc[1][1]);
                }
            }
            (void)wofs;
        } else {
        bf16x8 fa[4][2], fb[4][2];
#pragma unroll
        for (int s = 0; s < 3; ++s) { const int ko = 16 * (s < nst ? s : 0);
            fa[s][0] = *(const bf16x8*)(ap + ko); fa[s][1] = *(const bf16x8*)(ap + hop + ko); fb[s][0] = *(const bf16x8*)(bp + ko); fb[s][1] = *(const bf16x8*)(bp + hop + ko); }
        for (int st = 0; st < nst; st += 2) {
#pragma unroll
            for (int s2 = 0; s2 < 2; ++s2) {
                const int cur = (st + s2) & 3, nxs = (st + s2 + 3) & 3, nx = st + s2 + 3, ko = 16 * (nx < nst ? nx : 0);
                if (((st >> 1) & 1) == 0) {
                    fa[(s2 + 3) & 3][0] = *(const bf16x8*)(ap + ko); fa[(s2 + 3) & 3][1] = *(const bf16x8*)(ap + hop + ko); fb[(s2 + 3) & 3][0] = *(const bf16x8*)(bp + ko); fb[(s2 + 3) & 3][1] = *(const bf16x8*)(bp + hop + ko);
#pragma unroll
                    for (int a = 0; a < 2; ++a)
#pragma unroll
                        for (int b = 0; b < 2; ++b) acc[a][b] = MFMA32(fa[s2][a], fb[s2][b], acc[a][b]);
                } else {
                    fa[(s2 + 1) & 3][0] = *(const bf16x8*)(ap + ko); fa[(s2 + 1) & 3][1] = *(const bf16x8*)(ap + hop + ko); fb[(s2 + 1) & 3][0] = *(const bf16x8*)(bp + ko); fb[(s2 + 1) & 3][1] = *(const bf16x8*)(bp + hop + ko);
#pragma unroll
                    for (int a = 0; a < 2; ++a)
#pragma unroll
                        for (int b = 0; b < 2; ++b) acc[a][b] = MFMA32(fa[s2 + 2][a], fb[s2 + 2][b], acc[a][b]);
                }
                (void)cur; (void)nxs;
            }
        }
        }
        PG8_LAS float* red = (PG8_LAS float*)lds;
#pragma unroll
        for (int a = 0; a < 2; ++a)
#pragma unroll
            for (int b = 0; b < 2; ++b)
#pragma unroll
                for (int q = 0; q < 16; ++q) red[((wid * 4 + a * 2 + b) * 16 + q) * 64 + lane] = acc[a][b][q];
        __syncthreads();
        { const int blk = wid & 3, q0 = (wid >> 2) * 8, a = blk >> 1, b = blk & 1;
#pragma unroll
          for (int q = 0; q < 8; ++q) { float v = 0.f;
#pragma unroll
              for (int w = 0; w < 8; ++w) v += red[((w * 4 + blk) * 16 + q0 + q) * 64 + lane];
              const int qq = q0 + q; E.elem(m0 + 32 * a + (qq & 3) + 8 * (qq >> 2) + 4 * hh, n0 + 32 * b + r, v); } }
        __syncthreads();
    }
}
template <class Epi> __device__ __forceinline__ void gemm_site_n1024_part(LDSP lds, const bf16_t* A, const bf16_t* Bt, int K, const Epi& E, int G, int c) {
    Gemm g; g.A = A; g.Bt = Bt; g.M = M_P; g.N = 1024; g.K = K;
    StaticOrder S; S.init(M_P, 1024, G, c);
    pg8::gemm_phase<Epi, StaticOrder, false>(lds, g, S, E, nullptr);
    gemm_small<false>(lds, A, Bt, K, E, c, G);
}
template <class Epi> __device__ __forceinline__ void gemm_site_n1024_prompt(LDSP lds, const bf16_t* A, const bf16_t* Bt, int K, const Epi& E) {
    Gemm g; g.A = A; g.Bt = Bt; g.M = M_P; g.N = 1024; g.K = K;
    StaticOrder S; S.init(M_P, 1024, nblk_opaque(), bid_opaque());
    pg8::gemm_phase<Epi, StaticOrder, false>(lds, g, S, E, nullptr);
}
template <class Epi> __device__ __forceinline__ void gemm_site_n1024(LDSP lds, const bf16_t* A, const bf16_t* Bt, int K, const Epi& E) {
    for (int rep_ = 0; rep_ < PROBE_GSMALL; ++rep_) {
    Gemm g; g.A = A; g.Bt = Bt; g.M = M_P; g.N = 1024; g.K = K;
    StaticOrder S; S.init(M_P, 1024, nblk_opaque(), bid_opaque());
    pg8::gemm_phase<Epi, StaticOrder, false>(lds, g, S, E, nullptr);
    gemm_small<false>(lds, A, Bt, K, E);
    }
}
__global__ void __launch_bounds__(512, 2) k_mega(Params p_) {
    extern __shared__ __attribute__((aligned(16))) unsigned char shm[];
    LDSP lds = (LDSP)shm;
    volatile LAS unsigned* xbw = (volatile LAS unsigned*)(lds + MEGA_BODY);
    if (threadIdx.x < 4) xbw[threadIdx.x] = 0u;
    __syncthreads();
    XcdBarrier bar = xcd_barrier_post(kargs()->bar, xbw);
    for (int rep_ = 0; rep_ < PROBE_PRO; ++rep_) { { CPR p = *kargs(); ph_wt(p, lds); }
    { CPR p = *kargs(); ph_xprep(p); } }
    GRID_BARRIER();
    for (int l = 0; l < DEPTH; ++l) {
        { CPR p = *kargs(); float* out = p.out; const bf16_t* wl = p.wt + (size_t)l * WT_LAYER; EpiIn E; E.rs = p.rs; E.zb = p.zb; E.xbcb = p.xbcb; E.qb = p.qb; E.kb = p.kb; E.vb = p.vb; E.gb = p.gb; E.dtb = p.dtb; E.dt_bias = p.ssd_dt_bias + l * 32;
          E.kP = out + O_P_K + (size_t)l * M_P * 1024; E.vP = out + O_P_V + (size_t)l * M_P * 1024; E.kS = out + O_S_K + (size_t)l * M_S * 1024; E.vS = out + O_S_V + (size_t)l * M_S * 1024;
          E.convP = out + O_P_CONV + (size_t)l * 3 * 3072; E.convS = out + O_S_CONV + (size_t)l * DEC_BATCH * 3 * 3072;
          gemm_site(lds, p.xb, wl + OW1, N1, 1024, E); }
        GRID_BARRIER();
        for (int rep_ = 0; rep_ < PROBE_P1; ++rep_) { CPR p = *kargs(); ph_ssd_p1(p, l, lds); }
        for (int rep_ = 0; rep_ < PROBE_A; ++rep_) { CPR p = *kargs(); ph_attn(p, l, lds); }
        GRID_BARRIER();
        for (int rep_ = 0; rep_ < PROBE_P2; ++rep_) { CPR p = *kargs(); ph_ssd_p2(p, l); }
        { CPR p = *kargs(); float* out = p.out; const bf16_t* wl = p.wt + (size_t)l * WT_LAYER; EpiBr E; E.gb = p.gb; E.t1in = nullptr; E.dst = p.t1; E.mode = 0; E.pad = 0; gemm_site_n1024_prompt(lds, p.att, wl + OW3, 1024, E); }
        GRID_BARRIER();
        for (int rep_ = 0; rep_ < PROBE_P3; ++rep_) { CPR p = *kargs(); ph_ssd_p3(p, l, lds); }
        if (bid_opaque() >= 128) { __syncthreads(); CPR p = *kargs(); const bf16_t* wl = p.wt + (size_t)l * WT_LAYER; EpiBr E; E.gb = p.gb; E.t1in = nullptr; E.dst = p.t1; E.mode = 0; E.pad = 0; gemm_small<false>(lds, p.att, wl + OW3, 1024, E, bid_opaque() - 128, 128); }
        GRID_BARRIER();
        { CPR p = *kargs(); float* out = p.out; const bf16_t* wl = p.wt + (size_t)l * WT_LAYER; EpiBr E; E.gb = p.gb; E.t1in = p.t1; E.dst = p.mixin; E.mode = 1; E.pad = 0; gemm_site_n1024(lds, p.yn, wl + OW2, 2048, E); }
        GRID_BARRIER();
        { CPR p = *kargs(); float* out = p.out; const bf16_t* wl = p.wt + (size_t)l * WT_LAYER; EpiF32Out E; E.dst = p.mixed; gemm_site_n1024(lds, p.mixin, wl + OW4, 1024, E); }
        GRID_BARRIER();
        { CPR p = *kargs(); float* out = p.out; (void)out; ph_norm(p.mixed, p.norm_post_mix + l * 1024, p.xr, p.xb, nullptr, nullptr, p.xh); }
        GRID_BARRIER();
        { CPR p = *kargs(); const bf16_t* wl = p.wt + (size_t)l * WT_LAYER; EpiHalo E; E.rs = nullptr; E.gh = p.gh; gemm_small<true>(lds, p.xh, wl + OW5, 1024, E); }
        GRID_BARRIER();
        { CPR p = *kargs(); float* out = p.out; const bf16_t* wl = p.wt + (size_t)l * WT_LAYER; EpiUpAct E; E.rs = p.rs2; E.gh = p.gh; E.ffb = p.ffb;
          E.ffnP = out + O_P_FFN + (size_t)l * 2 * D_FF; E.ffnS = out + O_S_FFN + (size_t)l * DEC_BATCH * 2 * D_FF;
          E.cw = p.ffn_conv_w + (size_t)l * 3 * D_FF; E.cb = p.ffn_conv_b + (size_t)l * D_FF; E.hist = p.state_ffn_conv + (size_t)l * DEC_BATCH * 2 * D_FF;
          gemm_site(lds, p.xb, wl + OW5, 8192, 1024, E); }
        if (bid_opaque() >= 128) { CPR p = *kargs(); const bf16_t* wl = p.wt + (size_t)l * WT_LAYER; EpiPlain E; E.dst = p.plea; gemm_site_n1024_part(lds, p.pb + (size_t)l * M_ALL * 256, wl + OW7, 256, E, 128, bid_opaque() - 128); }
        GRID_BARRIER();
        { CPR p = *kargs(); float* out = p.out; const bf16_t* wl = p.wt + (size_t)l * WT_LAYER; EpiF32Out E; E.dst = p.down; gemm_site_n1024(lds, p.ffb, wl + OW6, 4096, E); }
        GRID_BARRIER();
        { CPR p = *kargs(); float* out = p.out; (void)out; ph_norm(p.down, p.norm_post_ffn + l * 1024, p.xr, nullptr, nullptr, nullptr); }
        GRID_BARRIER();
        { CPR p = *kargs(); float* out = p.out; const bf16_t* wl = p.wt + (size_t)l * WT_LAYER; EpiPle E; E.plea = p.plea; E.dst = p.ple; gemm_site_n1024(lds, p.xr, wl + OW8, 1024, E); }
        GRID_BARRIER();
        { CPR p = *kargs(); float* out = p.out; (void)out; ph_norm(p.ple, p.norm_ple + l * 1024, p.xr, p.xb, l == DEPTH - 1 ? out + O_Y_P : nullptr, out + O_Y_S); }
        if (l + 1 < DEPTH) GRID_BARRIER();
    }
}

struct Bump { char* base; size_t off; template <class T> T* take(size_t n) { off = (off + 255) & ~(size_t)255; T* p = (T*)(base + off); off += n * sizeof(T); return p; } };
__global__ void k_fail_code(float* out, float code) { if (threadIdx.x == 0 && blockIdx.x == 0) out[0] = code; }

extern "C" void kernel_launch(void* const* d_in, const int* in_sizes, int n_in, void* d_out, int out_size, void* d_ws, size_t ws_size, hipStream_t stream) {
    Params p; memset(&p, 0, sizeof p);
    p.x_prompt = (const float*)d_in[0]; p.x_sample = (const float*)d_in[1]; p.state_ssd_conv = (const float*)d_in[2]; p.state_ssd = (const float*)d_in[3];
    p.cache_k = (const float*)d_in[4]; p.cache_v = (const float*)d_in[5]; p.state_ffn_conv = (const float*)d_in[6]; p.p_prompt = (const float*)d_in[7]; p.p_sample = (const float*)d_in[8];
    p.norm_pre_mix = (const float*)d_in[9]; p.w_in = (const float*)d_in[10]; p.ssd_conv_w = (const float*)d_in[11]; p.ssd_conv_b = (const float*)d_in[12]; p.ssd_dt_bias = (const float*)d_in[13];
    p.ssd_a_log = (const float*)d_in[14]; p.ssd_d = (const float*)d_in[15]; p.ssd_norm = (const float*)d_in[16]; p.w_br_ssd = (const float*)d_in[17]; p.w_br_sb = (const float*)d_in[18];
    p.w_out = (const float*)d_in[19]; p.norm_post_mix = (const float*)d_in[20]; p.norm_pre_ffn = (const float*)d_in[21]; p.w_up = (const float*)d_in[22]; p.ffn_conv_w = (const float*)d_in[23];
    p.ffn_conv_b = (const float*)d_in[24]; p.w_down = (const float*)d_in[25]; p.norm_post_ffn = (const float*)d_in[26]; p.w_ple = (const float*)d_in[27]; p.w_ple_gate = (const float*)d_in[28];
    p.norm_ple = (const float*)d_in[29];
    float* out = (float*)d_out; p.out = out;

    Bump B{(char*)d_ws, 0};
    const size_t R = M_ALL;
    p.bar = B.take<unsigned>(4096);
    p.wt = B.take<bf16_t>(DEPTH * WT_LAYER);
    p.xr = B.take<bf16_t>(R * 1024); p.xb = B.take<bf16_t>(R * 1024); p.rs = B.take<float>(R); p.rs2 = B.take<float>(R); p.pb = B.take<bf16_t>(DEPTH * R * 256);
    p.zb = B.take<bf16_t>(R * 2048); p.xbcb = B.take<bf16_t>(R * 3072); p.qb = B.take<bf16_t>(R * 1024); p.kb = B.take<bf16_t>(R * 1024); p.vb = B.take<bf16_t>(R * 1024); p.gb = B.take<bf16_t>(R * 2048); p.dtb = B.take<float>(R * 32);
    p.sst = B.take<float>((size_t)NCHUNK * STATE_SZ / 2); p.dec = B.take<float>(NCHUNK * 32); p.hpb = B.take<bf16_t>((size_t)NCHUNK * STATE_SZ);
    p.yn = B.take<bf16_t>(R * 2048); p.att = B.take<bf16_t>(R * 1024); p.t1 = B.take<bf16_t>(R * 1024); p.mixin = B.take<bf16_t>(R * 1024); p.mixed = B.take<bf16_t>(R * 1024);
    p.gh = B.take<bf16_t>((size_t)768 * 4096); p.xh = B.take<bf16_t>((size_t)768 * 1024); p.ffb = B.take<bf16_t>(R * 4096); p.down = B.take<bf16_t>(R * 1024); p.plea = B.take<bf16_t>(R * 1024); p.ple = B.take<bf16_t>(R * 1024);
    if (B.off > ws_size) { k_fail_code<<<1, 64, 0, stream>>>(out, 777000.f); return; }

    (void)hipMemsetAsync(p.bar, 0, 4096 * 4, stream);
    static bool minit = false;
    if (!minit) { (void)hipFuncSetAttribute((const void*)k_mega, hipFuncAttributeMaxDynamicSharedMemorySize, MEGA_LDS); minit = true; }
    hipLaunchKernelGGL(k_mega, dim3(256), dim3(512), MEGA_LDS, stream, p);
}
```
